# Optimizing an MI355X kernel written in HIP

```python
import jax
import jax.numpy as jnp
from jax import lax
import numpy as np

D_MODEL = 2048
BATCH = 4
SEQ = 4096
DEPTH = 4

GRID_W = 64
CTX_LEN = 256

HEAD_DIM = 128
N_HEADS = 8
N_KV_HEADS = 2
Q_PER_KV = N_HEADS // N_KV_HEADS
ATTN_W = N_HEADS * HEAD_DIM
KV_W = N_KV_HEADS * HEAD_DIM
Q_BLOCK = 128
ROPE_THETA = 10000.0
ROPE_AXIS_DIM = HEAD_DIM // 2
ATTN_SCALE = HEAD_DIM ** -0.5

FOURIER_GROUPS = 4
FOURIER_W = FOURIER_GROUPS * HEAD_DIM

CONV_GROUPS = 4
CONV_W = CONV_GROUPS * HEAD_DIM
CONV_K = 3

GMLP_GROUPS = 4
GMLP_HEAD = HEAD_DIM
GMLP_W = GMLP_GROUPS * GMLP_HEAD
CHUNK = 128

MIX_W = ATTN_W + FOURIER_W + CONV_W + GMLP_W
SPLIT_SIZES = (ATTN_W, KV_W, KV_W, FOURIER_W, CONV_W, CONV_W, CONV_W, GMLP_W, GMLP_W)
IN_W = sum(SPLIT_SIZES)
SPLIT_POINTS = tuple(int(s) for s in np.cumsum(SPLIT_SIZES)[:-1])
OFF_K = ATTN_W
OFF_V = OFF_K + KV_W
OFF_F = OFF_V + KV_W

D_FF = 5632
FFN_CONV_K = 3

N_MOD = 6
EPS = 1e-6

kernel_name = "hybrid_parallel_groups_diffusion_block"


def rms_norm(x, g):
    xf = x.astype(jnp.float32)
    y = xf * lax.rsqrt(jnp.mean(xf * xf, axis=-1, keepdims=True) + EPS)
    return (y * g.astype(jnp.float32)).astype(x.dtype)


def layer_norm(x, g, b):
    xf = x.astype(jnp.float32)
    xc = xf - jnp.mean(xf, axis=-1, keepdims=True)
    y = xc * lax.rsqrt(jnp.mean(xc * xc, axis=-1, keepdims=True) + EPS)
    return (y * g.astype(jnp.float32) + b.astype(jnp.float32)).astype(x.dtype)


def modulate(h, shift, scale):
    return h * (1 + scale) + shift


def dwconv3(x, w):
    xp = jnp.pad(x, ((0, 0), (1, 1), (0, 0)))
    return xp[:, :-2] * w[0] + xp[:, 1:-1] * w[1] + xp[:, 2:] * w[2]


def axial_rope_tables(rows):
    row = jnp.repeat(jnp.arange(rows, dtype=jnp.float32), GRID_W)
    col = jnp.tile(jnp.arange(GRID_W, dtype=jnp.float32), rows)
    freqs = ROPE_THETA ** (-jnp.arange(0, ROPE_AXIS_DIM, 2, dtype=jnp.float32) / ROPE_AXIS_DIM)
    ang_r = row[:, None] * freqs[None, :]
    ang_c = col[:, None] * freqs[None, :]
    return (jnp.cos(ang_r), jnp.sin(ang_r), jnp.cos(ang_c), jnp.sin(ang_c))


def _rotate(xp, cos, sin):
    half = xp.shape[-1] // 2
    x1, x2 = xp[..., :half], xp[..., half:]
    cos = cos[None, :, None, :].astype(xp.dtype)
    sin = sin[None, :, None, :].astype(xp.dtype)
    return jnp.concatenate([x1 * cos - x2 * sin, x2 * cos + x1 * sin], axis=-1)


def rope_2d(x, tables):
    cos_r, sin_r, cos_c, sin_c = tables
    return jnp.concatenate([_rotate(x[..., :ROPE_AXIS_DIM], cos_r, sin_r),
                            _rotate(x[..., ROPE_AXIS_DIM:], cos_c, sin_c)], axis=-1)


def attn_kv(pk, pv, k_g):
    bsz, n = pk.shape[:2]
    k = rms_norm(pk.reshape(bsz, n, N_KV_HEADS, HEAD_DIM), k_g)
    v = pv.reshape(bsz, n, N_KV_HEADS, HEAD_DIM)
    return k, v


def gqa_attend(q, k, v):
    bsz, nq = q.shape[:2]
    qg = q.reshape(bsz, nq, N_KV_HEADS, Q_PER_KV, HEAD_DIM)
    s = jnp.einsum('bqhgd,bkhd->bhgqk', qg, k).astype(jnp.float32) * ATTN_SCALE
    p = jax.nn.softmax(s, axis=-1).astype(v.dtype)
    o = jnp.einsum('bhgqk,bkhd->bqhgd', p, v)
    return o.reshape(bsz, nq, ATTN_W)


def blocked_attention(q, k_all, v_all):
    bsz, n = q.shape[:2]
    nb = n // Q_BLOCK
    qb = q.reshape(bsz, nb, Q_BLOCK, N_HEADS, HEAD_DIM).swapaxes(0, 1)
    o = lax.map(lambda qq: gqa_attend(qq, k_all, v_all), qb)
    return o.swapaxes(0, 1).reshape(bsz, n, ATTN_W)


def fourier_mix(f):
    bsz, n = f.shape[:2]
    z = f.astype(jnp.float32).reshape(bsz, n, FOURIER_GROUPS, FOURIER_W // FOURIER_GROUPS)
    y = jnp.fft.fft2(z, axes=(1, 3), norm='ortho').real
    return y.reshape(bsz, n, FOURIER_W).astype(f.dtype)


def spatial_gating(pu, pv, ln_g, ln_b, ws, bs):
    u = jax.nn.gelu(pu)
    v = layer_norm(jax.nn.gelu(pv), ln_g, ln_b)
    bsz, n = v.shape[:2]
    vc = v.reshape(bsz, n // CHUNK, CHUNK, GMLP_GROUPS, GMLP_HEAD)
    s = jnp.einsum('gqp,bcpgd->bcqgd', ws, vc) + bs.T[None, None, :, :, None]
    return u * s.reshape(bsz, n, GMLP_W)


def token_mix(h, w_in, q_g, k_g, conv_w, gm_ln_g, gm_ln_b, gm_ws, gm_b, rope, ctx_kv):
    bsz, n = h.shape[:2]
    p = h @ w_in
    pq, pk, pv, pf, pcb, pcc, pch, pgu, pgv = jnp.split(p, SPLIT_POINTS, axis=-1)
    q = rms_norm(pq.reshape(bsz, n, N_HEADS, HEAD_DIM), q_g)
    k, v = attn_kv(pk, pv, k_g)
    if ctx_kv is None:
        attn = gqa_attend(q, k, v)
    else:
        q = rope_2d(q, rope)
        k = rope_2d(k, rope)
        k_all = jnp.concatenate([ctx_kv[0], k], axis=1)
        v_all = jnp.concatenate([ctx_kv[1], v], axis=1)
        attn = blocked_attention(q, k_all, v_all)
    four = fourier_mix(pf)
    conv = pcb * dwconv3(pcc * pch, conv_w)
    gm = spatial_gating(pgu, pgv, gm_ln_g, gm_ln_b, gm_ws, gm_b)
    mix = jnp.concatenate([attn, four, conv, gm], axis=-1)
    return mix, k, v


def conv_ffn(h, w_up, conv_w, conv_b, w_down):
    g, u = jnp.split(h @ w_up, 2, axis=-1)
    return (jax.nn.silu(dwconv3(g, conv_w) + conv_b) * u) @ w_down


def setup_inputs(seed: int = 0) -> dict:
    key = jax.random.key(seed)
    ks = jax.random.split(key, 24)
    f32 = jnp.float32

    def nrm(k, shape, s):
        return jax.random.normal(k, shape, f32) * s

    return {
        'x': nrm(ks[0], (BATCH, SEQ, D_MODEL), 1.0),
        'c': nrm(ks[1], (BATCH, D_MODEL), 1.0),
        'ctx': nrm(ks[2], (BATCH, CTX_LEN, D_MODEL), 1.0),
        'c_ctx': nrm(ks[3], (D_MODEL,), 1.0),
        'w_mod': nrm(ks[4], (DEPTH, D_MODEL, N_MOD * D_MODEL), 0.5 * D_MODEL ** -0.5),
        'b_mod': nrm(ks[5], (DEPTH, N_MOD * D_MODEL), 0.02),
        'norm1_g': 1.0 + nrm(ks[6], (DEPTH, D_MODEL), 0.02),
        'norm2_g': 1.0 + nrm(ks[7], (DEPTH, D_MODEL), 0.02),
        'w_in': nrm(ks[8], (DEPTH, D_MODEL, IN_W), D_MODEL ** -0.5),
        'q_norm_g': 1.0 + nrm(ks[9], (DEPTH, HEAD_DIM), 0.02),
        'k_norm_g': 1.0 + nrm(ks[10], (DEPTH, HEAD_DIM), 0.02),
        'conv_w': nrm(ks[11], (DEPTH, CONV_K, CONV_W), CONV_K ** -0.5),
        'gm_ln_g': 1.0 + nrm(ks[12], (DEPTH, GMLP_W), 0.02),
        'gm_ln_b': nrm(ks[13], (DEPTH, GMLP_W), 0.02),
        'gm_ws': nrm(ks[14], (DEPTH, GMLP_GROUPS, CHUNK, CHUNK), CHUNK ** -0.5),
        'gm_b': 1.0 + nrm(ks[15], (DEPTH, GMLP_GROUPS, CHUNK), 0.1),
        'w_out': nrm(ks[16], (DEPTH, MIX_W, D_MODEL), MIX_W ** -0.5),
        'w_up': nrm(ks[17], (DEPTH, D_MODEL, 2 * D_FF), D_MODEL ** -0.5),
        'ffn_conv_w': nrm(ks[18], (DEPTH, FFN_CONV_K, D_FF), FFN_CONV_K ** -0.5),
        'ffn_conv_b': nrm(ks[19], (DEPTH, D_FF), 0.02),
        'w_down': nrm(ks[20], (DEPTH, D_FF, D_MODEL), D_FF ** -0.5),
        'final_norm_g': 1.0 + nrm(ks[21], (D_MODEL,), 0.02),
    }


def reference(x, c, ctx, c_ctx, w_mod, b_mod, norm1_g, norm2_g, w_in, q_norm_g, k_norm_g,
              conv_w, gm_ln_g, gm_ln_b, gm_ws, gm_b, w_out, w_up, ffn_conv_w, ffn_conv_b,
              w_down, final_norm_g):
    n_lat = x.shape[1]
    rows = n_lat // GRID_W
    rope = axial_rope_tables(rows)
    silu_c = jax.nn.silu(c)
    silu_cc = jax.nn.silu(c_ctx)
    for l in range(DEPTH):
        mod_x = silu_c @ w_mod[l] + b_mod[l]
        mod_c = silu_cc @ w_mod[l] + b_mod[l]
        sh1, sc1, ga1, sh2, sc2, ga2 = jnp.split(mod_x[:, None, :], N_MOD, axis=-1)
        csh1, csc1, cga1, csh2, csc2, cga2 = jnp.split(mod_c, N_MOD, axis=-1)
        hc = modulate(rms_norm(ctx, norm1_g[l]), csh1, csc1)
        hx = modulate(rms_norm(x, norm1_g[l]), sh1, sc1)
        mixer_w = (w_in[l], q_norm_g[l], k_norm_g[l], conv_w[l],
                   gm_ln_g[l], gm_ln_b[l], gm_ws[l], gm_b[l])
        if l < DEPTH - 1:
            mix_c, k_c, v_c = token_mix(hc, *mixer_w, None, None)
            ctx_next = ctx + cga1 * (mix_c @ w_out[l])
            hc2 = modulate(rms_norm(ctx_next, norm2_g[l]), csh2, csc2)
            ctx_next = ctx_next + cga2 * conv_ffn(hc2, w_up[l], ffn_conv_w[l], ffn_conv_b[l], w_down[l])
        else:
            k_c, v_c = attn_kv(hc @ w_in[l][:, OFF_K:OFF_V], hc @ w_in[l][:, OFF_V:OFF_F], k_norm_g[l])
            ctx_next = ctx
        mix_x, _, _ = token_mix(hx, *mixer_w, rope, (k_c, v_c))
        x = x + ga1 * (mix_x @ w_out[l])
        hx2 = modulate(rms_norm(x, norm2_g[l]), sh2, sc2)
        x = x + ga2 * conv_ffn(hx2, w_up[l], ffn_conv_w[l], ffn_conv_b[l], w_down[l])
        ctx = ctx_next
    return rms_norm(x, final_norm_g)
```

```cpp
#include <hip/hip_runtime.h>
#include <cstdio>
#include <cstdint>

#ifndef DUPMASK
#define DUPMASK 0
#endif
#define DUP(k) ((DUPMASK >> (k)) & 1)
#ifndef MK_PER_PHASE
#define MK_PER_PHASE 0
#endif

namespace pg8 {
#define PG8_LAS __attribute__((address_space(3)))
typedef unsigned short bf16_t;
typedef short bf16x8 __attribute__((ext_vector_type(8)));
typedef float f32x4 __attribute__((ext_vector_type(4)));
typedef unsigned u32x4 __attribute__((ext_vector_type(4)));
constexpr int BM = 256, BK = 64, HALF = 128, HTB = HALF * BK * 2, STAGE_BYTES = 8 * HTB, NXCD = 8, WGM = 4;

__host__ __device__ __forceinline__ int lds_byte(int r, int c) { const int st = (r >> 4) * 2 + (c >> 5), rr = r & 15, cc = c & 31, ob = rr * 64 + cc * 2; return st * 1024 + (ob ^ (((ob >> 9) & 1) << 5)); }
__host__ __device__ __forceinline__ void stage_rc(int b, int& R, int& C) { const int st = b / 1024, sb = b % 1024, swz = sb ^ (((sb >> 9) & 1) << 5); R = (st >> 1) * 16 + swz / 64; C = (st & 1) * 32 + (swz % 64) / 2; }
__host__ __device__ __forceinline__ int perm32(int rho) { const int n = rho >> 4, i = rho & 15; return 8 * (i >> 2) + 4 * n + (i & 3); }

struct Unit { int pm, pn, kt0, nkt, split; };
struct Gemm { const bf16_t* A; const bf16_t* Bt; int M, N, K, lda, ldb; size_t bpm; int tiledA, tiledB; };

struct StaticOrder {
    int nM, nN, nwg, G, c, ntk;
    __host__ __device__ void init(int M, int N, int G_, int c_, int K) { nM = M / BM; nN = N / BM; nwg = nM * nN; G = G_; c = c_; ntk = K / BK; }
    __host__ __device__ bool next(int i, Unit& u) const {
        const long L = (long)i * G + c; if (L >= nwg) return false;
        return tile((int)L, u);
    }
    __host__ __device__ bool tile(int wgid, Unit& u) const {
        u.kt0 = 0; u.nkt = ntk; u.split = 0; { const int q = nwg / NXCD, r = nwg % NXCD, xcd = wgid % NXCD, off = wgid / NXCD; wgid = (xcd < r ? xcd * (q + 1) : r * (q + 1) + (xcd - r) * q) + off; }
        const int nig = WGM * nN, gid = wgid / nig, fm = gid * WGM, gsz = (nM - fm) < WGM ? (nM - fm) : WGM;
        u.pm = fm + ((wgid % nig) % gsz); u.pn = (wgid % nig) / gsz; return true;
    }
    __device__ __forceinline__ void a_ready(const Unit&) const {}
    __device__ __forceinline__ void done(const Unit&) const {}
};
struct SplitOrder {
    StaticOrder so; int xp, nsplit;
    __host__ __device__ void init(int Mfull, int xpanels, int N, int G_, int c_, int K) { so.init(Mfull, N, G_, c_, K); xp = xpanels; nsplit = xpanels * so.nN * 4; }
    __host__ __device__ bool next(int i, Unit& u) const {
        const int L = i * so.G + so.c; const bool full = L < so.nwg;
        Unit f; so.tile(full ? L : 0, f);
        const int q = L - so.nwg, ks = q & 3, t = q >> 2, qn = so.ntk / 4;
        u.pm = full ? f.pm : so.nM + t / so.nN; u.pn = full ? f.pn : t % so.nN; u.nkt = full ? f.nkt : qn; u.kt0 = full ? 0 : ks * qn; u.split = full ? 0 : 1;
        return full || q < nsplit;
    }
    __device__ __forceinline__ void a_ready(const Unit&) const {}
    __device__ __forceinline__ void done(const Unit&) const {}
};

__device__ __forceinline__ unsigned cvt_pk_bf16(float lo, float hi) { unsigned r; asm volatile("v_cvt_pk_bf16_f32 %0, %1, %2" : "=v"(r) : "v"(lo), "v"(hi)); return r; }

struct EpiNone {
    static constexpr bool PERM = true, AFTER_DRAIN = false;
    __device__ __forceinline__ void operator()(const f32x4 (&acc)[2][2][4][2], const Unit& u, int wr, int wc, int fr, int fq) const {
#pragma unroll
        for (int ai = 0; ai < 2; ++ai)
#pragma unroll
            for (int bj = 0; bj < 2; ++bj)
#pragma unroll
                for (int m = 0; m < 4; ++m)
#pragma unroll
                    for (int n = 0; n < 2; ++n) asm volatile("" :: "v"(acc[ai][bj][m][n]));
    }
};
struct EpiBf16 {
    static constexpr bool PERM = true, AFTER_DRAIN = false;
    bf16_t* O; int ldc;
    __device__ __forceinline__ void operator()(const f32x4 (&acc)[2][2][4][2], const Unit& u, int wr, int wc, int fr, int fq) const {
        const int row0 = u.pm * BM + wr * 64 + fr; const int col0 = u.pn * BM + wc * 32 + 8 * fq;
#pragma unroll
        for (int ai = 0; ai < 2; ++ai)
#pragma unroll
            for (int m = 0; m < 4; ++m) { bf16_t* rowp = O + (size_t)(row0 + ai * HALF + m * 16) * ldc + col0;
#pragma unroll
                for (int bj = 0; bj < 2; ++bj) { const f32x4 v0 = acc[ai][bj][m][0], v1 = acc[ai][bj][m][1];
                    u32x4 w; w.x = cvt_pk_bf16(v0[0], v0[1]); w.y = cvt_pk_bf16(v0[2], v0[3]); w.z = cvt_pk_bf16(v1[0], v1[1]); w.w = cvt_pk_bf16(v1[2], v1[3]);
                    *(u32x4*)(rowp + bj * HALF) = w; } }
    }
};
struct EpiDft {
    static constexpr bool PERM = true, AFTER_DRAIN = false;
    bf16_t* MIX; int rowbase, nper; float scale;
    __device__ __forceinline__ void operator()(const f32x4 (&acc)[2][2][4][2], const Unit& u, int wr, int wc, int fr, int fq) const {
        const int k0 = u.pm * BM + wr * 64 + fr; const int n0 = u.pn * BM + wc * 32 + 8 * fq;
#pragma unroll
        for (int ai = 0; ai < 2; ++ai)
#pragma unroll
            for (int m = 0; m < 4; ++m) { const int k = k0 + ai * HALF + m * 16;
#pragma unroll
                for (int bj = 0; bj < 2; ++bj) { const int n = n0 + bj * HALF; const int b = n >> 9, gd = n & 511;
                    const f32x4 v0 = acc[ai][bj][m][0] * scale, v1 = acc[ai][bj][m][1] * scale;
                    u32x4 w; w.x = cvt_pk_bf16(v0[0], v0[1]); w.y = cvt_pk_bf16(v0[2], v0[3]); w.z = cvt_pk_bf16(v1[0], v1[1]); w.w = cvt_pk_bf16(v1[2], v1[3]);
                    *(u32x4*)(MIX + (size_t)(rowbase + b * nper + k) * 2560 + 1024 + gd) = w; } }
    }
};

struct EpiS1 {
    static constexpr bool PERM = true, AFTER_DRAIN = false;
    bf16_t* S2;
    __device__ __forceinline__ void operator()(const f32x4 (&acc)[2][2][4][2], const Unit& u, int wr, int wc, int fr, int fq) const {
        const int m0 = wr * 64 + fr; const int n0 = u.pn * BM + wc * 32 + 8 * fq;
#pragma unroll
        for (int ai = 0; ai < 2; ++ai)
#pragma unroll
            for (int mm = 0; mm < 4; ++mm) { const int m = m0 + mm * 16; const int k2 = m >> 1, ro = m & 1;
#pragma unroll
                for (int bj = 0; bj < 2; ++bj) { const int np = n0 + bj * HALF; const int n = np >> 5, c = ai * 32 + (np & 31);
                    const f32x4 v0 = acc[ai][bj][mm][0], v1 = acc[ai][bj][mm][1];
                    u32x4 w; w.x = cvt_pk_bf16(v0[0], v0[1]); w.y = cvt_pk_bf16(v0[2], v0[3]); w.z = cvt_pk_bf16(v1[0], v1[1]); w.w = cvt_pk_bf16(v1[2], v1[3]);
                    *(u32x4*)(S2 + ((((size_t)(k2 >> 2) * 2048 + n) * 4 + (k2 & 3)) * 2 + ro) * 64 + c) = w; } }
    }
};
struct EpiS2 {
    static constexpr bool PERM = true, AFTER_DRAIN = false;
    bf16_t* MIX; float scale;
    __device__ __forceinline__ void operator()(const f32x4 (&acc)[2][2][4][2], const Unit& u, int wr, int wc, int fr, int fq) const {
        const int m0 = wr * 64 + fr; const int n0 = u.pn * BM + wc * 32 + 8 * fq;
#pragma unroll
        for (int ai = 0; ai < 2; ++ai)
#pragma unroll
            for (int mm = 0; mm < 4; ++mm) { const int m = ai * HALF + m0 + mm * 16; const int k = 4 * u.pm + (m >> 6) + 64 * (m & 63);
#pragma unroll
                for (int bj = 0; bj < 2; ++bj) { const int n = n0 + bj * HALF; const int b = n >> 9, gd = n & 511;
                    const f32x4 v0 = acc[ai][bj][mm][0] * scale, v1 = acc[ai][bj][mm][1] * scale;
                    u32x4 w; w.x = cvt_pk_bf16(v0[0], v0[1]); w.y = cvt_pk_bf16(v0[2], v0[3]); w.z = cvt_pk_bf16(v1[0], v1[1]); w.w = cvt_pk_bf16(v1[2], v1[3]);
                    *(u32x4*)(MIX + (size_t)(b * 4096 + k) * 2560 + 1024 + gd) = w; } }
    }
};
struct EpiResGate {
    static constexpr bool PERM = false, AFTER_DRAIN = false;
    bf16_t* X; const float* modl; int goff; float* XP; const float* basef;
    __device__ __forceinline__ void operator()(const f32x4 (&acc)[2][2][4][2], const Unit& u, int wr, int wc, int fr, int fq) const {
        typedef unsigned u32x2_ __attribute__((ext_vector_type(2)));
        const int row0 = u.pm * BM + wr * 64 + fr, col0 = u.pn * BM + wc * 32 + 4 * fq;
        const int v = u.pm < 64 ? (u.pm >> 4) : 4;
        const float* gate = modl + (size_t)v * 12288 + goff;
        f32x4 gv[2][2];
#pragma unroll
        for (int bj = 0; bj < 2; ++bj)
#pragma unroll
            for (int n = 0; n < 2; ++n) gv[bj][n] = *(const f32x4*)(gate + col0 + bj * HALF + n * 16);
#pragma unroll
        for (int ai = 0; ai < 2; ++ai)
#pragma unroll
            for (int m = 0; m < 4; ++m) { const size_t ro = (size_t)(row0 + ai * HALF + m * 16) * 2048 + col0;
#pragma unroll
                for (int bj = 0; bj < 2; ++bj)
#pragma unroll
                    for (int n = 0; n < 2; ++n) { const size_t o = ro + bj * HALF + n * 16; const f32x4 d = gv[bj][n] * acc[ai][bj][m][n];
                        if (u.split) *(f32x4*)(XP + ((size_t)(u.kt0 / u.nkt) * 1024 + (row0 + ai * HALF + m * 16 - 16384)) * 2048 + col0 + bj * HALF + n * 16) = d;
                        else { f32x4 b;
                            if (basef) b = *(const f32x4*)(basef + o);
                            else { const u32x2_ w = *(const u32x2_*)(X + o); b = (f32x4){__uint_as_float(w.x << 16), __uint_as_float(w.x & 0xffff0000u), __uint_as_float(w.y << 16), __uint_as_float(w.y & 0xffff0000u)}; }
                            const f32x4 xn = b + d; u32x2_ wo; wo.x = cvt_pk_bf16(xn[0], xn[1]); wo.y = cvt_pk_bf16(xn[2], xn[3]); *(u32x2_*)(X + o) = wo; } } }
    }
};


__device__ __forceinline__ float dpp_ror1(float x)  { return __builtin_bit_cast(float, __builtin_amdgcn_update_dpp(0, __builtin_bit_cast(int, x), 0x121, 0xF, 0xF, false)); }
__device__ __forceinline__ float dpp_ror15(float x) { return __builtin_bit_cast(float, __builtin_amdgcn_update_dpp(0, __builtin_bit_cast(int, x), 0x12F, 0xF, 0xF, false)); }
__device__ __forceinline__ f32x4 ror1v(const f32x4 v)  { return (f32x4){dpp_ror1(v[0]), dpp_ror1(v[1]), dpp_ror1(v[2]), dpp_ror1(v[3])}; }
__device__ __forceinline__ f32x4 ror15v(const f32x4 v) { return (f32x4){dpp_ror15(v[0]), dpp_ror15(v[1]), dpp_ror15(v[2]), dpp_ror15(v[3])}; }
struct EpiUp {
    static constexpr bool PERM = true, AFTER_DRAIN = false;
    bf16_t* ACT; float* EDGE; const float* cw; const float* cb; PG8_LAS float* xl; int dff;
    __device__ __forceinline__ void operator()(const f32x4 (&acc)[2][2][4][2], const Unit& u, int wr, int wc, int fr, int fq) const {
        const int ch0 = u.pn * 128 + wc * 32 + 8 * fq;
        f32x4 w0[2], w1[2], w2[2], bb[2];
#pragma unroll
        for (int n = 0; n < 2; ++n) { w0[n] = *(const f32x4*)(cw + ch0 + 4 * n); w1[n] = *(const f32x4*)(cw + dff + ch0 + 4 * n); w2[n] = *(const f32x4*)(cw + 2 * dff + ch0 + 4 * n); bb[n] = *(const f32x4*)(cb + ch0 + 4 * n); }
#pragma unroll
        for (int ai = 0; ai < 2; ++ai)
#pragma unroll
            for (int n = 0; n < 2; ++n) {
                if (fr == 0)  *(PG8_LAS f32x4*)(xl + ((((wr * 4 + wc) * 2 + ai) * 2 + 0) * 32) + 8 * fq + 4 * n) = acc[ai][0][0][n];
                if (fr == 15) *(PG8_LAS f32x4*)(xl + ((((wr * 4 + wc) * 2 + ai) * 2 + 1) * 32) + 8 * fq + 4 * n) = acc[ai][0][3][n];
            }
        { float* eg = EDGE + (size_t)u.pm * 6 * dff + ch0;
          if (wr == 0 && fr < 2) {
#pragma unroll
              for (int n = 0; n < 2; ++n) { *(f32x4*)(eg + (size_t)fr * dff + 4 * n) = acc[0][0][0][n]; if (fr == 0) *(f32x4*)(eg + (size_t)4 * dff + 4 * n) = acc[0][1][0][n]; } }
          if (wr == 1 && fr >= 14) {
#pragma unroll
              for (int n = 0; n < 2; ++n) { *(f32x4*)(eg + (size_t)(fr - 12) * dff + 4 * n) = acc[1][0][3][n]; if (fr == 15) *(f32x4*)(eg + (size_t)5 * dff + 4 * n) = acc[1][1][3][n]; } }
        }
        asm volatile("s_waitcnt lgkmcnt(0)" ::: "memory"); __builtin_amdgcn_s_barrier(); asm volatile("" ::: "memory");
        f32x4 pe[2][2], ne[2][2];
#pragma unroll
        for (int ai = 0; ai < 2; ++ai)
#pragma unroll
            for (int n = 0; n < 2; ++n) {
                const bool hp = (wr == 1) || (ai == 1), hn = (wr == 0) || (ai == 0);
                const int pai = (wr == 1) ? ai : ai - 1, nai = (wr == 0) ? ai : ai + 1;
                pe[ai][n] = hp ? *(const PG8_LAS f32x4*)(xl + (((((wr ^ 1) * 4 + wc) * 2 + pai) * 2 + 1) * 32) + 8 * fq + 4 * n) : (f32x4){0.f, 0.f, 0.f, 0.f};
                ne[ai][n] = hn ? *(const PG8_LAS f32x4*)(xl + (((((wr ^ 1) * 4 + wc) * 2 + nai) * 2 + 0) * 32) + 8 * fq + 4 * n) : (f32x4){0.f, 0.f, 0.f, 0.f};
            }
        const int row0 = u.pm * BM + wr * 64 + fr;
#pragma unroll
        for (int ai = 0; ai < 2; ++ai)
#pragma unroll
            for (int m = 0; m < 4; ++m) {
                f32x4 o[2];
#pragma unroll
                for (int n = 0; n < 2; ++n) {
                    const f32x4 g = acc[ai][0][m][n], uu = acc[ai][1][m][n];
                    const f32x4 P = ror1v(g), N = ror15v(g);
                    const f32x4 Pm = (m > 0) ? ror1v(acc[ai][0][m > 0 ? m - 1 : 0][n]) : pe[ai][n];
                    const f32x4 Np = (m < 3) ? ror15v(acc[ai][0][m < 3 ? m + 1 : 3][n]) : ne[ai][n];
                    const f32x4 prev = (fr > 0) ? P : Pm, next = (fr < 15) ? N : Np;
                    const f32x4 z = w0[n] * prev + w1[n] * g + w2[n] * next + bb[n];
#pragma unroll
                    for (int j = 0; j < 4; ++j) o[n][j] = z[j] * __builtin_amdgcn_rcpf(1.f + __expf(-z[j])) * uu[j];
                }
                u32x4 w; w.x = cvt_pk_bf16(o[0][0], o[0][1]); w.y = cvt_pk_bf16(o[0][2], o[0][3]); w.z = cvt_pk_bf16(o[1][0], o[1][1]); w.w = cvt_pk_bf16(o[1][2], o[1][3]);
                *(u32x4*)(ACT + (size_t)(row0 + ai * HALF + m * 16) * dff + ch0) = w;
            }
    }
};

template <class Epi, class Sched, bool ALIGN_EPI = false, bool SP2 = false>
__device__ __forceinline__ void gemm_phase(PG8_LAS unsigned char* lds, const Gemm g, const Sched& S, const Epi& E) {
    int tid_ = threadIdx.x; asm volatile("" : "+v"(tid_));
    const int tid = tid_, wid = __builtin_amdgcn_readfirstlane(tid >> 6), lane = tid & 63, wr = wid >> 2, wc = wid & 3, fr = lane & 15, fq = lane >> 4;
    unsigned voffA[2], voffB[2];
#pragma unroll
    for (int i = 0; i < 2; ++i) { int R, C; stage_rc(tid * 16 + i * 8192, R, C); const int Rb = Epi::PERM ? ((R & ~31) + perm32(R & 31)) : R;
        voffA[i] = (unsigned)(R * (g.tiledA ? BK : g.lda) + C) * 2u; voffB[i] = (unsigned)(Rb * (g.tiledB ? BK : g.ldb) + C) * 2u; }
    const size_t kstepA = g.tiledA ? (size_t)BM * BK * 2 : (size_t)(BK * 2), kstepB = g.tiledB ? (size_t)BM * BK * 2 : (size_t)(BK * 2);
    const size_t hstepA = (size_t)HALF * (g.tiledA ? BK : g.lda) * 2, hstepB = (size_t)HALF * (g.tiledB ? BK : g.ldb) * 2;
    const size_t tstepA = g.tiledA ? (size_t)(g.K / BK) * BM * BK * 2 : 2 * hstepA, tstepB = g.tiledB ? (size_t)(g.K / BK) * BM * BK * 2 : 2 * hstepB;
    const unsigned ldsw = (unsigned)wid * 1024u;
    const int aoff = lds_byte(wr * 64 + fr, fq * 8), boff = lds_byte(wc * 32 + fr, fq * 8);
#define PG8_SA(b, h) (((b) * 2 + (h)) * HTB)
#define PG8_SB(b, h) ((4 + (b) * 2 + (h)) * HTB)
#define PG8_STAGE(bufoff, gbase, voff) do { _Pragma("unroll") for (int _i = 0; _i < 2; ++_i) \
        __builtin_amdgcn_global_load_lds((const unsigned*)((const char*)(gbase) + (voff)[_i]), (PG8_LAS unsigned*)(lds + (bufoff) + ldsw + _i * 8192), 16, 0, 0); } while (0)
#define PG8_LDA(dst, b, h) do { _Pragma("unroll") for (int m = 0; m < 4; ++m) _Pragma("unroll") for (int k = 0; k < 2; ++k) dst[m][k] = *(const PG8_LAS bf16x8*)(lds + PG8_SA(b, h) + aoff + m * 2048 + k * 1024); } while (0)
#define PG8_LDB(dst, b, h) do { _Pragma("unroll") for (int n = 0; n < 2; ++n) _Pragma("unroll") for (int k = 0; k < 2; ++k) dst[n][k] = *(const PG8_LAS bf16x8*)(lds + PG8_SB(b, h) + boff + n * 2048 + k * 1024); } while (0)
#define PG8_MMA(ai, bj, At, Bt) do { __builtin_amdgcn_s_setprio(1); _Pragma("unroll") for (int m = 0; m < 4; ++m) _Pragma("unroll") for (int n = 0; n < 2; ++n) _Pragma("unroll") for (int k = 0; k < 2; ++k) \
        acc[ai][bj][m][n] = __builtin_amdgcn_mfma_f32_16x16x32_bf16(Bt[n][k], At[m][k], acc[ai][bj][m][n], 0, 0, 0); __builtin_amdgcn_s_setprio(0); } while (0)
#define PG8_WAIT_V(n) asm volatile("s_waitcnt vmcnt(" #n ")" ::: "memory")
#define PG8_WAIT_L(n) asm volatile("s_waitcnt lgkmcnt(" #n ")" ::: "memory")
#define PG8_BAR __builtin_amdgcn_s_barrier()
#define PG8_SCHED __builtin_amdgcn_sched_barrier(0)
    Unit cur, nxt; int ui = 0;
    if (!S.next(0, cur)) return;
    f32x4 acc[2][2][4][2];
#pragma unroll
    for (int a = 0; a < 2; ++a)
#pragma unroll
        for (int b = 0; b < 2; ++b)
#pragma unroll
            for (int m = 0; m < 4; ++m)
#pragma unroll
                for (int n = 0; n < 2; ++n) acc[a][b][m][n] = (f32x4){0.f, 0.f, 0.f, 0.f};
    bf16x8 At[4][2], B0[2][2], B1[2][2];
    const char* cA = (const char*)g.A + (size_t)cur.pm * tstepA + (size_t)cur.kt0 * kstepA; const char* cB = (const char*)g.Bt + (size_t)cur.pm * g.bpm + (size_t)cur.pn * tstepB + (size_t)cur.kt0 * kstepB;
    int nt = cur.nkt;
    S.a_ready(cur);
    if constexpr (SP2) {
        PG8_STAGE(PG8_SB(0, 0), cB, voffB); PG8_STAGE(PG8_SB(0, 1), cB + hstepB, voffB); PG8_STAGE(PG8_SA(0, 0), cA, voffA); PG8_STAGE(PG8_SA(0, 1), cA + hstepA, voffA);
        if (wr == 1) PG8_BAR;
        PG8_WAIT_V(2); PG8_BAR;
        PG8_STAGE(PG8_SB(1, 0), cB + kstepB, voffB); PG8_STAGE(PG8_SA(1, 0), cA + kstepA, voffA); PG8_STAGE(PG8_SB(1, 1), cB + hstepB + kstepB, voffB);
        PG8_WAIT_V(6); PG8_BAR;
    } else {
        PG8_STAGE(PG8_SB(0, 0), cB, voffB); PG8_STAGE(PG8_SA(0, 0), cA, voffA); PG8_STAGE(PG8_SB(0, 1), cB + hstepB, voffB); PG8_STAGE(PG8_SA(0, 1), cA + hstepA, voffA);
        if (wr == 1) PG8_BAR;
        PG8_WAIT_V(4); PG8_BAR;
        PG8_STAGE(PG8_SB(1, 0), cB + kstepB, voffB); PG8_STAGE(PG8_SA(1, 0), cA + kstepA, voffA); PG8_STAGE(PG8_SB(1, 1), cB + hstepB + kstepB, voffB);
        PG8_WAIT_V(6); PG8_BAR;
    }
    for (;;) {
        const bool has_next = S.next(ui + 1, nxt);
        const char* nA = has_next ? (const char*)g.A + (size_t)nxt.pm * tstepA + (size_t)nxt.kt0 * kstepA : cA; const char* nB = has_next ? (const char*)g.Bt + (size_t)nxt.pm * g.bpm + (size_t)nxt.pn * tstepB + (size_t)nxt.kt0 * kstepB : cB;
        for (int t = 0; t < nt; t += 2) {
            const bool last = (t == nt - 2);
            const char* a1 = cA + (size_t)(t + 1) * kstepA;
            const char* a2 = last ? nA : cA + (size_t)(t + 2) * kstepA; const char* b2 = last ? nB : cB + (size_t)(t + 2) * kstepB;
            const char* a3 = a2 + kstepA; const char* b3 = b2 + kstepB;
            if (last && has_next) S.a_ready(nxt);
            if constexpr (SP2) {
            PG8_LDB(B0, 0, 0); PG8_LDB(B1, 0, 1); PG8_SCHED; PG8_LDA(At, 0, 0); PG8_STAGE(PG8_SA(1, 1), a1 + hstepA, voffA);
            PG8_WAIT_V(8); PG8_WAIT_L(0); PG8_BAR; PG8_MMA(0, 0, At, B0); PG8_MMA(0, 1, At, B1); PG8_BAR; PG8_SCHED;
            PG8_LDA(At, 0, 1); PG8_STAGE(PG8_SB(0, 0), b2, voffB); PG8_STAGE(PG8_SB(0, 1), b2 + hstepB, voffB); PG8_STAGE(PG8_SA(0, 0), a2, voffA);
            PG8_WAIT_V(8); PG8_WAIT_L(0); PG8_BAR; PG8_MMA(1, 0, At, B0); PG8_MMA(1, 1, At, B1); PG8_BAR; PG8_SCHED;
            PG8_LDB(B0, 1, 0); PG8_LDB(B1, 1, 1); PG8_SCHED; PG8_LDA(At, 1, 0); PG8_STAGE(PG8_SA(0, 1), a2 + hstepA, voffA);
            PG8_WAIT_V(8); PG8_WAIT_L(0); PG8_BAR; PG8_MMA(0, 0, At, B0); PG8_MMA(0, 1, At, B1); PG8_BAR; PG8_SCHED;
            PG8_LDA(At, 1, 1); PG8_STAGE(PG8_SB(1, 0), b3, voffB); PG8_STAGE(PG8_SB(1, 1), b3 + hstepB, voffB); PG8_STAGE(PG8_SA(1, 0), a3, voffA);
            PG8_WAIT_V(8); PG8_WAIT_L(0); PG8_BAR; PG8_MMA(1, 0, At, B0); PG8_MMA(1, 1, At, B1); PG8_BAR; PG8_SCHED;
            } else {
            PG8_LDB(B0, 0, 0); PG8_SCHED; PG8_LDA(At, 0, 0); PG8_STAGE(PG8_SA(1, 1), a1 + hstepA, voffA);
            PG8_WAIT_L(8); PG8_BAR; PG8_WAIT_L(0); PG8_MMA(0, 0, At, B0); PG8_BAR; PG8_SCHED;
            PG8_LDB(B1, 0, 1); PG8_STAGE(PG8_SB(0, 0), b2, voffB);
            PG8_BAR; PG8_WAIT_L(0); PG8_MMA(0, 1, At, B1); PG8_BAR;
            PG8_LDA(At, 0, 1); PG8_STAGE(PG8_SA(0, 0), a2, voffA);
            PG8_BAR; PG8_WAIT_L(0); PG8_MMA(1, 0, At, B0); PG8_BAR; PG8_SCHED;
            PG8_STAGE(PG8_SB(0, 1), b2 + hstepB, voffB);
            PG8_WAIT_V(6); PG8_BAR; PG8_MMA(1, 1, At, B1); PG8_BAR;
            PG8_LDB(B0, 1, 0); PG8_SCHED; PG8_LDA(At, 1, 0); PG8_STAGE(PG8_SA(0, 1), a2 + hstepA, voffA);
            PG8_WAIT_L(8); PG8_BAR; PG8_WAIT_L(0); PG8_MMA(0, 0, At, B0); PG8_BAR; PG8_SCHED;
            PG8_LDB(B1, 1, 1); PG8_STAGE(PG8_SB(1, 0), b3, voffB);
            PG8_BAR; PG8_WAIT_L(0); PG8_MMA(0, 1, At, B1); PG8_BAR;
            PG8_LDA(At, 1, 1); PG8_STAGE(PG8_SA(1, 0), a3, voffA);
            PG8_BAR; PG8_WAIT_L(0); PG8_MMA(1, 0, At, B0); PG8_BAR; PG8_SCHED;
            PG8_STAGE(PG8_SB(1, 1), b3 + hstepB, voffB);
            PG8_WAIT_V(6); PG8_BAR; PG8_MMA(1, 1, At, B1); PG8_BAR;
            }
        }
        if constexpr (ALIGN_EPI) { if (wr == 0) PG8_BAR; }
        if constexpr (!Epi::AFTER_DRAIN) { E(acc, cur, wr, wc, fr, fq); S.done(cur); }
        if (!has_next) break;
#pragma unroll
        for (int a = 0; a < 2; ++a)
#pragma unroll
            for (int b = 0; b < 2; ++b)
#pragma unroll
                for (int m = 0; m < 4; ++m)
#pragma unroll
                    for (int n = 0; n < 2; ++n) acc[a][b][m][n] = (f32x4){0.f, 0.f, 0.f, 0.f};
        cur = nxt; cA = nA; cB = nB; nt = cur.nkt; ++ui;
        if constexpr (ALIGN_EPI) { if (wr == 1) PG8_BAR; }
    }
    PG8_WAIT_V(0);
    if constexpr (!ALIGN_EPI) { if (wr == 0) PG8_BAR; }
    PG8_BAR;
#undef PG8_SA
#undef PG8_SB
#undef PG8_STAGE
#undef PG8_LDA
#undef PG8_LDB
#undef PG8_MMA
#undef PG8_WAIT_V
#undef PG8_WAIT_L
#undef PG8_BAR
#undef PG8_SCHED
}
}

namespace att {
typedef unsigned short bf16;
constexpr int   D = 128, NW = 8, QBLK = 32, KVBLK = 64;
constexpr float SCALE = 0.088388347648318440f;
constexpr float THR = 8.f;
constexpr int LDQ = 1024, LDK = 256, LDO = 2560;
constexpr size_t SHM_V = KVBLK * D * 2, SHM_K = KVBLK * D * 2, SHM_ATTN = 2 * SHM_V + 2 * SHM_K + NW * 64 * 4;
using bf16x8 = __attribute__((ext_vector_type(8))) short;
using s16x4  = __attribute__((ext_vector_type(4))) short;
using f32x16 = __attribute__((ext_vector_type(16))) float;
using u32x4  = __attribute__((ext_vector_type(4))) unsigned;
#define KSWZ(row, colB) ((row) * 256 + ((colB) ^ (((row) & 7) << 4)))
#define SBAR() __builtin_amdgcn_sched_barrier(0)
__device__ __forceinline__ int crow(int r, int hi) { return (r & 3) + 8 * (r >> 2) + 4 * hi; }
__device__ __forceinline__ unsigned cvtpk(float lo, float hi) { unsigned r; asm volatile("v_cvt_pk_bf16_f32 %0, %1, %2" : "=v"(r) : "v"(lo), "v"(hi)); return r; }
__device__ __forceinline__ bf16x8 ld8(const bf16* p) { return *reinterpret_cast<const bf16x8*>(p); }

__device__ __forceinline__ void partialSM(f32x16& p0, f32x16& p1, float& m_reg, float& mn, float& alpha) {
  constexpr float C = SCALE * 1.4426950408889634f;
  float pmax = p0[0]; for (int r = 1; r < 16; ++r) pmax = fmaxf(pmax, p0[r]); for (int r = 0; r < 16; ++r) pmax = fmaxf(pmax, p1[r]);
  { auto rr = __builtin_amdgcn_permlane32_swap(__float_as_uint(pmax), __float_as_uint(pmax), false, false);
    pmax = fmaxf(__uint_as_float(rr[0]), __uint_as_float(rr[1])); }
  if (__builtin_expect(__all(pmax - m_reg <= THR / SCALE), 1)) { mn = m_reg; alpha = 1.f; }
  else { mn = fmaxf(m_reg, pmax); alpha = __builtin_amdgcn_exp2f((m_reg - mn) * C); m_reg = mn; }
  float mnC = -mn * C;
  for (int r = 0; r < 16; ++r) p0[r] = fmaf(p0[r], C, mnC); for (int r = 0; r < 16; ++r) p1[r] = fmaf(p1[r], C, mnC);
  for (int r = 0; r < 16; ++r) p0[r] = __builtin_amdgcn_exp2f(p0[r]);
}
__device__ __forceinline__ void finishSM(f32x16& p0, f32x16& p1, float alpha, float& l_reg, bf16x8& pa0, bf16x8& pa1, bf16x8& pa2, bf16x8& pa3) {
  for (int r = 0; r < 16; ++r) p1[r] = __builtin_amdgcn_exp2f(p1[r]);
  float ps = 0; for (int r = 0; r < 16; ++r) ps += p0[r]; for (int r = 0; r < 16; ++r) ps += p1[r];
  { auto rr = __builtin_amdgcn_permlane32_swap(__float_as_uint(ps), __float_as_uint(ps), false, false);
    ps = __uint_as_float(rr[0]) + __uint_as_float(rr[1]); }
  l_reg = l_reg * alpha + ps;
#define PK4(P, BASE, OUT) do { unsigned a0 = cvtpk(P[BASE + 0], P[BASE + 1]), a1 = cvtpk(P[BASE + 2], P[BASE + 3]);   \
    unsigned b0 = cvtpk(P[BASE + 4], P[BASE + 5]), b1 = cvtpk(P[BASE + 6], P[BASE + 7]);                              \
    auto r0 = __builtin_amdgcn_permlane32_swap(a0, b0, false, false); auto r1 = __builtin_amdgcn_permlane32_swap(a1, b1, false, false); \
    u32x4 w = {r0[0], r1[0], r0[1], r1[1]}; OUT = *reinterpret_cast<bf16x8*>(&w); } while (0)
  PK4(p0, 0, pa0); PK4(p0, 8, pa1); PK4(p1, 0, pa2); PK4(p1, 8, pa3);
#undef PK4
}
__device__ __forceinline__ void qkt(f32x16& p0, f32x16& p1, const bf16* Ks, const bf16x8* qr, int r32, int hi) {
  p0 = f32x16{}; p1 = f32x16{};
  for (int d0 = 0; d0 < 8; ++d0) { int cb = (d0 * 16 + hi * 8) * 2;
    bf16x8 b0 = *reinterpret_cast<const bf16x8*>((const char*)Ks + KSWZ(r32, cb));
    bf16x8 b1 = *reinterpret_cast<const bf16x8*>((const char*)Ks + KSWZ(32 + r32, cb));
    p0 = __builtin_amdgcn_mfma_f32_32x32x16_bf16(b0, qr[d0], p0, 0, 0, 0);
    p1 = __builtin_amdgcn_mfma_f32_32x32x16_bf16(b1, qr[d0], p1, 0, 0, 0); }
}
__device__ __forceinline__ int v_st(int k, int c) { const int kk = (k & ~0xC) | ((k & 4) << 1) | ((k & 8) >> 1); return ((kk >> 3) * 4 + (c >> 5)) * 512 + ((kk & 7) * 32 + (c & 31)) * 2; }
__device__ __forceinline__ int v_rd_base(int lane) { return ((lane & 3) << 3) | (((lane >> 2) & 3) << 6) | (((lane >> 4) & 1) << 5) | (((lane >> 5) & 1) << 8); }
constexpr int v_rd_off(int d0, int ks, int half) { return d0 * 512 + ks * 4096 + half * 2048; }
template <int OFF> __device__ __forceinline__ s16x4 tr_read(int vb) {
  s16x4 r; asm volatile("ds_read_b64_tr_b16 %0, %1 offset:%2" : "=&v"(r) : "v"(vb), "i"(OFF) : "memory"); return r;
}
template <int D0> __device__ __forceinline__ void pv_one(f32x16& od, int vb, bf16x8 pa0, bf16x8 pa1, bf16x8 pa2, bf16x8 pa3) {
  const s16x4 l0 = tr_read<v_rd_off(D0, 0, 0)>(vb), h0 = tr_read<v_rd_off(D0, 0, 1)>(vb), l1 = tr_read<v_rd_off(D0, 1, 0)>(vb), h1 = tr_read<v_rd_off(D0, 1, 1)>(vb);
  const s16x4 l2 = tr_read<v_rd_off(D0, 2, 0)>(vb), h2 = tr_read<v_rd_off(D0, 2, 1)>(vb), l3 = tr_read<v_rd_off(D0, 3, 0)>(vb), h3 = tr_read<v_rd_off(D0, 3, 1)>(vb);
  asm volatile("s_waitcnt lgkmcnt(0)" ::: "memory"); SBAR();
#define PK(L, H) (bf16x8){L[0], L[1], L[2], L[3], H[0], H[1], H[2], H[3]}
  od = __builtin_amdgcn_mfma_f32_32x32x16_bf16(pa0, PK(l0, h0), od, 0, 0, 0);
  od = __builtin_amdgcn_mfma_f32_32x32x16_bf16(pa1, PK(l1, h1), od, 0, 0, 0);
  od = __builtin_amdgcn_mfma_f32_32x32x16_bf16(pa2, PK(l2, h2), od, 0, 0, 0);
  od = __builtin_amdgcn_mfma_f32_32x32x16_bf16(pa3, PK(l3, h3), od, 0, 0, 0);
#undef PK
}
__device__ __forceinline__ void pv_d0(f32x16* o, int vb, bf16x8 pa0, bf16x8 pa1, bf16x8 pa2, bf16x8 pa3) {
  pv_one<0>(o[0], vb, pa0, pa1, pa2, pa3); pv_one<1>(o[1], vb, pa0, pa1, pa2, pa3); pv_one<2>(o[2], vb, pa0, pa1, pa2, pa3); pv_one<3>(o[3], vb, pa0, pa1, pa2, pa3);
}

__device__ __forceinline__ void attn_dense_body(const bf16* __restrict__ Qb, const bf16* __restrict__ Kh, const bf16* __restrict__ Vh,
                                                bf16* __restrict__ Ob, int seq, char* lds) {
  constexpr int SDEPTH = 2;
  int tid_ = threadIdx.x; asm volatile("" : "+v"(tid_));
  const int tid = tid_, wid = tid >> 6, lane = tid & 63, r32 = lane & 31, hi = lane >> 5;
  bf16* V_lds = (bf16*)lds; bf16* K_lds = (bf16*)(lds + 2 * SHM_V);
  float* ws = (float*)(lds + 2 * SHM_V + 2 * SHM_K) + wid * 64; float* li_l = ws; float* al_l = ws + 32;
  float m_reg = -1e30f, l_reg = 0; f32x16 o[4] = {}; bf16x8 qr[8];
  const bf16* Qw = Qb + (long)(wid * QBLK + r32) * LDQ + hi * 8;
#pragma unroll
  for (int d0 = 0; d0 < 8; ++d0) qr[d0] = ld8(Qw + d0 * 16);
  const int sr = tid >> 4, sc = (tid & 15) * 8, vst0 = v_st(sr, sc), vst1 = v_st(32 + sr, sc);
  const int vb0 = (int)(uintptr_t)V_lds + v_rd_base(lane);
  struct { bf16x8 vs0, vs1, ks0, ks1; } sr_[SDEPTH];
#define SLOAD(i, k0) do { sr_[i].vs0 = ld8(&Vh[(long)((k0) + sr) * LDK + sc]); sr_[i].vs1 = ld8(&Vh[(long)((k0) + 32 + sr) * LDK + sc]); \
    sr_[i].ks0 = ld8(&Kh[(long)((k0) + sr) * LDK + sc]); sr_[i].ks1 = ld8(&Kh[(long)((k0) + 32 + sr) * LDK + sc]); } while (0)
#define SWRITE(b, i) do { *(bf16x8*)((char*)V_lds + (b) * SHM_V + vst0) = sr_[i].vs0;          \
    *(bf16x8*)((char*)V_lds + (b) * SHM_V + vst1) = sr_[i].vs1; int kc = sc * 2;               \
    *(bf16x8*)((char*)K_lds + (b) * SHM_K + KSWZ(sr, kc)) = sr_[i].ks0;                       \
    *(bf16x8*)((char*)K_lds + (b) * SHM_K + KSWZ(32 + sr, kc)) = sr_[i].ks1; } while (0)
#define SWAIT() do { asm volatile("s_waitcnt vmcnt(4)" ::: "memory"); } while (0)
#define RESC(a) do { if (__any((a) < 1.f)) { if (hi == 0) al_l[r32] = (a); asm volatile("s_waitcnt lgkmcnt(0)" ::: "memory"); \
    for (int d = 0; d < 4; ++d) for (int r = 0; r < 16; ++r) o[d][r] *= al_l[crow(r, hi)]; } } while (0)
  f32x16 pA0, pA1, pB0, pB1; float mnA, mnB, alA, alB; bf16x8 pa0, pa1, pa2, pa3; const int NT = seq / KVBLK;
  constexpr int SE = 0, SO = SDEPTH - 1;
  SLOAD(SE, 0); asm volatile("s_waitcnt vmcnt(0)" ::: "memory"); SWRITE(0, SE); __syncthreads();
  qkt(pA0, pA1, K_lds, qr, r32, hi); partialSM(pA0, pA1, m_reg, mnA, alA);
  SLOAD(SO, KVBLK); if (2 < NT) SLOAD(SE, 2 * KVBLK);
  SWAIT(); SWRITE(1, SO); __syncthreads();
  for (int j = 1; j + 1 < NT; j += 2) {
    SBAR(); qkt(pB0, pB1, (bf16*)((char*)K_lds + SHM_K), qr, r32, hi);
    finishSM(pA0, pA1, alA, l_reg, pa0, pa1, pa2, pa3); SBAR();
    SLOAD(SO, (j + SDEPTH) * KVBLK); SBAR();
    pv_d0(o, vb0, pa0, pa1, pa2, pa3); partialSM(pB0, pB1, m_reg, mnB, alB);
    __syncthreads(); SWAIT(); SWRITE(0, SE);
    RESC(alB); __syncthreads();
    SBAR(); qkt(pA0, pA1, K_lds, qr, r32, hi);
    finishSM(pB0, pB1, alB, l_reg, pa0, pa1, pa2, pa3); SBAR();
    if (j + 3 < NT) SLOAD(SE, (j + 1 + SDEPTH) * KVBLK); SBAR();
    pv_d0(o, vb0 + (int)SHM_V, pa0, pa1, pa2, pa3); partialSM(pA0, pA1, m_reg, mnA, alA);
    __syncthreads(); SWAIT(); SWRITE(1, SO);
    RESC(alA); __syncthreads();
  }
  SBAR(); qkt(pB0, pB1, (bf16*)((char*)K_lds + SHM_K), qr, r32, hi);
  finishSM(pA0, pA1, alA, l_reg, pa0, pa1, pa2, pa3); SBAR();
  pv_d0(o, vb0, pa0, pa1, pa2, pa3); partialSM(pB0, pB1, m_reg, mnB, alB);
  __syncthreads(); RESC(alB);
  finishSM(pB0, pB1, alB, l_reg, pa0, pa1, pa2, pa3); SBAR();
  pv_d0(o, vb0 + (int)SHM_V, pa0, pa1, pa2, pa3);
  if (hi == 0) li_l[r32] = l_reg; asm volatile("s_waitcnt lgkmcnt(0)" ::: "memory");
  float rli[16];
#pragma unroll
  for (int r = 0; r < 16; ++r) rli[r] = __builtin_amdgcn_rcpf(li_l[crow(r, hi)]);
  bf16* Ow = Ob + (long)(wid * QBLK) * LDO;
#pragma unroll
  for (int r = 0; r < 16; ++r) { int orow = crow(r, hi);
#pragma unroll
    for (int d0 = 0; d0 < 4; ++d0) { const float val = o[d0][r] * rli[r]; Ow[(long)orow * LDO + d0 * 32 + r32] = (bf16)(cvtpk(val, val) & 0xffffu); } }
  __syncthreads();
#undef SLOAD
#undef SWRITE
#undef SWAIT
#undef RESC
}
#undef KSWZ
#undef SBAR
}

constexpr int NWAVES = 8, NTHR = 512;
constexpr int DM = 2048, NB = 4, SEQ = 4096, DEPTH = 4, CTXL = 256;
constexpr int ML = NB * SEQ, MC = NB * CTXL, MT = ML + MC;
constexpr int SKV = CTXL + SEQ;
constexpr int INW_SRC = 4608, PW = 5120;
constexpr int PQ = 0, PK = 1024, PV = 1280, PFA = 1536, PFB = 2048, PCB = 2560, PCC = 3072, PCH = 3584, PGU = 4096, PGV = 4608;
constexpr int MIXW = 2560, MX_ATT = 0, MX_FOUR = 1024, MX_CONV = 1536, MX_GM = 2048;
constexpr int DFF = 5632, UPW = 2 * DFF;
constexpr int NMOD = 6 * DM;
constexpr float EPS = 1e-6f;

constexpr size_t al256(size_t x) { return (x + 255) / 256 * 256; }
constexpr size_t WS_CTL = 0, CTL_ZERO_BYTES = 1u << 20;
constexpr size_t WS_WIN  = CTL_ZERO_BYTES;
constexpr size_t WS_WOUT = WS_WIN  + (size_t)DEPTH * PW * DM * 2;
constexpr size_t WS_WUP  = WS_WOUT + (size_t)DEPTH * DM * MIXW * 2;
constexpr size_t WS_WDN  = WS_WUP  + (size_t)DEPTH * UPW * DM * 2;
constexpr size_t WS_FN   = WS_WDN  + (size_t)DEPTH * DM * DFF * 2;
constexpr size_t WS_A1   = WS_FN;
constexpr size_t WS_A2   = WS_A1   + (size_t)256 * 256 * 2;
constexpr size_t WS_F256 = WS_A2   + (size_t)16 * 256 * 512 * 2;
constexpr size_t WS_MODP = WS_F256 + (size_t)256 * 512 * 2;
constexpr size_t WS_MOD  = WS_MODP + (size_t)16 * DEPTH * 5 * NMOD * 4;
constexpr size_t WS_ROPE = WS_MOD  + (size_t)DEPTH * 5 * NMOD * 4;
constexpr size_t WS_X    = WS_ROPE + 64 * 32 * 8;
constexpr size_t WS_H    = WS_X    + (size_t)MT * DM * 2;
constexpr size_t WS_R    = WS_H    + (size_t)MT * DM * 2;
constexpr size_t WS_P    = WS_R;
constexpr size_t WS_MIX  = WS_P    + (size_t)MT * PW * 2;
constexpr size_t WS_T1T  = WS_MIX  + (size_t)MT * MIXW * 2;
constexpr size_t WS_T1TC = WS_T1T  + (size_t)2048 * 8192 * 2;
constexpr size_t WS_KB   = WS_T1TC + (size_t)2048 * 512 * 2;
constexpr size_t WS_VB   = WS_KB   + (size_t)NB * SKV * 256 * 2;
constexpr size_t WS_QB   = WS_VB   + (size_t)NB * SKV * 256 * 2;
constexpr size_t WS_UB   = WS_QB   + (size_t)MT * 1024 * 2;
constexpr size_t WS_V2B  = WS_UB   + (size_t)MT * 512 * 2;
constexpr size_t WS_S2IN = WS_V2B  + (size_t)MT * 512 * 2;
constexpr size_t WS_RA_END = WS_S2IN + (size_t)16 * 2048 * 512 * 2;
constexpr size_t WS_ACT  = WS_R;
constexpr size_t WS_ACT_END = WS_ACT + (size_t)MT * DFF * 2;
constexpr size_t WS_R_END = WS_RA_END > WS_ACT_END ? WS_RA_END : WS_ACT_END;
constexpr size_t WS_EDGE = WS_R_END;
constexpr size_t WS_XP   = WS_EDGE + (size_t)(MT / 256) * 6 * DFF * 4;
constexpr size_t WS_END  = WS_XP   + (size_t)4 * MC * DM * 4;
static_assert(WS_END <= 1600000000ull, "d_ws budget");
static_assert(WS_WIN % 256 == 0 && WS_FN % 256 == 0 && WS_X % 256 == 0 && WS_H % 256 == 0 && WS_P % 256 == 0 && WS_MIX % 256 == 0 && WS_T1T % 256 == 0 && WS_KB % 256 == 0 && WS_ACT % 256 == 0 && WS_MOD % 256 == 0, "alignment");
constexpr int CW_TMO = 0, CW_BAR = 4096;

constexpr int RING_BYTES = 131072;
constexpr int LDSCTL_OFF = RING_BYTES, MISC_OFF = LDSCTL_OFF + 320;
constexpr int XL_OFF = RING_BYTES + 1024;
constexpr int LDS_BYTES = 147456;

#define GAS __attribute__((address_space(1)))
#define LAS __attribute__((address_space(3)))
typedef unsigned short bf16;
typedef unsigned v4u __attribute__((ext_vector_type(4)));
typedef unsigned v2u __attribute__((ext_vector_type(2)));
typedef float f32x4 __attribute__((ext_vector_type(4)));
typedef float f32x2 __attribute__((ext_vector_type(2)));
#define RLX_AGENT __ATOMIC_RELAXED, __HIP_MEMORY_SCOPE_AGENT
#define LDS_WAIT() asm volatile("s_waitcnt lgkmcnt(0)" ::: "memory")
#define VM_WAIT() asm volatile("s_waitcnt vmcnt(0)" ::: "memory")
__device__ __forceinline__ unsigned pk2(float lo, float hi) { unsigned r; asm volatile("v_cvt_pk_bf16_f32 %0, %1, %2" : "=v"(r) : "v"(lo), "v"(hi)); return r; }
__device__ __forceinline__ float bflo(unsigned w) { return __uint_as_float(w << 16); }
__device__ __forceinline__ float bfhi(unsigned w) { return __uint_as_float(w & 0xffff0000u); }
__device__ __forceinline__ void unpack8(const v4u w, float (&x)[8]) { x[0] = bflo(w.x); x[1] = bfhi(w.x); x[2] = bflo(w.y); x[3] = bfhi(w.y); x[4] = bflo(w.z); x[5] = bfhi(w.z); x[6] = bflo(w.w); x[7] = bfhi(w.w); }
__device__ __forceinline__ v4u pack8(const float (&x)[8]) { v4u w; w.x = pk2(x[0], x[1]); w.y = pk2(x[2], x[3]); w.z = pk2(x[4], x[5]); w.w = pk2(x[6], x[7]); return w; }
__device__ __forceinline__ float wave_sum(float v) {
#pragma unroll
    for (int o = 1; o < 64; o <<= 1) v += __shfl_xor(v, o);
    return v;
}
__device__ __forceinline__ float gelu_tanh(float x) { const float y = 0.7978845608028654f * (x + 0.044715f * x * x * x); return 0.5f * x * (1.f + tanhf(y)); }

#define XB_TMO      128
#define XB_XCNT(j)  (256  + 64 * (j))
#define XB_XSUB(j)  (1280 + 64 * (j))
#define XB_XGEN(j)  (2304 + 64 * (j))
#define XB_TOP      3328
#define XB_TOPGEN   3392
#define XCD_BAR_WORDS 3456
#define XB_SPIN_CAP (1u << 18)
__device__ __forceinline__ unsigned xb_ld(unsigned* p)              { return __hip_atomic_load(p, __ATOMIC_RELAXED, __HIP_MEMORY_SCOPE_AGENT); }
__device__ __forceinline__ unsigned xb_add(unsigned* p, unsigned v) { return __hip_atomic_fetch_add(p, v, __ATOMIC_RELAXED, __HIP_MEMORY_SCOPE_AGENT); }
__device__ __forceinline__ unsigned xb_xcc_id() { return (unsigned)__builtin_amdgcn_s_getreg((3 << 11) | 20) & 0xFu; }
#define XB_SPIN(cond, bar) do { unsigned _sp = 0; while (cond) { __builtin_amdgcn_s_sleep(1); \
    if ((++_sp & 255u) == 0u) { if (xb_ld(&(bar)[XB_TMO])) break; if (_sp > XB_SPIN_CAP) { atomicAdd(&(bar)[XB_TMO], 1u); break; } } } } while (0)
struct XcdBarrier { unsigned* bar; unsigned x; volatile LAS unsigned* st; };
__device__ __forceinline__ XcdBarrier xcd_barrier_post(unsigned* bar, volatile LAS unsigned* st) {
    XcdBarrier b; b.bar = bar; b.x = xb_xcc_id(); b.st = st;
    if (threadIdx.x == 0) (void)xb_add(&bar[XB_XCNT(b.x)], 1u);
    return b;
}
__device__ __forceinline__ void xcd_barrier_complete(unsigned* bar, unsigned x, unsigned& nloc, unsigned& nx) {
    const unsigned G = gridDim.x * gridDim.y * gridDim.z;
    unsigned sum, cnt, mine, sp = 0u;
    for (;;) {
        sum = 0u; cnt = 0u; mine = 0u;
#pragma unroll
        for (unsigned j = 0; j < 16; ++j) { const unsigned c = xb_ld(&bar[XB_XCNT(j)]); sum += c; cnt += (c > 0u) ? 1u : 0u; mine = (j == x) ? c : mine; }
        if (sum == G) break;
        __builtin_amdgcn_s_sleep(1);
        if ((++sp & 255u) == 0u) { if (xb_ld(&bar[XB_TMO])) break; if (sp > XB_SPIN_CAP) { atomicAdd(&bar[XB_TMO], 1u); break; } }
    }
    nloc = mine > 0u ? mine : 1u; nx = cnt > 0u ? cnt : 1u;
}
__device__ __forceinline__ void xcd_barrier(const XcdBarrier& b) {
    asm volatile("s_waitcnt vmcnt(0)" ::: "memory");
    __syncthreads();
    if (threadIdx.x == 0) {
        unsigned* bar = b.bar;
        __builtin_amdgcn_s_waitcnt(0);
        unsigned nloc = b.st[0], nx = b.st[1];
        if (nloc == 0u) { xcd_barrier_complete(bar, b.x, nloc, nx); b.st[0] = nloc; b.st[1] = nx; }
        const unsigned old = xb_add(&bar[XB_XSUB(b.x)], 1u);
        const unsigned gen = old / nloc;
        if (old + 1u == (gen + 1u) * nloc) {
            __builtin_amdgcn_fence(__ATOMIC_RELEASE, "agent");
            asm volatile("s_waitcnt vmcnt(0)" ::: "memory");
            const unsigned og = xb_add(&bar[XB_TOP], 1u);
            const unsigned tg = og / nx;
            if (og + 1u == (tg + 1u) * nx) xb_add(&bar[XB_TOPGEN], 1u);
            else XB_SPIN(xb_ld(&bar[XB_TOPGEN]) == tg, bar);
            __builtin_amdgcn_fence(__ATOMIC_ACQUIRE, "agent");
            xb_add(&bar[XB_XGEN(b.x)], 1u);
            asm volatile("s_waitcnt vmcnt(0)" ::: "memory");
        } else {
            XB_SPIN(xb_ld(&bar[XB_XGEN(b.x)]) == gen, bar);
            __builtin_amdgcn_fence(__ATOMIC_ACQUIRE, "agent");
            asm volatile("s_waitcnt vmcnt(0)" ::: "memory");
        }
    }
    __syncthreads();
}

struct Args { const float* in[22]; float* out; unsigned char* ws; int ph_lo, ph_hi; };
enum { I_X = 0, I_C, I_CTX, I_CCTX, I_WMOD, I_BMOD, I_N1G, I_N2G, I_WIN, I_QG, I_KG, I_CONVW, I_LNG, I_LNB, I_GMWS, I_GMB, I_WOUT, I_WUP, I_FCW, I_FCB, I_WDN, I_FNG };

typedef const Args __attribute__((address_space(4)))* KArgs;
__device__ __forceinline__ KArgs kargs() { KArgs p = (KArgs)__builtin_amdgcn_kernarg_segment_ptr(); asm volatile("" : "+s"(p)); return p; }
struct Frame {
    LAS unsigned char* lds;
    int tid, lane, wave, G, bx, gw, ngw;
    unsigned char* ws;
};
__device__ __forceinline__ Frame make_frame(KArgs a) {
    extern __shared__ __attribute__((aligned(16))) unsigned char lds_[];
    Frame F; int t = threadIdx.x; asm volatile("" : "+v"(t));
    F.lds = (LAS unsigned char*)lds_; F.tid = t; F.lane = t & 63; F.wave = __builtin_amdgcn_readfirstlane(t >> 6);
    F.G = gridDim.x; F.bx = blockIdx.x; F.gw = F.bx * NWAVES + F.wave; F.ngw = F.G * NWAVES; F.ws = a->ws;
    return F;
}

__device__ __forceinline__ size_t toff(int n, int k, int K) { return ((size_t)(n >> 8) * (K >> 6) + (k >> 6)) * 16384 + (size_t)(n & 255) * 64 + (k & 63); }
__device__ __forceinline__ void transpose_item(const float* W, int ldw, int k0, int ns0, bf16* WT, int ldt, int nd0, LAS float* scr, int lane) {
    f32x4 v[8];
#pragma unroll
    for (int i = 0; i < 8; ++i) v[i] = *(const f32x4*)(W + (size_t)(k0 + i * 8 + (lane >> 3)) * ldw + ns0 + (lane & 7) * 4);
#pragma unroll
    for (int i = 0; i < 8; ++i) { LAS float* d = scr + (i * 8 + (lane >> 3)) * 33 + (lane & 7) * 4; d[0] = v[i].x; d[1] = v[i].y; d[2] = v[i].z; d[3] = v[i].w; }
    LDS_WAIT(); asm volatile("" ::: "memory");
    const int c = lane & 7;
#pragma unroll
    for (int j = 0; j < 4; ++j) { const int n = (lane >> 3) + 8 * j; const LAS float* s = scr + (8 * c) * 33 + n;
        v4u o; o.x = pk2(s[0 * 33], s[1 * 33]); o.y = pk2(s[2 * 33], s[3 * 33]); o.z = pk2(s[4 * 33], s[5 * 33]); o.w = pk2(s[6 * 33], s[7 * 33]);
        *(v4u*)(WT + toff(nd0 + n, k0 + 8 * c, ldt)) = o; }
    LDS_WAIT(); asm volatile("" ::: "memory");
}

__device__ __forceinline__ void p0a_prologue(KArgs a) {
    Frame F = make_frame(a); unsigned char* ws = F.ws;
    {
        LAS float* scr = (LAS float*)(F.lds + F.wave * 16384);
        constexpr int I_IN = 32 * 128, I_OUT = 40 * 64, I_UP = 32 * 352, I_DN = 88 * 64, I_L = I_IN + I_OUT + I_UP + I_DN;
        for (int it = F.gw; it < DEPTH * I_L; it += F.ngw) {
            const int l = it / I_L; int r = it % I_L;
            if (r < I_IN) { const int kb = r / 128, nb = r % 128; const int ns0 = nb < 48 ? nb * 32 : 2048 + (nb - 48) * 32; const int nd0 = nb < 48 ? ns0 : ns0 + 512;
                transpose_item(a->in[I_WIN] + (size_t)l * DM * INW_SRC, INW_SRC, kb * 64, ns0, (bf16*)(ws + WS_WIN) + (size_t)l * PW * DM, DM, nd0, scr, F.lane); continue; }
            r -= I_IN;
            if (r < I_OUT) { const int kb = r / 64, nb = r % 64;
                transpose_item(a->in[I_WOUT] + (size_t)l * MIXW * DM, DM, kb * 64, nb * 32, (bf16*)(ws + WS_WOUT) + (size_t)l * DM * MIXW, MIXW, nb * 32, scr, F.lane); continue; }
            r -= I_OUT;
            if (r < I_UP) { const int kb = r / 352, nb = r % 352; const int nd0 = nb * 32, ns0 = ((nd0 >> 7) & 1) * DFF + (nd0 >> 8) * 128 + (nd0 & 127);
                transpose_item(a->in[I_WUP] + (size_t)l * DM * UPW, UPW, kb * 64, ns0, (bf16*)(ws + WS_WUP) + (size_t)l * UPW * DM, DM, nb * 32, scr, F.lane); continue; }
            r -= I_UP;
            { const int kb = r / 64, nb = r % 64;
                transpose_item(a->in[I_WDN] + (size_t)l * DFF * DM, DM, kb * 64, nb * 32, (bf16*)(ws + WS_WDN) + (size_t)l * DM * DFF, DFF, nb * 32, scr, F.lane); }
        }
    }
    __syncthreads();
    {
        LAS float* sl = (LAS float*)F.lds;
        for (int i = F.tid; i < 5 * DM; i += NTHR) { const int v = i / DM, k = i % DM; const float cv = v < 4 ? a->in[I_C][v * DM + k] : a->in[I_CCTX][k]; sl[i] = cv / (1.f + expf(-cv)); }
        __syncthreads();
        float* MODP = (float*)(ws + WS_MODP);
        for (int it = F.gw; it < DEPTH * 16 * 48; it += F.ngw) {
            const int l = it / 768, r = it % 768, ks = r / 48, cg = r % 48;
            const float* wp = a->in[I_WMOD] + ((size_t)l * DM + ks * 128) * NMOD + cg * 256 + F.lane * 4;
            f32x4 acc[5];
#pragma unroll
            for (int v = 0; v < 5; ++v) acc[v] = (f32x4){0.f, 0.f, 0.f, 0.f};
            for (int k = 0; k < 128; k += 8) {
                f32x4 w[8];
#pragma unroll
                for (int u = 0; u < 8; ++u) w[u] = *(const f32x4*)(wp + (size_t)(k + u) * NMOD);
#pragma unroll
                for (int u = 0; u < 8; ++u)
#pragma unroll
                    for (int v = 0; v < 5; ++v) acc[v] += w[u] * sl[v * DM + ks * 128 + k + u];
            }
#pragma unroll
            for (int v = 0; v < 5; ++v) *(f32x4*)(MODP + ((size_t)ks * (DEPTH * 5) + l * 5 + v) * NMOD + cg * 256 + F.lane * 4) = acc[v];
        }
    }
    __syncthreads();
    {
        LAS float* T128 = (LAS float*)F.lds;
        LAS float* Wl = (LAS float*)(F.lds + 1024);
        if (F.tid < 128) T128[F.tid] = cospif((float)F.tid * (1.f / 64.f));
        __syncthreads();
        for (int it = F.bx; it < DEPTH * 4 * 64; it += F.G) {
            const int l = it / 256, g = (it / 64) % 4, kb = it % 64;
            for (int i = F.tid; i < 32 * 128; i += NTHR) { const int kk = i / 128, dd = i % 128; Wl[i] = a->in[I_WIN][((size_t)l * DM + kb * 32 + kk) * INW_SRC + 1536 + g * 128 + dd]; }
            __syncthreads();
            const int dout = F.tid & 127, cs = (F.tid >> 7) & 1, kg = F.tid >> 8;
            float acc[16];
#pragma unroll
            for (int kk = 0; kk < 16; ++kk) acc[kk] = 0.f;
            for (int dd = 0; dd < 128; ++dd) {
                const float tr = T128[(dout * dd - (cs ? 32 : 0)) & 127];
#pragma unroll
                for (int kk = 0; kk < 16; ++kk) acc[kk] += Wl[(kg * 16 + kk) * 128 + dd] * tr;
            }
            bf16* dst = (bf16*)(ws + WS_WIN) + (size_t)l * PW * DM + toff(PFA + cs * 512 + g * 128 + dout, kb * 32 + kg * 16, DM);
            v4u o0, o1; o0.x = pk2(acc[0], acc[1]); o0.y = pk2(acc[2], acc[3]); o0.z = pk2(acc[4], acc[5]); o0.w = pk2(acc[6], acc[7]);
            o1.x = pk2(acc[8], acc[9]); o1.y = pk2(acc[10], acc[11]); o1.z = pk2(acc[12], acc[13]); o1.w = pk2(acc[14], acc[15]);
            *(v4u*)dst = o0; *(v4u*)(dst + 8) = o1;
            __syncthreads();
        }
    }
    __syncthreads();
    {
        LAS float* T = (LAS float*)F.lds;
        for (int i = F.tid; i < 4096; i += NTHR) T[i] = cospif((float)i * (1.f / 2048.f));
        __syncthreads();
        bf16* A1 = (bf16*)(ws + WS_A1);
        for (int idx = F.bx * NTHR + F.tid; idx < 256 * 32; idx += F.G * NTHR) {
            const int m = idx >> 5, kk0 = (idx & 31) * 8; const int cho = m >> 7, k2 = (m & 127) >> 1, ro = m & 1; float x[8];
#pragma unroll
            for (int e2 = 0; e2 < 8; ++e2) { const int kk = kk0 + e2, chi = kk >> 7, ri = (kk >> 6) & 1, aa = kk & 63;
                const float cs_ = T[(64 * k2 * aa) & 4095], sn_ = T[(64 * k2 * aa - 1024) & 4095];
                const float v = ro == 0 ? (ri == 0 ? cs_ : -sn_) : (ri == 0 ? -sn_ : -cs_);
                x[e2] = (cho == chi) ? v : 0.f; }
            *(v4u*)(A1 + (size_t)m * 256 + kk0) = pack8(x);
        }
        bf16* A2 = (bf16*)(ws + WS_A2);
        for (int idx = F.bx * NTHR + F.tid; idx < 16 * 256 * 64; idx += F.G * NTHR) {
            const int kk0 = (idx & 63) * 8, m = (idx >> 6) & 255, q = idx >> 14; const int k2p = m >> 6, k1 = m & 63, k = 4 * q + k2p + 64 * k1; float x[8];
#pragma unroll
            for (int e2 = 0; e2 < 8; ++e2) { const int kk = kk0 + e2, k2pp = kk >> 7, ro = (kk >> 6) & 1, c = kk & 63;
                const float v = ro == 0 ? T[(k * c) & 4095] : T[(k * c - 1024) & 4095];
                x[e2] = (k2pp == k2p) ? v : 0.f; }
            *(v4u*)(A2 + ((size_t)q * 256 + m) * 512 + kk0) = pack8(x);
        }
        bf16* F2 = (bf16*)(ws + WS_F256);
        for (int k = F.bx; k < 256; k += F.G) {
            if (F.tid < 64) { const int j0 = F.tid * 8; const int cs = j0 >> 8, t0 = j0 & 255; float x[8];
#pragma unroll
                for (int e = 0; e < 8; ++e) { const int m = (16 * k * (t0 + e) - (cs ? 1024 : 0)) & 4095; const float v = T[m]; x[e] = cs ? -v : v; }
                *(v4u*)(F2 + (size_t)k * 512 + j0) = pack8(x); }
        }
    }
    if (F.bx == 0) {
        f32x2* ROPE = (f32x2*)(ws + WS_ROPE);
        for (int i = F.tid; i < 64 * 32; i += NTHR) { const int pos = i >> 5, ii = i & 31; const float freq = powf(10000.f, -(float)(2 * ii) / 64.f); const float ang = (float)pos * freq;
            ROPE[i] = (f32x2){cosf(ang), sinf(ang)}; }
    }
    __syncthreads();
}

__device__ __forceinline__ void p0b_modreduce(KArgs a) {
    Frame F = make_frame(a);
    const float* MODP = (const float*)(F.ws + WS_MODP); float* MOD = (float*)(F.ws + WS_MOD);
    for (int i = F.bx * NTHR + F.tid; i < DEPTH * 5 * (NMOD / 4); i += F.G * NTHR) {
        const int j4 = i % (NMOD / 4), lv = i / (NMOD / 4), l = lv / 5;
        f32x4 s = *(const f32x4*)(a->in[I_BMOD] + (size_t)l * NMOD + j4 * 4);
#pragma unroll
        for (int ks = 0; ks < 16; ++ks) s += *(const f32x4*)(MODP + ((size_t)ks * (DEPTH * 5) + lv) * NMOD + j4 * 4);
        *(f32x4*)(MOD + (size_t)lv * NMOD + j4 * 4) = s;
    }
}

__device__ __forceinline__ void norm_phase(KArgs a, int M, const float* g, const float* modl, int shoff, int scoff, bool fold, bool lat_in, bool ctx_in) {
    Frame F = make_frame(a);
    bf16* X = (bf16*)(F.ws + WS_X); bf16* H = (bf16*)(F.ws + WS_H); const float* XP = (const float*)(F.ws + WS_XP);
    for (int row = F.gw; row < M; row += F.ngw) {
        const int v = row < ML ? row >> 12 : 4;
        const float* sh = modl + (size_t)v * NMOD + shoff; const float* sc = modl + (size_t)v * NMOD + scoff;
        v2u* xr = (v2u*)(X + (size_t)row * DM) + F.lane;
        f32x4 x[8]; float ss = 0.f;
        if (row < ML ? lat_in : ctx_in) { const f32x4* xs = (const f32x4*)(row < ML ? a->in[I_X] + (size_t)row * DM : a->in[I_CTX] + (size_t)(row - ML) * DM) + F.lane;
#pragma unroll
            for (int j = 0; j < 8; ++j) x[j] = xs[64 * j]; }
        else {
#pragma unroll
            for (int j = 0; j < 8; ++j) { const v2u w = xr[64 * j]; x[j] = (f32x4){bflo(w.x), bfhi(w.x), bflo(w.y), bfhi(w.y)}; } }
        if (fold && row >= ML) {
#pragma unroll
            for (int ks = 0; ks < 4; ++ks) { const f32x4* pr = (const f32x4*)(XP + ((size_t)ks * MC + (row - ML)) * DM) + F.lane;
#pragma unroll
                for (int j = 0; j < 8; ++j) x[j] += pr[64 * j]; }
#pragma unroll
            for (int j = 0; j < 8; ++j) { v2u w; w.x = pk2(x[j].x, x[j].y); w.y = pk2(x[j].z, x[j].w); xr[64 * j] = w; }
        }
#pragma unroll
        for (int j = 0; j < 8; ++j) ss += (x[j].x * x[j].x + x[j].y * x[j].y) + (x[j].z * x[j].z + x[j].w * x[j].w);
        const float rstd = 1.0f / sqrtf(wave_sum(ss) * (1.f / DM) + EPS);
#pragma unroll
        for (int j = 0; j < 8; ++j) { const int col = F.lane * 4 + 256 * j;
            const f32x4 gg = *(const f32x4*)(g + col), s1 = *(const f32x4*)(sc + col), s0 = *(const f32x4*)(sh + col);
            const f32x4 y = x[j] * rstd * gg * (s1 + 1.0f) + s0;
            v2u o; o.x = pk2(y.x, y.y); o.y = pk2(y.z, y.w);
            *(v2u*)(H + (size_t)row * DM + col) = o; }
    }
}

__device__ __forceinline__ void final_norm_phase(KArgs a, const float* g, float* out) {
    Frame F = make_frame(a);
    const bf16* X = (const bf16*)(F.ws + WS_X);
    for (int row = F.gw; row < ML; row += F.ngw) {
        const v2u* xr = (const v2u*)(X + (size_t)row * DM) + F.lane;
        f32x4 x[8]; float ss = 0.f;
#pragma unroll
        for (int j = 0; j < 8; ++j) { const v2u w = xr[64 * j]; x[j] = (f32x4){bflo(w.x), bfhi(w.x), bflo(w.y), bfhi(w.y)}; ss += (x[j].x * x[j].x + x[j].y * x[j].y) + (x[j].z * x[j].z + x[j].w * x[j].w); }
        const float rstd = 1.0f / sqrtf(wave_sum(ss) * (1.f / DM) + EPS);
#pragma unroll
        for (int j = 0; j < 8; ++j) { const int col = F.lane * 4 + 256 * j; const f32x4 gg = *(const f32x4*)(g + col);
            *(f32x4*)(out + (size_t)row * DM + col) = x[j] * rstd * gg; }
    }
}

__device__ __forceinline__ float gelu_fast(float x) { const float y = 1.5957691216057308f * (x + 0.044715f * x * x * x); return x * __builtin_amdgcn_rcpf(1.f + __expf(-y)); }

__device__ __forceinline__ void postA_phase(KArgs a, int l) {
    Frame F = make_frame(a); unsigned char* ws = F.ws;
    const bf16* P = (const bf16*)(ws + WS_P); bf16* MIX = (bf16*)(ws + WS_MIX); bf16* KB = (bf16*)(ws + WS_KB); bf16* VB = (bf16*)(ws + WS_VB);
    bf16* QB = (bf16*)(ws + WS_QB); bf16* V2B = (bf16*)(ws + WS_V2B);
    const f32x4* ROPE4 = (const f32x4*)(ws + WS_ROPE);
    const int lane = F.lane, tid = F.tid;
    {
        const int hl = lane & 15, axis = hl >> 3, i0 = (lane & 3) * 8; const bool first = (lane & 7) < 4;
        float qg8[8], kg8[8], cw0[8], cw1[8], cw2[8], lg8[8], lb8[8];
        { const float* qg = a->in[I_QG] + l * 128 + hl * 8; const float* kg = a->in[I_KG] + l * 128 + hl * 8; const float* cw = a->in[I_CONVW] + (size_t)l * 3 * 512 + lane * 8;
          const float* lng = a->in[I_LNG] + l * 512 + lane * 8; const float* lnb = a->in[I_LNB] + l * 512 + lane * 8;
#pragma unroll
          for (int e = 0; e < 8; ++e) { qg8[e] = qg[e]; kg8[e] = kg[e]; cw0[e] = cw[e]; cw1[e] = cw[512 + e]; cw2[e] = cw[1024 + e]; lg8[e] = lng[e]; lb8[e] = lnb[e]; } }
        for (int row = F.gw; row < MT; row += F.ngw) {
            const bool is_ctx = row >= ML;
            const int b = is_ctx ? (row - ML) >> 8 : row >> 12, p = is_ctx ? (row - ML) & 255 : row & 4095, nseq = is_ctx ? CTXL : SEQ;
            const bool kv_only = is_ctx && (l == DEPTH - 1);
            const bf16* Pr = P + (size_t)row * PW;
            const int kvpos = is_ctx ? p : CTXL + p;
            const v4u rkv = *(const v4u*)(Pr + PK + lane * 8);
            f32x4 c4[4];
            if (!is_ctx) { const int posax = axis ? (p & 63) : (p >> 6);
#pragma unroll
                for (int e = 0; e < 4; ++e) c4[e] = ROPE4[posax * 16 + (i0 >> 1) + e]; }
            {
                float x[8]; unpack8(rkv, x); float ss = 0.f;
#pragma unroll
                for (int e = 0; e < 8; ++e) ss += x[e] * x[e];
                ss += __shfl_xor(ss, 1); ss += __shfl_xor(ss, 2); ss += __shfl_xor(ss, 4); ss += __shfl_xor(ss, 8);
                const float rstd = 1.0f / sqrtf(ss * (1.f / 128.f) + EPS);
                float y[8];
#pragma unroll
                for (int e = 0; e < 8; ++e) y[e] = x[e] * rstd * kg8[e];
                if (!is_ctx) {
#pragma unroll
                    for (int e = 0; e < 8; ++e) { const float pr = __shfl_xor(y[e], 4); const float cs_ = c4[e >> 1][(e & 1) * 2], sn_ = c4[e >> 1][(e & 1) * 2 + 1]; y[e] = first ? y[e] * cs_ - pr * sn_ : y[e] * cs_ + pr * sn_; } }
                if (lane < 32) *(v4u*)(KB + ((size_t)b * SKV + kvpos) * 256 + lane * 8) = pack8(y);
                else *(v4u*)(VB + ((size_t)b * SKV + kvpos) * 256 + (lane - 32) * 8) = rkv;
            }
            if (kv_only) continue;
            const v4u rq0 = *(const v4u*)(Pr + PQ + lane * 8), rq1 = *(const v4u*)(Pr + PQ + 512 + lane * 8);
            const v4u rcb = *(const v4u*)(Pr + PCB + lane * 8), rc0 = *(const v4u*)(Pr + PCC + lane * 8), rh0 = *(const v4u*)(Pr + PCH + lane * 8);
            const bool hp = p > 0, hn = p < nseq - 1;
            const bf16* Pm = hp ? Pr - PW : Pr; const bf16* Pn = hn ? Pr + PW : Pr;
            const v4u rcm = *(const v4u*)(Pm + PCC + lane * 8), rhm = *(const v4u*)(Pm + PCH + lane * 8), rcp = *(const v4u*)(Pn + PCC + lane * 8), rhp = *(const v4u*)(Pn + PCH + lane * 8);
            const v4u rgv = *(const v4u*)(Pr + PGV + lane * 8);
#pragma unroll
            for (int part = 0; part < 2; ++part) {
                float x[8]; unpack8(part ? rq1 : rq0, x); float ss = 0.f;
#pragma unroll
                for (int e = 0; e < 8; ++e) ss += x[e] * x[e];
                ss += __shfl_xor(ss, 1); ss += __shfl_xor(ss, 2); ss += __shfl_xor(ss, 4); ss += __shfl_xor(ss, 8);
                const float rstd = 1.0f / sqrtf(ss * (1.f / 128.f) + EPS);
                float y[8];
#pragma unroll
                for (int e = 0; e < 8; ++e) y[e] = x[e] * rstd * qg8[e];
                if (!is_ctx) {
#pragma unroll
                    for (int e = 0; e < 8; ++e) { const float pr = __shfl_xor(y[e], 4); const float cs_ = c4[e >> 1][(e & 1) * 2], sn_ = c4[e >> 1][(e & 1) * 2 + 1]; y[e] = first ? y[e] * cs_ - pr * sn_ : y[e] * cs_ + pr * sn_; } }
                *(v4u*)(QB + (size_t)row * 1024 + part * 512 + lane * 8) = pack8(y);
            }
            {
                float cb[8], c0[8], h0[8], cm[8], hm[8], cp[8], hq[8], o[8];
                unpack8(rcb, cb); unpack8(rc0, c0); unpack8(rh0, h0); unpack8(rcm, cm); unpack8(rhm, hm); unpack8(rcp, cp); unpack8(rhp, hq);
                const float fp = hp ? 1.f : 0.f, fn = hn ? 1.f : 0.f;
#pragma unroll
                for (int e = 0; e < 8; ++e) o[e] = cb[e] * (cw0[e] * fp * (cm[e] * hm[e]) + cw1[e] * (c0[e] * h0[e]) + cw2[e] * fn * (cp[e] * hq[e]));
                *(v4u*)(MIX + (size_t)row * MIXW + MX_CONV + lane * 8) = pack8(o);
            }
            {
                float t[8]; unpack8(rgv, t);
                float s = 0.f;
#pragma unroll
                for (int e = 0; e < 8; ++e) { t[e] = gelu_fast(t[e]); s += t[e]; }
                const float mean = wave_sum(s) * (1.f / 512.f);
                float q = 0.f;
#pragma unroll
                for (int e = 0; e < 8; ++e) { t[e] -= mean; q += t[e] * t[e]; }
                const float rstd = 1.0f / sqrtf(wave_sum(q) * (1.f / 512.f) + EPS);
#pragma unroll
                for (int e = 0; e < 8; ++e) t[e] = t[e] * rstd * lg8[e] + lb8[e];
                *(v4u*)(V2B + (size_t)row * 512 + lane * 8) = pack8(t);
            }
        }
    }
    {
        LAS unsigned* tb = (LAS unsigned*)F.lds;
        bf16* S1 = (bf16*)(ws + WS_T1T);
        for (int un = F.bx; un < 512; un += F.G) {
            const int ab = un >> 6, b = (un >> 4) & 3, slab = un & 15;
            const size_t rowb = (size_t)b * SEQ + (size_t)ab * 512;
#pragma unroll
            for (int it = 0; it < 4; ++it) {
                const int idx = tid + it * NTHR; const int j = idx & 3, c = (idx >> 2) & 63, c8 = idx >> 8;
                const bf16* src0 = P + (rowb + (size_t)(2 * j) * 64 + c) * PW + PFA + slab * 64 + c8 * 8;
                const v4u r0 = *(const v4u*)src0, r1 = *(const v4u*)(src0 + (size_t)64 * PW);
                const unsigned a0[4] = {r0.x, r0.y, r0.z, r0.w}, a1[4] = {r1.x, r1.y, r1.z, r1.w};
#pragma unroll
                for (int w = 0; w < 4; ++w) {
                    tb[((c8 * 8 + 2 * w) * 64 + c) * 4 + j]     = (a0[w] & 0xffffu) | (a1[w] << 16);
                    tb[((c8 * 8 + 2 * w + 1) * 64 + c) * 4 + j] = (a0[w] >> 16) | (a1[w] & 0xffff0000u);
                }
            }
            __syncthreads();
#pragma unroll
            for (int it = 0; it < 8; ++it) {
                const int idx = tid + it * NTHR; const int c = idx & 63, col = idx >> 6;
                const v4u o = *(const LAS v4u*)(tb + (col * 64 + c) * 4);
                const int gcol = slab * 64 + col, ri = gcol >> 9, n = b * 512 + (gcol & 511);
                *(v4u*)(S1 + ((((size_t)n * 32 + (c & 31)) * 2 + (c >> 5)) * 2 + ri) * 64 + ab * 8) = o;
            }
            __syncthreads();
        }
    }
    if (l < DEPTH - 1) {
        LAS unsigned* tb = (LAS unsigned*)F.lds;
        for (int un = F.bx; un < 32; un += F.G) {
            const int chc = un >> 2, slab = un & 3;
            const int b = chc >> 1, p0 = (chc & 1) * 128;
            const int row0 = ML + b * CTXL + p0;
            bf16* T1 = (bf16*)(ws + WS_T1TC);
#pragma unroll
            for (int it = 0; it < 4; ++it) {
                const int q = tid + it * NTHR;
                const int c8 = ((q >> 6) & 3) * 8 + (q & 7), rp = (q >> 8) * 8 + ((q >> 3) & 7);
                const v4u r0 = *(const v4u*)(P + (size_t)(row0 + 2 * rp) * PW + PFA + slab * 256 + c8 * 8);
                const v4u r1 = *(const v4u*)(P + (size_t)(row0 + 2 * rp + 1) * PW + PFA + slab * 256 + c8 * 8);
                const unsigned a0[4] = {r0.x, r0.y, r0.z, r0.w}, a1[4] = {r1.x, r1.y, r1.z, r1.w};
#pragma unroll
                for (int w = 0; w < 4; ++w) {
                    tb[(c8 * 8 + 2 * w) * 65 + rp]     = (a0[w] & 0xffffu) | (a1[w] << 16);
                    tb[(c8 * 8 + 2 * w + 1) * 65 + rp] = (a0[w] >> 16) | (a1[w] & 0xffff0000u);
                }
            }
            __syncthreads();
#pragma unroll
            for (int it = 0; it < 8; ++it) {
                const int idx = tid + it * NTHR; const int cc = idx >> 4, t8 = idx & 15;
                v4u o; o.x = tb[cc * 65 + t8 * 4]; o.y = tb[cc * 65 + t8 * 4 + 1]; o.z = tb[cc * 65 + t8 * 4 + 2]; o.w = tb[cc * 65 + t8 * 4 + 3];
                const int col = slab * 256 + cc, csn = col >> 9, gd = col & 511;
                *(v4u*)(T1 + (size_t)(b * 512 + gd) * 512 + csn * CTXL + p0 + t8 * 8) = o;
            }
            __syncthreads();
        }
    }
}

__device__ __forceinline__ void gate_phase(KArgs a, int l, int wg0, int nwg, int u_lo, int u_hi) {
    Frame F = make_frame(a); unsigned char* ws = F.ws;
    F.bx -= wg0; if (F.bx < 0 || F.bx >= nwg) return;
    const bf16* P = (const bf16*)(ws + WS_P); const bf16* V2B = (const bf16*)(ws + WS_V2B); bf16* MIX = (bf16*)(ws + WS_MIX);
    const float* gws = a->in[I_GMWS] + (size_t)l * 4 * 128 * 128; const float* gmb = a->in[I_GMB] + l * 4 * 128;
    const int tid = F.tid, lane = F.lane, r32 = lane & 31, hi = lane >> 5, gsel = F.wave >> 2, qb = F.wave & 3;
    for (int un = u_lo + F.bx; un < u_hi; un += nwg) {
        const int ch = un >> 1, gp = un & 1;
        const bool is_ctx = ch >= 128;
        const int b = is_ctx ? (ch - 128) >> 1 : ch >> 5;
        const int p0 = is_ctx ? ((ch - 128) & 1) * 128 : (ch & 31) * 128;
        const int row0 = is_ctx ? ML + b * CTXL + p0 : b * SEQ + p0;
#pragma unroll
        for (int it = 0; it < 8; ++it) { const int idx = tid + it * NTHR; const int gi = idx >> 11, pp = (idx >> 4) & 127, c8 = idx & 15;
            const v4u v = *(const v4u*)(V2B + (size_t)(row0 + pp) * 512 + (2 * gp + gi) * 128 + c8 * 8);
            *(LAS v4u*)(F.lds + (gi * 2 + (pp >> 6)) * 16384 + att::v_st(pp & 63, c8 * 8)) = v; }
        __syncthreads();
        const int g = 2 * gp + gsel;
        att::f32x16 o[4] = {};
#pragma unroll
        for (int kt = 0; kt < 2; ++kt) {
            const float* wrow = gws + ((size_t)g * 128 + 32 * qb + r32) * 128 + 64 * kt + 8 * hi;
            att::bf16x8 pa[4];
#pragma unroll
            for (int ks = 0; ks < 4; ++ks) { const f32x4 w0 = *(const f32x4*)(wrow + 16 * ks), w1 = *(const f32x4*)(wrow + 16 * ks + 4);
                v4u w; w.x = pk2(w0.x, w0.y); w.y = pk2(w0.z, w0.w); w.z = pk2(w1.x, w1.y); w.w = pk2(w1.z, w1.w); pa[ks] = *reinterpret_cast<att::bf16x8*>(&w); }
            const int vb = (int)(unsigned)(uintptr_t)(F.lds + (gsel * 2 + kt) * 16384) + att::v_rd_base(lane);
            att::pv_d0(o, vb, pa[0], pa[1], pa[2], pa[3]);
        }
#pragma unroll
        for (int r = 0; r < 16; ++r) { const int q = 32 * qb + att::crow(r, hi); const float bias = gmb[g * 128 + q];
            const bf16* up = P + (size_t)(row0 + q) * PW + PGU + g * 128 + r32; bf16* mp = MIX + (size_t)(row0 + q) * MIXW + MX_GM + g * 128 + r32;
#pragma unroll
            for (int d0 = 0; d0 < 4; ++d0) { const float u = gelu_fast(__uint_as_float((unsigned)up[d0 * 32] << 16)); const float val = u * (o[d0][r] + bias); mp[d0 * 32] = (bf16)(pk2(val, val) & 0xffffu); } }
        __syncthreads();
    }
}

__device__ __forceinline__ void act_fix_phase(KArgs a, int l, int M) {
    Frame F = make_frame(a);
    const float* EDGE = (const float*)(F.ws + WS_EDGE); bf16* ACT = (bf16*)(F.ws + WS_ACT);
    const float* cw = a->in[I_FCW] + (size_t)l * 3 * DFF; const float* cb = a->in[I_FCB] + (size_t)l * DFF;
    constexpr int CG = DFF / 4;
    const int total = (M / 256) * 2 * CG;
    for (int idx = F.bx * NTHR + F.tid; idx < total; idx += F.G * NTHR) {
        const int c0 = (idx % CG) * 4, pw = idx / CG, which = pw & 1, pm = pw >> 1;
        const bool first = pm >= 64 || (pm & 15) == 0, last = pm >= 64 || (pm & 15) == 15;
        const float* e = EDGE + (size_t)pm * 6 * DFF + c0;
        f32x4 prev, cur, next, uu; const f32x4 zero = (f32x4){0.f, 0.f, 0.f, 0.f};
        if (which == 0) { prev = first ? zero : *(const f32x4*)(e - (size_t)6 * DFF + (size_t)3 * DFF); cur = *(const f32x4*)e; next = *(const f32x4*)(e + DFF); uu = *(const f32x4*)(e + (size_t)4 * DFF); }
        else { prev = *(const f32x4*)(e + (size_t)2 * DFF); cur = *(const f32x4*)(e + (size_t)3 * DFF); next = last ? zero : *(const f32x4*)(e + (size_t)6 * DFF); uu = *(const f32x4*)(e + (size_t)5 * DFF); }
        const f32x4 z = *(const f32x4*)(cw + c0) * prev + *(const f32x4*)(cw + DFF + c0) * cur + *(const f32x4*)(cw + 2 * DFF + c0) * next + *(const f32x4*)(cb + c0);
        float o[4];
#pragma unroll
        for (int j = 0; j < 4; ++j) o[j] = z[j] * __builtin_amdgcn_rcpf(1.f + __expf(-z[j])) * uu[j];
        v2u w; w.x = pk2(o[0], o[1]); w.y = pk2(o[2], o[3]);
        *(v2u*)(ACT + (size_t)(pm * 256 + (which ? 255 : 0)) * DFF + c0) = w;
    }
}

constexpr int PH_P0A = 0, PH_P0B = 1, PH_L0 = 2, PH_PER_LAYER = 10, PH_FINAL = PH_L0 + DEPTH * PH_PER_LAYER, N_PHASES = PH_FINAL + 1;

__device__ __forceinline__ void gemm_in_phase(KArgs a, int l) {
    unsigned char* ws = a->ws; extern __shared__ __attribute__((aligned(16))) unsigned char lds_[];
    pg8::Gemm g{(const bf16*)(ws + WS_H), (const bf16*)(ws + WS_WIN) + (size_t)l * PW * DM, MT, PW, DM, DM, DM, 0, 0, 1};
    pg8::StaticOrder S; S.init(MT, PW, gridDim.x, blockIdx.x, DM);
    pg8::EpiBf16 E{(bf16*)(ws + WS_P), PW};
    pg8::gemm_phase<pg8::EpiBf16, pg8::StaticOrder, true, true>((LAS unsigned char*)lds_, g, S, E);
}
__device__ __forceinline__ void gemm_in_probe(KArgs a, int l) {
    unsigned char* ws = a->ws; extern __shared__ __attribute__((aligned(16))) unsigned char lds_[];
    pg8::Gemm g{(const bf16*)(ws + WS_H), (const bf16*)(ws + WS_WIN) + (size_t)l * PW * DM, MT, PW, DM, DM, DM, 0, 0, 1};
    pg8::StaticOrder S; S.init(MT, PW, gridDim.x, blockIdx.x, DM);
    pg8::EpiNone E{};
    pg8::gemm_phase<pg8::EpiNone, pg8::StaticOrder, true, true>((LAS unsigned char*)lds_, g, S, E);
}
__device__ __forceinline__ void gemm_up_phase(KArgs a, int l, int M2) {
    unsigned char* ws = a->ws; extern __shared__ __attribute__((aligned(16))) unsigned char lds_[];
    pg8::Gemm g{(const bf16*)(ws + WS_H), (const bf16*)(ws + WS_WUP) + (size_t)l * UPW * DM, M2, UPW, DM, DM, DM, 0, 0, 1};
    pg8::StaticOrder S; S.init(M2, UPW, gridDim.x, blockIdx.x, DM);
    pg8::EpiUp E{(bf16*)(ws + WS_ACT), (float*)(ws + WS_EDGE), a->in[I_FCW] + (size_t)l * 3 * DFF, a->in[I_FCB] + (size_t)l * DFF, (LAS float*)((LAS unsigned char*)lds_ + XL_OFF), DFF};
    pg8::gemm_phase<pg8::EpiUp, pg8::StaticOrder, true, true>((LAS unsigned char*)lds_, g, S, E);
}
__device__ __forceinline__ void gemm_out_phase(KArgs a, int l, int M2) {
    unsigned char* ws = a->ws; extern __shared__ __attribute__((aligned(16))) unsigned char lds_[];
    pg8::Gemm g{(const bf16*)(ws + WS_MIX), (const bf16*)(ws + WS_WOUT) + (size_t)l * DM * MIXW, M2, DM, MIXW, MIXW, MIXW, 0, 0, 1};
    pg8::SplitOrder S; S.init(ML, (M2 - ML) / 256, DM, gridDim.x, blockIdx.x, MIXW);
    pg8::EpiResGate E{(bf16*)(ws + WS_X), (const float*)(ws + WS_MOD) + (size_t)l * 5 * NMOD, 2 * DM, (float*)(ws + WS_XP), l == 0 ? a->in[I_X] : (const float*)nullptr};
    pg8::gemm_phase<pg8::EpiResGate, pg8::SplitOrder, true, true>((LAS unsigned char*)lds_, g, S, E);
}
__device__ __forceinline__ void gemm_down_phase(KArgs a, int l, int M2) {
    unsigned char* ws = a->ws; extern __shared__ __attribute__((aligned(16))) unsigned char lds_[];
    pg8::Gemm g{(const bf16*)(ws + WS_ACT), (const bf16*)(ws + WS_WDN) + (size_t)l * DM * DFF, M2, DM, DFF, DFF, DFF, 0, 0, 1};
    pg8::SplitOrder S; S.init(ML, (M2 - ML) / 256, DM, gridDim.x, blockIdx.x, DFF);
    pg8::EpiResGate E{(bf16*)(ws + WS_X), (const float*)(ws + WS_MOD) + (size_t)l * 5 * NMOD, 5 * DM, (float*)(ws + WS_XP), (const float*)nullptr};
    pg8::gemm_phase<pg8::EpiResGate, pg8::SplitOrder, true, true>((LAS unsigned char*)lds_, g, S, E);
}
__device__ __forceinline__ void attn_phase(KArgs a, int l, int part, int wg0) {
    unsigned char* ws = a->ws; extern __shared__ __attribute__((aligned(16))) unsigned char lds_[];
    const bf16* QB = (const bf16*)(ws + WS_QB); const bf16* KB = (const bf16*)(ws + WS_KB); const bf16* VB = (const bf16*)(ws + WS_VB); bf16* MIX = (bf16*)(ws + WS_MIX);
    const int G = gridDim.x, bx = blockIdx.x;
    const int xcd = bx & 7, wq = bx >> 3;
    const int ulo = part ? 512 + ((bx - wg0 + G) % G) : bx, uhi = part ? ((l < DEPTH - 1) ? 544 : 0) : 512;
    for (int u = ulo; u < uhi; u += G) {
        int b, h, kvh, qrow, seq;
        if (u < 512) { const int i = u / G; const int j = (G == 256) ? wq + 32 * i : (u >> 3), x = (G == 256) ? xcd : (u & 7);
            b = x >> 1; kvh = x & 1; h = kvh * 4 + (j >> 4); qrow = b * SEQ + (j & 15) * 256; seq = SKV; }
        else { const int c = u - 512; b = c >> 3; h = c & 7; kvh = h >> 2; qrow = ML + b * CTXL; seq = CTXL; }
        att::attn_dense_body(QB + (size_t)qrow * 1024 + h * 128, KB + (size_t)b * SKV * 256 + kvh * 128, VB + (size_t)b * SKV * 256 + kvh * 128,
                             MIX + (size_t)qrow * MIXW + MX_ATT + h * 128, seq, (char*)lds_);
    }
}
__device__ __forceinline__ void dft1_phase(KArgs a, int l) {
    unsigned char* ws = a->ws; extern __shared__ __attribute__((aligned(16))) unsigned char lds_[];
    pg8::Gemm g{(const bf16*)(ws + WS_A1), (const bf16*)(ws + WS_T1T), 256, 65536, 256, 256, 256, 0};
    pg8::StaticOrder S; S.init(256, 65536, gridDim.x, blockIdx.x, 256);
    pg8::EpiS1 E{(bf16*)(ws + WS_S2IN)};
    pg8::gemm_phase<pg8::EpiS1, pg8::StaticOrder, true, true>((LAS unsigned char*)lds_, g, S, E);
}
__device__ __forceinline__ void dft2_phase(KArgs a, int l) {
    unsigned char* ws = a->ws; extern __shared__ __attribute__((aligned(16))) unsigned char lds_[];
    const int G = gridDim.x, bx = blockIdx.x;
    {
        pg8::Gemm g{(const bf16*)(ws + WS_A2), (const bf16*)(ws + WS_S2IN), 4096, 2048, 512, 512, 512, (size_t)2048 * 512 * 2};
        pg8::StaticOrder S; S.init(4096, 2048, G, (bx + G / 2) % G, 512);
        pg8::EpiS2 E{(bf16*)(ws + WS_MIX), 0.0013810679320049757f};
        pg8::gemm_phase<pg8::EpiS2, pg8::StaticOrder, true, true>((LAS unsigned char*)lds_, g, S, E);
    }
    if (l < DEPTH - 1) {
        pg8::Gemm g{(const bf16*)(ws + WS_F256), (const bf16*)(ws + WS_T1TC), CTXL, 2048, 512, 512, 512, 0};
        pg8::StaticOrder S; S.init(CTXL, 2048, G, (bx + G - 96) % G, 512);
        pg8::EpiDft E{(bf16*)(ws + WS_MIX), ML, CTXL, 0.005524271728019903f};
        pg8::gemm_phase<pg8::EpiDft, pg8::StaticOrder, true, true>((LAS unsigned char*)lds_, g, S, E);
    }
}

__global__ void __launch_bounds__(NTHR, 2) hybrid_fwd(Args args_by_value) {
    extern __shared__ __attribute__((aligned(16))) unsigned char lds[];
    (void)args_by_value;
    int lo, hi; unsigned* ctl;
    { KArgs a = kargs(); lo = a->ph_lo; hi = a->ph_hi; ctl = (unsigned*)(a->ws + WS_CTL); }
    volatile LAS unsigned* MISC = (volatile LAS unsigned*)((LAS unsigned char*)lds + MISC_OFF);
    for (int u = threadIdx.x; u < (LDS_BYTES - LDSCTL_OFF) / 4; u += NTHR) ((LAS unsigned*)((LAS unsigned char*)lds + LDSCTL_OFF))[u] = 0u;
    __syncthreads();
    XcdBarrier bar; bar.bar = ctl + CW_BAR; bar.x = 0; bar.st = nullptr;
    if (!MK_PER_PHASE) bar = xcd_barrier_post(ctl + CW_BAR, MISC + 8);
#define IN(k) (lo <= (k) && (k) < hi)
#define SEAM(k) do { if (IN((k) + 1)) { if (MK_PER_PHASE) { if (threadIdx.x == 0) __hip_atomic_store(ctl + CW_TMO, 0xBADBA0u, RLX_AGENT); } else { xcd_barrier(bar); if (DUP(8)) xcd_barrier(bar); } } } while (0)

    for (int rep = 0; rep < (DUP(13) ? 2 : 1); ++rep) {
    if (rep) xcd_barrier(bar);
    if (IN(PH_P0A)) { p0a_prologue(kargs()); if (DUP(0)) p0a_prologue(kargs()); SEAM(PH_P0A); }
    if (IN(PH_P0B)) { p0b_modreduce(kargs()); SEAM(PH_P0B); }

    for (int l = 0; l < DEPTH; ++l) {
        int ph = PH_L0 + l * PH_PER_LAYER;
        const int M2 = (l == DEPTH - 1) ? ML : MT;
#define PHASE(kbit, call) do { if (IN(ph)) { call; if (DUP(kbit)) { if (DUP(15) && !MK_PER_PHASE) xcd_barrier(bar); call; } SEAM(ph); } ++ph; } while (0)
#define MODL ((const float*)(kargs()->ws + WS_MOD) + (size_t)l * 5 * NMOD)
        PHASE(12, norm_phase(kargs(), MT, kargs()->in[I_N1G] + l * DM, MODL, 0 * DM, 1 * DM, l > 0, l == 0, l == 0));
        PHASE(2, gemm_in_phase(kargs(), l));
        if (DUP(11) && IN(ph)) { gemm_in_probe(kargs(), l); xcd_barrier(bar); }
        PHASE(9, postA_phase(kargs(), l));
        PHASE(3, { attn_phase(kargs(), l, 0, 0); dft1_phase(kargs(), l); gate_phase(kargs(), l, 0, (int)gridDim.x, 0, min((int)gridDim.x, (l == DEPTH - 1 ? 128 : 136) * 2)); });
        PHASE(6, { gate_phase(kargs(), l, 0, (int)gridDim.x / 2, (int)gridDim.x, (l == DEPTH - 1 ? 128 : 136) * 2); attn_phase(kargs(), l, 1, 16); dft2_phase(kargs(), l); });
        PHASE(14, gemm_out_phase(kargs(), l, M2));
        PHASE(12, norm_phase(kargs(), M2, kargs()->in[I_N2G] + l * DM, MODL, 3 * DM, 4 * DM, l < DEPTH - 1, false, l == 0));
        PHASE(5, gemm_up_phase(kargs(), l, M2));
        PHASE(10, act_fix_phase(kargs(), l, M2));
        PHASE(14, gemm_down_phase(kargs(), l, M2));
#undef MODL
#undef PHASE
    }
    if (IN(PH_FINAL)) { KArgs a = kargs(); final_norm_phase(a, a->in[I_FNG], a->out); }
    }
#undef IN
#undef SEAM
}

extern "C" void kernel_launch(void* const* d_in, const int* in_sizes, int n_in, void* d_out, int out_size, void* d_ws, size_t ws_size, hipStream_t stream) {
    static int grid = 0;
    if (grid == 0) {
        if (n_in != 22 || out_size != ML * DM || ws_size < WS_END) { fprintf(stderr, "kernel_launch: unexpected shapes: n_in %d out %d ws %zu (need %zu)\n", n_in, out_size, ws_size, (size_t)WS_END); grid = -1; return; }
        int dev = 0, cus = 0, per_cu = 0;
        if (hipGetDevice(&dev) != hipSuccess || hipDeviceGetAttribute(&cus, hipDeviceAttributeMultiprocessorCount, dev) != hipSuccess) { grid = -1; return; }
        if (hipFuncSetAttribute((const void*)hybrid_fwd, hipFuncAttributeMaxDynamicSharedMemorySize, LDS_BYTES) != hipSuccess) { fprintf(stderr, "kernel_launch: hipFuncSetAttribute failed\n"); grid = -1; return; }
        if (hipOccupancyMaxActiveBlocksPerMultiprocessor(&per_cu, (const void*)hybrid_fwd, NTHR, LDS_BYTES) != hipSuccess || per_cu < 1)
            fprintf(stderr, "kernel_launch: occupancy query reports %d workgroups per CU\n", per_cu);
        (void)hipGetLastError();
        grid = cus;
    }
    if (grid < 0) return;
    if (hipMemsetAsync((char*)d_ws + WS_CTL, 0, CTL_ZERO_BYTES, stream) != hipSuccess) return;
    Args a{};
    for (int i = 0; i < 22; ++i) a.in[i] = (const float*)d_in[i];
    a.out = (float*)d_out; a.ws = (unsigned char*)d_ws;
#if MK_PER_PHASE
    for (int ph = 0; ph < N_PHASES; ++ph) { a.ph_lo = ph; a.ph_hi = ph + 1; hipLaunchKernelGGL(hybrid_fwd, dim3(grid), dim3(NTHR), LDS_BYTES, stream, a); }
#else
    a.ph_lo = 0; a.ph_hi = N_PHASES;
    hipLaunchKernelGGL(hybrid_fwd, dim3(grid), dim3(NTHR), LDS_BYTES, stream, a);
#endif
    const hipError_t le = hipPeekAtLastError();
    if (le != hipSuccess) fprintf(stderr, "kernel_launch: launch failed: %s\n", hipGetErrorName(le));
}
```

```cpp
#include <hip/hip_runtime.h>
#include <cstdio>
#include <cstdint>

#ifndef DUPMASK
#define DUPMASK 0
#endif
#define DUP(k) ((DUPMASK >> (k)) & 1)
#ifndef MK_PER_PHASE
#define MK_PER_PHASE 0
#endif

namespace pg8 {
#define PG8_LAS __attribute__((address_space(3)))
typedef unsigned short bf16_t;
typedef short bf16x8 __attribute__((ext_vector_type(8)));
typedef float f32x4 __attribute__((ext_vector_type(4)));
typedef unsigned u32x4 __attribute__((ext_vector_type(4)));
constexpr int BM = 256, BK = 64, HALF = 128, HTB = HALF * BK * 2, STAGE_BYTES = 8 * HTB, NXCD = 8, WGM = 4;

__host__ __device__ __forceinline__ int lds_byte(int r, int c) { const int st = (r >> 4) * 2 + (c >> 5), rr = r & 15, cc = c & 31, ob = rr * 64 + cc * 2; return st * 1024 + (ob ^ (((ob >> 9) & 1) << 5)); }
__host__ __device__ __forceinline__ void stage_rc(int b, int& R, int& C) { const int st = b / 1024, sb = b % 1024, swz = sb ^ (((sb >> 9) & 1) << 5); R = (st >> 1) * 16 + swz / 64; C = (st & 1) * 32 + (swz % 64) / 2; }
__host__ __device__ __forceinline__ int perm32(int rho) { const int n = rho >> 4, i = rho & 15; return 8 * (i >> 2) + 4 * n + (i & 3); }

struct Unit { int pm, pn, kt0, nkt, split; };
struct Gemm { const bf16_t* A; const bf16_t* Bt; int M, N, K, lda, ldb; size_t bpm; int tiledA, tiledB; };

struct StaticOrder {
    int nM, nN, nwg, G, c, ntk;
    __host__ __device__ void init(int M, int N, int G_, int c_, int K) { nM = M / BM; nN = N / BM; nwg = nM * nN; G = G_; c = c_; ntk = K / BK; }
    __host__ __device__ bool next(int i, Unit& u) const {
        const long L = (long)i * G + c; if (L >= nwg) return false;
        return tile((int)L, u);
    }
    __host__ __device__ bool tile(int wgid, Unit& u) const {
        u.kt0 = 0; u.nkt = ntk; u.split = 0; { const int q = nwg / NXCD, r = nwg % NXCD, xcd = wgid % NXCD, off = wgid / NXCD; wgid = (xcd < r ? xcd * (q + 1) : r * (q + 1) + (xcd - r) * q) + off; }
        const int nig = WGM * nN, gid = wgid / nig, fm = gid * WGM, gsz = (nM - fm) < WGM ? (nM - fm) : WGM;
        u.pm = fm + ((wgid % nig) % gsz); u.pn = (wgid % nig) / gsz; return true;
    }
    __device__ __forceinline__ void a_ready(const Unit&) const {}
    __device__ __forceinline__ void done(const Unit&) const {}
};
struct SplitOrder {
    StaticOrder so; int xp, nsplit;
    __host__ __device__ void init(int Mfull, int xpanels, int N, int G_, int c_, int K) { so.init(Mfull, N, G_, c_, K); xp = xpanels; nsplit = xpanels * so.nN * 4; }
    __host__ __device__ bool next(int i, Unit& u) const {
        const int L = i * so.G + so.c; const bool full = L < so.nwg;
        Unit f; so.tile(full ? L : 0, f);
        const int q = L - so.nwg, ks = q & 3, t = q >> 2, qn = so.ntk / 4;
        u.pm = full ? f.pm : so.nM + t / so.nN; u.pn = full ? f.pn : t % so.nN; u.nkt = full ? f.nkt : qn; u.kt0 = full ? 0 : ks * qn; u.split = full ? 0 : 1;
        return full || q < nsplit;
    }
    __device__ __forceinline__ void a_ready(const Unit&) const {}
    __device__ __forceinline__ void done(const Unit&) const {}
};

__device__ __forceinline__ unsigned cvt_pk_bf16(float lo, float hi) { unsigned r; asm volatile("v_cvt_pk_bf16_f32 %0, %1, %2" : "=v"(r) : "v"(lo), "v"(hi)); return r; }

struct EpiNone {
    static constexpr bool PERM = true, AFTER_DRAIN = false;
    __device__ __forceinline__ void operator()(const f32x4 (&acc)[2][2][4][2], const Unit& u, int wr, int wc, int fr, int fq) const {
#pragma unroll
        for (int ai = 0; ai < 2; ++ai)
#pragma unroll
            for (int bj = 0; bj < 2; ++bj)
#pragma unroll
                for (int m = 0; m < 4; ++m)
#pragma unroll
                    for (int n = 0; n < 2; ++n) asm volatile("" :: "v"(acc[ai][bj][m][n]));
    }
};
struct EpiBf16 {
    static constexpr bool PERM = true, AFTER_DRAIN = false;
    bf16_t* O; int ldc;
    __device__ __forceinline__ void operator()(const f32x4 (&acc)[2][2][4][2], const Unit& u, int wr, int wc, int fr, int fq) const {
        const int row0 = u.pm * BM + wr * 64 + fr; const int col0 = u.pn * BM + wc * 32 + 8 * fq;
#pragma unroll
        for (int ai = 0; ai < 2; ++ai)
#pragma unroll
            for (int m = 0; m < 4; ++m) { bf16_t* rowp = O + (size_t)(row0 + ai * HALF + m * 16) * ldc + col0;
#pragma unroll
                for (int bj = 0; bj < 2; ++bj) { const f32x4 v0 = acc[ai][bj][m][0], v1 = acc[ai][bj][m][1];
                    u32x4 w; w.x = cvt_pk_bf16(v0[0], v0[1]); w.y = cvt_pk_bf16(v0[2], v0[3]); w.z = cvt_pk_bf16(v1[0], v1[1]); w.w = cvt_pk_bf16(v1[2], v1[3]);
                    *(u32x4*)(rowp + bj * HALF) = w; } }
    }
};
struct EpiDft {
    static constexpr bool PERM = true, AFTER_DRAIN = false;
    bf16_t* MIX; int rowbase, nper; float scale;
    __device__ __forceinline__ void operator()(const f32x4 (&acc)[2][2][4][2], const Unit& u, int wr, int wc, int fr, int fq) const {
        const int k0 = u.pm * BM + wr * 64 + fr; const int n0 = u.pn * BM + wc * 32 + 8 * fq;
#pragma unroll
        for (int ai = 0; ai < 2; ++ai)
#pragma unroll
            for (int m = 0; m < 4; ++m) { const int k = k0 + ai * HALF + m * 16;
#pragma unroll
                for (int bj = 0; bj < 2; ++bj) { const int n = n0 + bj * HALF; const int b = n >> 9, gd = n & 511;
                    const f32x4 v0 = acc[ai][bj][m][0] * scale, v1 = acc[ai][bj][m][1] * scale;
                    u32x4 w; w.x = cvt_pk_bf16(v0[0], v0[1]); w.y = cvt_pk_bf16(v0[2], v0[3]); w.z = cvt_pk_bf16(v1[0], v1[1]); w.w = cvt_pk_bf16(v1[2], v1[3]);
                    *(u32x4*)(MIX + (size_t)(rowbase + b * nper + k) * 2560 + 1024 + gd) = w; } }
    }
};

struct EpiS1 {
    static constexpr bool PERM = true, AFTER_DRAIN = false;
    bf16_t* S2;
    __device__ __forceinline__ void operator()(const f32x4 (&acc)[2][2][4][2], const Unit& u, int wr, int wc, int fr, int fq) const {
        const int m0 = wr * 64 + fr; const int n0 = u.pn * BM + wc * 32 + 8 * fq;
#pragma unroll
        for (int ai = 0; ai < 2; ++ai)
#pragma unroll
            for (int mm = 0; mm < 4; ++mm) { const int m = m0 + mm * 16; const int k2 = m >> 1, ro = m & 1;
#pragma unroll
                for (int bj = 0; bj < 2; ++bj) { const int np = n0 + bj * HALF; const int n = np >> 5, c = ai * 32 + (np & 31);
                    const f32x4 v0 = acc[ai][bj][mm][0], v1 = acc[ai][bj][mm][1];
                    u32x4 w; w.x = cvt_pk_bf16(v0[0], v0[1]); w.y = cvt_pk_bf16(v0[2], v0[3]); w.z = cvt_pk_bf16(v1[0], v1[1]); w.w = cvt_pk_bf16(v1[2], v1[3]);
                    *(u32x4*)(S2 + ((((size_t)(k2 >> 2) * 2048 + n) * 4 + (k2 & 3)) * 2 + ro) * 64 + c) = w; } }
    }
};
struct EpiS2 {
    static constexpr bool PERM = true, AFTER_DRAIN = false;
    bf16_t* MIX; float scale;
    __device__ __forceinline__ void operator()(const f32x4 (&acc)[2][2][4][2], const Unit& u, int wr, int wc, int fr, int fq) const {
        const int m0 = wr * 64 + fr; const int n0 = u.pn * BM + wc * 32 + 8 * fq;
#pragma unroll
        for (int ai = 0; ai < 2; ++ai)
#pragma unroll
            for (int mm = 0; mm < 4; ++mm) { const int m = ai * HALF + m0 + mm * 16; const int k = 4 * u.pm + (m >> 6) + 64 * (m & 63);
#pragma unroll
                for (int bj = 0; bj < 2; ++bj) { const int n = n0 + bj * HALF; const int b = n >> 9, gd = n & 511;
                    const f32x4 v0 = acc[ai][bj][mm][0] * scale, v1 = acc[ai][bj][mm][1] * scale;
                    u32x4 w; w.x = cvt_pk_bf16(v0[0], v0[1]); w.y = cvt_pk_bf16(v0[2], v0[3]); w.z = cvt_pk_bf16(v1[0], v1[1]); w.w = cvt_pk_bf16(v1[2], v1[3]);
                    *(u32x4*)(MIX + (size_t)(b * 4096 + k) * 2560 + 1024 + gd) = w; } }
    }
};
struct EpiResGate {
    static constexpr bool PERM = false, AFTER_DRAIN = false;
    bf16_t* X; const float* modl; int goff; float* XP; const float* basef;
    __device__ __forceinline__ void operator()(const f32x4 (&acc)[2][2][4][2], const Unit& u, int wr, int wc, int fr, int fq) const {
        typedef unsigned u32x2_ __attribute__((ext_vector_type(2)));
        const int row0 = u.pm * BM + wr * 64 + fr, col0 = u.pn * BM + wc * 32 + 4 * fq;
        const int v = u.pm < 64 ? (u.pm >> 4) : 4;
        const float* gate = modl + (size_t)v * 12288 + goff;
        f32x4 gv[2][2];
#pragma unroll
        for (int bj = 0; bj < 2; ++bj)
#pragma unroll
            for (int n = 0; n < 2; ++n) gv[bj][n] = *(const f32x4*)(gate + col0 + bj * HALF + n * 16);
#pragma unroll
        for (int ai = 0; ai < 2; ++ai)
#pragma unroll
            for (int m = 0; m < 4; ++m) { const size_t ro = (size_t)(row0 + ai * HALF + m * 16) * 2048 + col0;
#pragma unroll
                for (int bj = 0; bj < 2; ++bj)
#pragma unroll
                    for (int n = 0; n < 2; ++n) { const size_t o = ro + bj * HALF + n * 16; const f32x4 d = gv[bj][n] * acc[ai][bj][m][n];
                        if (u.split) *(f32x4*)(XP + ((size_t)(u.kt0 / u.nkt) * 1024 + (row0 + ai * HALF + m * 16 - 16384)) * 2048 + col0 + bj * HALF + n * 16) = d;
                        else { f32x4 b;
                            if (basef) b = *(const f32x4*)(basef + o);
                            else { const u32x2_ w = *(const u32x2_*)(X + o); b = (f32x4){__uint_as_float(w.x << 16), __uint_as_float(w.x & 0xffff0000u), __uint_as_float(w.y << 16), __uint_as_float(w.y & 0xffff0000u)}; }
                            const f32x4 xn = b + d; u32x2_ wo; wo.x = cvt_pk_bf16(xn[0], xn[1]); wo.y = cvt_pk_bf16(xn[2], xn[3]); *(u32x2_*)(X + o) = wo; } } }
    }
};


__device__ __forceinline__ float dpp_ror1(float x)  { return __builtin_bit_cast(float, __builtin_amdgcn_update_dpp(0, __builtin_bit_cast(int, x), 0x121, 0xF, 0xF, false)); }
__device__ __forceinline__ float dpp_ror15(float x) { return __builtin_bit_cast(float, __builtin_amdgcn_update_dpp(0, __builtin_bit_cast(int, x), 0x12F, 0xF, 0xF, false)); }
__device__ __forceinline__ f32x4 ror1v(const f32x4 v)  { return (f32x4){dpp_ror1(v[0]), dpp_ror1(v[1]), dpp_ror1(v[2]), dpp_ror1(v[3])}; }
__device__ __forceinline__ f32x4 ror15v(const f32x4 v) { return (f32x4){dpp_ror15(v[0]), dpp_ror15(v[1]), dpp_ror15(v[2]), dpp_ror15(v[3])}; }
struct EpiUp {
    static constexpr bool PERM = true, AFTER_DRAIN = false;
    bf16_t* ACT; float* EDGE; const float* cw; const float* cb; PG8_LAS float* xl; int dff;
    __device__ __forceinline__ void operator()(const f32x4 (&acc)[2][2][4][2], const Unit& u, int wr, int wc, int fr, int fq) const {
        const int ch0 = u.pn * 128 + wc * 32 + 8 * fq;
        f32x4 w0[2], w1[2], w2[2], bb[2];
#pragma unroll
        for (int n = 0; n < 2; ++n) { w0[n] = *(const f32x4*)(cw + ch0 + 4 * n); w1[n] = *(const f32x4*)(cw + dff + ch0 + 4 * n); w2[n] = *(const f32x4*)(cw + 2 * dff + ch0 + 4 * n); bb[n] = *(const f32x4*)(cb + ch0 + 4 * n); }
#pragma unroll
        for (int ai = 0; ai < 2; ++ai)
#pragma unroll
            for (int n = 0; n < 2; ++n) {
                if (fr == 0)  *(PG8_LAS f32x4*)(xl + ((((wr * 4 + wc) * 2 + ai) * 2 + 0) * 32) + 8 * fq + 4 * n) = acc[ai][0][0][n];
                if (fr == 15) *(PG8_LAS f32x4*)(xl + ((((wr * 4 + wc) * 2 + ai) * 2 + 1) * 32) + 8 * fq + 4 * n) = acc[ai][0][3][n];
            }
        { float* eg = EDGE + (size_t)u.pm * 6 * dff + ch0;
          if (wr == 0 && fr < 2) {
#pragma unroll
              for (int n = 0; n < 2; ++n) { *(f32x4*)(eg + (size_t)fr * dff + 4 * n) = acc[0][0][0][n]; if (fr == 0) *(f32x4*)(eg + (size_t)4 * dff + 4 * n) = acc[0][1][0][n]; } }
          if (wr == 1 && fr >= 14) {
#pragma unroll
              for (int n = 0; n < 2; ++n) { *(f32x4*)(eg + (size_t)(fr - 12) * dff + 4 * n) = acc[1][0][3][n]; if (fr == 15) *(f32x4*)(eg + (size_t)5 * dff + 4 * n) = acc[1][1][3][n]; } }
        }
        asm volatile("s_waitcnt lgkmcnt(0)" ::: "memory"); __builtin_amdgcn_s_barrier(); asm volatile("" ::: "memory");
        f32x4 pe[2][2], ne[2][2];
#pragma unroll
        for (int ai = 0; ai < 2; ++ai)
#pragma unroll
            for (int n = 0; n < 2; ++n) {
                const bool hp = (wr == 1) || (ai == 1), hn = (wr == 0) || (ai == 0);
                const int pai = (wr == 1) ? ai : ai - 1, nai = (wr == 0) ? ai : ai + 1;
                pe[ai][n] = hp ? *(const PG8_LAS f32x4*)(xl + (((((wr ^ 1) * 4 + wc) * 2 + pai) * 2 + 1) * 32) + 8 * fq + 4 * n) : (f32x4){0.f, 0.f, 0.f, 0.f};
                ne[ai][n] = hn ? *(const PG8_LAS f32x4*)(xl + (((((wr ^ 1) * 4 + wc) * 2 + nai) * 2 + 0) * 32) + 8 * fq + 4 * n) : (f32x4){0.f, 0.f, 0.f, 0.f};
            }
        const int row0 = u.pm * BM + wr * 64 + fr;
#pragma unroll
        for (int ai = 0; ai < 2; ++ai)
#pragma unroll
            for (int m = 0; m < 4; ++m) {
                float z[8], t[8];
#pragma unroll
                for (int n = 0; n < 2; ++n) {
                    const f32x4 g = acc[ai][0][m][n];
                    const f32x4 gp = (m > 0) ? acc[ai][0][m > 0 ? m - 1 : 0][n] : pe[ai][n];
                    const f32x4 gn = (m < 3) ? acc[ai][0][m < 3 ? m + 1 : 3][n] : ne[ai][n];
                    const f32x4 zz = w1[n] * g + bb[n];
#pragma unroll
                    for (int j = 0; j < 4; ++j) { float zj = zz[j];
                        if ((m == 0 || m == 3) && n == 0 && j == 0)
                            asm("s_nop 1\n\t"
                                "v_fmac_f32_dpp %0, %1, %4 row_shr:1 row_mask:0xf bank_mask:0xf\n\t"
                                "v_fmac_f32_dpp %0, %2, %4 row_shl:15 row_mask:0xf bank_mask:0xf\n\t"
                                "v_fmac_f32_dpp %0, %1, %5 row_shl:1 row_mask:0xf bank_mask:0xf\n\t"
                                "v_fmac_f32_dpp %0, %3, %5 row_shr:15 row_mask:0xf bank_mask:0xf"
                                : "+v"(zj) : "v"(g[j]), "v"(gp[j]), "v"(gn[j]), "v"(w0[n][j]), "v"(w2[n][j]));
                        else
                            asm("v_fmac_f32_dpp %0, %1, %4 row_shr:1 row_mask:0xf bank_mask:0xf\n\t"
                                "v_fmac_f32_dpp %0, %2, %4 row_shl:15 row_mask:0xf bank_mask:0xf\n\t"
                                "v_fmac_f32_dpp %0, %1, %5 row_shl:1 row_mask:0xf bank_mask:0xf\n\t"
                                "v_fmac_f32_dpp %0, %3, %5 row_shr:15 row_mask:0xf bank_mask:0xf"
                                : "+v"(zj) : "v"(g[j]), "v"(gp[j]), "v"(gn[j]), "v"(w0[n][j]), "v"(w2[n][j]));
                        z[n * 4 + j] = zj; }
                }
#pragma unroll
                for (int i = 0; i < 8; ++i) t[i] = -1.4426950408889634f * z[i];
#pragma unroll
                for (int i = 0; i < 8; ++i) t[i] = __builtin_amdgcn_exp2f(t[i]);
#pragma unroll
                for (int i = 0; i < 8; ++i) t[i] = 1.f + t[i];
#pragma unroll
                for (int i = 0; i < 8; ++i) t[i] = __builtin_amdgcn_rcpf(t[i]);
#pragma unroll
                for (int i = 0; i < 8; ++i) t[i] = z[i] * t[i] * acc[ai][1][m][i >> 2][i & 3];
                u32x4 w; w.x = cvt_pk_bf16(t[0], t[1]); w.y = cvt_pk_bf16(t[2], t[3]); w.z = cvt_pk_bf16(t[4], t[5]); w.w = cvt_pk_bf16(t[6], t[7]);
                *(u32x4*)(ACT + (size_t)(row0 + ai * HALF + m * 16) * dff + ch0) = w;
            }
    }
};

template <class Epi, class Sched, bool ALIGN_EPI = false, bool SP2 = false>
__device__ __forceinline__ void gemm_phase(PG8_LAS unsigned char* lds, const Gemm g, const Sched& S, const Epi& E) {
    int tid_ = threadIdx.x; asm volatile("" : "+v"(tid_));
    const int tid = tid_, wid = __builtin_amdgcn_readfirstlane(tid >> 6), lane = tid & 63, wr = wid >> 2, wc = wid & 3, fr = lane & 15, fq = lane >> 4;
    unsigned voffA[2], voffB[2];
#pragma unroll
    for (int i = 0; i < 2; ++i) { int R, C; stage_rc(tid * 16 + i * 8192, R, C); const int Rb = Epi::PERM ? ((R & ~31) + perm32(R & 31)) : R;
        voffA[i] = (unsigned)(R * (g.tiledA ? BK : g.lda) + C) * 2u; voffB[i] = (unsigned)(Rb * (g.tiledB ? BK : g.ldb) + C) * 2u; }
    const size_t kstepA = g.tiledA ? (size_t)BM * BK * 2 : (size_t)(BK * 2), kstepB = g.tiledB ? (size_t)BM * BK * 2 : (size_t)(BK * 2);
    const size_t hstepA = (size_t)HALF * (g.tiledA ? BK : g.lda) * 2, hstepB = (size_t)HALF * (g.tiledB ? BK : g.ldb) * 2;
    const size_t tstepA = g.tiledA ? (size_t)(g.K / BK) * BM * BK * 2 : 2 * hstepA, tstepB = g.tiledB ? (size_t)(g.K / BK) * BM * BK * 2 : 2 * hstepB;
    const unsigned ldsw = (unsigned)wid * 1024u;
    const int aoff = lds_byte(wr * 64 + fr, fq * 8), boff = lds_byte(wc * 32 + fr, fq * 8);
#define PG8_SA(b, h) (((b) * 2 + (h)) * HTB)
#define PG8_SB(b, h) ((4 + (b) * 2 + (h)) * HTB)
#define PG8_STAGE(bufoff, gbase, voff) do { _Pragma("unroll") for (int _i = 0; _i < 2; ++_i) \
        __builtin_amdgcn_global_load_lds((const unsigned*)((const char*)(gbase) + (voff)[_i]), (PG8_LAS unsigned*)(lds + (bufoff) + ldsw + _i * 8192), 16, 0, 0); } while (0)
#define PG8_LDA(dst, b, h) do { _Pragma("unroll") for (int m = 0; m < 4; ++m) _Pragma("unroll") for (int k = 0; k < 2; ++k) dst[m][k] = *(const PG8_LAS bf16x8*)(lds + PG8_SA(b, h) + aoff + m * 2048 + k * 1024); } while (0)
#define PG8_LDB(dst, b, h) do { _Pragma("unroll") for (int n = 0; n < 2; ++n) _Pragma("unroll") for (int k = 0; k < 2; ++k) dst[n][k] = *(const PG8_LAS bf16x8*)(lds + PG8_SB(b, h) + boff + n * 2048 + k * 1024); } while (0)
#define PG8_MMA(ai, bj, At, Bt) do { __builtin_amdgcn_s_setprio(1); _Pragma("unroll") for (int m = 0; m < 4; ++m) _Pragma("unroll") for (int n = 0; n < 2; ++n) _Pragma("unroll") for (int k = 0; k < 2; ++k) \
        acc[ai][bj][m][n] = __builtin_amdgcn_mfma_f32_16x16x32_bf16(Bt[n][k], At[m][k], acc[ai][bj][m][n], 0, 0, 0); __builtin_amdgcn_s_setprio(0); } while (0)
#define PG8_WAIT_V(n) asm volatile("s_waitcnt vmcnt(" #n ")" ::: "memory")
#define PG8_WAIT_L(n) asm volatile("s_waitcnt lgkmcnt(" #n ")" ::: "memory")
#define PG8_BAR __builtin_amdgcn_s_barrier()
#define PG8_SCHED __builtin_amdgcn_sched_barrier(0)
    Unit cur, nxt; int ui = 0;
    if (!S.next(0, cur)) return;
    f32x4 acc[2][2][4][2];
#pragma unroll
    for (int a = 0; a < 2; ++a)
#pragma unroll
        for (int b = 0; b < 2; ++b)
#pragma unroll
            for (int m = 0; m < 4; ++m)
#pragma unroll
                for (int n = 0; n < 2; ++n) acc[a][b][m][n] = (f32x4){0.f, 0.f, 0.f, 0.f};
    bf16x8 At[4][2], B0[2][2], B1[2][2];
    const char* cA = (const char*)g.A + (size_t)cur.pm * tstepA + (size_t)cur.kt0 * kstepA; const char* cB = (const char*)g.Bt + (size_t)cur.pm * g.bpm + (size_t)cur.pn * tstepB + (size_t)cur.kt0 * kstepB;
    int nt = cur.nkt;
    S.a_ready(cur);
    if constexpr (SP2) {
        PG8_STAGE(PG8_SB(0, 0), cB, voffB); PG8_STAGE(PG8_SB(0, 1), cB + hstepB, voffB); PG8_STAGE(PG8_SA(0, 0), cA, voffA); PG8_STAGE(PG8_SA(0, 1), cA + hstepA, voffA);
        if (wr == 1) PG8_BAR;
        PG8_WAIT_V(2); PG8_BAR;
        PG8_STAGE(PG8_SB(1, 0), cB + kstepB, voffB); PG8_STAGE(PG8_SA(1, 0), cA + kstepA, voffA); PG8_STAGE(PG8_SB(1, 1), cB + hstepB + kstepB, voffB);
        PG8_WAIT_V(6); PG8_BAR;
    } else {
        PG8_STAGE(PG8_SB(0, 0), cB, voffB); PG8_STAGE(PG8_SA(0, 0), cA, voffA); PG8_STAGE(PG8_SB(0, 1), cB + hstepB, voffB); PG8_STAGE(PG8_SA(0, 1), cA + hstepA, voffA);
        if (wr == 1) PG8_BAR;
        PG8_WAIT_V(4); PG8_BAR;
        PG8_STAGE(PG8_SB(1, 0), cB + kstepB, voffB); PG8_STAGE(PG8_SA(1, 0), cA + kstepA, voffA); PG8_STAGE(PG8_SB(1, 1), cB + hstepB + kstepB, voffB);
        PG8_WAIT_V(6); PG8_BAR;
    }
    for (;;) {
        const bool has_next = S.next(ui + 1, nxt);
        const char* nA = has_next ? (const char*)g.A + (size_t)nxt.pm * tstepA + (size_t)nxt.kt0 * kstepA : cA; const char* nB = has_next ? (const char*)g.Bt + (size_t)nxt.pm * g.bpm + (size_t)nxt.pn * tstepB + (size_t)nxt.kt0 * kstepB : cB;
        for (int t = 0; t < nt; t += 2) {
            const bool last = (t == nt - 2);
            const char* a1 = cA + (size_t)(t + 1) * kstepA;
            const char* a2 = last ? nA : cA + (size_t)(t + 2) * kstepA; const char* b2 = last ? nB : cB + (size_t)(t + 2) * kstepB;
            const char* a3 = a2 + kstepA; const char* b3 = b2 + kstepB;
            if (last && has_next) S.a_ready(nxt);
            if constexpr (SP2) {
            PG8_LDB(B0, 0, 0); PG8_LDB(B1, 0, 1); PG8_SCHED; PG8_LDA(At, 0, 0); PG8_STAGE(PG8_SA(1, 1), a1 + hstepA, voffA);
            PG8_WAIT_V(8); PG8_WAIT_L(0); PG8_BAR; PG8_MMA(0, 0, At, B0); PG8_MMA(0, 1, At, B1); PG8_BAR; PG8_SCHED;
            PG8_LDA(At, 0, 1); PG8_STAGE(PG8_SB(0, 0), b2, voffB); PG8_STAGE(PG8_SB(0, 1), b2 + hstepB, voffB); PG8_STAGE(PG8_SA(0, 0), a2, voffA);
            PG8_WAIT_V(8); PG8_WAIT_L(0); PG8_BAR; PG8_MMA(1, 0, At, B0); PG8_MMA(1, 1, At, B1); PG8_BAR; PG8_SCHED;
            PG8_LDB(B0, 1, 0); PG8_LDB(B1, 1, 1); PG8_SCHED; PG8_LDA(At, 1, 0); PG8_STAGE(PG8_SA(0, 1), a2 + hstepA, voffA);
            PG8_WAIT_V(8); PG8_WAIT_L(0); PG8_BAR; PG8_MMA(0, 0, At, B0); PG8_MMA(0, 1, At, B1); PG8_BAR; PG8_SCHED;
            PG8_LDA(At, 1, 1); PG8_STAGE(PG8_SB(1, 0), b3, voffB); PG8_STAGE(PG8_SB(1, 1), b3 + hstepB, voffB); PG8_STAGE(PG8_SA(1, 0), a3, voffA);
            PG8_WAIT_V(8); PG8_WAIT_L(0); PG8_BAR; PG8_MMA(1, 0, At, B0); PG8_MMA(1, 1, At, B1); PG8_BAR; PG8_SCHED;
            } else {
            PG8_LDB(B0, 0, 0); PG8_SCHED; PG8_LDA(At, 0, 0); PG8_STAGE(PG8_SA(1, 1), a1 + hstepA, voffA);
            PG8_WAIT_L(8); PG8_BAR; PG8_WAIT_L(0); PG8_MMA(0, 0, At, B0); PG8_BAR; PG8_SCHED;
            PG8_LDB(B1, 0, 1); PG8_STAGE(PG8_SB(0, 0), b2, voffB);
            PG8_BAR; PG8_WAIT_L(0); PG8_MMA(0, 1, At, B1); PG8_BAR;
            PG8_LDA(At, 0, 1); PG8_STAGE(PG8_SA(0, 0), a2, voffA);
            PG8_BAR; PG8_WAIT_L(0); PG8_MMA(1, 0, At, B0); PG8_BAR; PG8_SCHED;
            PG8_STAGE(PG8_SB(0, 1), b2 + hstepB, voffB);
            PG8_WAIT_V(6); PG8_BAR; PG8_MMA(1, 1, At, B1); PG8_BAR;
            PG8_LDB(B0, 1, 0); PG8_SCHED; PG8_LDA(At, 1, 0); PG8_STAGE(PG8_SA(0, 1), a2 + hstepA, voffA);
            PG8_WAIT_L(8); PG8_BAR; PG8_WAIT_L(0); PG8_MMA(0, 0, At, B0); PG8_BAR; PG8_SCHED;
            PG8_LDB(B1, 1, 1); PG8_STAGE(PG8_SB(1, 0), b3, voffB);
            PG8_BAR; PG8_WAIT_L(0); PG8_MMA(0, 1, At, B1); PG8_BAR;
            PG8_LDA(At, 1, 1); PG8_STAGE(PG8_SA(1, 0), a3, voffA);
            PG8_BAR; PG8_WAIT_L(0); PG8_MMA(1, 0, At, B0); PG8_BAR; PG8_SCHED;
            PG8_STAGE(PG8_SB(1, 1), b3 + hstepB, voffB);
            PG8_WAIT_V(6); PG8_BAR; PG8_MMA(1, 1, At, B1); PG8_BAR;
            }
        }
        if constexpr (ALIGN_EPI) { if (wr == 0) PG8_BAR; }
        if constexpr (!Epi::AFTER_DRAIN) { E(acc, cur, wr, wc, fr, fq); S.done(cur); }
        if (!has_next) break;
#pragma unroll
        for (int a = 0; a < 2; ++a)
#pragma unroll
            for (int b = 0; b < 2; ++b)
#pragma unroll
                for (int m = 0; m < 4; ++m)
#pragma unroll
                    for (int n = 0; n < 2; ++n) acc[a][b][m][n] = (f32x4){0.f, 0.f, 0.f, 0.f};
        cur = nxt; cA = nA; cB = nB; nt = cur.nkt; ++ui;
        if constexpr (ALIGN_EPI) { if (wr == 1) PG8_BAR; }
    }
    PG8_WAIT_V(0);
    if constexpr (!ALIGN_EPI) { if (wr == 0) PG8_BAR; }
    PG8_BAR;
#undef PG8_SA
#undef PG8_SB
#undef PG8_STAGE
#undef PG8_LDA
#undef PG8_LDB
#undef PG8_MMA
#undef PG8_WAIT_V
#undef PG8_WAIT_L
#undef PG8_BAR
#undef PG8_SCHED
}
}

namespace att {
typedef unsigned short bf16;
constexpr int   D = 128, NW = 8, QBLK = 32, KVBLK = 64;
constexpr float SCALE = 0.088388347648318440f;
constexpr float THR = 8.f;
constexpr int LDQ = 1024, LDK = 256, LDO = 2560;
constexpr size_t SHM_V = KVBLK * D * 2, SHM_K = KVBLK * D * 2, SHM_ATTN = 2 * SHM_V + 2 * SHM_K + NW * 64 * 4;
using bf16x8 = __attribute__((ext_vector_type(8))) short;
using s16x4  = __attribute__((ext_vector_type(4))) short;
using f32x16 = __attribute__((ext_vector_type(16))) float;
using u32x4  = __attribute__((ext_vector_type(4))) unsigned;
#define KSWZ(row, colB) ((row) * 256 + ((colB) ^ (((row) & 7) << 4)))
#define SBAR() __builtin_amdgcn_sched_barrier(0)
__device__ __forceinline__ int crow(int r, int hi) { return (r & 3) + 8 * (r >> 2) + 4 * hi; }
__device__ __forceinline__ unsigned cvtpk(float lo, float hi) { unsigned r; asm volatile("v_cvt_pk_bf16_f32 %0, %1, %2" : "=v"(r) : "v"(lo), "v"(hi)); return r; }
__device__ __forceinline__ bf16x8 ld8(const bf16* p) { return *reinterpret_cast<const bf16x8*>(p); }

__device__ __forceinline__ void partialSM(f32x16& p0, f32x16& p1, float& m_reg, float& mn, float& alpha) {
  constexpr float C = SCALE * 1.4426950408889634f;
  float pmax = p0[0]; for (int r = 1; r < 16; ++r) pmax = fmaxf(pmax, p0[r]); for (int r = 0; r < 16; ++r) pmax = fmaxf(pmax, p1[r]);
  { auto rr = __builtin_amdgcn_permlane32_swap(__float_as_uint(pmax), __float_as_uint(pmax), false, false);
    pmax = fmaxf(__uint_as_float(rr[0]), __uint_as_float(rr[1])); }
  if (__builtin_expect(__all(pmax - m_reg <= THR / SCALE), 1)) { mn = m_reg; alpha = 1.f; }
  else { mn = fmaxf(m_reg, pmax); alpha = __builtin_amdgcn_exp2f((m_reg - mn) * C); m_reg = mn; }
  float mnC = -mn * C;
  for (int r = 0; r < 16; ++r) p0[r] = fmaf(p0[r], C, mnC); for (int r = 0; r < 16; ++r) p1[r] = fmaf(p1[r], C, mnC);
  for (int r = 0; r < 16; ++r) p0[r] = __builtin_amdgcn_exp2f(p0[r]);
}
__device__ __forceinline__ void finishSM(f32x16& p0, f32x16& p1, float alpha, float& l_reg, bf16x8& pa0, bf16x8& pa1, bf16x8& pa2, bf16x8& pa3) {
  for (int r = 0; r < 16; ++r) p1[r] = __builtin_amdgcn_exp2f(p1[r]);
  float ps = 0; for (int r = 0; r < 16; ++r) ps += p0[r]; for (int r = 0; r < 16; ++r) ps += p1[r];
  { auto rr = __builtin_amdgcn_permlane32_swap(__float_as_uint(ps), __float_as_uint(ps), false, false);
    ps = __uint_as_float(rr[0]) + __uint_as_float(rr[1]); }
  l_reg = l_reg * alpha + ps;
#define PK4(P, BASE, OUT) do { unsigned a0 = cvtpk(P[BASE + 0], P[BASE + 1]), a1 = cvtpk(P[BASE + 2], P[BASE + 3]);   \
    unsigned b0 = cvtpk(P[BASE + 4], P[BASE + 5]), b1 = cvtpk(P[BASE + 6], P[BASE + 7]);                              \
    auto r0 = __builtin_amdgcn_permlane32_swap(a0, b0, false, false); auto r1 = __builtin_amdgcn_permlane32_swap(a1, b1, false, false); \
    u32x4 w = {r0[0], r1[0], r0[1], r1[1]}; OUT = *reinterpret_cast<bf16x8*>(&w); } while (0)
  PK4(p0, 0, pa0); PK4(p0, 8, pa1); PK4(p1, 0, pa2); PK4(p1, 8, pa3);
#undef PK4
}
__device__ __forceinline__ void qkt(f32x16& p0, f32x16& p1, const bf16* Ks, const bf16x8* qr, int r32, int hi) {
  p0 = f32x16{}; p1 = f32x16{};
  for (int d0 = 0; d0 < 8; ++d0) { int cb = (d0 * 16 + hi * 8) * 2;
    bf16x8 b0 = *reinterpret_cast<const bf16x8*>((const char*)Ks + KSWZ(r32, cb));
    bf16x8 b1 = *reinterpret_cast<const bf16x8*>((const char*)Ks + KSWZ(32 + r32, cb));
    p0 = __builtin_amdgcn_mfma_f32_32x32x16_bf16(b0, qr[d0], p0, 0, 0, 0);
    p1 = __builtin_amdgcn_mfma_f32_32x32x16_bf16(b1, qr[d0], p1, 0, 0, 0); }
}
__device__ __forceinline__ int v_st(int k, int c) { const int kk = (k & ~0xC) | ((k & 4) << 1) | ((k & 8) >> 1); return ((kk >> 3) * 4 + (c >> 5)) * 512 + ((kk & 7) * 32 + (c & 31)) * 2; }
__device__ __forceinline__ int v_rd_base(int lane) { return ((lane & 3) << 3) | (((lane >> 2) & 3) << 6) | (((lane >> 4) & 1) << 5) | (((lane >> 5) & 1) << 8); }
constexpr int v_rd_off(int d0, int ks, int half) { return d0 * 512 + ks * 4096 + half * 2048; }
template <int OFF> __device__ __forceinline__ s16x4 tr_read(int vb) {
  s16x4 r; asm volatile("ds_read_b64_tr_b16 %0, %1 offset:%2" : "=&v"(r) : "v"(vb), "i"(OFF) : "memory"); return r;
}
template <int D0> __device__ __forceinline__ void pv_one(f32x16& od, int vb, bf16x8 pa0, bf16x8 pa1, bf16x8 pa2, bf16x8 pa3) {
  const s16x4 l0 = tr_read<v_rd_off(D0, 0, 0)>(vb), h0 = tr_read<v_rd_off(D0, 0, 1)>(vb), l1 = tr_read<v_rd_off(D0, 1, 0)>(vb), h1 = tr_read<v_rd_off(D0, 1, 1)>(vb);
  const s16x4 l2 = tr_read<v_rd_off(D0, 2, 0)>(vb), h2 = tr_read<v_rd_off(D0, 2, 1)>(vb), l3 = tr_read<v_rd_off(D0, 3, 0)>(vb), h3 = tr_read<v_rd_off(D0, 3, 1)>(vb);
  asm volatile("s_waitcnt lgkmcnt(0)" ::: "memory"); SBAR();
#define PK(L, H) (bf16x8){L[0], L[1], L[2], L[3], H[0], H[1], H[2], H[3]}
  od = __builtin_amdgcn_mfma_f32_32x32x16_bf16(pa0, PK(l0, h0), od, 0, 0, 0);
  od = __builtin_amdgcn_mfma_f32_32x32x16_bf16(pa1, PK(l1, h1), od, 0, 0, 0);
  od = __builtin_amdgcn_mfma_f32_32x32x16_bf16(pa2, PK(l2, h2), od, 0, 0, 0);
  od = __builtin_amdgcn_mfma_f32_32x32x16_bf16(pa3, PK(l3, h3), od, 0, 0, 0);
#undef PK
}
__device__ __forceinline__ void pv_d0(f32x16* o, int vb, bf16x8 pa0, bf16x8 pa1, bf16x8 pa2, bf16x8 pa3) {
  pv_one<0>(o[0], vb, pa0, pa1, pa2, pa3); pv_one<1>(o[1], vb, pa0, pa1, pa2, pa3); pv_one<2>(o[2], vb, pa0, pa1, pa2, pa3); pv_one<3>(o[3], vb, pa0, pa1, pa2, pa3);
}

__device__ __forceinline__ void attn_dense_body(const bf16* __restrict__ Qb, const bf16* __restrict__ Kh, const bf16* __restrict__ Vh,
                                                bf16* __restrict__ Ob, int seq, char* lds) {
  constexpr int SDEPTH = 2;
  int tid_ = threadIdx.x; asm volatile("" : "+v"(tid_));
  const int tid = tid_, wid = tid >> 6, lane = tid & 63, r32 = lane & 31, hi = lane >> 5;
  bf16* V_lds = (bf16*)lds; bf16* K_lds = (bf16*)(lds + 2 * SHM_V);
  float* ws = (float*)(lds + 2 * SHM_V + 2 * SHM_K) + wid * 64; float* li_l = ws; float* al_l = ws + 32;
  float m_reg = -1e30f, l_reg = 0; f32x16 o[4] = {}; bf16x8 qr[8];
  const bf16* Qw = Qb + (long)(wid * QBLK + r32) * LDQ + hi * 8;
#pragma unroll
  for (int d0 = 0; d0 < 8; ++d0) qr[d0] = ld8(Qw + d0 * 16);
  const int sr = tid >> 4, sc = (tid & 15) * 8, vst0 = v_st(sr, sc), vst1 = v_st(32 + sr, sc);
  const int vb0 = (int)(uintptr_t)V_lds + v_rd_base(lane);
  struct { bf16x8 vs0, vs1, ks0, ks1; } sr_[SDEPTH];
#define SLOAD(i, k0) do { sr_[i].vs0 = ld8(&Vh[(long)((k0) + sr) * LDK + sc]); sr_[i].vs1 = ld8(&Vh[(long)((k0) + 32 + sr) * LDK + sc]); \
    sr_[i].ks0 = ld8(&Kh[(long)((k0) + sr) * LDK + sc]); sr_[i].ks1 = ld8(&Kh[(long)((k0) + 32 + sr) * LDK + sc]); } while (0)
#define SWRITE(b, i) do { *(bf16x8*)((char*)V_lds + (b) * SHM_V + vst0) = sr_[i].vs0;          \
    *(bf16x8*)((char*)V_lds + (b) * SHM_V + vst1) = sr_[i].vs1; int kc = sc * 2;               \
    *(bf16x8*)((char*)K_lds + (b) * SHM_K + KSWZ(sr, kc)) = sr_[i].ks0;                       \
    *(bf16x8*)((char*)K_lds + (b) * SHM_K + KSWZ(32 + sr, kc)) = sr_[i].ks1; } while (0)
#define SWAIT() do { asm volatile("s_waitcnt vmcnt(4)" ::: "memory"); } while (0)
#define RESC(a) do { if (__any((a) < 1.f)) { if (hi == 0) al_l[r32] = (a); asm volatile("s_waitcnt lgkmcnt(0)" ::: "memory"); \
    for (int d = 0; d < 4; ++d) for (int r = 0; r < 16; ++r) o[d][r] *= al_l[crow(r, hi)]; } } while (0)
  f32x16 pA0, pA1, pB0, pB1; float mnA, mnB, alA, alB; bf16x8 pa0, pa1, pa2, pa3; const int NT = seq / KVBLK;
  constexpr int SE = 0, SO = SDEPTH - 1;
  SLOAD(SE, 0); asm volatile("s_waitcnt vmcnt(0)" ::: "memory"); SWRITE(0, SE); __syncthreads();
  qkt(pA0, pA1, K_lds, qr, r32, hi); partialSM(pA0, pA1, m_reg, mnA, alA);
  SLOAD(SO, KVBLK); if (2 < NT) SLOAD(SE, 2 * KVBLK);
  SWAIT(); SWRITE(1, SO); __syncthreads();
  for (int j = 1; j + 1 < NT; j += 2) {
    SBAR(); qkt(pB0, pB1, (bf16*)((char*)K_lds + SHM_K), qr, r32, hi);
    finishSM(pA0, pA1, alA, l_reg, pa0, pa1, pa2, pa3); SBAR();
    SLOAD(SO, (j + SDEPTH) * KVBLK); SBAR();
    pv_d0(o, vb0, pa0, pa1, pa2, pa3); partialSM(pB0, pB1, m_reg, mnB, alB);
    __syncthreads(); SWAIT(); SWRITE(0, SE);
    RESC(alB); __syncthreads();
    SBAR(); qkt(pA0, pA1, K_lds, qr, r32, hi);
    finishSM(pB0, pB1, alB, l_reg, pa0, pa1, pa2, pa3); SBAR();
    if (j + 3 < NT) SLOAD(SE, (j + 1 + SDEPTH) * KVBLK); SBAR();
    pv_d0(o, vb0 + (int)SHM_V, pa0, pa1, pa2, pa3); partialSM(pA0, pA1, m_reg, mnA, alA);
    __syncthreads(); SWAIT(); SWRITE(1, SO);
    RESC(alA); __syncthreads();
  }
  SBAR(); qkt(pB0, pB1, (bf16*)((char*)K_lds + SHM_K), qr, r32, hi);
  finishSM(pA0, pA1, alA, l_reg, pa0, pa1, pa2, pa3); SBAR();
  pv_d0(o, vb0, pa0, pa1, pa2, pa3); partialSM(pB0, pB1, m_reg, mnB, alB);
  __syncthreads(); RESC(alB);
  finishSM(pB0, pB1, alB, l_reg, pa0, pa1, pa2, pa3); SBAR();
  pv_d0(o, vb0 + (int)SHM_V, pa0, pa1, pa2, pa3);
  if (hi == 0) li_l[r32] = l_reg; asm volatile("s_waitcnt lgkmcnt(0)" ::: "memory");
  float rli[16];
#pragma unroll
  for (int r = 0; r < 16; ++r) rli[r] = __builtin_amdgcn_rcpf(li_l[crow(r, hi)]);
  bf16* Ow = Ob + (long)(wid * QBLK) * LDO;
#pragma unroll
  for (int r = 0; r < 16; ++r) { int orow = crow(r, hi);
#pragma unroll
    for (int d0 = 0; d0 < 4; ++d0) { const float val = o[d0][r] * rli[r]; Ow[(long)orow * LDO + d0 * 32 + r32] = (bf16)(cvtpk(val, val) & 0xffffu); } }
  __syncthreads();
#undef SLOAD
#undef SWRITE
#undef SWAIT
#undef RESC
}
#undef KSWZ
#undef SBAR
}

constexpr int NWAVES = 8, NTHR = 512;
constexpr int DM = 2048, NB = 4, SEQ = 4096, DEPTH = 4, CTXL = 256;
constexpr int ML = NB * SEQ, MC = NB * CTXL, MT = ML + MC;
constexpr int SKV = CTXL + SEQ;
constexpr int INW_SRC = 4608, PW = 5120;
constexpr int PQ = 0, PK = 1024, PV = 1280, PFA = 1536, PFB = 2048, PCB = 2560, PCC = 3072, PCH = 3584, PGU = 4096, PGV = 4608;
constexpr int MIXW = 2560, MX_ATT = 0, MX_FOUR = 1024, MX_CONV = 1536, MX_GM = 2048;
constexpr int DFF = 5632, UPW = 2 * DFF;
constexpr int NMOD = 6 * DM;
constexpr float EPS = 1e-6f;

constexpr size_t al256(size_t x) { return (x + 255) / 256 * 256; }
constexpr size_t WS_CTL = 0, CTL_ZERO_BYTES = 1u << 20;
constexpr size_t WS_WIN  = CTL_ZERO_BYTES;
constexpr size_t WS_WOUT = WS_WIN  + (size_t)DEPTH * PW * DM * 2;
constexpr size_t WS_WUP  = WS_WOUT + (size_t)DEPTH * DM * MIXW * 2;
constexpr size_t WS_WDN  = WS_WUP  + (size_t)DEPTH * UPW * DM * 2;
constexpr size_t WS_FN   = WS_WDN  + (size_t)DEPTH * DM * DFF * 2;
constexpr size_t WS_A1   = WS_FN;
constexpr size_t WS_A2   = WS_A1   + (size_t)256 * 256 * 2;
constexpr size_t WS_F256 = WS_A2   + (size_t)16 * 256 * 512 * 2;
constexpr size_t WS_MODP = WS_F256 + (size_t)256 * 512 * 2;
constexpr size_t WS_MOD  = WS_MODP + (size_t)16 * DEPTH * 5 * NMOD * 4;
constexpr size_t WS_ROPE = WS_MOD  + (size_t)DEPTH * 5 * NMOD * 4;
constexpr size_t WS_X    = WS_ROPE + 64 * 32 * 8;
constexpr size_t WS_H    = WS_X    + (size_t)MT * DM * 2;
constexpr size_t WS_R    = WS_H    + (size_t)MT * DM * 2;
constexpr size_t WS_P    = WS_R;
constexpr size_t WS_MIX  = WS_P    + (size_t)MT * PW * 2;
constexpr size_t WS_T1T  = WS_MIX  + (size_t)MT * MIXW * 2;
constexpr size_t WS_T1TC = WS_T1T  + (size_t)2048 * 8192 * 2;
constexpr size_t WS_KB   = WS_T1TC + (size_t)2048 * 512 * 2;
constexpr size_t WS_VB   = WS_KB   + (size_t)NB * SKV * 256 * 2;
constexpr size_t WS_QB   = WS_VB   + (size_t)NB * SKV * 256 * 2;
constexpr size_t WS_UB   = WS_QB   + (size_t)MT * 1024 * 2;
constexpr size_t WS_V2B  = WS_UB   + (size_t)MT * 512 * 2;
constexpr size_t WS_S2IN = WS_V2B  + (size_t)MT * 512 * 2;
constexpr size_t WS_RA_END = WS_S2IN + (size_t)16 * 2048 * 512 * 2;
constexpr size_t WS_ACT  = WS_R;
constexpr size_t WS_ACT_END = WS_ACT + (size_t)MT * DFF * 2;
constexpr size_t WS_R_END = WS_RA_END > WS_ACT_END ? WS_RA_END : WS_ACT_END;
constexpr size_t WS_EDGE = WS_R_END;
constexpr size_t WS_XP   = WS_EDGE + (size_t)(MT / 256) * 6 * DFF * 4;
constexpr size_t WS_END  = WS_XP   + (size_t)4 * MC * DM * 4;
static_assert(WS_END <= 1600000000ull, "d_ws budget");
static_assert(WS_WIN % 256 == 0 && WS_FN % 256 == 0 && WS_X % 256 == 0 && WS_H % 256 == 0 && WS_P % 256 == 0 && WS_MIX % 256 == 0 && WS_T1T % 256 == 0 && WS_KB % 256 == 0 && WS_ACT % 256 == 0 && WS_MOD % 256 == 0, "alignment");
constexpr int CW_TMO = 0, CW_BAR = 4096;

constexpr int RING_BYTES = 131072;
constexpr int LDSCTL_OFF = RING_BYTES, MISC_OFF = LDSCTL_OFF + 320;
constexpr int XL_OFF = RING_BYTES + 1024;
constexpr int LDS_BYTES = 147456;

#define GAS __attribute__((address_space(1)))
#define LAS __attribute__((address_space(3)))
typedef unsigned short bf16;
typedef unsigned v4u __attribute__((ext_vector_type(4)));
typedef unsigned v2u __attribute__((ext_vector_type(2)));
typedef float f32x4 __attribute__((ext_vector_type(4)));
typedef float f32x2 __attribute__((ext_vector_type(2)));
#define RLX_AGENT __ATOMIC_RELAXED, __HIP_MEMORY_SCOPE_AGENT
#define LDS_WAIT() asm volatile("s_waitcnt lgkmcnt(0)" ::: "memory")
#define VM_WAIT() asm volatile("s_waitcnt vmcnt(0)" ::: "memory")
__device__ __forceinline__ unsigned pk2(float lo, float hi) { unsigned r; asm volatile("v_cvt_pk_bf16_f32 %0, %1, %2" : "=v"(r) : "v"(lo), "v"(hi)); return r; }
__device__ __forceinline__ float bflo(unsigned w) { return __uint_as_float(w << 16); }
__device__ __forceinline__ float bfhi(unsigned w) { return __uint_as_float(w & 0xffff0000u); }
__device__ __forceinline__ void unpack8(const v4u w, float (&x)[8]) { x[0] = bflo(w.x); x[1] = bfhi(w.x); x[2] = bflo(w.y); x[3] = bfhi(w.y); x[4] = bflo(w.z); x[5] = bfhi(w.z); x[6] = bflo(w.w); x[7] = bfhi(w.w); }
__device__ __forceinline__ v4u pack8(const float (&x)[8]) { v4u w; w.x = pk2(x[0], x[1]); w.y = pk2(x[2], x[3]); w.z = pk2(x[4], x[5]); w.w = pk2(x[6], x[7]); return w; }
__device__ __forceinline__ float wave_sum(float v) {
#pragma unroll
    for (int o = 1; o < 64; o <<= 1) v += __shfl_xor(v, o);
    return v;
}
__device__ __forceinline__ float gelu_tanh(float x) { const float y = 0.7978845608028654f * (x + 0.044715f * x * x * x); return 0.5f * x * (1.f + tanhf(y)); }

#define XB_TMO      128
#define XB_XCNT(j)  (256  + 64 * (j))
#define XB_XSUB(j)  (1280 + 64 * (j))
#define XB_XGEN(j)  (2304 + 64 * (j))
#define XB_TOP      3328
#define XB_TOPGEN   3392
#define XCD_BAR_WORDS 3456
#define XB_SPIN_CAP (1u << 18)
__device__ __forceinline__ unsigned xb_ld(unsigned* p)              { return __hip_atomic_load(p, __ATOMIC_RELAXED, __HIP_MEMORY_SCOPE_AGENT); }
__device__ __forceinline__ unsigned xb_add(unsigned* p, unsigned v) { return __hip_atomic_fetch_add(p, v, __ATOMIC_RELAXED, __HIP_MEMORY_SCOPE_AGENT); }
__device__ __forceinline__ unsigned xb_xcc_id() { return (unsigned)__builtin_amdgcn_s_getreg((3 << 11) | 20) & 0xFu; }
#define XB_SPIN(cond, bar) do { unsigned _sp = 0; while (cond) { __builtin_amdgcn_s_sleep(1); \
    if ((++_sp & 255u) == 0u) { if (xb_ld(&(bar)[XB_TMO])) break; if (_sp > XB_SPIN_CAP) { atomicAdd(&(bar)[XB_TMO], 1u); break; } } } } while (0)
struct XcdBarrier { unsigned* bar; unsigned x; volatile LAS unsigned* st; };
__device__ __forceinline__ XcdBarrier xcd_barrier_post(unsigned* bar, volatile LAS unsigned* st) {
    XcdBarrier b; b.bar = bar; b.x = xb_xcc_id(); b.st = st;
    if (threadIdx.x == 0) (void)xb_add(&bar[XB_XCNT(b.x)], 1u);
    return b;
}
__device__ __forceinline__ void xcd_barrier_complete(unsigned* bar, unsigned x, unsigned& nloc, unsigned& nx) {
    const unsigned G = gridDim.x * gridDim.y * gridDim.z;
    unsigned sum, cnt, mine, sp = 0u;
    for (;;) {
        sum = 0u; cnt = 0u; mine = 0u;
#pragma unroll
        for (unsigned j = 0; j < 16; ++j) { const unsigned c = xb_ld(&bar[XB_XCNT(j)]); sum += c; cnt += (c > 0u) ? 1u : 0u; mine = (j == x) ? c : mine; }
        if (sum == G) break;
        __builtin_amdgcn_s_sleep(1);
        if ((++sp & 255u) == 0u) { if (xb_ld(&bar[XB_TMO])) break; if (sp > XB_SPIN_CAP) { atomicAdd(&bar[XB_TMO], 1u); break; } }
    }
    nloc = mine > 0u ? mine : 1u; nx = cnt > 0u ? cnt : 1u;
}
__device__ __forceinline__ void xcd_barrier(const XcdBarrier& b) {
    asm volatile("s_waitcnt vmcnt(0)" ::: "memory");
    __syncthreads();
    if (threadIdx.x == 0) {
        unsigned* bar = b.bar;
        __builtin_amdgcn_s_waitcnt(0);
        unsigned nloc = b.st[0], nx = b.st[1];
        if (nloc == 0u) { xcd_barrier_complete(bar, b.x, nloc, nx); b.st[0] = nloc; b.st[1] = nx; }
        const unsigned old = xb_add(&bar[XB_XSUB(b.x)], 1u);
        const unsigned gen = old / nloc;
        if (old + 1u == (gen + 1u) * nloc) {
            __builtin_amdgcn_fence(__ATOMIC_RELEASE, "agent");
            asm volatile("s_waitcnt vmcnt(0)" ::: "memory");
            const unsigned og = xb_add(&bar[XB_TOP], 1u);
            const unsigned tg = og / nx;
            if (og + 1u == (tg + 1u) * nx) xb_add(&bar[XB_TOPGEN], 1u);
            else XB_SPIN(xb_ld(&bar[XB_TOPGEN]) == tg, bar);
            __builtin_amdgcn_fence(__ATOMIC_ACQUIRE, "agent");
            xb_add(&bar[XB_XGEN(b.x)], 1u);
            asm volatile("s_waitcnt vmcnt(0)" ::: "memory");
        } else {
            XB_SPIN(xb_ld(&bar[XB_XGEN(b.x)]) == gen, bar);
            __builtin_amdgcn_fence(__ATOMIC_ACQUIRE, "agent");
            asm volatile("s_waitcnt vmcnt(0)" ::: "memory");
        }
    }
    __syncthreads();
}

struct Args { const float* in[22]; float* out; unsigned char* ws; int ph_lo, ph_hi; };
enum { I_X = 0, I_C, I_CTX, I_CCTX, I_WMOD, I_BMOD, I_N1G, I_N2G, I_WIN, I_QG, I_KG, I_CONVW, I_LNG, I_LNB, I_GMWS, I_GMB, I_WOUT, I_WUP, I_FCW, I_FCB, I_WDN, I_FNG };

typedef const Args __attribute__((address_space(4)))* KArgs;
__device__ __forceinline__ KArgs kargs() { KArgs p = (KArgs)__builtin_amdgcn_kernarg_segment_ptr(); asm volatile("" : "+s"(p)); return p; }
struct Frame {
    LAS unsigned char* lds;
    int tid, lane, wave, G, bx, gw, ngw;
    unsigned char* ws;
};
__device__ __forceinline__ Frame make_frame(KArgs a) {
    extern __shared__ __attribute__((aligned(16))) unsigned char lds_[];
    Frame F; int t = threadIdx.x; asm volatile("" : "+v"(t));
    F.lds = (LAS unsigned char*)lds_; F.tid = t; F.lane = t & 63; F.wave = __builtin_amdgcn_readfirstlane(t >> 6);
    F.G = gridDim.x; F.bx = blockIdx.x; F.gw = F.bx * NWAVES + F.wave; F.ngw = F.G * NWAVES; F.ws = a->ws;
    return F;
}

__device__ __forceinline__ size_t toff(int n, int k, int K) { return ((size_t)(n >> 8) * (K >> 6) + (k >> 6)) * 16384 + (size_t)(n & 255) * 64 + (k & 63); }
__device__ __forceinline__ void transpose_item(const float* W, int ldw, int k0, int ns0, bf16* WT, int ldt, int nd0, LAS float* scr, int lane) {
    f32x4 v[8];
#pragma unroll
    for (int i = 0; i < 8; ++i) v[i] = *(const f32x4*)(W + (size_t)(k0 + i * 8 + (lane >> 3)) * ldw + ns0 + (lane & 7) * 4);
#pragma unroll
    for (int i = 0; i < 8; ++i) { LAS float* d = scr + (i * 8 + (lane >> 3)) * 33 + (lane & 7) * 4; d[0] = v[i].x; d[1] = v[i].y; d[2] = v[i].z; d[3] = v[i].w; }
    LDS_WAIT(); asm volatile("" ::: "memory");
    const int c = lane & 7;
#pragma unroll
    for (int j = 0; j < 4; ++j) { const int n = (lane >> 3) + 8 * j; const LAS float* s = scr + (8 * c) * 33 + n;
        v4u o; o.x = pk2(s[0 * 33], s[1 * 33]); o.y = pk2(s[2 * 33], s[3 * 33]); o.z = pk2(s[4 * 33], s[5 * 33]); o.w = pk2(s[6 * 33], s[7 * 33]);
        *(v4u*)(WT + toff(nd0 + n, k0 + 8 * c, ldt)) = o; }
    LDS_WAIT(); asm volatile("" ::: "memory");
}

__device__ __forceinline__ void p0a_prologue(KArgs a) {
    Frame F = make_frame(a); unsigned char* ws = F.ws;
    {
        LAS float* scr = (LAS float*)(F.lds + F.wave * 16384);
        constexpr int I_IN = 32 * 128, I_OUT = 40 * 64, I_UP = 32 * 352, I_DN = 88 * 64, I_L = I_IN + I_OUT + I_UP + I_DN;
        for (int it = F.gw; it < DEPTH * I_L; it += F.ngw) {
            const int l = it / I_L; int r = it % I_L;
            if (r < I_IN) { const int kb = r / 128, nb = r % 128; const int ns0 = nb < 48 ? nb * 32 : 2048 + (nb - 48) * 32; const int nd0 = nb < 48 ? ns0 : ns0 + 512;
                transpose_item(a->in[I_WIN] + (size_t)l * DM * INW_SRC, INW_SRC, kb * 64, ns0, (bf16*)(ws + WS_WIN) + (size_t)l * PW * DM, DM, nd0, scr, F.lane); continue; }
            r -= I_IN;
            if (r < I_OUT) { const int kb = r / 64, nb = r % 64;
                transpose_item(a->in[I_WOUT] + (size_t)l * MIXW * DM, DM, kb * 64, nb * 32, (bf16*)(ws + WS_WOUT) + (size_t)l * DM * MIXW, MIXW, nb * 32, scr, F.lane); continue; }
            r -= I_OUT;
            if (r < I_UP) { const int kb = r / 352, nb = r % 352; const int nd0 = nb * 32, ns0 = ((nd0 >> 7) & 1) * DFF + (nd0 >> 8) * 128 + (nd0 & 127);
                transpose_item(a->in[I_WUP] + (size_t)l * DM * UPW, UPW, kb * 64, ns0, (bf16*)(ws + WS_WUP) + (size_t)l * UPW * DM, DM, nb * 32, scr, F.lane); continue; }
            r -= I_UP;
            { const int kb = r / 64, nb = r % 64;
                transpose_item(a->in[I_WDN] + (size_t)l * DFF * DM, DM, kb * 64, nb * 32, (bf16*)(ws + WS_WDN) + (size_t)l * DM * DFF, DFF, nb * 32, scr, F.lane); }
        }
    }
    __syncthreads();
    {
        LAS float* sl = (LAS float*)F.lds;
        for (int i = F.tid; i < 5 * DM; i += NTHR) { const int v = i / DM, k = i % DM; const float cv = v < 4 ? a->in[I_C][v * DM + k] : a->in[I_CCTX][k]; sl[i] = cv / (1.f + expf(-cv)); }
        __syncthreads();
        float* MODP = (float*)(ws + WS_MODP);
        for (int it = F.gw; it < DEPTH * 16 * 48; it += F.ngw) {
            const int l = it / 768, r = it % 768, ks = r / 48, cg = r % 48;
            const float* wp = a->in[I_WMOD] + ((size_t)l * DM + ks * 128) * NMOD + cg * 256 + F.lane * 4;
            f32x4 acc[5];
#pragma unroll
            for (int v = 0; v < 5; ++v) acc[v] = (f32x4){0.f, 0.f, 0.f, 0.f};
            for (int k = 0; k < 128; k += 8) {
                f32x4 w[8];
#pragma unroll
                for (int u = 0; u < 8; ++u) w[u] = *(const f32x4*)(wp + (size_t)(k + u) * NMOD);
#pragma unroll
                for (int u = 0; u < 8; ++u)
#pragma unroll
                    for (int v = 0; v < 5; ++v) acc[v] += w[u] * sl[v * DM + ks * 128 + k + u];
            }
#pragma unroll
            for (int v = 0; v < 5; ++v) *(f32x4*)(MODP + ((size_t)ks * (DEPTH * 5) + l * 5 + v) * NMOD + cg * 256 + F.lane * 4) = acc[v];
        }
    }
    __syncthreads();
    {
        LAS float* T128 = (LAS float*)F.lds;
        LAS float* Wl = (LAS float*)(F.lds + 1024);
        if (F.tid < 128) T128[F.tid] = cospif((float)F.tid * (1.f / 64.f));
        __syncthreads();
        for (int it = F.bx; it < DEPTH * 4 * 64; it += F.G) {
            const int l = it / 256, g = (it / 64) % 4, kb = it % 64;
            for (int i = F.tid; i < 32 * 128; i += NTHR) { const int kk = i / 128, dd = i % 128; Wl[i] = a->in[I_WIN][((size_t)l * DM + kb * 32 + kk) * INW_SRC + 1536 + g * 128 + dd]; }
            __syncthreads();
            const int dout = F.tid & 127, cs = (F.tid >> 7) & 1, kg = F.tid >> 8;
            float acc[16];
#pragma unroll
            for (int kk = 0; kk < 16; ++kk) acc[kk] = 0.f;
            for (int dd = 0; dd < 128; ++dd) {
                const float tr = T128[(dout * dd - (cs ? 32 : 0)) & 127];
#pragma unroll
                for (int kk = 0; kk < 16; ++kk) acc[kk] += Wl[(kg * 16 + kk) * 128 + dd] * tr;
            }
            bf16* dst = (bf16*)(ws + WS_WIN) + (size_t)l * PW * DM + toff(PFA + cs * 512 + g * 128 + dout, kb * 32 + kg * 16, DM);
            v4u o0, o1; o0.x = pk2(acc[0], acc[1]); o0.y = pk2(acc[2], acc[3]); o0.z = pk2(acc[4], acc[5]); o0.w = pk2(acc[6], acc[7]);
            o1.x = pk2(acc[8], acc[9]); o1.y = pk2(acc[10], acc[11]); o1.z = pk2(acc[12], acc[13]); o1.w = pk2(acc[14], acc[15]);
            *(v4u*)dst = o0; *(v4u*)(dst + 8) = o1;
            __syncthreads();
        }
    }
    __syncthreads();
    {
        LAS float* T = (LAS float*)F.lds;
        for (int i = F.tid; i < 4096; i += NTHR) T[i] = cospif((float)i * (1.f / 2048.f));
        __syncthreads();
        bf16* A1 = (bf16*)(ws + WS_A1);
        for (int idx = F.bx * NTHR + F.tid; idx < 256 * 32; idx += F.G * NTHR) {
            const int m = idx >> 5, kk0 = (idx & 31) * 8; const int cho = m >> 7, k2 = (m & 127) >> 1, ro = m & 1; float x[8];
#pragma unroll
            for (int e2 = 0; e2 < 8; ++e2) { const int kk = kk0 + e2, chi = kk >> 7, ri = (kk >> 6) & 1, aa = kk & 63;
                const float cs_ = T[(64 * k2 * aa) & 4095], sn_ = T[(64 * k2 * aa - 1024) & 4095];
                const float v = ro == 0 ? (ri == 0 ? cs_ : -sn_) : (ri == 0 ? -sn_ : -cs_);
                x[e2] = (cho == chi) ? v : 0.f; }
            *(v4u*)(A1 + (size_t)m * 256 + kk0) = pack8(x);
        }
        bf16* A2 = (bf16*)(ws + WS_A2);
        for (int idx = F.bx * NTHR + F.tid; idx < 16 * 256 * 64; idx += F.G * NTHR) {
            const int kk0 = (idx & 63) * 8, m = (idx >> 6) & 255, q = idx >> 14; const int k2p = m >> 6, k1 = m & 63, k = 4 * q + k2p + 64 * k1; float x[8];
#pragma unroll
            for (int e2 = 0; e2 < 8; ++e2) { const int kk = kk0 + e2, k2pp = kk >> 7, ro = (kk >> 6) & 1, c = kk & 63;
                const float v = ro == 0 ? T[(k * c) & 4095] : T[(k * c - 1024) & 4095];
                x[e2] = (k2pp == k2p) ? v : 0.f; }
            *(v4u*)(A2 + ((size_t)q * 256 + m) * 512 + kk0) = pack8(x);
        }
        bf16* F2 = (bf16*)(ws + WS_F256);
        for (int k = F.bx; k < 256; k += F.G) {
            if (F.tid < 64) { const int j0 = F.tid * 8; const int cs = j0 >> 8, t0 = j0 & 255; float x[8];
#pragma unroll
                for (int e = 0; e < 8; ++e) { const int m = (16 * k * (t0 + e) - (cs ? 1024 : 0)) & 4095; const float v = T[m]; x[e] = cs ? -v : v; }
                *(v4u*)(F2 + (size_t)k * 512 + j0) = pack8(x); }
        }
    }
    if (F.bx == 0) {
        f32x2* ROPE = (f32x2*)(ws + WS_ROPE);
        for (int i = F.tid; i < 64 * 32; i += NTHR) { const int pos = i >> 5, ii = i & 31; const float freq = powf(10000.f, -(float)(2 * ii) / 64.f); const float ang = (float)pos * freq;
            ROPE[i] = (f32x2){cosf(ang), sinf(ang)}; }
    }
    __syncthreads();
}

__device__ __forceinline__ void p0b_modreduce(KArgs a) {
    Frame F = make_frame(a);
    const float* MODP = (const float*)(F.ws + WS_MODP); float* MOD = (float*)(F.ws + WS_MOD);
    for (int i = F.bx * NTHR + F.tid; i < DEPTH * 5 * (NMOD / 4); i += F.G * NTHR) {
        const int j4 = i % (NMOD / 4), lv = i / (NMOD / 4), l = lv / 5;
        f32x4 s = *(const f32x4*)(a->in[I_BMOD] + (size_t)l * NMOD + j4 * 4);
#pragma unroll
        for (int ks = 0; ks < 16; ++ks) s += *(const f32x4*)(MODP + ((size_t)ks * (DEPTH * 5) + lv) * NMOD + j4 * 4);
        *(f32x4*)(MOD + (size_t)lv * NMOD + j4 * 4) = s;
    }
}

__device__ __forceinline__ void norm_phase(KArgs a, int M, const float* g, const float* modl, int shoff, int scoff, bool fold, bool lat_in, bool ctx_in) {
    Frame F = make_frame(a);
    bf16* X = (bf16*)(F.ws + WS_X); bf16* H = (bf16*)(F.ws + WS_H); const float* XP = (const float*)(F.ws + WS_XP);
    for (int row = F.gw; row < M; row += F.ngw) {
        const int v = row < ML ? row >> 12 : 4;
        const float* sh = modl + (size_t)v * NMOD + shoff; const float* sc = modl + (size_t)v * NMOD + scoff;
        v2u* xr = (v2u*)(X + (size_t)row * DM) + F.lane;
        f32x4 x[8]; float ss = 0.f;
        if (row < ML ? lat_in : ctx_in) { const f32x4* xs = (const f32x4*)(row < ML ? a->in[I_X] + (size_t)row * DM : a->in[I_CTX] + (size_t)(row - ML) * DM) + F.lane;
#pragma unroll
            for (int j = 0; j < 8; ++j) x[j] = xs[64 * j]; }
        else {
#pragma unroll
            for (int j = 0; j < 8; ++j) { const v2u w = xr[64 * j]; x[j] = (f32x4){bflo(w.x), bfhi(w.x), bflo(w.y), bfhi(w.y)}; } }
        if (fold && row >= ML) {
#pragma unroll
            for (int ks = 0; ks < 4; ++ks) { const f32x4* pr = (const f32x4*)(XP + ((size_t)ks * MC + (row - ML)) * DM) + F.lane;
#pragma unroll
                for (int j = 0; j < 8; ++j) x[j] += pr[64 * j]; }
#pragma unroll
            for (int j = 0; j < 8; ++j) { v2u w; w.x = pk2(x[j].x, x[j].y); w.y = pk2(x[j].z, x[j].w); xr[64 * j] = w; }
        }
#pragma unroll
        for (int j = 0; j < 8; ++j) ss += (x[j].x * x[j].x + x[j].y * x[j].y) + (x[j].z * x[j].z + x[j].w * x[j].w);
        const float rstd = 1.0f / sqrtf(wave_sum(ss) * (1.f / DM) + EPS);
#pragma unroll
        for (int j = 0; j < 8; ++j) { const int col = F.lane * 4 + 256 * j;
            const f32x4 gg = *(const f32x4*)(g + col), s1 = *(const f32x4*)(sc + col), s0 = *(const f32x4*)(sh + col);
            const f32x4 y = x[j] * rstd * gg * (s1 + 1.0f) + s0;
            v2u o; o.x = pk2(y.x, y.y); o.y = pk2(y.z, y.w);
            *(v2u*)(H + (size_t)row * DM + col) = o; }
    }
}

__device__ __forceinline__ void final_norm_phase(KArgs a, const float* g, float* out) {
    Frame F = make_frame(a);
    const bf16* X = (const bf16*)(F.ws + WS_X);
    for (int row = F.gw; row < ML; row += F.ngw) {
        const v2u* xr = (const v2u*)(X + (size_t)row * DM) + F.lane;
        f32x4 x[8]; float ss = 0.f;
#pragma unroll
        for (int j = 0; j < 8; ++j) { const v2u w = xr[64 * j]; x[j] = (f32x4){bflo(w.x), bfhi(w.x), bflo(w.y), bfhi(w.y)}; ss += (x[j].x * x[j].x + x[j].y * x[j].y) + (x[j].z * x[j].z + x[j].w * x[j].w); }
        const float rstd = 1.0f / sqrtf(wave_sum(ss) * (1.f / DM) + EPS);
#pragma unroll
        for (int j = 0; j < 8; ++j) { const int col = F.lane * 4 + 256 * j; const f32x4 gg = *(const f32x4*)(g + col);
            *(f32x4*)(out + (size_t)row * DM + col) = x[j] * rstd * gg; }
    }
}

__device__ __forceinline__ float gelu_fast(float x) { const float y = 1.5957691216057308f * (x + 0.044715f * x * x * x); return x * __builtin_amdgcn_rcpf(1.f + __expf(-y)); }

__device__ __forceinline__ void postA_phase(KArgs a, int l) {
    Frame F = make_frame(a); unsigned char* ws = F.ws;
    const bf16* P = (const bf16*)(ws + WS_P); bf16* MIX = (bf16*)(ws + WS_MIX); bf16* KB = (bf16*)(ws + WS_KB); bf16* VB = (bf16*)(ws + WS_VB);
    bf16* QB = (bf16*)(ws + WS_QB); bf16* UB = (bf16*)(ws + WS_UB); bf16* V2B = (bf16*)(ws + WS_V2B);
    const f32x4* ROPE4 = (const f32x4*)(ws + WS_ROPE);
    const int lane = F.lane, tid = F.tid;
    {
        const int hl = lane & 15, axis = hl >> 3, i0 = (lane & 3) * 8; const bool first = (lane & 7) < 4;
        float qg8[8], kg8[8], cw0[8], cw1[8], cw2[8], lg8[8], lb8[8];
        { const float* qg = a->in[I_QG] + l * 128 + hl * 8; const float* kg = a->in[I_KG] + l * 128 + hl * 8; const float* cw = a->in[I_CONVW] + (size_t)l * 3 * 512 + lane * 8;
          const float* lng = a->in[I_LNG] + l * 512 + lane * 8; const float* lnb = a->in[I_LNB] + l * 512 + lane * 8;
#pragma unroll
          for (int e = 0; e < 8; ++e) { qg8[e] = qg[e]; kg8[e] = kg[e]; cw0[e] = cw[e]; cw1[e] = cw[512 + e]; cw2[e] = cw[1024 + e]; lg8[e] = lng[e]; lb8[e] = lnb[e]; } }
        for (int row = F.gw; row < MT; row += F.ngw) {
            const bool is_ctx = row >= ML;
            const int b = is_ctx ? (row - ML) >> 8 : row >> 12, p = is_ctx ? (row - ML) & 255 : row & 4095, nseq = is_ctx ? CTXL : SEQ;
            const bool kv_only = is_ctx && (l == DEPTH - 1);
            const bf16* Pr = P + (size_t)row * PW;
            const int kvpos = is_ctx ? p : CTXL + p;
            const v4u rkv = *(const v4u*)(Pr + PK + lane * 8);
            f32x4 c4[4];
            if (!is_ctx) { const int posax = axis ? (p & 63) : (p >> 6);
#pragma unroll
                for (int e = 0; e < 4; ++e) c4[e] = ROPE4[posax * 16 + (i0 >> 1) + e]; }
            {
                float x[8]; unpack8(rkv, x); float ss = 0.f;
#pragma unroll
                for (int e = 0; e < 8; ++e) ss += x[e] * x[e];
                ss += __shfl_xor(ss, 1); ss += __shfl_xor(ss, 2); ss += __shfl_xor(ss, 4); ss += __shfl_xor(ss, 8);
                const float rstd = 1.0f / sqrtf(ss * (1.f / 128.f) + EPS);
                float y[8];
#pragma unroll
                for (int e = 0; e < 8; ++e) y[e] = x[e] * rstd * kg8[e];
                if (!is_ctx) {
#pragma unroll
                    for (int e = 0; e < 8; ++e) { const float pr = __shfl_xor(y[e], 4); const float cs_ = c4[e >> 1][(e & 1) * 2], sn_ = c4[e >> 1][(e & 1) * 2 + 1]; y[e] = first ? y[e] * cs_ - pr * sn_ : y[e] * cs_ + pr * sn_; } }
                if (lane < 32) *(v4u*)(KB + ((size_t)b * SKV + kvpos) * 256 + lane * 8) = pack8(y);
                else *(v4u*)(VB + ((size_t)b * SKV + kvpos) * 256 + (lane - 32) * 8) = rkv;
            }
            if (kv_only) continue;
            const v4u rq0 = *(const v4u*)(Pr + PQ + lane * 8), rq1 = *(const v4u*)(Pr + PQ + 512 + lane * 8);
            const v4u rcb = *(const v4u*)(Pr + PCB + lane * 8), rc0 = *(const v4u*)(Pr + PCC + lane * 8), rh0 = *(const v4u*)(Pr + PCH + lane * 8);
            const bool hp = p > 0, hn = p < nseq - 1;
            const bf16* Pm = hp ? Pr - PW : Pr; const bf16* Pn = hn ? Pr + PW : Pr;
            const v4u rcm = *(const v4u*)(Pm + PCC + lane * 8), rhm = *(const v4u*)(Pm + PCH + lane * 8), rcp = *(const v4u*)(Pn + PCC + lane * 8), rhp = *(const v4u*)(Pn + PCH + lane * 8);
            const v4u rgu = *(const v4u*)(Pr + PGU + lane * 8), rgv = *(const v4u*)(Pr + PGV + lane * 8);
#pragma unroll
            for (int part = 0; part < 2; ++part) {
                float x[8]; unpack8(part ? rq1 : rq0, x); float ss = 0.f;
#pragma unroll
                for (int e = 0; e < 8; ++e) ss += x[e] * x[e];
                ss += __shfl_xor(ss, 1); ss += __shfl_xor(ss, 2); ss += __shfl_xor(ss, 4); ss += __shfl_xor(ss, 8);
                const float rstd = 1.0f / sqrtf(ss * (1.f / 128.f) + EPS);
                float y[8];
#pragma unroll
                for (int e = 0; e < 8; ++e) y[e] = x[e] * rstd * qg8[e];
                if (!is_ctx) {
#pragma unroll
                    for (int e = 0; e < 8; ++e) { const float pr = __shfl_xor(y[e], 4); const float cs_ = c4[e >> 1][(e & 1) * 2], sn_ = c4[e >> 1][(e & 1) * 2 + 1]; y[e] = first ? y[e] * cs_ - pr * sn_ : y[e] * cs_ + pr * sn_; } }
                *(v4u*)(QB + (size_t)row * 1024 + part * 512 + lane * 8) = pack8(y);
            }
            {
                float cb[8], c0[8], h0[8], cm[8], hm[8], cp[8], hq[8], o[8];
                unpack8(rcb, cb); unpack8(rc0, c0); unpack8(rh0, h0); unpack8(rcm, cm); unpack8(rhm, hm); unpack8(rcp, cp); unpack8(rhp, hq);
                const float fp = hp ? 1.f : 0.f, fn = hn ? 1.f : 0.f;
#pragma unroll
                for (int e = 0; e < 8; ++e) o[e] = cb[e] * (cw0[e] * fp * (cm[e] * hm[e]) + cw1[e] * (c0[e] * h0[e]) + cw2[e] * fn * (cp[e] * hq[e]));
                *(v4u*)(MIX + (size_t)row * MIXW + MX_CONV + lane * 8) = pack8(o);
            }
            {
                float u[8], t[8]; unpack8(rgu, u); unpack8(rgv, t);
                float s = 0.f;
#pragma unroll
                for (int e = 0; e < 8; ++e) { u[e] = gelu_fast(u[e]); t[e] = gelu_fast(t[e]); s += t[e]; }
                const float mean = wave_sum(s) * (1.f / 512.f);
                float q = 0.f;
#pragma unroll
                for (int e = 0; e < 8; ++e) { t[e] -= mean; q += t[e] * t[e]; }
                const float rstd = 1.0f / sqrtf(wave_sum(q) * (1.f / 512.f) + EPS);
#pragma unroll
                for (int e = 0; e < 8; ++e) t[e] = t[e] * rstd * lg8[e] + lb8[e];
                *(v4u*)(UB + (size_t)row * 512 + lane * 8) = pack8(u); *(v4u*)(V2B + (size_t)row * 512 + lane * 8) = pack8(t);
            }
        }
    }
    {
        LAS unsigned* tb = (LAS unsigned*)F.lds;
        bf16* S1 = (bf16*)(ws + WS_T1T);
        for (int un = F.bx; un < 512; un += F.G) {
            const int ab = un >> 6, b = (un >> 4) & 3, slab = un & 15;
            const size_t rowb = (size_t)b * SEQ + (size_t)ab * 512;
#pragma unroll
            for (int it = 0; it < 4; ++it) {
                const int idx = tid + it * NTHR; const int j = idx & 3, c = (idx >> 2) & 63, c8 = idx >> 8;
                const bf16* src0 = P + (rowb + (size_t)(2 * j) * 64 + c) * PW + PFA + slab * 64 + c8 * 8;
                const v4u r0 = *(const v4u*)src0, r1 = *(const v4u*)(src0 + (size_t)64 * PW);
                const unsigned a0[4] = {r0.x, r0.y, r0.z, r0.w}, a1[4] = {r1.x, r1.y, r1.z, r1.w};
#pragma unroll
                for (int w = 0; w < 4; ++w) {
                    tb[((c8 * 8 + 2 * w) * 64 + c) * 4 + j]     = (a0[w] & 0xffffu) | (a1[w] << 16);
                    tb[((c8 * 8 + 2 * w + 1) * 64 + c) * 4 + j] = (a0[w] >> 16) | (a1[w] & 0xffff0000u);
                }
            }
            __syncthreads();
#pragma unroll
            for (int it = 0; it < 8; ++it) {
                const int idx = tid + it * NTHR; const int c = idx & 63, col = idx >> 6;
                const v4u o = *(const LAS v4u*)(tb + (col * 64 + c) * 4);
                const int gcol = slab * 64 + col, ri = gcol >> 9, n = b * 512 + (gcol & 511);
                *(v4u*)(S1 + ((((size_t)n * 32 + (c & 31)) * 2 + (c >> 5)) * 2 + ri) * 64 + ab * 8) = o;
            }
            __syncthreads();
        }
    }
    if (l < DEPTH - 1) {
        LAS unsigned* tb = (LAS unsigned*)F.lds;
        for (int un = F.bx; un < 32; un += F.G) {
            const int chc = un >> 2, slab = un & 3;
            const int b = chc >> 1, p0 = (chc & 1) * 128;
            const int row0 = ML + b * CTXL + p0;
            bf16* T1 = (bf16*)(ws + WS_T1TC);
#pragma unroll
            for (int it = 0; it < 4; ++it) {
                const int q = tid + it * NTHR;
                const int c8 = ((q >> 6) & 3) * 8 + (q & 7), rp = (q >> 8) * 8 + ((q >> 3) & 7);
                const v4u r0 = *(const v4u*)(P + (size_t)(row0 + 2 * rp) * PW + PFA + slab * 256 + c8 * 8);
                const v4u r1 = *(const v4u*)(P + (size_t)(row0 + 2 * rp + 1) * PW + PFA + slab * 256 + c8 * 8);
                const unsigned a0[4] = {r0.x, r0.y, r0.z, r0.w}, a1[4] = {r1.x, r1.y, r1.z, r1.w};
#pragma unroll
                for (int w = 0; w < 4; ++w) {
                    tb[(c8 * 8 + 2 * w) * 65 + rp]     = (a0[w] & 0xffffu) | (a1[w] << 16);
                    tb[(c8 * 8 + 2 * w + 1) * 65 + rp] = (a0[w] >> 16) | (a1[w] & 0xffff0000u);
                }
            }
            __syncthreads();
#pragma unroll
            for (int it = 0; it < 8; ++it) {
                const int idx = tid + it * NTHR; const int cc = idx >> 4, t8 = idx & 15;
                v4u o; o.x = tb[cc * 65 + t8 * 4]; o.y = tb[cc * 65 + t8 * 4 + 1]; o.z = tb[cc * 65 + t8 * 4 + 2]; o.w = tb[cc * 65 + t8 * 4 + 3];
                const int col = slab * 256 + cc, csn = col >> 9, gd = col & 511;
                *(v4u*)(T1 + (size_t)(b * 512 + gd) * 512 + csn * CTXL + p0 + t8 * 8) = o;
            }
            __syncthreads();
        }
    }
}

__device__ __forceinline__ void gate_phase(KArgs a, int l, int wg0, int nwg, int u_lo, int u_hi) {
    Frame F = make_frame(a); unsigned char* ws = F.ws;
    F.bx -= wg0; if (F.bx < 0 || F.bx >= nwg) return;
    const bf16* UB = (const bf16*)(ws + WS_UB); const bf16* V2B = (const bf16*)(ws + WS_V2B); bf16* MIX = (bf16*)(ws + WS_MIX);
    const float* gws = a->in[I_GMWS] + (size_t)l * 4 * 128 * 128; const float* gmb = a->in[I_GMB] + l * 4 * 128;
    const int tid = F.tid, lane = F.lane, r32 = lane & 31, hi = lane >> 5, gsel = F.wave >> 2, qb = F.wave & 3;
    for (int un = u_lo + F.bx; un < u_hi; un += nwg) {
        const int ch = un >> 1, gp = un & 1;
        const bool is_ctx = ch >= 128;
        const int b = is_ctx ? (ch - 128) >> 1 : ch >> 5;
        const int p0 = is_ctx ? ((ch - 128) & 1) * 128 : (ch & 31) * 128;
        const int row0 = is_ctx ? ML + b * CTXL + p0 : b * SEQ + p0;
#pragma unroll
        for (int it = 0; it < 8; ++it) { const int idx = tid + it * NTHR; const int gi = idx >> 11, pp = (idx >> 4) & 127, c8 = idx & 15;
            const v4u v = *(const v4u*)(V2B + (size_t)(row0 + pp) * 512 + (2 * gp + gi) * 128 + c8 * 8);
            *(LAS v4u*)(F.lds + (gi * 2 + (pp >> 6)) * 16384 + att::v_st(pp & 63, c8 * 8)) = v; }
        __syncthreads();
        const int g = 2 * gp + gsel;
        att::f32x16 o[4] = {};
#pragma unroll
        for (int kt = 0; kt < 2; ++kt) {
            const float* wrow = gws + ((size_t)g * 128 + 32 * qb + r32) * 128 + 64 * kt + 8 * hi;
            att::bf16x8 pa[4];
#pragma unroll
            for (int ks = 0; ks < 4; ++ks) { const f32x4 w0 = *(const f32x4*)(wrow + 16 * ks), w1 = *(const f32x4*)(wrow + 16 * ks + 4);
                v4u w; w.x = pk2(w0.x, w0.y); w.y = pk2(w0.z, w0.w); w.z = pk2(w1.x, w1.y); w.w = pk2(w1.z, w1.w); pa[ks] = *reinterpret_cast<att::bf16x8*>(&w); }
            const int vb = (int)(unsigned)(uintptr_t)(F.lds + (gsel * 2 + kt) * 16384) + att::v_rd_base(lane);
            att::pv_d0(o, vb, pa[0], pa[1], pa[2], pa[3]);
        }
#pragma unroll
        for (int r = 0; r < 16; ++r) { const int q = 32 * qb + att::crow(r, hi); const float bias = gmb[g * 128 + q];
            const bf16* up = UB + (size_t)(row0 + q) * 512 + g * 128 + r32; bf16* mp = MIX + (size_t)(row0 + q) * MIXW + MX_GM + g * 128 + r32;
#pragma unroll
            for (int d0 = 0; d0 < 4; ++d0) { const float u = __uint_as_float((unsigned)up[d0 * 32] << 16); const float val = u * (o[d0][r] + bias); mp[d0 * 32] = (bf16)(pk2(val, val) & 0xffffu); } }
        __syncthreads();
    }
}

__device__ __forceinline__ void act_fix_phase(KArgs a, int l, int M) {
    Frame F = make_frame(a);
    const float* EDGE = (const float*)(F.ws + WS_EDGE); bf16* ACT = (bf16*)(F.ws + WS_ACT);
    const float* cw = a->in[I_FCW] + (size_t)l * 3 * DFF; const float* cb = a->in[I_FCB] + (size_t)l * DFF;
    constexpr int CG = DFF / 4;
    const int total = (M / 256) * 2 * CG;
    for (int idx = F.bx * NTHR + F.tid; idx < total; idx += F.G * NTHR) {
        const int c0 = (idx % CG) * 4, pw = idx / CG, which = pw & 1, pm = pw >> 1;
        const bool first = pm >= 64 || (pm & 15) == 0, last = pm >= 64 || (pm & 15) == 15;
        const float* e = EDGE + (size_t)pm * 6 * DFF + c0;
        f32x4 prev, cur, next, uu; const f32x4 zero = (f32x4){0.f, 0.f, 0.f, 0.f};
        if (which == 0) { prev = first ? zero : *(const f32x4*)(e - (size_t)6 * DFF + (size_t)3 * DFF); cur = *(const f32x4*)e; next = *(const f32x4*)(e + DFF); uu = *(const f32x4*)(e + (size_t)4 * DFF); }
        else { prev = *(const f32x4*)(e + (size_t)2 * DFF); cur = *(const f32x4*)(e + (size_t)3 * DFF); next = last ? zero : *(const f32x4*)(e + (size_t)6 * DFF); uu = *(const f32x4*)(e + (size_t)5 * DFF); }
        const f32x4 z = *(const f32x4*)(cw + c0) * prev + *(const f32x4*)(cw + DFF + c0) * cur + *(const f32x4*)(cw + 2 * DFF + c0) * next + *(const f32x4*)(cb + c0);
        float o[4];
#pragma unroll
        for (int j = 0; j < 4; ++j) o[j] = z[j] * __builtin_amdgcn_rcpf(1.f + __expf(-z[j])) * uu[j];
        v2u w; w.x = pk2(o[0], o[1]); w.y = pk2(o[2], o[3]);
        *(v2u*)(ACT + (size_t)(pm * 256 + (which ? 255 : 0)) * DFF + c0) = w;
    }
}

constexpr int PH_P0A = 0, PH_P0B = 1, PH_L0 = 2, PH_PER_LAYER = 10, PH_FINAL = PH_L0 + DEPTH * PH_PER_LAYER, N_PHASES = PH_FINAL + 1;

__device__ __forceinline__ void gemm_in_phase(KArgs a, int l) {
    unsigned char* ws = a->ws; extern __shared__ __attribute__((aligned(16))) unsigned char lds_[];
    pg8::Gemm g{(const bf16*)(ws + WS_H), (const bf16*)(ws + WS_WIN) + (size_t)l * PW * DM, MT, PW, DM, DM, DM, 0, 0, 1};
    pg8::StaticOrder S; S.init(MT, PW, gridDim.x, blockIdx.x, DM);
    pg8::EpiBf16 E{(bf16*)(ws + WS_P), PW};
    pg8::gemm_phase<pg8::EpiBf16, pg8::StaticOrder, true, true>((LAS unsigned char*)lds_, g, S, E);
}
__device__ __forceinline__ void gemm_in_probe(KArgs a, int l) {
    unsigned char* ws = a->ws; extern __shared__ __attribute__((aligned(16))) unsigned char lds_[];
    pg8::Gemm g{(const bf16*)(ws + WS_H), (const bf16*)(ws + WS_WIN) + (size_t)l * PW * DM, MT, PW, DM, DM, DM, 0, 0, 1};
    pg8::StaticOrder S; S.init(MT, PW, gridDim.x, blockIdx.x, DM);
    pg8::EpiNone E{};
    pg8::gemm_phase<pg8::EpiNone, pg8::StaticOrder, true, true>((LAS unsigned char*)lds_, g, S, E);
}
__device__ __forceinline__ void gemm_up_phase(KArgs a, int l, int M2) {
    unsigned char* ws = a->ws; extern __shared__ __attribute__((aligned(16))) unsigned char lds_[];
    pg8::Gemm g{(const bf16*)(ws + WS_H), (const bf16*)(ws + WS_WUP) + (size_t)l * UPW * DM, M2, UPW, DM, DM, DM, 0, 0, 1};
    pg8::StaticOrder S; S.init(M2, UPW, gridDim.x, blockIdx.x, DM);
    pg8::EpiUp E{(bf16*)(ws + WS_ACT), (float*)(ws + WS_EDGE), a->in[I_FCW] + (size_t)l * 3 * DFF, a->in[I_FCB] + (size_t)l * DFF, (LAS float*)((LAS unsigned char*)lds_ + XL_OFF), DFF};
    pg8::gemm_phase<pg8::EpiUp, pg8::StaticOrder, true, true>((LAS unsigned char*)lds_, g, S, E);
}
__device__ __forceinline__ void gemm_out_phase(KArgs a, int l, int M2) {
    unsigned char* ws = a->ws; extern __shared__ __attribute__((aligned(16))) unsigned char lds_[];
    pg8::Gemm g{(const bf16*)(ws + WS_MIX), (const bf16*)(ws + WS_WOUT) + (size_t)l * DM * MIXW, M2, DM, MIXW, MIXW, MIXW, 0, 0, 1};
    pg8::SplitOrder S; S.init(ML, (M2 - ML) / 256, DM, gridDim.x, blockIdx.x, MIXW);
    pg8::EpiResGate E{(bf16*)(ws + WS_X), (const float*)(ws + WS_MOD) + (size_t)l * 5 * NMOD, 2 * DM, (float*)(ws + WS_XP), l == 0 ? a->in[I_X] : (const float*)nullptr};
    pg8::gemm_phase<pg8::EpiResGate, pg8::SplitOrder, true, true>((LAS unsigned char*)lds_, g, S, E);
}
__device__ __forceinline__ void gemm_down_phase(KArgs a, int l, int M2) {
    unsigned char* ws = a->ws; extern __shared__ __attribute__((aligned(16))) unsigned char lds_[];
    pg8::Gemm g{(const bf16*)(ws + WS_ACT), (const bf16*)(ws + WS_WDN) + (size_t)l * DM * DFF, M2, DM, DFF, DFF, DFF, 0, 0, 1};
    pg8::SplitOrder S; S.init(ML, (M2 - ML) / 256, DM, gridDim.x, blockIdx.x, DFF);
    pg8::EpiResGate E{(bf16*)(ws + WS_X), (const float*)(ws + WS_MOD) + (size_t)l * 5 * NMOD, 5 * DM, (float*)(ws + WS_XP), (const float*)nullptr};
    pg8::gemm_phase<pg8::EpiResGate, pg8::SplitOrder, true, true>((LAS unsigned char*)lds_, g, S, E);
}
__device__ __forceinline__ void attn_phase(KArgs a, int l, int part, int wg0) {
    unsigned char* ws = a->ws; extern __shared__ __attribute__((aligned(16))) unsigned char lds_[];
    const bf16* QB = (const bf16*)(ws + WS_QB); const bf16* KB = (const bf16*)(ws + WS_KB); const bf16* VB = (const bf16*)(ws + WS_VB); bf16* MIX = (bf16*)(ws + WS_MIX);
    const int G = gridDim.x, bx = blockIdx.x;
    const int xcd = bx & 7, wq = bx >> 3;
    const int ulo = part ? 512 + ((bx - wg0 + G) % G) : bx, uhi = part ? ((l < DEPTH - 1) ? 544 : 0) : 512;
    for (int u = ulo; u < uhi; u += G) {
        int b, h, kvh, qrow, seq;
        if (u < 512) { const int i = u / G; const int j = (G == 256) ? wq + 32 * i : (u >> 3), x = (G == 256) ? xcd : (u & 7);
            b = x >> 1; kvh = x & 1; h = kvh * 4 + (j >> 4); qrow = b * SEQ + (j & 15) * 256; seq = SKV; }
        else { const int c = u - 512; b = c >> 3; h = c & 7; kvh = h >> 2; qrow = ML + b * CTXL; seq = CTXL; }
        att::attn_dense_body(QB + (size_t)qrow * 1024 + h * 128, KB + (size_t)b * SKV * 256 + kvh * 128, VB + (size_t)b * SKV * 256 + kvh * 128,
                             MIX + (size_t)qrow * MIXW + MX_ATT + h * 128, seq, (char*)lds_);
    }
}
__device__ __forceinline__ void dft1_phase(KArgs a, int l) {
    unsigned char* ws = a->ws; extern __shared__ __attribute__((aligned(16))) unsigned char lds_[];
    pg8::Gemm g{(const bf16*)(ws + WS_A1), (const bf16*)(ws + WS_T1T), 256, 65536, 256, 256, 256, 0};
    pg8::StaticOrder S; S.init(256, 65536, gridDim.x, blockIdx.x, 256);
    pg8::EpiS1 E{(bf16*)(ws + WS_S2IN)};
    pg8::gemm_phase<pg8::EpiS1, pg8::StaticOrder, true, true>((LAS unsigned char*)lds_, g, S, E);
}
__device__ __forceinline__ void dft2_phase(KArgs a, int l) {
    unsigned char* ws = a->ws; extern __shared__ __attribute__((aligned(16))) unsigned char lds_[];
    const int G = gridDim.x, bx = blockIdx.x;
    {
        pg8::Gemm g{(const bf16*)(ws + WS_A2), (const bf16*)(ws + WS_S2IN), 4096, 2048, 512, 512, 512, (size_t)2048 * 512 * 2};
        pg8::StaticOrder S; S.init(4096, 2048, G, (bx + G / 2) % G, 512);
        pg8::EpiS2 E{(bf16*)(ws + WS_MIX), 0.0013810679320049757f};
        pg8::gemm_phase<pg8::EpiS2, pg8::StaticOrder, true, true>((LAS unsigned char*)lds_, g, S, E);
    }
    if (l < DEPTH - 1) {
        pg8::Gemm g{(const bf16*)(ws + WS_F256), (const bf16*)(ws + WS_T1TC), CTXL, 2048, 512, 512, 512, 0};
        pg8::StaticOrder S; S.init(CTXL, 2048, G, (bx + G - 96) % G, 512);
        pg8::EpiDft E{(bf16*)(ws + WS_MIX), ML, CTXL, 0.005524271728019903f};
        pg8::gemm_phase<pg8::EpiDft, pg8::StaticOrder, true, true>((LAS unsigned char*)lds_, g, S, E);
    }
}

__global__ void __launch_bounds__(NTHR, 2) hybrid_fwd(Args args_by_value) {
    extern __shared__ __attribute__((aligned(16))) unsigned char lds[];
    (void)args_by_value;
    int lo, hi; unsigned* ctl;
    { KArgs a = kargs(); lo = a->ph_lo; hi = a->ph_hi; ctl = (unsigned*)(a->ws + WS_CTL); }
    volatile LAS unsigned* MISC = (volatile LAS unsigned*)((LAS unsigned char*)lds + MISC_OFF);
    for (int u = threadIdx.x; u < (LDS_BYTES - LDSCTL_OFF) / 4; u += NTHR) ((LAS unsigned*)((LAS unsigned char*)lds + LDSCTL_OFF))[u] = 0u;
    __syncthreads();
    XcdBarrier bar; bar.bar = ctl + CW_BAR; bar.x = 0; bar.st = nullptr;
    if (!MK_PER_PHASE) bar = xcd_barrier_post(ctl + CW_BAR, MISC + 8);
#define IN(k) (lo <= (k) && (k) < hi)
#define SEAM(k) do { if (IN((k) + 1)) { if (MK_PER_PHASE) { if (threadIdx.x == 0) __hip_atomic_store(ctl + CW_TMO, 0xBADBA0u, RLX_AGENT); } else { xcd_barrier(bar); if (DUP(8)) xcd_barrier(bar); } } } while (0)

    for (int rep = 0; rep < (DUP(13) ? 2 : 1); ++rep) {
    if (rep) xcd_barrier(bar);
    if (IN(PH_P0A)) { p0a_prologue(kargs()); if (DUP(0)) p0a_prologue(kargs()); SEAM(PH_P0A); }
    if (IN(PH_P0B)) { p0b_modreduce(kargs()); SEAM(PH_P0B); }

    for (int l = 0; l < DEPTH; ++l) {
        int ph = PH_L0 + l * PH_PER_LAYER;
        const int M2 = (l == DEPTH - 1) ? ML : MT;
#define PHASE(kbit, call) do { if (IN(ph)) { call; if (DUP(kbit)) { if (DUP(15) && !MK_PER_PHASE) xcd_barrier(bar); call; } SEAM(ph); } ++ph; } while (0)
#define MODL ((const float*)(kargs()->ws + WS_MOD) + (size_t)l * 5 * NMOD)
        PHASE(12, norm_phase(kargs(), MT, kargs()->in[I_N1G] + l * DM, MODL, 0 * DM, 1 * DM, l > 0, l == 0, l == 0));
        PHASE(2, gemm_in_phase(kargs(), l));
        if (DUP(11) && IN(ph)) { gemm_in_probe(kargs(), l); xcd_barrier(bar); }
        PHASE(9, postA_phase(kargs(), l));
        PHASE(3, { attn_phase(kargs(), l, 0, 0); dft1_phase(kargs(), l); gate_phase(kargs(), l, 0, (int)gridDim.x, 0, min((int)gridDim.x, (l == DEPTH - 1 ? 128 : 136) * 2)); });
        PHASE(6, { gate_phase(kargs(), l, 0, (int)gridDim.x / 2, (int)gridDim.x, (l == DEPTH - 1 ? 128 : 136) * 2); attn_phase(kargs(), l, 1, 16); dft2_phase(kargs(), l); });
        PHASE(14, gemm_out_phase(kargs(), l, M2));
        PHASE(12, norm_phase(kargs(), M2, kargs()->in[I_N2G] + l * DM, MODL, 3 * DM, 4 * DM, l < DEPTH - 1, false, l == 0));
        PHASE(5, gemm_up_phase(kargs(), l, M2));
        PHASE(10, act_fix_phase(kargs(), l, M2));
        PHASE(14, gemm_down_phase(kargs(), l, M2));
#undef MODL
#undef PHASE
    }
    if (IN(PH_FINAL)) { KArgs a = kargs(); final_norm_phase(a, a->in[I_FNG], a->out); }
    }
#undef IN
#undef SEAM
}

extern "C" void kernel_launch(void* const* d_in, const int* in_sizes, int n_in, void* d_out, int out_size, void* d_ws, size_t ws_size, hipStream_t stream) {
    static int grid = 0;
    if (grid == 0) {
        if (n_in != 22 || out_size != ML * DM || ws_size < WS_END) { fprintf(stderr, "kernel_launch: unexpected shapes: n_in %d out %d ws %zu (need %zu)\n", n_in, out_size, ws_size, (size_t)WS_END); grid = -1; return; }
        int dev = 0, cus = 0, per_cu = 0;
        if (hipGetDevice(&dev) != hipSuccess || hipDeviceGetAttribute(&cus, hipDeviceAttributeMultiprocessorCount, dev) != hipSuccess) { grid = -1; return; }
        if (hipFuncSetAttribute((const void*)hybrid_fwd, hipFuncAttributeMaxDynamicSharedMemorySize, LDS_BYTES) != hipSuccess) { fprintf(stderr, "kernel_launch: hipFuncSetAttribute failed\n"); grid = -1; return; }
        if (hipOccupancyMaxActiveBlocksPerMultiprocessor(&per_cu, (const void*)hybrid_fwd, NTHR, LDS_BYTES) != hipSuccess || per_cu < 1)
            fprintf(stderr, "kernel_launch: occupancy query reports %d workgroups per CU\n", per_cu);
        (void)hipGetLastError();
        grid = cus;
    }
    if (grid < 0) return;
    if (hipMemsetAsync((char*)d_ws + WS_CTL, 0, CTL_ZERO_BYTES, stream) != hipSuccess) return;
    Args a{};
    for (int i = 0; i < 22; ++i) a.in[i] = (const float*)d_in[i];
    a.out = (float*)d_out; a.ws = (unsigned char*)d_ws;
#if MK_PER_PHASE
    for (int ph = 0; ph < N_PHASES; ++ph) { a.ph_lo = ph; a.ph_hi = ph + 1; hipLaunchKernelGGL(hybrid_fwd, dim3(grid), dim3(NTHR), LDS_BYTES, stream, a); }
#else
    a.ph_lo = 0; a.ph_hi = N_PHASES;
    hipLaunchKernelGGL(hybrid_fwd, dim3(grid), dim3(NTHR), LDS_BYTES, stream, a);
#endif
    const hipError_t le = hipPeekAtLastError();
    if (le != hipSuccess) fprintf(stderr, "kernel_launch: launch failed: %s\n", hipGetErrorName(le));
}
```

```cpp
#include <hip/hip_runtime.h>
#include <cstdio>
#include <cstdint>

#ifndef DUPMASK
#define DUPMASK 0
#endif
#define DUP(k) ((DUPMASK >> (k)) & 1)
#ifndef MK_PER_PHASE
#define MK_PER_PHASE 0
#endif

namespace pg8 {
#define PG8_LAS __attribute__((address_space(3)))
typedef unsigned short bf16_t;
typedef short bf16x8 __attribute__((ext_vector_type(8)));
typedef float f32x4 __attribute__((ext_vector_type(4)));
typedef unsigned u32x4 __attribute__((ext_vector_type(4)));
constexpr int BM = 256, BK = 64, HALF = 128, HTB = HALF * BK * 2, STAGE_BYTES = 8 * HTB, NXCD = 8, WGM = 4;

__host__ __device__ __forceinline__ int lds_byte(int r, int c) { const int st = (r >> 4) * 2 + (c >> 5), rr = r & 15, cc = c & 31, ob = rr * 64 + cc * 2; return st * 1024 + (ob ^ (((ob >> 9) & 1) << 5)); }
__host__ __device__ __forceinline__ void stage_rc(int b, int& R, int& C) { const int st = b / 1024, sb = b % 1024, swz = sb ^ (((sb >> 9) & 1) << 5); R = (st >> 1) * 16 + swz / 64; C = (st & 1) * 32 + (swz % 64) / 2; }
__host__ __device__ __forceinline__ int perm32(int rho) { const int n = rho >> 4, i = rho & 15; return 8 * (i >> 2) + 4 * n + (i & 3); }

struct Unit { int pm, pn, kt0, nkt, split; };
struct Gemm { const bf16_t* A; const bf16_t* Bt; int M, N, K, lda, ldb; size_t bpm; int tiledA, tiledB; };

struct StaticOrder {
    int nM, nN, nwg, G, c, ntk;
    __host__ __device__ void init(int M, int N, int G_, int c_, int K) { nM = M / BM; nN = N / BM; nwg = nM * nN; G = G_; c = c_; ntk = K / BK; }
    __host__ __device__ bool next(int i, Unit& u) const {
        const long L = (long)i * G + c; if (L >= nwg) return false;
        return tile((int)L, u);
    }
    __host__ __device__ bool tile(int wgid, Unit& u) const {
        u.kt0 = 0; u.nkt = ntk; u.split = 0; { const int q = nwg / NXCD, r = nwg % NXCD, xcd = wgid % NXCD, off = wgid / NXCD; wgid = (xcd < r ? xcd * (q + 1) : r * (q + 1) + (xcd - r) * q) + off; }
        const int nig = WGM * nN, gid = wgid / nig, fm = gid * WGM, gsz = (nM - fm) < WGM ? (nM - fm) : WGM;
        u.pm = fm + ((wgid % nig) % gsz); u.pn = (wgid % nig) / gsz; return true;
    }
    __device__ __forceinline__ void a_ready(const Unit&) const {}
    __device__ __forceinline__ void done(const Unit&) const {}
};
struct SplitOrder {
    StaticOrder so; int xp, nsplit;
    __host__ __device__ void init(int Mfull, int xpanels, int N, int G_, int c_, int K) { so.init(Mfull, N, G_, c_, K); xp = xpanels; nsplit = xpanels * so.nN * 4; }
    __host__ __device__ bool next(int i, Unit& u) const {
        const int L = i * so.G + so.c; const bool full = L < so.nwg;
        Unit f; so.tile(full ? L : 0, f);
        const int q = L - so.nwg, ks = q & 3, t = q >> 2, qn = so.ntk / 4;
        u.pm = full ? f.pm : so.nM + t / so.nN; u.pn = full ? f.pn : t % so.nN; u.nkt = full ? f.nkt : qn; u.kt0 = full ? 0 : ks * qn; u.split = full ? 0 : 1;
        return full || q < nsplit;
    }
    __device__ __forceinline__ void a_ready(const Unit&) const {}
    __device__ __forceinline__ void done(const Unit&) const {}
};

__device__ __forceinline__ unsigned cvt_pk_bf16(float lo, float hi) { unsigned r; asm volatile("v_cvt_pk_bf16_f32 %0, %1, %2" : "=v"(r) : "v"(lo), "v"(hi)); return r; }

struct EpiNone {
    static constexpr bool PERM = true, AFTER_DRAIN = false;
    __device__ __forceinline__ void operator()(const f32x4 (&acc)[2][2][4][2], const Unit& u, int wr, int wc, int fr, int fq) const {
#pragma unroll
        for (int ai = 0; ai < 2; ++ai)
#pragma unroll
            for (int bj = 0; bj < 2; ++bj)
#pragma unroll
                for (int m = 0; m < 4; ++m)
#pragma unroll
                    for (int n = 0; n < 2; ++n) asm volatile("" :: "v"(acc[ai][bj][m][n]));
    }
};
struct EpiBf16 {
    static constexpr bool PERM = true, AFTER_DRAIN = false;
    bf16_t* O; int ldc;
    __device__ __forceinline__ void operator()(const f32x4 (&acc)[2][2][4][2], const Unit& u, int wr, int wc, int fr, int fq) const {
        const int row0 = u.pm * BM + wr * 64 + fr; const int col0 = u.pn * BM + wc * 32 + 8 * fq;
#pragma unroll
        for (int ai = 0; ai < 2; ++ai)
#pragma unroll
            for (int m = 0; m < 4; ++m) { bf16_t* rowp = O + (size_t)(row0 + ai * HALF + m * 16) * ldc + col0;
#pragma unroll
                for (int bj = 0; bj < 2; ++bj) { const f32x4 v0 = acc[ai][bj][m][0], v1 = acc[ai][bj][m][1];
                    u32x4 w; w.x = cvt_pk_bf16(v0[0], v0[1]); w.y = cvt_pk_bf16(v0[2], v0[3]); w.z = cvt_pk_bf16(v1[0], v1[1]); w.w = cvt_pk_bf16(v1[2], v1[3]);
                    *(u32x4*)(rowp + bj * HALF) = w; } }
    }
};
struct EpiDft {
    static constexpr bool PERM = true, AFTER_DRAIN = false;
    bf16_t* MIX; int rowbase, nper; float scale;
    __device__ __forceinline__ void operator()(const f32x4 (&acc)[2][2][4][2], const Unit& u, int wr, int wc, int fr, int fq) const {
        const int k0 = u.pm * BM + wr * 64 + fr; const int n0 = u.pn * BM + wc * 32 + 8 * fq;
#pragma unroll
        for (int ai = 0; ai < 2; ++ai)
#pragma unroll
            for (int m = 0; m < 4; ++m) { const int k = k0 + ai * HALF + m * 16;
#pragma unroll
                for (int bj = 0; bj < 2; ++bj) { const int n = n0 + bj * HALF; const int b = n >> 9, gd = n & 511;
                    const f32x4 v0 = acc[ai][bj][m][0] * scale, v1 = acc[ai][bj][m][1] * scale;
                    u32x4 w; w.x = cvt_pk_bf16(v0[0], v0[1]); w.y = cvt_pk_bf16(v0[2], v0[3]); w.z = cvt_pk_bf16(v1[0], v1[1]); w.w = cvt_pk_bf16(v1[2], v1[3]);
                    *(u32x4*)(MIX + (size_t)(rowbase + b * nper + k) * 2560 + 1024 + gd) = w; } }
    }
};

struct EpiS1 {
    static constexpr bool PERM = true, AFTER_DRAIN = false;
    bf16_t* S2;
    __device__ __forceinline__ void operator()(const f32x4 (&acc)[2][2][4][2], const Unit& u, int wr, int wc, int fr, int fq) const {
        const int m0 = wr * 64 + fr; const int n0 = u.pn * BM + wc * 32 + 8 * fq;
#pragma unroll
        for (int ai = 0; ai < 2; ++ai)
#pragma unroll
            for (int mm = 0; mm < 4; ++mm) { const int m = m0 + mm * 16; const int k2 = m >> 1, ro = m & 1;
#pragma unroll
                for (int bj = 0; bj < 2; ++bj) { const int np = n0 + bj * HALF; const int n = np >> 5, c = ai * 32 + (np & 31);
                    const f32x4 v0 = acc[ai][bj][mm][0], v1 = acc[ai][bj][mm][1];
                    u32x4 w; w.x = cvt_pk_bf16(v0[0], v0[1]); w.y = cvt_pk_bf16(v0[2], v0[3]); w.z = cvt_pk_bf16(v1[0], v1[1]); w.w = cvt_pk_bf16(v1[2], v1[3]);
                    *(u32x4*)(S2 + ((((size_t)(k2 >> 2) * 2048 + n) * 4 + (k2 & 3)) * 2 + ro) * 64 + c) = w; } }
    }
};
struct EpiS2 {
    static constexpr bool PERM = true, AFTER_DRAIN = false;
    bf16_t* MIX; float scale;
    __device__ __forceinline__ void operator()(const f32x4 (&acc)[2][2][4][2], const Unit& u, int wr, int wc, int fr, int fq) const {
        const int m0 = wr * 64 + fr; const int n0 = u.pn * BM + wc * 32 + 8 * fq;
#pragma unroll
        for (int ai = 0; ai < 2; ++ai)
#pragma unroll
            for (int mm = 0; mm < 4; ++mm) { const int m = ai * HALF + m0 + mm * 16; const int k = 4 * u.pm + (m >> 6) + 64 * (m & 63);
#pragma unroll
                for (int bj = 0; bj < 2; ++bj) { const int n = n0 + bj * HALF; const int b = n >> 9, gd = n & 511;
                    const f32x4 v0 = acc[ai][bj][mm][0] * scale, v1 = acc[ai][bj][mm][1] * scale;
                    u32x4 w; w.x = cvt_pk_bf16(v0[0], v0[1]); w.y = cvt_pk_bf16(v0[2], v0[3]); w.z = cvt_pk_bf16(v1[0], v1[1]); w.w = cvt_pk_bf16(v1[2], v1[3]);
                    *(u32x4*)(MIX + (size_t)(b * 4096 + k) * 2560 + 1024 + gd) = w; } }
    }
};
struct EpiResGate {
    static constexpr bool PERM = false, AFTER_DRAIN = false;
    bf16_t* X; const float* modl; int goff; float* XP; const float* basef;
    __device__ __forceinline__ void operator()(const f32x4 (&acc)[2][2][4][2], const Unit& u, int wr, int wc, int fr, int fq) const {
        typedef unsigned u32x2_ __attribute__((ext_vector_type(2)));
        const int row0 = u.pm * BM + wr * 64 + fr, col0 = u.pn * BM + wc * 32 + 4 * fq;
        const int v = u.pm < 64 ? (u.pm >> 4) : 4;
        const float* gate = modl + (size_t)v * 12288 + goff;
        f32x4 gv[2][2];
#pragma unroll
        for (int bj = 0; bj < 2; ++bj)
#pragma unroll
            for (int n = 0; n < 2; ++n) gv[bj][n] = *(const f32x4*)(gate + col0 + bj * HALF + n * 16);
#pragma unroll
        for (int ai = 0; ai < 2; ++ai)
#pragma unroll
            for (int m = 0; m < 4; ++m) { const size_t ro = (size_t)(row0 + ai * HALF + m * 16) * 2048 + col0;
#pragma unroll
                for (int bj = 0; bj < 2; ++bj)
#pragma unroll
                    for (int n = 0; n < 2; ++n) { const size_t o = ro + bj * HALF + n * 16; const f32x4 d = gv[bj][n] * acc[ai][bj][m][n];
                        if (u.split) *(f32x4*)(XP + ((size_t)(u.kt0 / u.nkt) * 1024 + (row0 + ai * HALF + m * 16 - 16384)) * 2048 + col0 + bj * HALF + n * 16) = d;
                        else { f32x4 b;
                            if (basef) b = *(const f32x4*)(basef + o);
                            else { const u32x2_ w = *(const u32x2_*)(X + o); b = (f32x4){__uint_as_float(w.x << 16), __uint_as_float(w.x & 0xffff0000u), __uint_as_float(w.y << 16), __uint_as_float(w.y & 0xffff0000u)}; }
                            const f32x4 xn = b + d; u32x2_ wo; wo.x = cvt_pk_bf16(xn[0], xn[1]); wo.y = cvt_pk_bf16(xn[2], xn[3]); *(u32x2_*)(X + o) = wo; } } }
    }
};


__device__ __forceinline__ float dpp_ror1(float x)  { return __builtin_bit_cast(float, __builtin_amdgcn_update_dpp(0, __builtin_bit_cast(int, x), 0x121, 0xF, 0xF, false)); }
__device__ __forceinline__ float dpp_ror15(float x) { return __builtin_bit_cast(float, __builtin_amdgcn_update_dpp(0, __builtin_bit_cast(int, x), 0x12F, 0xF, 0xF, false)); }
__device__ __forceinline__ f32x4 ror1v(const f32x4 v)  { return (f32x4){dpp_ror1(v[0]), dpp_ror1(v[1]), dpp_ror1(v[2]), dpp_ror1(v[3])}; }
__device__ __forceinline__ f32x4 ror15v(const f32x4 v) { return (f32x4){dpp_ror15(v[0]), dpp_ror15(v[1]), dpp_ror15(v[2]), dpp_ror15(v[3])}; }
struct EpiUp {
    static constexpr bool PERM = true, AFTER_DRAIN = false;
    bf16_t* ACT; float* EDGE; const float* cw; const float* cb; PG8_LAS float* xl; int dff;
    __device__ __forceinline__ void operator()(const f32x4 (&acc)[2][2][4][2], const Unit& u, int wr, int wc, int fr, int fq) const {
        const int ch0 = u.pn * 128 + wc * 32 + 8 * fq;
        f32x4 w0[2], w1[2], w2[2], bb[2];
#pragma unroll
        for (int n = 0; n < 2; ++n) { w0[n] = *(const f32x4*)(cw + ch0 + 4 * n); w1[n] = *(const f32x4*)(cw + dff + ch0 + 4 * n); w2[n] = *(const f32x4*)(cw + 2 * dff + ch0 + 4 * n); bb[n] = *(const f32x4*)(cb + ch0 + 4 * n); }
#pragma unroll
        for (int ai = 0; ai < 2; ++ai)
#pragma unroll
            for (int n = 0; n < 2; ++n) {
                if (fr == 0)  *(PG8_LAS f32x4*)(xl + ((((wr * 4 + wc) * 2 + ai) * 2 + 0) * 32) + 8 * fq + 4 * n) = acc[ai][0][0][n];
                if (fr == 15) *(PG8_LAS f32x4*)(xl + ((((wr * 4 + wc) * 2 + ai) * 2 + 1) * 32) + 8 * fq + 4 * n) = acc[ai][0][3][n];
            }
        { float* eg = EDGE + (size_t)u.pm * 6 * dff + ch0;
          if (wr == 0 && fr < 2) {
#pragma unroll
              for (int n = 0; n < 2; ++n) { *(f32x4*)(eg + (size_t)fr * dff + 4 * n) = acc[0][0][0][n]; if (fr == 0) *(f32x4*)(eg + (size_t)4 * dff + 4 * n) = acc[0][1][0][n]; } }
          if (wr == 1 && fr >= 14) {
#pragma unroll
              for (int n = 0; n < 2; ++n) { *(f32x4*)(eg + (size_t)(fr - 12) * dff + 4 * n) = acc[1][0][3][n]; if (fr == 15) *(f32x4*)(eg + (size_t)5 * dff + 4 * n) = acc[1][1][3][n]; } }
        }
        asm volatile("s_waitcnt lgkmcnt(0)" ::: "memory"); __builtin_amdgcn_s_barrier(); asm volatile("" ::: "memory");
        f32x4 pe[2][2], ne[2][2];
#pragma unroll
        for (int ai = 0; ai < 2; ++ai)
#pragma unroll
            for (int n = 0; n < 2; ++n) {
                const bool hp = (wr == 1) || (ai == 1), hn = (wr == 0) || (ai == 0);
                const int pai = (wr == 1) ? ai : ai - 1, nai = (wr == 0) ? ai : ai + 1;
                pe[ai][n] = hp ? *(const PG8_LAS f32x4*)(xl + (((((wr ^ 1) * 4 + wc) * 2 + pai) * 2 + 1) * 32) + 8 * fq + 4 * n) : (f32x4){0.f, 0.f, 0.f, 0.f};
                ne[ai][n] = hn ? *(const PG8_LAS f32x4*)(xl + (((((wr ^ 1) * 4 + wc) * 2 + nai) * 2 + 0) * 32) + 8 * fq + 4 * n) : (f32x4){0.f, 0.f, 0.f, 0.f};
            }
        const int row0 = u.pm * BM + wr * 64 + fr;
#pragma unroll
        for (int ai = 0; ai < 2; ++ai)
#pragma unroll
            for (int m = 0; m < 4; ++m) {
                float z[8], t[8];
#pragma unroll
                for (int n = 0; n < 2; ++n) {
                    const f32x4 g = acc[ai][0][m][n];
                    const f32x4 gp = (m > 0) ? acc[ai][0][m > 0 ? m - 1 : 0][n] : pe[ai][n];
                    const f32x4 gn = (m < 3) ? acc[ai][0][m < 3 ? m + 1 : 3][n] : ne[ai][n];
                    const f32x4 zz = w1[n] * g + bb[n];
#pragma unroll
                    for (int j = 0; j < 4; ++j) { float zj = zz[j];
                        if ((m == 0 || m == 3) && n == 0 && j == 0)
                            asm("s_nop 1\n\t"
                                "v_fmac_f32_dpp %0, %1, %4 row_shr:1 row_mask:0xf bank_mask:0xf\n\t"
                                "v_fmac_f32_dpp %0, %2, %4 row_shl:15 row_mask:0xf bank_mask:0xf\n\t"
                                "v_fmac_f32_dpp %0, %1, %5 row_shl:1 row_mask:0xf bank_mask:0xf\n\t"
                                "v_fmac_f32_dpp %0, %3, %5 row_shr:15 row_mask:0xf bank_mask:0xf"
                                : "+v"(zj) : "v"(g[j]), "v"(gp[j]), "v"(gn[j]), "v"(w0[n][j]), "v"(w2[n][j]));
                        else
                            asm("v_fmac_f32_dpp %0, %1, %4 row_shr:1 row_mask:0xf bank_mask:0xf\n\t"
                                "v_fmac_f32_dpp %0, %2, %4 row_shl:15 row_mask:0xf bank_mask:0xf\n\t"
                                "v_fmac_f32_dpp %0, %1, %5 row_shl:1 row_mask:0xf bank_mask:0xf\n\t"
                                "v_fmac_f32_dpp %0, %3, %5 row_shr:15 row_mask:0xf bank_mask:0xf"
                                : "+v"(zj) : "v"(g[j]), "v"(gp[j]), "v"(gn[j]), "v"(w0[n][j]), "v"(w2[n][j]));
                        z[n * 4 + j] = zj; }
                }
#pragma unroll
                for (int i = 0; i < 8; ++i) t[i] = -1.4426950408889634f * z[i];
#pragma unroll
                for (int i = 0; i < 8; ++i) t[i] = __builtin_amdgcn_exp2f(t[i]);
#pragma unroll
                for (int i = 0; i < 8; ++i) t[i] = 1.f + t[i];
#pragma unroll
                for (int i = 0; i < 8; ++i) t[i] = __builtin_amdgcn_rcpf(t[i]);
#pragma unroll
                for (int i = 0; i < 8; ++i) t[i] = z[i] * t[i] * acc[ai][1][m][i >> 2][i & 3];
                u32x4 w; w.x = cvt_pk_bf16(t[0], t[1]); w.y = cvt_pk_bf16(t[2], t[3]); w.z = cvt_pk_bf16(t[4], t[5]); w.w = cvt_pk_bf16(t[6], t[7]);
                *(u32x4*)(ACT + (size_t)(row0 + ai * HALF + m * 16) * dff + ch0) = w;
            }
    }
};

template <class Epi, class Sched, bool ALIGN_EPI = false, bool SP2 = false>
__device__ __forceinline__ void gemm_phase(PG8_LAS unsigned char* lds, const Gemm g, const Sched& S, const Epi& E) {
    int tid_ = threadIdx.x; asm volatile("" : "+v"(tid_));
    const int tid = tid_, wid = __builtin_amdgcn_readfirstlane(tid >> 6), lane = tid & 63, wr = wid >> 2, wc = wid & 3, fr = lane & 15, fq = lane >> 4;
    unsigned voffA[2], voffB[2];
#pragma unroll
    for (int i = 0; i < 2; ++i) { int R, C; stage_rc(tid * 16 + i * 8192, R, C); const int Rb = Epi::PERM ? ((R & ~31) + perm32(R & 31)) : R;
        voffA[i] = (unsigned)(R * (g.tiledA ? BK : g.lda) + C) * 2u; voffB[i] = (unsigned)(Rb * (g.tiledB ? BK : g.ldb) + C) * 2u; }
    const size_t kstepA = g.tiledA ? (size_t)BM * BK * 2 : (size_t)(BK * 2), kstepB = g.tiledB ? (size_t)BM * BK * 2 : (size_t)(BK * 2);
    const size_t hstepA = (size_t)HALF * (g.tiledA ? BK : g.lda) * 2, hstepB = (size_t)HALF * (g.tiledB ? BK : g.ldb) * 2;
    const size_t tstepA = g.tiledA ? (size_t)(g.K / BK) * BM * BK * 2 : 2 * hstepA, tstepB = g.tiledB ? (size_t)(g.K / BK) * BM * BK * 2 : 2 * hstepB;
    const unsigned ldsw = (unsigned)wid * 1024u;
    const int aoff = lds_byte(wr * 64 + fr, fq * 8), boff = lds_byte(wc * 32 + fr, fq * 8);
#define PG8_SA(b, h) (((b) * 2 + (h)) * HTB)
#define PG8_SB(b, h) ((4 + (b) * 2 + (h)) * HTB)
#define PG8_STAGE(bufoff, gbase, voff) do { _Pragma("unroll") for (int _i = 0; _i < 2; ++_i) \
        __builtin_amdgcn_global_load_lds((const unsigned*)((const char*)(gbase) + (voff)[_i]), (PG8_LAS unsigned*)(lds + (bufoff) + ldsw + _i * 8192), 16, 0, 0); } while (0)
#define PG8_LDA(dst, b, h) do { _Pragma("unroll") for (int m = 0; m < 4; ++m) _Pragma("unroll") for (int k = 0; k < 2; ++k) dst[m][k] = *(const PG8_LAS bf16x8*)(lds + PG8_SA(b, h) + aoff + m * 2048 + k * 1024); } while (0)
#define PG8_LDB(dst, b, h) do { _Pragma("unroll") for (int n = 0; n < 2; ++n) _Pragma("unroll") for (int k = 0; k < 2; ++k) dst[n][k] = *(const PG8_LAS bf16x8*)(lds + PG8_SB(b, h) + boff + n * 2048 + k * 1024); } while (0)
#define PG8_MMA(ai, bj, At, Bt) do { __builtin_amdgcn_s_setprio(1); _Pragma("unroll") for (int m = 0; m < 4; ++m) _Pragma("unroll") for (int n = 0; n < 2; ++n) _Pragma("unroll") for (int k = 0; k < 2; ++k) \
        acc[ai][bj][m][n] = __builtin_amdgcn_mfma_f32_16x16x32_bf16(Bt[n][k], At[m][k], acc[ai][bj][m][n], 0, 0, 0); __builtin_amdgcn_s_setprio(0); } while (0)
#define PG8_WAIT_V(n) asm volatile("s_waitcnt vmcnt(" #n ")" ::: "memory")
#define PG8_WAIT_L(n) asm volatile("s_waitcnt lgkmcnt(" #n ")" ::: "memory")
#define PG8_BAR __builtin_amdgcn_s_barrier()
#define PG8_SCHED __builtin_amdgcn_sched_barrier(0)
    Unit cur, nxt; int ui = 0;
    if (!S.next(0, cur)) return;
    f32x4 acc[2][2][4][2];
#pragma unroll
    for (int a = 0; a < 2; ++a)
#pragma unroll
        for (int b = 0; b < 2; ++b)
#pragma unroll
            for (int m = 0; m < 4; ++m)
#pragma unroll
                for (int n = 0; n < 2; ++n) acc[a][b][m][n] = (f32x4){0.f, 0.f, 0.f, 0.f};
    bf16x8 At[4][2], B0[2][2], B1[2][2];
    const char* cA = (const char*)g.A + (size_t)cur.pm * tstepA + (size_t)cur.kt0 * kstepA; const char* cB = (const char*)g.Bt + (size_t)cur.pm * g.bpm + (size_t)cur.pn * tstepB + (size_t)cur.kt0 * kstepB;
    int nt = cur.nkt;
    S.a_ready(cur);
    if constexpr (SP2) {
        PG8_STAGE(PG8_SB(0, 0), cB, voffB); PG8_STAGE(PG8_SB(0, 1), cB + hstepB, voffB); PG8_STAGE(PG8_SA(0, 0), cA, voffA); PG8_STAGE(PG8_SA(0, 1), cA + hstepA, voffA);
        if (wr == 1) PG8_BAR;
        PG8_WAIT_V(2); PG8_BAR;
        PG8_STAGE(PG8_SB(1, 0), cB + kstepB, voffB); PG8_STAGE(PG8_SA(1, 0), cA + kstepA, voffA); PG8_STAGE(PG8_SB(1, 1), cB + hstepB + kstepB, voffB);
        PG8_WAIT_V(6); PG8_BAR;
    } else {
        PG8_STAGE(PG8_SB(0, 0), cB, voffB); PG8_STAGE(PG8_SA(0, 0), cA, voffA); PG8_STAGE(PG8_SB(0, 1), cB + hstepB, voffB); PG8_STAGE(PG8_SA(0, 1), cA + hstepA, voffA);
        if (wr == 1) PG8_BAR;
        PG8_WAIT_V(4); PG8_BAR;
        PG8_STAGE(PG8_SB(1, 0), cB + kstepB, voffB); PG8_STAGE(PG8_SA(1, 0), cA + kstepA, voffA); PG8_STAGE(PG8_SB(1, 1), cB + hstepB + kstepB, voffB);
        PG8_WAIT_V(6); PG8_BAR;
    }
    for (;;) {
        const bool has_next = S.next(ui + 1, nxt);
        const char* nA = has_next ? (const char*)g.A + (size_t)nxt.pm * tstepA + (size_t)nxt.kt0 * kstepA : cA; const char* nB = has_next ? (const char*)g.Bt + (size_t)nxt.pm * g.bpm + (size_t)nxt.pn * tstepB + (size_t)nxt.kt0 * kstepB : cB;
        for (int t = 0; t < nt; t += 2) {
            const bool last = (t == nt - 2);
            const char* a1 = cA + (size_t)(t + 1) * kstepA;
            const char* a2 = last ? nA : cA + (size_t)(t + 2) * kstepA; const char* b2 = last ? nB : cB + (size_t)(t + 2) * kstepB;
            const char* a3 = a2 + kstepA; const char* b3 = b2 + kstepB;
            if (last && has_next) S.a_ready(nxt);
            if constexpr (SP2) {
            PG8_LDB(B0, 0, 0); PG8_LDB(B1, 0, 1); PG8_SCHED; PG8_LDA(At, 0, 0); PG8_STAGE(PG8_SA(1, 1), a1 + hstepA, voffA);
            PG8_WAIT_V(8); PG8_WAIT_L(0); PG8_BAR; PG8_MMA(0, 0, At, B0); PG8_MMA(0, 1, At, B1); PG8_BAR; PG8_SCHED;
            PG8_LDA(At, 0, 1); PG8_STAGE(PG8_SB(0, 0), b2, voffB); PG8_STAGE(PG8_SB(0, 1), b2 + hstepB, voffB); PG8_STAGE(PG8_SA(0, 0), a2, voffA);
            PG8_WAIT_V(8); PG8_WAIT_L(0); PG8_BAR; PG8_MMA(1, 0, At, B0); PG8_MMA(1, 1, At, B1); PG8_BAR; PG8_SCHED;
            PG8_LDB(B0, 1, 0); PG8_LDB(B1, 1, 1); PG8_SCHED; PG8_LDA(At, 1, 0); PG8_STAGE(PG8_SA(0, 1), a2 + hstepA, voffA);
            PG8_WAIT_V(8); PG8_WAIT_L(0); PG8_BAR; PG8_MMA(0, 0, At, B0); PG8_MMA(0, 1, At, B1); PG8_BAR; PG8_SCHED;
            PG8_LDA(At, 1, 1); PG8_STAGE(PG8_SB(1, 0), b3, voffB); PG8_STAGE(PG8_SB(1, 1), b3 + hstepB, voffB); PG8_STAGE(PG8_SA(1, 0), a3, voffA);
            PG8_WAIT_V(8); PG8_WAIT_L(0); PG8_BAR; PG8_MMA(1, 0, At, B0); PG8_MMA(1, 1, At, B1); PG8_BAR; PG8_SCHED;
            } else {
            PG8_LDB(B0, 0, 0); PG8_SCHED; PG8_LDA(At, 0, 0); PG8_STAGE(PG8_SA(1, 1), a1 + hstepA, voffA);
            PG8_WAIT_L(8); PG8_BAR; PG8_WAIT_L(0); PG8_MMA(0, 0, At, B0); PG8_BAR; PG8_SCHED;
            PG8_LDB(B1, 0, 1); PG8_STAGE(PG8_SB(0, 0), b2, voffB);
            PG8_BAR; PG8_WAIT_L(0); PG8_MMA(0, 1, At, B1); PG8_BAR;
            PG8_LDA(At, 0, 1); PG8_STAGE(PG8_SA(0, 0), a2, voffA);
            PG8_BAR; PG8_WAIT_L(0); PG8_MMA(1, 0, At, B0); PG8_BAR; PG8_SCHED;
            PG8_STAGE(PG8_SB(0, 1), b2 + hstepB, voffB);
            PG8_WAIT_V(6); PG8_BAR; PG8_MMA(1, 1, At, B1); PG8_BAR;
            PG8_LDB(B0, 1, 0); PG8_SCHED; PG8_LDA(At, 1, 0); PG8_STAGE(PG8_SA(0, 1), a2 + hstepA, voffA);
            PG8_WAIT_L(8); PG8_BAR; PG8_WAIT_L(0); PG8_MMA(0, 0, At, B0); PG8_BAR; PG8_SCHED;
            PG8_LDB(B1, 1, 1); PG8_STAGE(PG8_SB(1, 0), b3, voffB);
            PG8_BAR; PG8_WAIT_L(0); PG8_MMA(0, 1, At, B1); PG8_BAR;
            PG8_LDA(At, 1, 1); PG8_STAGE(PG8_SA(1, 0), a3, voffA);
            PG8_BAR; PG8_WAIT_L(0); PG8_MMA(1, 0, At, B0); PG8_BAR; PG8_SCHED;
            PG8_STAGE(PG8_SB(1, 1), b3 + hstepB, voffB);
            PG8_WAIT_V(6); PG8_BAR; PG8_MMA(1, 1, At, B1); PG8_BAR;
            }
        }
        if constexpr (ALIGN_EPI) { if (wr == 0) PG8_BAR; }
        if constexpr (!Epi::AFTER_DRAIN) { E(acc, cur, wr, wc, fr, fq); S.done(cur); }
        if (!has_next) break;
#pragma unroll
        for (int a = 0; a < 2; ++a)
#pragma unroll
            for (int b = 0; b < 2; ++b)
#pragma unroll
                for (int m = 0; m < 4; ++m)
#pragma unroll
                    for (int n = 0; n < 2; ++n) acc[a][b][m][n] = (f32x4){0.f, 0.f, 0.f, 0.f};
        cur = nxt; cA = nA; cB = nB; nt = cur.nkt; ++ui;
        if constexpr (ALIGN_EPI) { if (wr == 1) PG8_BAR; }
    }
    PG8_WAIT_V(0);
    if constexpr (!ALIGN_EPI) { if (wr == 0) PG8_BAR; }
    PG8_BAR;
#undef PG8_SA
#undef PG8_SB
#undef PG8_STAGE
#undef PG8_LDA
#undef PG8_LDB
#undef PG8_MMA
#undef PG8_WAIT_V
#undef PG8_WAIT_L
#undef PG8_BAR
#undef PG8_SCHED
}
}

namespace att {
typedef unsigned short bf16;
constexpr int   D = 128, NW = 8, QBLK = 32, KVBLK = 64;
constexpr float SCALE = 0.088388347648318440f;
constexpr float THR = 8.f;
constexpr int LDQ = 1024, LDK = 256, LDO = 2560;
constexpr size_t SHM_V = KVBLK * D * 2, SHM_K = KVBLK * D * 2, SHM_ATTN = 2 * SHM_V + 2 * SHM_K + NW * 64 * 4;
using bf16x8 = __attribute__((ext_vector_type(8))) short;
using s16x4  = __attribute__((ext_vector_type(4))) short;
using f32x16 = __attribute__((ext_vector_type(16))) float;
using u32x4  = __attribute__((ext_vector_type(4))) unsigned;
#define KSWZ(row, colB) ((row) * 256 + ((colB) ^ (((row) & 7) << 4)))
#define SBAR() __builtin_amdgcn_sched_barrier(0)
__device__ __forceinline__ int crow(int r, int hi) { return (r & 3) + 8 * (r >> 2) + 4 * hi; }
__device__ __forceinline__ unsigned cvtpk(float lo, float hi) { unsigned r; asm volatile("v_cvt_pk_bf16_f32 %0, %1, %2" : "=v"(r) : "v"(lo), "v"(hi)); return r; }
__device__ __forceinline__ bf16x8 ld8(const bf16* p) { return *reinterpret_cast<const bf16x8*>(p); }

__device__ __forceinline__ void partialSM(f32x16& p0, f32x16& p1, float& m_reg, float& mn, float& alpha) {
  constexpr float C = SCALE * 1.4426950408889634f;
  float pmax = p0[0]; for (int r = 1; r < 16; ++r) pmax = fmaxf(pmax, p0[r]); for (int r = 0; r < 16; ++r) pmax = fmaxf(pmax, p1[r]);
  { auto rr = __builtin_amdgcn_permlane32_swap(__float_as_uint(pmax), __float_as_uint(pmax), false, false);
    pmax = fmaxf(__uint_as_float(rr[0]), __uint_as_float(rr[1])); }
  if (__builtin_expect(__all(pmax - m_reg <= THR / SCALE), 1)) { mn = m_reg; alpha = 1.f; }
  else { mn = fmaxf(m_reg, pmax); alpha = __builtin_amdgcn_exp2f((m_reg - mn) * C); m_reg = mn; }
  float mnC = -mn * C;
  for (int r = 0; r < 16; ++r) p0[r] = fmaf(p0[r], C, mnC); for (int r = 0; r < 16; ++r) p1[r] = fmaf(p1[r], C, mnC);
  for (int r = 0; r < 16; ++r) p0[r] = __builtin_amdgcn_exp2f(p0[r]);
}
__device__ __forceinline__ void finishSM(f32x16& p0, f32x16& p1, float alpha, float& l_reg, bf16x8& pa0, bf16x8& pa1, bf16x8& pa2, bf16x8& pa3) {
  for (int r = 0; r < 16; ++r) p1[r] = __builtin_amdgcn_exp2f(p1[r]);
  float ps = 0; for (int r = 0; r < 16; ++r) ps += p0[r]; for (int r = 0; r < 16; ++r) ps += p1[r];
  { auto rr = __builtin_amdgcn_permlane32_swap(__float_as_uint(ps), __float_as_uint(ps), false, false);
    ps = __uint_as_float(rr[0]) + __uint_as_float(rr[1]); }
  l_reg = l_reg * alpha + ps;
#define PK4(P, BASE, OUT) do { unsigned a0 = cvtpk(P[BASE + 0], P[BASE + 1]), a1 = cvtpk(P[BASE + 2], P[BASE + 3]);   \
    unsigned b0 = cvtpk(P[BASE + 4], P[BASE + 5]), b1 = cvtpk(P[BASE + 6], P[BASE + 7]);                              \
    auto r0 = __builtin_amdgcn_permlane32_swap(a0, b0, false, false); auto r1 = __builtin_amdgcn_permlane32_swap(a1, b1, false, false); \
    u32x4 w = {r0[0], r1[0], r0[1], r1[1]}; OUT = *reinterpret_cast<bf16x8*>(&w); } while (0)
  PK4(p0, 0, pa0); PK4(p0, 8, pa1); PK4(p1, 0, pa2); PK4(p1, 8, pa3);
#undef PK4
}
__device__ __forceinline__ void qkt(f32x16& p0, f32x16& p1, const bf16* Ks, const bf16x8* qr, int r32, int hi) {
  p0 = f32x16{}; p1 = f32x16{};
  for (int d0 = 0; d0 < 8; ++d0) { int cb = (d0 * 16 + hi * 8) * 2;
    bf16x8 b0 = *reinterpret_cast<const bf16x8*>((const char*)Ks + KSWZ(r32, cb));
    bf16x8 b1 = *reinterpret_cast<const bf16x8*>((const char*)Ks + KSWZ(32 + r32, cb));
    p0 = __builtin_amdgcn_mfma_f32_32x32x16_bf16(b0, qr[d0], p0, 0, 0, 0);
    p1 = __builtin_amdgcn_mfma_f32_32x32x16_bf16(b1, qr[d0], p1, 0, 0, 0); }
}
__device__ __forceinline__ int v_st(int k, int c) { const int kk = (k & ~0xC) | ((k & 4) << 1) | ((k & 8) >> 1); return ((kk >> 3) * 4 + (c >> 5)) * 512 + ((kk & 7) * 32 + (c & 31)) * 2; }
__device__ __forceinline__ int v_rd_base(int lane) { return ((lane & 3) << 3) | (((lane >> 2) & 3) << 6) | (((lane >> 4) & 1) << 5) | (((lane >> 5) & 1) << 8); }
constexpr int v_rd_off(int d0, int ks, int half) { return d0 * 512 + ks * 4096 + half * 2048; }
template <int OFF> __device__ __forceinline__ s16x4 tr_read(int vb) {
  s16x4 r; asm volatile("ds_read_b64_tr_b16 %0, %1 offset:%2" : "=&v"(r) : "v"(vb), "i"(OFF) : "memory"); return r;
}
template <int D0> __device__ __forceinline__ void pv_one(f32x16& od, int vb, bf16x8 pa0, bf16x8 pa1, bf16x8 pa2, bf16x8 pa3) {
  const s16x4 l0 = tr_read<v_rd_off(D0, 0, 0)>(vb), h0 = tr_read<v_rd_off(D0, 0, 1)>(vb), l1 = tr_read<v_rd_off(D0, 1, 0)>(vb), h1 = tr_read<v_rd_off(D0, 1, 1)>(vb);
  const s16x4 l2 = tr_read<v_rd_off(D0, 2, 0)>(vb), h2 = tr_read<v_rd_off(D0, 2, 1)>(vb), l3 = tr_read<v_rd_off(D0, 3, 0)>(vb), h3 = tr_read<v_rd_off(D0, 3, 1)>(vb);
  asm volatile("s_waitcnt lgkmcnt(0)" ::: "memory"); SBAR();
#define PK(L, H) (bf16x8){L[0], L[1], L[2], L[3], H[0], H[1], H[2], H[3]}
  od = __builtin_amdgcn_mfma_f32_32x32x16_bf16(pa0, PK(l0, h0), od, 0, 0, 0);
  od = __builtin_amdgcn_mfma_f32_32x32x16_bf16(pa1, PK(l1, h1), od, 0, 0, 0);
  od = __builtin_amdgcn_mfma_f32_32x32x16_bf16(pa2, PK(l2, h2), od, 0, 0, 0);
  od = __builtin_amdgcn_mfma_f32_32x32x16_bf16(pa3, PK(l3, h3), od, 0, 0, 0);
#undef PK
}
__device__ __forceinline__ void pv_d0(f32x16* o, int vb, bf16x8 pa0, bf16x8 pa1, bf16x8 pa2, bf16x8 pa3) {
  pv_one<0>(o[0], vb, pa0, pa1, pa2, pa3); pv_one<1>(o[1], vb, pa0, pa1, pa2, pa3); pv_one<2>(o[2], vb, pa0, pa1, pa2, pa3); pv_one<3>(o[3], vb, pa0, pa1, pa2, pa3);
}

__device__ __forceinline__ void attn_dense_body(const bf16* __restrict__ Qb, const bf16* __restrict__ Kh, const bf16* __restrict__ Vh,
                                                bf16* __restrict__ Ob, int seq, char* lds) {
  constexpr int SDEPTH = 2;
  int tid_ = threadIdx.x; asm volatile("" : "+v"(tid_));
  const int tid = tid_, wid = tid >> 6, lane = tid & 63, r32 = lane & 31, hi = lane >> 5;
  bf16* V_lds = (bf16*)lds; bf16* K_lds = (bf16*)(lds + 2 * SHM_V);
  float* ws = (float*)(lds + 2 * SHM_V + 2 * SHM_K) + wid * 64; float* li_l = ws; float* al_l = ws + 32;
  float m_reg = -1e30f, l_reg = 0; f32x16 o[4] = {}; bf16x8 qr[8];
  const bf16* Qw = Qb + (long)(wid * QBLK + r32) * LDQ + hi * 8;
#pragma unroll
  for (int d0 = 0; d0 < 8; ++d0) qr[d0] = ld8(Qw + d0 * 16);
  const int sr = tid >> 4, sc = (tid & 15) * 8, vst0 = v_st(sr, sc), vst1 = v_st(32 + sr, sc);
  const int vb0 = (int)(uintptr_t)V_lds + v_rd_base(lane);
  struct { bf16x8 vs0, vs1, ks0, ks1; } sr_[SDEPTH];
#define SLOAD(i, k0) do { sr_[i].vs0 = ld8(&Vh[(long)((k0) + sr) * LDK + sc]); sr_[i].vs1 = ld8(&Vh[(long)((k0) + 32 + sr) * LDK + sc]); \
    sr_[i].ks0 = ld8(&Kh[(long)((k0) + sr) * LDK + sc]); sr_[i].ks1 = ld8(&Kh[(long)((k0) + 32 + sr) * LDK + sc]); } while (0)
#define SWRITE(b, i) do { *(bf16x8*)((char*)V_lds + (b) * SHM_V + vst0) = sr_[i].vs0;          \
    *(bf16x8*)((char*)V_lds + (b) * SHM_V + vst1) = sr_[i].vs1; int kc = sc * 2;               \
    *(bf16x8*)((char*)K_lds + (b) * SHM_K + KSWZ(sr, kc)) = sr_[i].ks0;                       \
    *(bf16x8*)((char*)K_lds + (b) * SHM_K + KSWZ(32 + sr, kc)) = sr_[i].ks1; } while (0)
#define SWAIT() do { asm volatile("s_waitcnt vmcnt(4)" ::: "memory"); } while (0)
#define RESC(a) do { if (__any((a) < 1.f)) { if (hi == 0) al_l[r32] = (a); asm volatile("s_waitcnt lgkmcnt(0)" ::: "memory"); \
    for (int d = 0; d < 4; ++d) for (int r = 0; r < 16; ++r) o[d][r] *= al_l[crow(r, hi)]; } } while (0)
  f32x16 pA0, pA1, pB0, pB1; float mnA, mnB, alA, alB; bf16x8 pa0, pa1, pa2, pa3; const int NT = seq / KVBLK;
  constexpr int SE = 0, SO = SDEPTH - 1;
  SLOAD(SE, 0); asm volatile("s_waitcnt vmcnt(0)" ::: "memory"); SWRITE(0, SE); __syncthreads();
  qkt(pA0, pA1, K_lds, qr, r32, hi); partialSM(pA0, pA1, m_reg, mnA, alA);
  SLOAD(SO, KVBLK); if (2 < NT) SLOAD(SE, 2 * KVBLK);
  SWAIT(); SWRITE(1, SO); __syncthreads();
  for (int j = 1; j + 1 < NT; j += 2) {
    SBAR(); qkt(pB0, pB1, (bf16*)((char*)K_lds + SHM_K), qr, r32, hi);
    finishSM(pA0, pA1, alA, l_reg, pa0, pa1, pa2, pa3); SBAR();
    SLOAD(SO, (j + SDEPTH) * KVBLK); SBAR();
    pv_d0(o, vb0, pa0, pa1, pa2, pa3); partialSM(pB0, pB1, m_reg, mnB, alB);
    __syncthreads(); SWAIT(); SWRITE(0, SE);
    RESC(alB); __syncthreads();
    SBAR(); qkt(pA0, pA1, K_lds, qr, r32, hi);
    finishSM(pB0, pB1, alB, l_reg, pa0, pa1, pa2, pa3); SBAR();
    if (j + 3 < NT) SLOAD(SE, (j + 1 + SDEPTH) * KVBLK); SBAR();
    pv_d0(o, vb0 + (int)SHM_V, pa0, pa1, pa2, pa3); partialSM(pA0, pA1, m_reg, mnA, alA);
    __syncthreads(); SWAIT(); SWRITE(1, SO);
    RESC(alA); __syncthreads();
  }
  SBAR(); qkt(pB0, pB1, (bf16*)((char*)K_lds + SHM_K), qr, r32, hi);
  finishSM(pA0, pA1, alA, l_reg, pa0, pa1, pa2, pa3); SBAR();
  pv_d0(o, vb0, pa0, pa1, pa2, pa3); partialSM(pB0, pB1, m_reg, mnB, alB);
  __syncthreads(); RESC(alB);
  finishSM(pB0, pB1, alB, l_reg, pa0, pa1, pa2, pa3); SBAR();
  pv_d0(o, vb0 + (int)SHM_V, pa0, pa1, pa2, pa3);
  if (hi == 0) li_l[r32] = l_reg; asm volatile("s_waitcnt lgkmcnt(0)" ::: "memory");
  float rli[16];
#pragma unroll
  for (int r = 0; r < 16; ++r) rli[r] = __builtin_amdgcn_rcpf(li_l[crow(r, hi)]);
  bf16* Ow = Ob + (long)(wid * QBLK) * LDO;
#pragma unroll
  for (int r = 0; r < 16; ++r) { int orow = crow(r, hi);
#pragma unroll
    for (int d0 = 0; d0 < 4; ++d0) { const float val = o[d0][r] * rli[r]; Ow[(long)orow * LDO + d0 * 32 + r32] = (bf16)(cvtpk(val, val) & 0xffffu); } }
  __syncthreads();
#undef SLOAD
#undef SWRITE
#undef SWAIT
#undef RESC
}
#undef KSWZ
#undef SBAR
}

constexpr int NWAVES = 8, NTHR = 512;
constexpr int DM = 2048, NB = 4, SEQ = 4096, DEPTH = 4, CTXL = 256;
constexpr int ML = NB * SEQ, MC = NB * CTXL, MT = ML + MC;
constexpr int SKV = CTXL + SEQ;
constexpr int INW_SRC = 4608, PW = 5120;
constexpr int PQ = 0, PK = 1024, PV = 1280, PFA = 1536, PFB = 2048, PCB = 2560, PCC = 3072, PCH = 3584, PGU = 4096, PGV = 4608;
constexpr int MIXW = 2560, MX_ATT = 0, MX_FOUR = 1024, MX_CONV = 1536, MX_GM = 2048;
constexpr int DFF = 5632, UPW = 2 * DFF;
constexpr int NMOD = 6 * DM;
constexpr float EPS = 1e-6f;

constexpr size_t al256(size_t x) { return (x + 255) / 256 * 256; }
constexpr size_t WS_CTL = 0, CTL_ZERO_BYTES = 1u << 20;
constexpr size_t WS_WIN  = CTL_ZERO_BYTES;
constexpr size_t WS_WOUT = WS_WIN  + (size_t)DEPTH * PW * DM * 2;
constexpr size_t WS_WUP  = WS_WOUT + (size_t)DEPTH * DM * MIXW * 2;
constexpr size_t WS_WDN  = WS_WUP  + (size_t)DEPTH * UPW * DM * 2;
constexpr size_t WS_FN   = WS_WDN  + (size_t)DEPTH * DM * DFF * 2;
constexpr size_t WS_A1   = WS_FN;
constexpr size_t WS_A2   = WS_A1   + (size_t)256 * 256 * 2;
constexpr size_t WS_F256 = WS_A2   + (size_t)16 * 256 * 512 * 2;
constexpr size_t WS_MODP = WS_F256 + (size_t)256 * 512 * 2;
constexpr size_t WS_MOD  = WS_MODP + (size_t)16 * DEPTH * 5 * NMOD * 4;
constexpr size_t WS_ROPE = WS_MOD  + (size_t)DEPTH * 5 * NMOD * 4;
constexpr size_t WS_X    = WS_ROPE + 64 * 32 * 8;
constexpr size_t WS_H    = WS_X    + (size_t)MT * DM * 2;
constexpr size_t WS_R    = WS_H    + (size_t)MT * DM * 2;
constexpr size_t WS_P    = WS_R;
constexpr size_t WS_MIX  = WS_P    + (size_t)MT * PW * 2;
constexpr size_t WS_T1T  = WS_MIX  + (size_t)MT * MIXW * 2;
constexpr size_t WS_T1TC = WS_T1T  + (size_t)2048 * 8192 * 2;
constexpr size_t WS_KB   = WS_T1TC + (size_t)2048 * 512 * 2;
constexpr size_t WS_VB   = WS_KB   + (size_t)NB * SKV * 256 * 2;
constexpr size_t WS_QB   = WS_VB   + (size_t)NB * SKV * 256 * 2;
constexpr size_t WS_UB   = WS_QB   + (size_t)MT * 1024 * 2;
constexpr size_t WS_V2B  = WS_UB   + (size_t)MT * 512 * 2;
constexpr size_t WS_S2IN = WS_V2B  + (size_t)MT * 512 * 2;
constexpr size_t WS_RA_END = WS_S2IN + (size_t)16 * 2048 * 512 * 2;
constexpr size_t WS_ACT  = WS_R;
constexpr size_t WS_ACT_END = WS_ACT + (size_t)MT * DFF * 2;
constexpr size_t WS_R_END = WS_RA_END > WS_ACT_END ? WS_RA_END : WS_ACT_END;
constexpr size_t WS_EDGE = WS_R_END;
constexpr size_t WS_XP   = WS_EDGE + (size_t)(MT / 256) * 6 * DFF * 4;
constexpr size_t WS_END  = WS_XP   + (size_t)4 * MC * DM * 4;
static_assert(WS_END <= 1600000000ull, "d_ws budget");
static_assert(WS_WIN % 256 == 0 && WS_FN % 256 == 0 && WS_X % 256 == 0 && WS_H % 256 == 0 && WS_P % 256 == 0 && WS_MIX % 256 == 0 && WS_T1T % 256 == 0 && WS_KB % 256 == 0 && WS_ACT % 256 == 0 && WS_MOD % 256 == 0, "alignment");
constexpr int CW_TMO = 0, CW_BAR = 4096;

constexpr int RING_BYTES = 131072;
constexpr int LDSCTL_OFF = RING_BYTES, MISC_OFF = LDSCTL_OFF + 320;
constexpr int XL_OFF = RING_BYTES + 1024;
constexpr int LDS_BYTES = 147456;

#define GAS __attribute__((address_space(1)))
#define LAS __attribute__((address_space(3)))
typedef unsigned short bf16;
typedef unsigned v4u __attribute__((ext_vector_type(4)));
typedef unsigned v2u __attribute__((ext_vector_type(2)));
typedef float f32x4 __attribute__((ext_vector_type(4)));
typedef float f32x2 __attribute__((ext_vector_type(2)));
#define RLX_AGENT __ATOMIC_RELAXED, __HIP_MEMORY_SCOPE_AGENT
#define LDS_WAIT() asm volatile("s_waitcnt lgkmcnt(0)" ::: "memory")
#define VM_WAIT() asm volatile("s_waitcnt vmcnt(0)" ::: "memory")
__device__ __forceinline__ unsigned pk2(float lo, float hi) { unsigned r; asm volatile("v_cvt_pk_bf16_f32 %0, %1, %2" : "=v"(r) : "v"(lo), "v"(hi)); return r; }
__device__ __forceinline__ float bflo(unsigned w) { return __uint_as_float(w << 16); }
__device__ __forceinline__ float bfhi(unsigned w) { return __uint_as_float(w & 0xffff0000u); }
__device__ __forceinline__ void unpack8(const v4u w, float (&x)[8]) { x[0] = bflo(w.x); x[1] = bfhi(w.x); x[2] = bflo(w.y); x[3] = bfhi(w.y); x[4] = bflo(w.z); x[5] = bfhi(w.z); x[6] = bflo(w.w); x[7] = bfhi(w.w); }
__device__ __forceinline__ v4u pack8(const float (&x)[8]) { v4u w; w.x = pk2(x[0], x[1]); w.y = pk2(x[2], x[3]); w.z = pk2(x[4], x[5]); w.w = pk2(x[6], x[7]); return w; }
__device__ __forceinline__ float wave_sum(float v) {
#pragma unroll
    for (int o = 1; o < 64; o <<= 1) v += __shfl_xor(v, o);
    return v;
}
__device__ __forceinline__ float gelu_tanh(float x) { const float y = 0.7978845608028654f * (x + 0.044715f * x * x * x); return 0.5f * x * (1.f + tanhf(y)); }

#define XB_TMO      128
#define XB_XCNT(j)  (256  + 64 * (j))
#define XB_XSUB(j)  (1280 + 64 * (j))
#define XB_XGEN(j)  (2304 + 64 * (j))
#define XB_TOP      3328
#define XB_TOPGEN   3392
#define XCD_BAR_WORDS 3456
#define XB_SPIN_CAP (1u << 18)
__device__ __forceinline__ unsigned xb_ld(unsigned* p)              { return __hip_atomic_load(p, __ATOMIC_RELAXED, __HIP_MEMORY_SCOPE_AGENT); }
__device__ __forceinline__ unsigned xb_add(unsigned* p, unsigned v) { return __hip_atomic_fetch_add(p, v, __ATOMIC_RELAXED, __HIP_MEMORY_SCOPE_AGENT); }
__device__ __forceinline__ unsigned xb_xcc_id() { return (unsigned)__builtin_amdgcn_s_getreg((3 << 11) | 20) & 0xFu; }
#define XB_SPIN(cond, bar) do { unsigned _sp = 0; while (cond) { __builtin_amdgcn_s_sleep(1); \
    if ((++_sp & 255u) == 0u) { if (xb_ld(&(bar)[XB_TMO])) break; if (_sp > XB_SPIN_CAP) { atomicAdd(&(bar)[XB_TMO], 1u); break; } } } } while (0)
struct XcdBarrier { unsigned* bar; unsigned x; volatile LAS unsigned* st; };
__device__ __forceinline__ XcdBarrier xcd_barrier_post(unsigned* bar, volatile LAS unsigned* st) {
    XcdBarrier b; b.bar = bar; b.x = xb_xcc_id(); b.st = st;
    if (threadIdx.x == 0) (void)xb_add(&bar[XB_XCNT(b.x)], 1u);
    return b;
}
__device__ __forceinline__ void xcd_barrier_complete(unsigned* bar, unsigned x, unsigned& nloc, unsigned& nx) {
    const unsigned G = gridDim.x * gridDim.y * gridDim.z;
    unsigned sum, cnt, mine, sp = 0u;
    for (;;) {
        sum = 0u; cnt = 0u; mine = 0u;
#pragma unroll
        for (unsigned j = 0; j < 16; ++j) { const unsigned c = xb_ld(&bar[XB_XCNT(j)]); sum += c; cnt += (c > 0u) ? 1u : 0u; mine = (j == x) ? c : mine; }
        if (sum == G) break;
        __builtin_amdgcn_s_sleep(1);
        if ((++sp & 255u) == 0u) { if (xb_ld(&bar[XB_TMO])) break; if (sp > XB_SPIN_CAP) { atomicAdd(&bar[XB_TMO], 1u); break; } }
    }
    nloc = mine > 0u ? mine : 1u; nx = cnt > 0u ? cnt : 1u;
}
__device__ __forceinline__ void xcd_barrier(const XcdBarrier& b) {
    asm volatile("s_waitcnt vmcnt(0)" ::: "memory");
    __syncthreads();
    if (threadIdx.x == 0) {
        unsigned* bar = b.bar;
        __builtin_amdgcn_s_waitcnt(0);
        unsigned nloc = b.st[0], nx = b.st[1];
        if (nloc == 0u) { xcd_barrier_complete(bar, b.x, nloc, nx); b.st[0] = nloc; b.st[1] = nx; }
        const unsigned old = xb_add(&bar[XB_XSUB(b.x)], 1u);
        const unsigned gen = old / nloc;
        if (old + 1u == (gen + 1u) * nloc) {
            __builtin_amdgcn_fence(__ATOMIC_RELEASE, "agent");
            asm volatile("s_waitcnt vmcnt(0)" ::: "memory");
            const unsigned og = xb_add(&bar[XB_TOP], 1u);
            const unsigned tg = og / nx;
            if (og + 1u == (tg + 1u) * nx) xb_add(&bar[XB_TOPGEN], 1u);
            else XB_SPIN(xb_ld(&bar[XB_TOPGEN]) == tg, bar);
            __builtin_amdgcn_fence(__ATOMIC_ACQUIRE, "agent");
            xb_add(&bar[XB_XGEN(b.x)], 1u);
            asm volatile("s_waitcnt vmcnt(0)" ::: "memory");
        } else {
            XB_SPIN(xb_ld(&bar[XB_XGEN(b.x)]) == gen, bar);
            __builtin_amdgcn_fence(__ATOMIC_ACQUIRE, "agent");
            asm volatile("s_waitcnt vmcnt(0)" ::: "memory");
        }
    }
    __syncthreads();
}

struct Args { const float* in[22]; float* out; unsigned char* ws; int ph_lo, ph_hi; };
enum { I_X = 0, I_C, I_CTX, I_CCTX, I_WMOD, I_BMOD, I_N1G, I_N2G, I_WIN, I_QG, I_KG, I_CONVW, I_LNG, I_LNB, I_GMWS, I_GMB, I_WOUT, I_WUP, I_FCW, I_FCB, I_WDN, I_FNG };

typedef const Args __attribute__((address_space(4)))* KArgs;
__device__ __forceinline__ KArgs kargs() { KArgs p = (KArgs)__builtin_amdgcn_kernarg_segment_ptr(); asm volatile("" : "+s"(p)); return p; }
struct Frame {
    LAS unsigned char* lds;
    int tid, lane, wave, G, bx, gw, ngw;
    unsigned char* ws;
};
__device__ __forceinline__ Frame make_frame(KArgs a) {
    extern __shared__ __attribute__((aligned(16))) unsigned char lds_[];
    Frame F; int t = threadIdx.x; asm volatile("" : "+v"(t));
    F.lds = (LAS unsigned char*)lds_; F.tid = t; F.lane = t & 63; F.wave = __builtin_amdgcn_readfirstlane(t >> 6);
    F.G = gridDim.x; F.bx = blockIdx.x; F.gw = F.bx * NWAVES + F.wave; F.ngw = F.G * NWAVES; F.ws = a->ws;
    return F;
}

__device__ __forceinline__ size_t toff(int n, int k, int K) { return ((size_t)(n >> 8) * (K >> 6) + (k >> 6)) * 16384 + (size_t)(n & 255) * 64 + (k & 63); }
__device__ __forceinline__ void transpose_item(const float* W, int ldw, int k0, int ns0, bf16* WT, int ldt, int nd0, LAS float* scr, int lane) {
    f32x4 v[8];
#pragma unroll
    for (int i = 0; i < 8; ++i) v[i] = *(const f32x4*)(W + (size_t)(k0 + i * 8 + (lane >> 3)) * ldw + ns0 + (lane & 7) * 4);
#pragma unroll
    for (int i = 0; i < 8; ++i) { LAS float* d = scr + (i * 8 + (lane >> 3)) * 33 + (lane & 7) * 4; d[0] = v[i].x; d[1] = v[i].y; d[2] = v[i].z; d[3] = v[i].w; }
    LDS_WAIT(); asm volatile("" ::: "memory");
    const int c = lane & 7;
#pragma unroll
    for (int j = 0; j < 4; ++j) { const int n = (lane >> 3) + 8 * j; const LAS float* s = scr + (8 * c) * 33 + n;
        v4u o; o.x = pk2(s[0 * 33], s[1 * 33]); o.y = pk2(s[2 * 33], s[3 * 33]); o.z = pk2(s[4 * 33], s[5 * 33]); o.w = pk2(s[6 * 33], s[7 * 33]);
        *(v4u*)(WT + toff(nd0 + n, k0 + 8 * c, ldt)) = o; }
    LDS_WAIT(); asm volatile("" ::: "memory");
}

__device__ __forceinline__ void p0a_prologue(KArgs a) {
    Frame F = make_frame(a); unsigned char* ws = F.ws;
    {
        LAS float* scr = (LAS float*)(F.lds + F.wave * 16384);
        constexpr int I_IN = 32 * 128, I_OUT = 40 * 64, I_UP = 32 * 352, I_DN = 88 * 64, I_L = I_IN + I_OUT + I_UP + I_DN;
        for (int it = F.gw; it < DEPTH * I_L; it += F.ngw) {
            const int l = it / I_L; int r = it % I_L;
            if (r < I_IN) { const int kb = r / 128, nb = r % 128; const int ns0 = nb < 48 ? nb * 32 : 2048 + (nb - 48) * 32; const int nd0 = nb < 48 ? ns0 : ns0 + 512;
                transpose_item(a->in[I_WIN] + (size_t)l * DM * INW_SRC, INW_SRC, kb * 64, ns0, (bf16*)(ws + WS_WIN) + (size_t)l * PW * DM, DM, nd0, scr, F.lane); continue; }
            r -= I_IN;
            if (r < I_OUT) { const int kb = r / 64, nb = r % 64;
                transpose_item(a->in[I_WOUT] + (size_t)l * MIXW * DM, DM, kb * 64, nb * 32, (bf16*)(ws + WS_WOUT) + (size_t)l * DM * MIXW, MIXW, nb * 32, scr, F.lane); continue; }
            r -= I_OUT;
            if (r < I_UP) { const int kb = r / 352, nb = r % 352; const int nd0 = nb * 32, ns0 = ((nd0 >> 7) & 1) * DFF + (nd0 >> 8) * 128 + (nd0 & 127);
                transpose_item(a->in[I_WUP] + (size_t)l * DM * UPW, UPW, kb * 64, ns0, (bf16*)(ws + WS_WUP) + (size_t)l * UPW * DM, DM, nb * 32, scr, F.lane); continue; }
            r -= I_UP;
            { const int kb = r / 64, nb = r % 64;
                transpose_item(a->in[I_WDN] + (size_t)l * DFF * DM, DM, kb * 64, nb * 32, (bf16*)(ws + WS_WDN) + (size_t)l * DM * DFF, DFF, nb * 32, scr, F.lane); }
        }
    }
    __syncthreads();
    {
        LAS float* sl = (LAS float*)F.lds;
        for (int i = F.tid; i < 5 * DM; i += NTHR) { const int v = i / DM, k = i % DM; const float cv = v < 4 ? a->in[I_C][v * DM + k] : a->in[I_CCTX][k]; sl[i] = cv / (1.f + expf(-cv)); }
        __syncthreads();
        float* MODP = (float*)(ws + WS_MODP);
        for (int it = F.gw; it < DEPTH * 16 * 48; it += F.ngw) {
            const int l = it / 768, r = it % 768, ks = r / 48, cg = r % 48;
            const float* wp = a->in[I_WMOD] + ((size_t)l * DM + ks * 128) * NMOD + cg * 256 + F.lane * 4;
            f32x4 acc[5];
#pragma unroll
            for (int v = 0; v < 5; ++v) acc[v] = (f32x4){0.f, 0.f, 0.f, 0.f};
            for (int k = 0; k < 128; k += 8) {
                f32x4 w[8];
#pragma unroll
                for (int u = 0; u < 8; ++u) w[u] = *(const f32x4*)(wp + (size_t)(k + u) * NMOD);
#pragma unroll
                for (int u = 0; u < 8; ++u)
#pragma unroll
                    for (int v = 0; v < 5; ++v) acc[v] += w[u] * sl[v * DM + ks * 128 + k + u];
            }
#pragma unroll
            for (int v = 0; v < 5; ++v) *(f32x4*)(MODP + ((size_t)ks * (DEPTH * 5) + l * 5 + v) * NMOD + cg * 256 + F.lane * 4) = acc[v];
        }
    }
    __syncthreads();
    {
        LAS float* T128 = (LAS float*)F.lds;
        LAS float* Wl = (LAS float*)(F.lds + 1024);
        if (F.tid < 128) T128[F.tid] = cospif((float)F.tid * (1.f / 64.f));
        __syncthreads();
        for (int it = F.bx; it < DEPTH * 4 * 64; it += F.G) {
            const int l = it / 256, g = (it / 64) % 4, kb = it % 64;
            for (int i = F.tid; i < 32 * 128; i += NTHR) { const int kk = i / 128, dd = i % 128; Wl[i] = a->in[I_WIN][((size_t)l * DM + kb * 32 + kk) * INW_SRC + 1536 + g * 128 + dd]; }
            __syncthreads();
            const int dout = F.tid & 127, cs = (F.tid >> 7) & 1, kg = F.tid >> 8;
            float acc[16];
#pragma unroll
            for (int kk = 0; kk < 16; ++kk) acc[kk] = 0.f;
            for (int dd = 0; dd < 128; ++dd) {
                const float tr = T128[(dout * dd - (cs ? 32 : 0)) & 127];
#pragma unroll
                for (int kk = 0; kk < 16; ++kk) acc[kk] += Wl[(kg * 16 + kk) * 128 + dd] * tr;
            }
            bf16* dst = (bf16*)(ws + WS_WIN) + (size_t)l * PW * DM + toff(PFA + cs * 512 + g * 128 + dout, kb * 32 + kg * 16, DM);
            v4u o0, o1; o0.x = pk2(acc[0], acc[1]); o0.y = pk2(acc[2], acc[3]); o0.z = pk2(acc[4], acc[5]); o0.w = pk2(acc[6], acc[7]);
            o1.x = pk2(acc[8], acc[9]); o1.y = pk2(acc[10], acc[11]); o1.z = pk2(acc[12], acc[13]); o1.w = pk2(acc[14], acc[15]);
            *(v4u*)dst = o0; *(v4u*)(dst + 8) = o1;
            __syncthreads();
        }
    }
    __syncthreads();
    {
        LAS float* T = (LAS float*)F.lds;
        for (int i = F.tid; i < 4096; i += NTHR) T[i] = cospif((float)i * (1.f / 2048.f));
        __syncthreads();
        bf16* A1 = (bf16*)(ws + WS_A1);
        for (int idx = F.bx * NTHR + F.tid; idx < 256 * 32; idx += F.G * NTHR) {
            const int m = idx >> 5, kk0 = (idx & 31) * 8; const int cho = m >> 7, k2 = (m & 127) >> 1, ro = m & 1; float x[8];
#pragma unroll
            for (int e2 = 0; e2 < 8; ++e2) { const int kk = kk0 + e2, chi = kk >> 7, ri = (kk >> 6) & 1, aa = kk & 63;
                const float cs_ = T[(64 * k2 * aa) & 4095], sn_ = T[(64 * k2 * aa - 1024) & 4095];
                const float v = ro == 0 ? (ri == 0 ? cs_ : -sn_) : (ri == 0 ? -sn_ : -cs_);
                x[e2] = (cho == chi) ? v : 0.f; }
            *(v4u*)(A1 + (size_t)m * 256 + kk0) = pack8(x);
        }
        bf16* A2 = (bf16*)(ws + WS_A2);
        for (int idx = F.bx * NTHR + F.tid; idx < 16 * 256 * 64; idx += F.G * NTHR) {
            const int kk0 = (idx & 63) * 8, m = (idx >> 6) & 255, q = idx >> 14; const int k2p = m >> 6, k1 = m & 63, k = 4 * q + k2p + 64 * k1; float x[8];
#pragma unroll
            for (int e2 = 0; e2 < 8; ++e2) { const int kk = kk0 + e2, k2pp = kk >> 7, ro = (kk >> 6) & 1, c = kk & 63;
                const float v = ro == 0 ? T[(k * c) & 4095] : T[(k * c - 1024) & 4095];
                x[e2] = (k2pp == k2p) ? v : 0.f; }
            *(v4u*)(A2 + ((size_t)q * 256 + m) * 512 + kk0) = pack8(x);
        }
        bf16* F2 = (bf16*)(ws + WS_F256);
        for (int k = F.bx; k < 256; k += F.G) {
            if (F.tid < 64) { const int j0 = F.tid * 8; const int cs = j0 >> 8, t0 = j0 & 255; float x[8];
#pragma unroll
                for (int e = 0; e < 8; ++e) { const int m = (16 * k * (t0 + e) - (cs ? 1024 : 0)) & 4095; const float v = T[m]; x[e] = cs ? -v : v; }
                *(v4u*)(F2 + (size_t)k * 512 + j0) = pack8(x); }
        }
    }
    if (F.bx == 0) {
        f32x2* ROPE = (f32x2*)(ws + WS_ROPE);
        for (int i = F.tid; i < 64 * 32; i += NTHR) { const int pos = i >> 5, ii = i & 31; const float freq = powf(10000.f, -(float)(2 * ii) / 64.f); const float ang = (float)pos * freq;
            ROPE[i] = (f32x2){cosf(ang), sinf(ang)}; }
    }
    __syncthreads();
}

__device__ __forceinline__ void p0b_modreduce(KArgs a) {
    Frame F = make_frame(a);
    const float* MODP = (const float*)(F.ws + WS_MODP); float* MOD = (float*)(F.ws + WS_MOD);
    for (int i = F.bx * NTHR + F.tid; i < DEPTH * 5 * (NMOD / 4); i += F.G * NTHR) {
        const int j4 = i % (NMOD / 4), lv = i / (NMOD / 4), l = lv / 5;
        f32x4 s = *(const f32x4*)(a->in[I_BMOD] + (size_t)l * NMOD + j4 * 4);
#pragma unroll
        for (int ks = 0; ks < 16; ++ks) s += *(const f32x4*)(MODP + ((size_t)ks * (DEPTH * 5) + lv) * NMOD + j4 * 4);
        *(f32x4*)(MOD + (size_t)lv * NMOD + j4 * 4) = s;
    }
}

__device__ __forceinline__ void norm_phase(KArgs a, int M, const float* g, const float* modl, int shoff, int scoff, bool fold, bool lat_in, bool ctx_in) {
    Frame F = make_frame(a);
    bf16* X = (bf16*)(F.ws + WS_X); bf16* H = (bf16*)(F.ws + WS_H); const float* XP = (const float*)(F.ws + WS_XP);
    for (int row = F.gw; row < M; row += F.ngw) {
        const int v = row < ML ? row >> 12 : 4;
        const float* sh = modl + (size_t)v * NMOD + shoff; const float* sc = modl + (size_t)v * NMOD + scoff;
        v4u* xr = (v4u*)(X + (size_t)row * DM) + F.lane;
        f32x4 x[4][2]; float ss = 0.f;
        if (row < ML ? lat_in : ctx_in) { const f32x4* xs = (const f32x4*)(row < ML ? a->in[I_X] + (size_t)row * DM : a->in[I_CTX] + (size_t)(row - ML) * DM) + 2 * F.lane;
#pragma unroll
            for (int j = 0; j < 4; ++j) { x[j][0] = xs[128 * j]; x[j][1] = xs[128 * j + 1]; } }
        else {
#pragma unroll
            for (int j = 0; j < 4; ++j) { const v4u w = xr[64 * j]; x[j][0] = (f32x4){bflo(w.x), bfhi(w.x), bflo(w.y), bfhi(w.y)}; x[j][1] = (f32x4){bflo(w.z), bfhi(w.z), bflo(w.w), bfhi(w.w)}; } }
        if (fold && row >= ML) {
#pragma unroll
            for (int ks = 0; ks < 4; ++ks) { const f32x4* pr = (const f32x4*)(XP + ((size_t)ks * MC + (row - ML)) * DM) + 2 * F.lane;
#pragma unroll
                for (int j = 0; j < 4; ++j) { x[j][0] += pr[128 * j]; x[j][1] += pr[128 * j + 1]; } }
#pragma unroll
            for (int j = 0; j < 4; ++j) { v4u w; w.x = pk2(x[j][0].x, x[j][0].y); w.y = pk2(x[j][0].z, x[j][0].w); w.z = pk2(x[j][1].x, x[j][1].y); w.w = pk2(x[j][1].z, x[j][1].w); xr[64 * j] = w; }
        }
#pragma unroll
        for (int j = 0; j < 4; ++j)
#pragma unroll
            for (int h = 0; h < 2; ++h) ss += (x[j][h].x * x[j][h].x + x[j][h].y * x[j][h].y) + (x[j][h].z * x[j][h].z + x[j][h].w * x[j][h].w);
        const float rstd = 1.0f / sqrtf(wave_sum(ss) * (1.f / DM) + EPS);
#pragma unroll
        for (int j = 0; j < 4; ++j) { const int col = F.lane * 8 + 512 * j; f32x4 y[2];
#pragma unroll
            for (int h = 0; h < 2; ++h) { const f32x4 gg = *(const f32x4*)(g + col + 4 * h), s1 = *(const f32x4*)(sc + col + 4 * h), s0 = *(const f32x4*)(sh + col + 4 * h);
                y[h] = x[j][h] * rstd * gg * (s1 + 1.0f) + s0; }
            v4u o; o.x = pk2(y[0].x, y[0].y); o.y = pk2(y[0].z, y[0].w); o.z = pk2(y[1].x, y[1].y); o.w = pk2(y[1].z, y[1].w);
            *(v4u*)(H + (size_t)row * DM + col) = o; }
    }
}

__device__ __forceinline__ void final_norm_phase(KArgs a, const float* g, float* out) {
    Frame F = make_frame(a);
    const bf16* X = (const bf16*)(F.ws + WS_X);
    for (int row = F.gw; row < ML; row += F.ngw) {
        const v2u* xr = (const v2u*)(X + (size_t)row * DM) + F.lane;
        f32x4 x[8]; float ss = 0.f;
#pragma unroll
        for (int j = 0; j < 8; ++j) { const v2u w = xr[64 * j]; x[j] = (f32x4){bflo(w.x), bfhi(w.x), bflo(w.y), bfhi(w.y)}; ss += (x[j].x * x[j].x + x[j].y * x[j].y) + (x[j].z * x[j].z + x[j].w * x[j].w); }
        const float rstd = 1.0f / sqrtf(wave_sum(ss) * (1.f / DM) + EPS);
#pragma unroll
        for (int j = 0; j < 8; ++j) { const int col = F.lane * 4 + 256 * j; const f32x4 gg = *(const f32x4*)(g + col);
            *(f32x4*)(out + (size_t)row * DM + col) = x[j] * rstd * gg; }
    }
}

__device__ __forceinline__ float gelu_fast(float x) { const float y = 1.5957691216057308f * (x + 0.044715f * x * x * x); return x * __builtin_amdgcn_rcpf(1.f + __expf(-y)); }

__device__ __forceinline__ void postA_phase(KArgs a, int l) {
    Frame F = make_frame(a); unsigned char* ws = F.ws;
    const bf16* P = (const bf16*)(ws + WS_P); bf16* MIX = (bf16*)(ws + WS_MIX); bf16* KB = (bf16*)(ws + WS_KB); bf16* VB = (bf16*)(ws + WS_VB);
    bf16* QB = (bf16*)(ws + WS_QB); bf16* UB = (bf16*)(ws + WS_UB); bf16* V2B = (bf16*)(ws + WS_V2B);
    const f32x4* ROPE4 = (const f32x4*)(ws + WS_ROPE);
    const int lane = F.lane, tid = F.tid;
    {
        const int hl = lane & 15, axis = hl >> 3, i0 = (lane & 3) * 8; const bool first = (lane & 7) < 4;
        float qg8[8], kg8[8], cw0[8], cw1[8], cw2[8], lg8[8], lb8[8];
        { const float* qg = a->in[I_QG] + l * 128 + hl * 8; const float* kg = a->in[I_KG] + l * 128 + hl * 8; const float* cw = a->in[I_CONVW] + (size_t)l * 3 * 512 + lane * 8;
          const float* lng = a->in[I_LNG] + l * 512 + lane * 8; const float* lnb = a->in[I_LNB] + l * 512 + lane * 8;
#pragma unroll
          for (int e = 0; e < 8; ++e) { qg8[e] = qg[e]; kg8[e] = kg[e]; cw0[e] = cw[e]; cw1[e] = cw[512 + e]; cw2[e] = cw[1024 + e]; lg8[e] = lng[e]; lb8[e] = lnb[e]; } }
        for (int row = F.gw; row < MT; row += F.ngw) {
            const bool is_ctx = row >= ML;
            const int b = is_ctx ? (row - ML) >> 8 : row >> 12, p = is_ctx ? (row - ML) & 255 : row & 4095, nseq = is_ctx ? CTXL : SEQ;
            const bool kv_only = is_ctx && (l == DEPTH - 1);
            const bf16* Pr = P + (size_t)row * PW;
            const int kvpos = is_ctx ? p : CTXL + p;
            const v4u rkv = *(const v4u*)(Pr + PK + lane * 8);
            f32x4 c4[4];
            if (!is_ctx) { const int posax = axis ? (p & 63) : (p >> 6);
#pragma unroll
                for (int e = 0; e < 4; ++e) c4[e] = ROPE4[posax * 16 + (i0 >> 1) + e]; }
            {
                float x[8]; unpack8(rkv, x); float ss = 0.f;
#pragma unroll
                for (int e = 0; e < 8; ++e) ss += x[e] * x[e];
                ss += __shfl_xor(ss, 1); ss += __shfl_xor(ss, 2); ss += __shfl_xor(ss, 4); ss += __shfl_xor(ss, 8);
                const float rstd = 1.0f / sqrtf(ss * (1.f / 128.f) + EPS);
                float y[8];
#pragma unroll
                for (int e = 0; e < 8; ++e) y[e] = x[e] * rstd * kg8[e];
                if (!is_ctx) {
#pragma unroll
                    for (int e = 0; e < 8; ++e) { const float pr = __shfl_xor(y[e], 4); const float cs_ = c4[e >> 1][(e & 1) * 2], sn_ = c4[e >> 1][(e & 1) * 2 + 1]; y[e] = first ? y[e] * cs_ - pr * sn_ : y[e] * cs_ + pr * sn_; } }
                if (lane < 32) *(v4u*)(KB + ((size_t)b * SKV + kvpos) * 256 + lane * 8) = pack8(y);
                else *(v4u*)(VB + ((size_t)b * SKV + kvpos) * 256 + (lane - 32) * 8) = rkv;
            }
            if (kv_only) continue;
            const v4u rq0 = *(const v4u*)(Pr + PQ + lane * 8), rq1 = *(const v4u*)(Pr + PQ + 512 + lane * 8);
            const v4u rcb = *(const v4u*)(Pr + PCB + lane * 8), rc0 = *(const v4u*)(Pr + PCC + lane * 8), rh0 = *(const v4u*)(Pr + PCH + lane * 8);
            const bool hp = p > 0, hn = p < nseq - 1;
            const bf16* Pm = hp ? Pr - PW : Pr; const bf16* Pn = hn ? Pr + PW : Pr;
            const v4u rcm = *(const v4u*)(Pm + PCC + lane * 8), rhm = *(const v4u*)(Pm + PCH + lane * 8), rcp = *(const v4u*)(Pn + PCC + lane * 8), rhp = *(const v4u*)(Pn + PCH + lane * 8);
            const v4u rgu = *(const v4u*)(Pr + PGU + lane * 8), rgv = *(const v4u*)(Pr + PGV + lane * 8);
#pragma unroll
            for (int part = 0; part < 2; ++part) {
                float x[8]; unpack8(part ? rq1 : rq0, x); float ss = 0.f;
#pragma unroll
                for (int e = 0; e < 8; ++e) ss += x[e] * x[e];
                ss += __shfl_xor(ss, 1); ss += __shfl_xor(ss, 2); ss += __shfl_xor(ss, 4); ss += __shfl_xor(ss, 8);
                const float rstd = 1.0f / sqrtf(ss * (1.f / 128.f) + EPS);
                float y[8];
#pragma unroll
                for (int e = 0; e < 8; ++e) y[e] = x[e] * rstd * qg8[e];
                if (!is_ctx) {
#pragma unroll
                    for (int e = 0; e < 8; ++e) { const float pr = __shfl_xor(y[e], 4); const float cs_ = c4[e >> 1][(e & 1) * 2], sn_ = c4[e >> 1][(e & 1) * 2 + 1]; y[e] = first ? y[e] * cs_ - pr * sn_ : y[e] * cs_ + pr * sn_; } }
                *(v4u*)(QB + (size_t)row * 1024 + part * 512 + lane * 8) = pack8(y);
            }
            {
                float cb[8], c0[8], h0[8], cm[8], hm[8], cp[8], hq[8], o[8];
                unpack8(rcb, cb); unpack8(rc0, c0); unpack8(rh0, h0); unpack8(rcm, cm); unpack8(rhm, hm); unpack8(rcp, cp); unpack8(rhp, hq);
                const float fp = hp ? 1.f : 0.f, fn = hn ? 1.f : 0.f;
#pragma unroll
                for (int e = 0; e < 8; ++e) o[e] = cb[e] * (cw0[e] * fp * (cm[e] * hm[e]) + cw1[e] * (c0[e] * h0[e]) + cw2[e] * fn * (cp[e] * hq[e]));
                *(v4u*)(MIX + (size_t)row * MIXW + MX_CONV + lane * 8) = pack8(o);
            }
            {
                float u[8], t[8]; unpack8(rgu, u); unpack8(rgv, t);
                float s = 0.f;
#pragma unroll
                for (int e = 0; e < 8; ++e) { u[e] = gelu_fast(u[e]); t[e] = gelu_fast(t[e]); s += t[e]; }
                const float mean = wave_sum(s) * (1.f / 512.f);
                float q = 0.f;
#pragma unroll
                for (int e = 0; e < 8; ++e) { t[e] -= mean; q += t[e] * t[e]; }
                const float rstd = 1.0f / sqrtf(wave_sum(q) * (1.f / 512.f) + EPS);
#pragma unroll
                for (int e = 0; e < 8; ++e) t[e] = t[e] * rstd * lg8[e] + lb8[e];
                *(v4u*)(UB + (size_t)row * 512 + lane * 8) = pack8(u); *(v4u*)(V2B + (size_t)row * 512 + lane * 8) = pack8(t);
            }
        }
    }
    {
        LAS unsigned* tb = (LAS unsigned*)F.lds;
        bf16* S1 = (bf16*)(ws + WS_T1T);
        for (int un = F.bx; un < 512; un += F.G) {
            const int ab = un >> 6, b = (un >> 4) & 3, slab = un & 15;
            const size_t rowb = (size_t)b * SEQ + (size_t)ab * 512;
#pragma unroll
            for (int it = 0; it < 4; ++it) {
                const int idx = tid + it * NTHR; const int j = idx & 3, c = (idx >> 2) & 63, c8 = idx >> 8;
                const bf16* src0 = P + (rowb + (size_t)(2 * j) * 64 + c) * PW + PFA + slab * 64 + c8 * 8;
                const v4u r0 = *(const v4u*)src0, r1 = *(const v4u*)(src0 + (size_t)64 * PW);
                const unsigned a0[4] = {r0.x, r0.y, r0.z, r0.w}, a1[4] = {r1.x, r1.y, r1.z, r1.w};
#pragma unroll
                for (int w = 0; w < 4; ++w) {
                    tb[((c8 * 8 + 2 * w) * 64 + c) * 4 + j]     = (a0[w] & 0xffffu) | (a1[w] << 16);
                    tb[((c8 * 8 + 2 * w + 1) * 64 + c) * 4 + j] = (a0[w] >> 16) | (a1[w] & 0xffff0000u);
                }
            }
            __syncthreads();
#pragma unroll
            for (int it = 0; it < 8; ++it) {
                const int idx = tid + it * NTHR; const int c = idx & 63, col = idx >> 6;
                const v4u o = *(const LAS v4u*)(tb + (col * 64 + c) * 4);
                const int gcol = slab * 64 + col, ri = gcol >> 9, n = b * 512 + (gcol & 511);
                *(v4u*)(S1 + ((((size_t)n * 32 + (c & 31)) * 2 + (c >> 5)) * 2 + ri) * 64 + ab * 8) = o;
            }
            __syncthreads();
        }
    }
    if (l < DEPTH - 1) {
        LAS unsigned* tb = (LAS unsigned*)F.lds;
        for (int un = F.bx; un < 32; un += F.G) {
            const int chc = un >> 2, slab = un & 3;
            const int b = chc >> 1, p0 = (chc & 1) * 128;
            const int row0 = ML + b * CTXL + p0;
            bf16* T1 = (bf16*)(ws + WS_T1TC);
#pragma unroll
            for (int it = 0; it < 4; ++it) {
                const int q = tid + it * NTHR;
                const int c8 = ((q >> 6) & 3) * 8 + (q & 7), rp = (q >> 8) * 8 + ((q >> 3) & 7);
                const v4u r0 = *(const v4u*)(P + (size_t)(row0 + 2 * rp) * PW + PFA + slab * 256 + c8 * 8);
                const v4u r1 = *(const v4u*)(P + (size_t)(row0 + 2 * rp + 1) * PW + PFA + slab * 256 + c8 * 8);
                const unsigned a0[4] = {r0.x, r0.y, r0.z, r0.w}, a1[4] = {r1.x, r1.y, r1.z, r1.w};
#pragma unroll
                for (int w = 0; w < 4; ++w) {
                    tb[(c8 * 8 + 2 * w) * 65 + rp]     = (a0[w] & 0xffffu) | (a1[w] << 16);
                    tb[(c8 * 8 + 2 * w + 1) * 65 + rp] = (a0[w] >> 16) | (a1[w] & 0xffff0000u);
                }
            }
            __syncthreads();
#pragma unroll
            for (int it = 0; it < 8; ++it) {
                const int idx = tid + it * NTHR; const int cc = idx >> 4, t8 = idx & 15;
                v4u o; o.x = tb[cc * 65 + t8 * 4]; o.y = tb[cc * 65 + t8 * 4 + 1]; o.z = tb[cc * 65 + t8 * 4 + 2]; o.w = tb[cc * 65 + t8 * 4 + 3];
                const int col = slab * 256 + cc, csn = col >> 9, gd = col & 511;
                *(v4u*)(T1 + (size_t)(b * 512 + gd) * 512 + csn * CTXL + p0 + t8 * 8) = o;
            }
            __syncthreads();
        }
    }
}

__device__ __forceinline__ void gate_phase(KArgs a, int l, int wg0, int nwg, int u_lo, int u_hi) {
    Frame F = make_frame(a); unsigned char* ws = F.ws;
    F.bx -= wg0; if (F.bx < 0 || F.bx >= nwg) return;
    const bf16* UB = (const bf16*)(ws + WS_UB); const bf16* V2B = (const bf16*)(ws + WS_V2B); bf16* MIX = (bf16*)(ws + WS_MIX);
    const float* gws = a->in[I_GMWS] + (size_t)l * 4 * 128 * 128; const float* gmb = a->in[I_GMB] + l * 4 * 128;
    const int tid = F.tid, lane = F.lane, r32 = lane & 31, hi = lane >> 5, gsel = F.wave >> 2, qb = F.wave & 3;
    for (int un = u_lo + F.bx; un < u_hi; un += nwg) {
        const int ch = un >> 1, gp = un & 1;
        const bool is_ctx = ch >= 128;
        const int b = is_ctx ? (ch - 128) >> 1 : ch >> 5;
        const int p0 = is_ctx ? ((ch - 128) & 1) * 128 : (ch & 31) * 128;
        const int row0 = is_ctx ? ML + b * CTXL + p0 : b * SEQ + p0;
#pragma unroll
        for (int it = 0; it < 8; ++it) { const int idx = tid + it * NTHR; const int gi = idx >> 11, pp = (idx >> 4) & 127, c8 = idx & 15;
            const v4u v = *(const v4u*)(V2B + (size_t)(row0 + pp) * 512 + (2 * gp + gi) * 128 + c8 * 8);
            *(LAS v4u*)(F.lds + (gi * 2 + (pp >> 6)) * 16384 + att::v_st(pp & 63, c8 * 8)) = v; }
        __syncthreads();
        const int g = 2 * gp + gsel;
        att::f32x16 o[4] = {};
#pragma unroll
        for (int kt = 0; kt < 2; ++kt) {
            const float* wrow = gws + ((size_t)g * 128 + 32 * qb + r32) * 128 + 64 * kt + 8 * hi;
            att::bf16x8 pa[4];
#pragma unroll
            for (int ks = 0; ks < 4; ++ks) { const f32x4 w0 = *(const f32x4*)(wrow + 16 * ks), w1 = *(const f32x4*)(wrow + 16 * ks + 4);
                v4u w; w.x = pk2(w0.x, w0.y); w.y = pk2(w0.z, w0.w); w.z = pk2(w1.x, w1.y); w.w = pk2(w1.z, w1.w); pa[ks] = *reinterpret_cast<att::bf16x8*>(&w); }
            const int vb = (int)(unsigned)(uintptr_t)(F.lds + (gsel * 2 + kt) * 16384) + att::v_rd_base(lane);
            att::pv_d0(o, vb, pa[0], pa[1], pa[2], pa[3]);
        }
#pragma unroll
        for (int r = 0; r < 16; ++r) { const int q = 32 * qb + att::crow(r, hi); const float bias = gmb[g * 128 + q];
            const bf16* up = UB + (size_t)(row0 + q) * 512 + g * 128 + r32; bf16* mp = MIX + (size_t)(row0 + q) * MIXW + MX_GM + g * 128 + r32;
#pragma unroll
            for (int d0 = 0; d0 < 4; ++d0) { const float u = __uint_as_float((unsigned)up[d0 * 32] << 16); const float val = u * (o[d0][r] + bias); mp[d0 * 32] = (bf16)(pk2(val, val) & 0xffffu); } }
        __syncthreads();
    }
}

__device__ __forceinline__ void act_fix_phase(KArgs a, int l, int M) {
    Frame F = make_frame(a);
    const float* EDGE = (const float*)(F.ws + WS_EDGE); bf16* ACT = (bf16*)(F.ws + WS_ACT);
    const float* cw = a->in[I_FCW] + (size_t)l * 3 * DFF; const float* cb = a->in[I_FCB] + (size_t)l * DFF;
    constexpr int CG = DFF / 4;
    const int total = (M / 256) * 2 * CG;
    for (int idx = F.bx * NTHR + F.tid; idx < total; idx += F.G * NTHR) {
        const int c0 = (idx % CG) * 4, pw = idx / CG, which = pw & 1, pm = pw >> 1;
        const bool first = pm >= 64 || (pm & 15) == 0, last = pm >= 64 || (pm & 15) == 15;
        const float* e = EDGE + (size_t)pm * 6 * DFF + c0;
        f32x4 prev, cur, next, uu; const f32x4 zero = (f32x4){0.f, 0.f, 0.f, 0.f};
        if (which == 0) { prev = first ? zero : *(const f32x4*)(e - (size_t)6 * DFF + (size_t)3 * DFF); cur = *(const f32x4*)e; next = *(const f32x4*)(e + DFF); uu = *(const f32x4*)(e + (size_t)4 * DFF); }
        else { prev = *(const f32x4*)(e + (size_t)2 * DFF); cur = *(const f32x4*)(e + (size_t)3 * DFF); next = last ? zero : *(const f32x4*)(e + (size_t)6 * DFF); uu = *(const f32x4*)(e + (size_t)5 * DFF); }
        const f32x4 z = *(const f32x4*)(cw + c0) * prev + *(const f32x4*)(cw + DFF + c0) * cur + *(const f32x4*)(cw + 2 * DFF + c0) * next + *(const f32x4*)(cb + c0);
        float o[4];
#pragma unroll
        for (int j = 0; j < 4; ++j) o[j] = z[j] * __builtin_amdgcn_rcpf(1.f + __expf(-z[j])) * uu[j];
        v2u w; w.x = pk2(o[0], o[1]); w.y = pk2(o[2], o[3]);
        *(v2u*)(ACT + (size_t)(pm * 256 + (which ? 255 : 0)) * DFF + c0) = w;
    }
}

constexpr int PH_P0A = 0, PH_P0B = 1, PH_L0 = 2, PH_PER_LAYER = 10, PH_FINAL = PH_L0 + DEPTH * PH_PER_LAYER, N_PHASES = PH_FINAL + 1;

__device__ __forceinline__ void gemm_in_phase(KArgs a, int l) {
    unsigned char* ws = a->ws; extern __shared__ __attribute__((aligned(16))) unsigned char lds_[];
    pg8::Gemm g{(const bf16*)(ws + WS_H), (const bf16*)(ws + WS_WIN) + (size_t)l * PW * DM, MT, PW, DM, DM, DM, 0, 0, 1};
    pg8::StaticOrder S; S.init(MT, PW, gridDim.x, blockIdx.x, DM);
    pg8::EpiBf16 E{(bf16*)(ws + WS_P), PW};
    pg8::gemm_phase<pg8::EpiBf16, pg8::StaticOrder, true, true>((LAS unsigned char*)lds_, g, S, E);
}
__device__ __forceinline__ void gemm_in_probe(KArgs a, int l) {
    unsigned char* ws = a->ws; extern __shared__ __attribute__((aligned(16))) unsigned char lds_[];
    pg8::Gemm g{(const bf16*)(ws + WS_H), (const bf16*)(ws + WS_WIN) + (size_t)l * PW * DM, MT, PW, DM, DM, DM, 0, 0, 1};
    pg8::StaticOrder S; S.init(MT, PW, gridDim.x, blockIdx.x, DM);
    pg8::EpiNone E{};
    pg8::gemm_phase<pg8::EpiNone, pg8::StaticOrder, true, true>((LAS unsigned char*)lds_, g, S, E);
}
__device__ __forceinline__ void gemm_up_phase(KArgs a, int l, int M2) {
    unsigned char* ws = a->ws; extern __shared__ __attribute__((aligned(16))) unsigned char lds_[];
    pg8::Gemm g{(const bf16*)(ws + WS_H), (const bf16*)(ws + WS_WUP) + (size_t)l * UPW * DM, M2, UPW, DM, DM, DM, 0, 0, 1};
    pg8::StaticOrder S; S.init(M2, UPW, gridDim.x, blockIdx.x, DM);
    pg8::EpiUp E{(bf16*)(ws + WS_ACT), (float*)(ws + WS_EDGE), a->in[I_FCW] + (size_t)l * 3 * DFF, a->in[I_FCB] + (size_t)l * DFF, (LAS float*)((LAS unsigned char*)lds_ + XL_OFF), DFF};
    pg8::gemm_phase<pg8::EpiUp, pg8::StaticOrder, true, true>((LAS unsigned char*)lds_, g, S, E);
}
__device__ __forceinline__ void gemm_out_phase(KArgs a, int l, int M2) {
    unsigned char* ws = a->ws; extern __shared__ __attribute__((aligned(16))) unsigned char lds_[];
    pg8::Gemm g{(const bf16*)(ws + WS_MIX), (const bf16*)(ws + WS_WOUT) + (size_t)l * DM * MIXW, M2, DM, MIXW, MIXW, MIXW, 0, 0, 1};
    pg8::SplitOrder S; S.init(ML, (M2 - ML) / 256, DM, gridDim.x, blockIdx.x, MIXW);
    pg8::EpiResGate E{(bf16*)(ws + WS_X), (const float*)(ws + WS_MOD) + (size_t)l * 5 * NMOD, 2 * DM, (float*)(ws + WS_XP), l == 0 ? a->in[I_X] : (const float*)nullptr};
    pg8::gemm_phase<pg8::EpiResGate, pg8::SplitOrder, true, true>((LAS unsigned char*)lds_, g, S, E);
}
__device__ __forceinline__ void gemm_down_phase(KArgs a, int l, int M2) {
    unsigned char* ws = a->ws; extern __shared__ __attribute__((aligned(16))) unsigned char lds_[];
    pg8::Gemm g{(const bf16*)(ws + WS_ACT), (const bf16*)(ws + WS_WDN) + (size_t)l * DM * DFF, M2, DM, DFF, DFF, DFF, 0, 0, 1};
    pg8::SplitOrder S; S.init(ML, (M2 - ML) / 256, DM, gridDim.x, blockIdx.x, DFF);
    pg8::EpiResGate E{(bf16*)(ws + WS_X), (const float*)(ws + WS_MOD) + (size_t)l * 5 * NMOD, 5 * DM, (float*)(ws + WS_XP), (const float*)nullptr};
    pg8::gemm_phase<pg8::EpiResGate, pg8::SplitOrder, true, true>((LAS unsigned char*)lds_, g, S, E);
}
__device__ __forceinline__ void attn_phase(KArgs a, int l, int part, int wg0) {
    unsigned char* ws = a->ws; extern __shared__ __attribute__((aligned(16))) unsigned char lds_[];
    const bf16* QB = (const bf16*)(ws + WS_QB); const bf16* KB = (const bf16*)(ws + WS_KB); const bf16* VB = (const bf16*)(ws + WS_VB); bf16* MIX = (bf16*)(ws + WS_MIX);
    const int G = gridDim.x, bx = blockIdx.x;
    const int xcd = bx & 7, wq = bx >> 3;
    const int ulo = part ? 512 + ((bx - wg0 + G) % G) : bx, uhi = part ? ((l < DEPTH - 1) ? 544 : 0) : 512;
    for (int u = ulo; u < uhi; u += G) {
        int b, h, kvh, qrow, seq;
        if (u < 512) { const int i = u / G; const int j = (G == 256) ? wq + 32 * i : (u >> 3), x = (G == 256) ? xcd : (u & 7);
            b = x >> 1; kvh = x & 1; h = kvh * 4 + (j >> 4); qrow = b * SEQ + (j & 15) * 256; seq = SKV; }
        else { const int c = u - 512; b = c >> 3; h = c & 7; kvh = h >> 2; qrow = ML + b * CTXL; seq = CTXL; }
        att::attn_dense_body(QB + (size_t)qrow * 1024 + h * 128, KB + (size_t)b * SKV * 256 + kvh * 128, VB + (size_t)b * SKV * 256 + kvh * 128,
                             MIX + (size_t)qrow * MIXW + MX_ATT + h * 128, seq, (char*)lds_);
    }
}
__device__ __forceinline__ void dft1_phase(KArgs a, int l) {
    unsigned char* ws = a->ws; extern __shared__ __attribute__((aligned(16))) unsigned char lds_[];
    pg8::Gemm g{(const bf16*)(ws + WS_A1), (const bf16*)(ws + WS_T1T), 256, 65536, 256, 256, 256, 0};
    pg8::StaticOrder S; S.init(256, 65536, gridDim.x, blockIdx.x, 256);
    pg8::EpiS1 E{(bf16*)(ws + WS_S2IN)};
    pg8::gemm_phase<pg8::EpiS1, pg8::StaticOrder, true, true>((LAS unsigned char*)lds_, g, S, E);
}
__device__ __forceinline__ void dft2_phase(KArgs a, int l) {
    unsigned char* ws = a->ws; extern __shared__ __attribute__((aligned(16))) unsigned char lds_[];
    const int G = gridDim.x, bx = blockIdx.x;
    {
        pg8::Gemm g{(const bf16*)(ws + WS_A2), (const bf16*)(ws + WS_S2IN), 4096, 2048, 512, 512, 512, (size_t)2048 * 512 * 2};
        pg8::StaticOrder S; S.init(4096, 2048, G, (bx + G / 2) % G, 512);
        pg8::EpiS2 E{(bf16*)(ws + WS_MIX), 0.0013810679320049757f};
        pg8::gemm_phase<pg8::EpiS2, pg8::StaticOrder, true, true>((LAS unsigned char*)lds_, g, S, E);
    }
    if (l < DEPTH - 1) {
        pg8::Gemm g{(const bf16*)(ws + WS_F256), (const bf16*)(ws + WS_T1TC), CTXL, 2048, 512, 512, 512, 0};
        pg8::StaticOrder S; S.init(CTXL, 2048, G, (bx + G - 96) % G, 512);
        pg8::EpiDft E{(bf16*)(ws + WS_MIX), ML, CTXL, 0.005524271728019903f};
        pg8::gemm_phase<pg8::EpiDft, pg8::StaticOrder, true, true>((LAS unsigned char*)lds_, g, S, E);
    }
}

__global__ void __launch_bounds__(NTHR, 2) hybrid_fwd(Args args_by_value) {
    extern __shared__ __attribute__((aligned(16))) unsigned char lds[];
    (void)args_by_value;
    int lo, hi; unsigned* ctl;
    { KArgs a = kargs(); lo = a->ph_lo; hi = a->ph_hi; ctl = (unsigned*)(a->ws + WS_CTL); }
    volatile LAS unsigned* MISC = (volatile LAS unsigned*)((LAS unsigned char*)lds + MISC_OFF);
    for (int u = threadIdx.x; u < (LDS_BYTES - LDSCTL_OFF) / 4; u += NTHR) ((LAS unsigned*)((LAS unsigned char*)lds + LDSCTL_OFF))[u] = 0u;
    __syncthreads();
    XcdBarrier bar; bar.bar = ctl + CW_BAR; bar.x = 0; bar.st = nullptr;
    if (!MK_PER_PHASE) bar = xcd_barrier_post(ctl + CW_BAR, MISC + 8);
#define IN(k) (lo <= (k) && (k) < hi)
#define SEAM(k) do { if (IN((k) + 1)) { if (MK_PER_PHASE) { if (threadIdx.x == 0) __hip_atomic_store(ctl + CW_TMO, 0xBADBA0u, RLX_AGENT); } else { xcd_barrier(bar); if (DUP(8)) xcd_barrier(bar); } } } while (0)

    for (int rep = 0; rep < (DUP(13) ? 2 : 1); ++rep) {
    if (rep) xcd_barrier(bar);
    if (IN(PH_P0A)) { p0a_prologue(kargs()); if (DUP(0)) p0a_prologue(kargs()); SEAM(PH_P0A); }
    if (IN(PH_P0B)) { p0b_modreduce(kargs()); SEAM(PH_P0B); }

    for (int l = 0; l < DEPTH; ++l) {
        int ph = PH_L0 + l * PH_PER_LAYER;
        const int M2 = (l == DEPTH - 1) ? ML : MT;
#define PHASE(kbit, call) do { if (IN(ph)) { call; if (DUP(kbit)) { if (DUP(15) && !MK_PER_PHASE) xcd_barrier(bar); call; } SEAM(ph); } ++ph; } while (0)
#define MODL ((const float*)(kargs()->ws + WS_MOD) + (size_t)l * 5 * NMOD)
        PHASE(12, norm_phase(kargs(), MT, kargs()->in[I_N1G] + l * DM, MODL, 0 * DM, 1 * DM, l > 0, l == 0, l == 0));
        PHASE(2, gemm_in_phase(kargs(), l));
        if (DUP(11) && IN(ph)) { gemm_in_probe(kargs(), l); xcd_barrier(bar); }
        PHASE(9, postA_phase(kargs(), l));
        PHASE(3, { attn_phase(kargs(), l, 0, 0); dft1_phase(kargs(), l); gate_phase(kargs(), l, 0, (int)gridDim.x, 0, min((int)gridDim.x, (l == DEPTH - 1 ? 128 : 136) * 2)); });
        PHASE(6, { gate_phase(kargs(), l, 0, (int)gridDim.x / 2, (int)gridDim.x, (l == DEPTH - 1 ? 128 : 136) * 2); attn_phase(kargs(), l, 1, 16); dft2_phase(kargs(), l); });
        PHASE(14, gemm_out_phase(kargs(), l, M2));
        PHASE(12, norm_phase(kargs(), M2, kargs()->in[I_N2G] + l * DM, MODL, 3 * DM, 4 * DM, l < DEPTH - 1, false, l == 0));
        PHASE(5, gemm_up_phase(kargs(), l, M2));
        PHASE(10, act_fix_phase(kargs(), l, M2));
        PHASE(14, gemm_down_phase(kargs(), l, M2));
#undef MODL
#undef PHASE
    }
    if (IN(PH_FINAL)) { KArgs a = kargs(); final_norm_phase(a, a->in[I_FNG], a->out); }
    }
#undef IN
#undef SEAM
}

extern "C" void kernel_launch(void* const* d_in, const int* in_sizes, int n_in, void* d_out, int out_size, void* d_ws, size_t ws_size, hipStream_t stream) {
    static int grid = 0;
    if (grid == 0) {
        if (n_in != 22 || out_size != ML * DM || ws_size < WS_END) { fprintf(stderr, "kernel_launch: unexpected shapes: n_in %d out %d ws %zu (need %zu)\n", n_in, out_size, ws_size, (size_t)WS_END); grid = -1; return; }
        int dev = 0, cus = 0, per_cu = 0;
        if (hipGetDevice(&dev) != hipSuccess || hipDeviceGetAttribute(&cus, hipDeviceAttributeMultiprocessorCount, dev) != hipSuccess) { grid = -1; return; }
        if (hipFuncSetAttribute((const void*)hybrid_fwd, hipFuncAttributeMaxDynamicSharedMemorySize, LDS_BYTES) != hipSuccess) { fprintf(stderr, "kernel_launch: hipFuncSetAttribute failed\n"); grid = -1; return; }
        if (hipOccupancyMaxActiveBlocksPerMultiprocessor(&per_cu, (const void*)hybrid_fwd, NTHR, LDS_BYTES) != hipSuccess || per_cu < 1)
            fprintf(stderr, "kernel_launch: occupancy query reports %d workgroups per CU\n", per_cu);
        (void)hipGetLastError();
        grid = cus;
    }
    if (grid < 0) return;
    if (hipMemsetAsync((char*)d_ws + WS_CTL, 0, CTL_ZERO_BYTES, stream) != hipSuccess) return;
    Args a{};
    for (int i = 0; i < 22; ++i) a.in[i] = (const float*)d_in[i];
    a.out = (float*)d_out; a.ws = (unsigned char*)d_ws;
#if MK_PER_PHASE
    for (int ph = 0; ph < N_PHASES; ++ph) { a.ph_lo = ph; a.ph_hi = ph + 1; hipLaunchKernelGGL(hybrid_fwd, dim3(grid), dim3(NTHR), LDS_BYTES, stream, a); }
#else
    a.ph_lo = 0; a.ph_hi = N_PHASES;
    hipLaunchKernelGGL(hybrid_fwd, dim3(grid), dim3(NTHR), LDS_BYTES, stream, a);
#endif
    const hipError_t le = hipPeekAtLastError();
    if (le != hipSuccess) fprintf(stderr, "kernel_launch: launch failed: %s\n", hipGetErrorName(le));
}
```

```cpp
#include <hip/hip_runtime.h>
#include <cstdio>
#include <cstdint>

#ifndef DUPMASK
#define DUPMASK 0
#endif
#define DUP(k) ((DUPMASK >> (k)) & 1)
#ifndef MK_PER_PHASE
#define MK_PER_PHASE 0
#endif

namespace pg8 {
#define PG8_LAS __attribute__((address_space(3)))
typedef unsigned short bf16_t;
typedef short bf16x8 __attribute__((ext_vector_type(8)));
typedef float f32x4 __attribute__((ext_vector_type(4)));
typedef unsigned u32x4 __attribute__((ext_vector_type(4)));
constexpr int BM = 256, BK = 64, HALF = 128, HTB = HALF * BK * 2, STAGE_BYTES = 8 * HTB, NXCD = 8, WGM = 4;

__host__ __device__ __forceinline__ int lds_byte(int r, int c) { const int st = (r >> 4) * 2 + (c >> 5), rr = r & 15, cc = c & 31, ob = rr * 64 + cc * 2; return st * 1024 + (ob ^ (((ob >> 9) & 1) << 5)); }
__host__ __device__ __forceinline__ void stage_rc(int b, int& R, int& C) { const int st = b / 1024, sb = b % 1024, swz = sb ^ (((sb >> 9) & 1) << 5); R = (st >> 1) * 16 + swz / 64; C = (st & 1) * 32 + (swz % 64) / 2; }
__host__ __device__ __forceinline__ int perm32(int rho) { const int n = rho >> 4, i = rho & 15; return 8 * (i >> 2) + 4 * n + (i & 3); }

struct Unit { int pm, pn, kt0, nkt, split; };
struct Gemm { const bf16_t* A; const bf16_t* Bt; int M, N, K, lda, ldb; size_t bpm; int tiledA, tiledB; };

struct StaticOrder {
    int nM, nN, nwg, G, c, ntk;
    __host__ __device__ void init(int M, int N, int G_, int c_, int K) { nM = M / BM; nN = N / BM; nwg = nM * nN; G = G_; c = c_; ntk = K / BK; }
    __host__ __device__ bool next(int i, Unit& u) const {
        const long L = (long)i * G + c; if (L >= nwg) return false;
        return tile((int)L, u);
    }
    __host__ __device__ bool tile(int wgid, Unit& u) const {
        u.kt0 = 0; u.nkt = ntk; u.split = 0; { const int q = nwg / NXCD, r = nwg % NXCD, xcd = wgid % NXCD, off = wgid / NXCD; wgid = (xcd < r ? xcd * (q + 1) : r * (q + 1) + (xcd - r) * q) + off; }
        const int nig = WGM * nN, gid = wgid / nig, fm = gid * WGM, gsz = (nM - fm) < WGM ? (nM - fm) : WGM;
        u.pm = fm + ((wgid % nig) % gsz); u.pn = (wgid % nig) / gsz; return true;
    }
    __device__ __forceinline__ void a_ready(const Unit&) const {}
    __device__ __forceinline__ void done(const Unit&) const {}
};
struct SplitOrder {
    StaticOrder so; int xp, nsplit;
    __host__ __device__ void init(int Mfull, int xpanels, int N, int G_, int c_, int K) { so.init(Mfull, N, G_, c_, K); xp = xpanels; nsplit = xpanels * so.nN * 4; }
    __host__ __device__ bool next(int i, Unit& u) const {
        const int L = i * so.G + so.c; const bool full = L < so.nwg;
        Unit f; so.tile(full ? L : 0, f);
        const int q = L - so.nwg, ks = q & 3, t = q >> 2, qn = so.ntk / 4;
        u.pm = full ? f.pm : so.nM + t / so.nN; u.pn = full ? f.pn : t % so.nN; u.nkt = full ? f.nkt : qn; u.kt0 = full ? 0 : ks * qn; u.split = full ? 0 : 1;
        return full || q < nsplit;
    }
    __device__ __forceinline__ void a_ready(const Unit&) const {}
    __device__ __forceinline__ void done(const Unit&) const {}
};

__device__ __forceinline__ unsigned cvt_pk_bf16(float lo, float hi) { unsigned r; asm volatile("v_cvt_pk_bf16_f32 %0, %1, %2" : "=v"(r) : "v"(lo), "v"(hi)); return r; }

struct EpiNone {
    static constexpr bool PERM = true, AFTER_DRAIN = false;
    __device__ __forceinline__ void operator()(const f32x4 (&acc)[2][2][4][2], const Unit& u, int wr, int wc, int fr, int fq) const {
#pragma unroll
        for (int ai = 0; ai < 2; ++ai)
#pragma unroll
            for (int bj = 0; bj < 2; ++bj)
#pragma unroll
                for (int m = 0; m < 4; ++m)
#pragma unroll
                    for (int n = 0; n < 2; ++n) asm volatile("" :: "v"(acc[ai][bj][m][n]));
    }
};
struct EpiBf16 {
    static constexpr bool PERM = true, AFTER_DRAIN = false;
    bf16_t* O; int ldc;
    __device__ __forceinline__ void operator()(const f32x4 (&acc)[2][2][4][2], const Unit& u, int wr, int wc, int fr, int fq) const {
        const int row0 = u.pm * BM + wr * 64 + fr; const int col0 = u.pn * BM + wc * 32 + 8 * fq;
#pragma unroll
        for (int ai = 0; ai < 2; ++ai)
#pragma unroll
            for (int m = 0; m < 4; ++m) { bf16_t* rowp = O + (size_t)(row0 + ai * HALF + m * 16) * ldc + col0;
#pragma unroll
                for (int bj = 0; bj < 2; ++bj) { const f32x4 v0 = acc[ai][bj][m][0], v1 = acc[ai][bj][m][1];
                    u32x4 w; w.x = cvt_pk_bf16(v0[0], v0[1]); w.y = cvt_pk_bf16(v0[2], v0[3]); w.z = cvt_pk_bf16(v1[0], v1[1]); w.w = cvt_pk_bf16(v1[2], v1[3]);
                    *(u32x4*)(rowp + bj * HALF) = w; } }
    }
};
struct EpiDft {
    static constexpr bool PERM = true, AFTER_DRAIN = false;
    bf16_t* MIX; int rowbase, nper; float scale;
    __device__ __forceinline__ void operator()(const f32x4 (&acc)[2][2][4][2], const Unit& u, int wr, int wc, int fr, int fq) const {
        const int k0 = u.pm * BM + wr * 64 + fr; const int n0 = u.pn * BM + wc * 32 + 8 * fq;
#pragma unroll
        for (int ai = 0; ai < 2; ++ai)
#pragma unroll
            for (int m = 0; m < 4; ++m) { const int k = k0 + ai * HALF + m * 16;
#pragma unroll
                for (int bj = 0; bj < 2; ++bj) { const int n = n0 + bj * HALF; const int b = n >> 9, gd = n & 511;
                    const f32x4 v0 = acc[ai][bj][m][0] * scale, v1 = acc[ai][bj][m][1] * scale;
                    u32x4 w; w.x = cvt_pk_bf16(v0[0], v0[1]); w.y = cvt_pk_bf16(v0[2], v0[3]); w.z = cvt_pk_bf16(v1[0], v1[1]); w.w = cvt_pk_bf16(v1[2], v1[3]);
                    *(u32x4*)(MIX + (size_t)(rowbase + b * nper + k) * 2560 + 1024 + gd) = w; } }
    }
};

struct EpiS1 {
    static constexpr bool PERM = true, AFTER_DRAIN = false;
    bf16_t* S2;
    __device__ __forceinline__ void operator()(const f32x4 (&acc)[2][2][4][2], const Unit& u, int wr, int wc, int fr, int fq) const {
        const int m0 = wr * 64 + fr; const int n0 = u.pn * BM + wc * 32 + 8 * fq;
#pragma unroll
        for (int ai = 0; ai < 2; ++ai)
#pragma unroll
            for (int mm = 0; mm < 4; ++mm) { const int m = m0 + mm * 16; const int k2 = m >> 1, ro = m & 1;
#pragma unroll
                for (int bj = 0; bj < 2; ++bj) { const int np = n0 + bj * HALF; const int n = np >> 5, c = ai * 32 + (np & 31);
                    const f32x4 v0 = acc[ai][bj][mm][0], v1 = acc[ai][bj][mm][1];
                    u32x4 w; w.x = cvt_pk_bf16(v0[0], v0[1]); w.y = cvt_pk_bf16(v0[2], v0[3]); w.z = cvt_pk_bf16(v1[0], v1[1]); w.w = cvt_pk_bf16(v1[2], v1[3]);
                    *(u32x4*)(S2 + ((((size_t)(k2 >> 2) * 2048 + n) * 4 + (k2 & 3)) * 2 + ro) * 64 + c) = w; } }
    }
};
struct EpiS2 {
    static constexpr bool PERM = true, AFTER_DRAIN = false;
    bf16_t* MIX; float scale;
    __device__ __forceinline__ void operator()(const f32x4 (&acc)[2][2][4][2], const Unit& u, int wr, int wc, int fr, int fq) const {
        const int m0 = wr * 64 + fr; const int n0 = u.pn * BM + wc * 32 + 8 * fq;
#pragma unroll
        for (int ai = 0; ai < 2; ++ai)
#pragma unroll
            for (int mm = 0; mm < 4; ++mm) { const int m = ai * HALF + m0 + mm * 16; const int k = 4 * u.pm + (m >> 6) + 64 * (m & 63);
#pragma unroll
                for (int bj = 0; bj < 2; ++bj) { const int n = n0 + bj * HALF; const int b = n >> 9, gd = n & 511;
                    const f32x4 v0 = acc[ai][bj][mm][0] * scale, v1 = acc[ai][bj][mm][1] * scale;
                    u32x4 w; w.x = cvt_pk_bf16(v0[0], v0[1]); w.y = cvt_pk_bf16(v0[2], v0[3]); w.z = cvt_pk_bf16(v1[0], v1[1]); w.w = cvt_pk_bf16(v1[2], v1[3]);
                    *(u32x4*)(MIX + (size_t)(b * 4096 + k) * 2560 + 1024 + gd) = w; } }
    }
};
struct EpiResGate {
    static constexpr bool PERM = false, AFTER_DRAIN = false;
    bf16_t* X; const float* modl; int goff; float* XP; const float* basef;
    __device__ __forceinline__ void operator()(const f32x4 (&acc)[2][2][4][2], const Unit& u, int wr, int wc, int fr, int fq) const {
        typedef unsigned u32x2_ __attribute__((ext_vector_type(2)));
        const int row0 = u.pm * BM + wr * 64 + fr, col0 = u.pn * BM + wc * 32 + 4 * fq;
        const int v = u.pm < 64 ? (u.pm >> 4) : 4;
        const float* gate = modl + (size_t)v * 12288 + goff;
        f32x4 gv[2][2];
#pragma unroll
        for (int bj = 0; bj < 2; ++bj)
#pragma unroll
            for (int n = 0; n < 2; ++n) gv[bj][n] = *(const f32x4*)(gate + col0 + bj * HALF + n * 16);
#pragma unroll
        for (int ai = 0; ai < 2; ++ai)
#pragma unroll
            for (int m = 0; m < 4; ++m) { const size_t ro = (size_t)(row0 + ai * HALF + m * 16) * 2048 + col0;
#pragma unroll
                for (int bj = 0; bj < 2; ++bj)
#pragma unroll
                    for (int n = 0; n < 2; ++n) { const size_t o = ro + bj * HALF + n * 16; const f32x4 d = gv[bj][n] * acc[ai][bj][m][n];
                        if (u.split) *(f32x4*)(XP + ((size_t)(u.kt0 / u.nkt) * 1024 + (row0 + ai * HALF + m * 16 - 16384)) * 2048 + col0 + bj * HALF + n * 16) = d;
                        else { f32x4 b;
                            if (basef) b = *(const f32x4*)(basef + o);
                            else { const u32x2_ w = *(const u32x2_*)(X + o); b = (f32x4){__uint_as_float(w.x << 16), __uint_as_float(w.x & 0xffff0000u), __uint_as_float(w.y << 16), __uint_as_float(w.y & 0xffff0000u)}; }
                            const f32x4 xn = b + d; u32x2_ wo; wo.x = cvt_pk_bf16(xn[0], xn[1]); wo.y = cvt_pk_bf16(xn[2], xn[3]); *(u32x2_*)(X + o) = wo; } } }
    }
};


__device__ __forceinline__ float dpp_ror1(float x)  { return __builtin_bit_cast(float, __builtin_amdgcn_update_dpp(0, __builtin_bit_cast(int, x), 0x121, 0xF, 0xF, false)); }
__device__ __forceinline__ float dpp_ror15(float x) { return __builtin_bit_cast(float, __builtin_amdgcn_update_dpp(0, __builtin_bit_cast(int, x), 0x12F, 0xF, 0xF, false)); }
__device__ __forceinline__ f32x4 ror1v(const f32x4 v)  { return (f32x4){dpp_ror1(v[0]), dpp_ror1(v[1]), dpp_ror1(v[2]), dpp_ror1(v[3])}; }
__device__ __forceinline__ f32x4 ror15v(const f32x4 v) { return (f32x4){dpp_ror15(v[0]), dpp_ror15(v[1]), dpp_ror15(v[2]), dpp_ror15(v[3])}; }
struct EpiUp {
    static constexpr bool PERM = true, AFTER_DRAIN = false;
    bf16_t* ACT; float* EDGE; const float* cw; const float* cb; PG8_LAS float* xl; int dff;
    __device__ __forceinline__ void operator()(const f32x4 (&acc)[2][2][4][2], const Unit& u, int wr, int wc, int fr, int fq) const {
        const int ch0 = u.pn * 128 + wc * 32 + 8 * fq;
        f32x4 w0[2], w1[2], w2[2], bb[2];
#pragma unroll
        for (int n = 0; n < 2; ++n) { w0[n] = *(const f32x4*)(cw + ch0 + 4 * n); w1[n] = *(const f32x4*)(cw + dff + ch0 + 4 * n); w2[n] = *(const f32x4*)(cw + 2 * dff + ch0 + 4 * n); bb[n] = *(const f32x4*)(cb + ch0 + 4 * n); }
#pragma unroll
        for (int ai = 0; ai < 2; ++ai)
#pragma unroll
            for (int n = 0; n < 2; ++n) {
                if (fr == 0)  *(PG8_LAS f32x4*)(xl + ((((wr * 4 + wc) * 2 + ai) * 2 + 0) * 32) + 8 * fq + 4 * n) = acc[ai][0][0][n];
                if (fr == 15) *(PG8_LAS f32x4*)(xl + ((((wr * 4 + wc) * 2 + ai) * 2 + 1) * 32) + 8 * fq + 4 * n) = acc[ai][0][3][n];
            }
        { float* eg = EDGE + (size_t)u.pm * 6 * dff + ch0;
          if (wr == 0 && fr < 2) {
#pragma unroll
              for (int n = 0; n < 2; ++n) { *(f32x4*)(eg + (size_t)fr * dff + 4 * n) = acc[0][0][0][n]; if (fr == 0) *(f32x4*)(eg + (size_t)4 * dff + 4 * n) = acc[0][1][0][n]; } }
          if (wr == 1 && fr >= 14) {
#pragma unroll
              for (int n = 0; n < 2; ++n) { *(f32x4*)(eg + (size_t)(fr - 12) * dff + 4 * n) = acc[1][0][3][n]; if (fr == 15) *(f32x4*)(eg + (size_t)5 * dff + 4 * n) = acc[1][1][3][n]; } }
        }
        asm volatile("s_waitcnt lgkmcnt(0)" ::: "memory"); __builtin_amdgcn_s_barrier(); asm volatile("" ::: "memory");
        f32x4 pe[2][2], ne[2][2];
#pragma unroll
        for (int ai = 0; ai < 2; ++ai)
#pragma unroll
            for (int n = 0; n < 2; ++n) {
                const bool hp = (wr == 1) || (ai == 1), hn = (wr == 0) || (ai == 0);
                const int pai = (wr == 1) ? ai : ai - 1, nai = (wr == 0) ? ai : ai + 1;
                pe[ai][n] = hp ? *(const PG8_LAS f32x4*)(xl + (((((wr ^ 1) * 4 + wc) * 2 + pai) * 2 + 1) * 32) + 8 * fq + 4 * n) : (f32x4){0.f, 0.f, 0.f, 0.f};
                ne[ai][n] = hn ? *(const PG8_LAS f32x4*)(xl + (((((wr ^ 1) * 4 + wc) * 2 + nai) * 2 + 0) * 32) + 8 * fq + 4 * n) : (f32x4){0.f, 0.f, 0.f, 0.f};
            }
        const int row0 = u.pm * BM + wr * 64 + fr;
#pragma unroll
        for (int ai = 0; ai < 2; ++ai)
#pragma unroll
            for (int m = 0; m < 4; ++m) {
                float z[8], t[8];
#pragma unroll
                for (int n = 0; n < 2; ++n) {
                    const f32x4 g = acc[ai][0][m][n];
                    const f32x4 gp = (m > 0) ? acc[ai][0][m > 0 ? m - 1 : 0][n] : pe[ai][n];
                    const f32x4 gn = (m < 3) ? acc[ai][0][m < 3 ? m + 1 : 3][n] : ne[ai][n];
                    const f32x4 zz = w1[n] * g + bb[n];
#pragma unroll
                    for (int j = 0; j < 4; ++j) { float zj = zz[j];
                        if ((m == 0 || m == 3) && n == 0 && j == 0)
                            asm("s_nop 1\n\t"
                                "v_fmac_f32_dpp %0, %1, %4 row_shr:1 row_mask:0xf bank_mask:0xf\n\t"
                                "v_fmac_f32_dpp %0, %2, %4 row_shl:15 row_mask:0xf bank_mask:0xf\n\t"
                                "v_fmac_f32_dpp %0, %1, %5 row_shl:1 row_mask:0xf bank_mask:0xf\n\t"
                                "v_fmac_f32_dpp %0, %3, %5 row_shr:15 row_mask:0xf bank_mask:0xf"
                                : "+v"(zj) : "v"(g[j]), "v"(gp[j]), "v"(gn[j]), "v"(w0[n][j]), "v"(w2[n][j]));
                        else
                            asm("v_fmac_f32_dpp %0, %1, %4 row_shr:1 row_mask:0xf bank_mask:0xf\n\t"
                                "v_fmac_f32_dpp %0, %2, %4 row_shl:15 row_mask:0xf bank_mask:0xf\n\t"
                                "v_fmac_f32_dpp %0, %1, %5 row_shl:1 row_mask:0xf bank_mask:0xf\n\t"
                                "v_fmac_f32_dpp %0, %3, %5 row_shr:15 row_mask:0xf bank_mask:0xf"
                                : "+v"(zj) : "v"(g[j]), "v"(gp[j]), "v"(gn[j]), "v"(w0[n][j]), "v"(w2[n][j]));
                        z[n * 4 + j] = zj; }
                }
#pragma unroll
                for (int i = 0; i < 8; ++i) t[i] = -1.4426950408889634f * z[i];
#pragma unroll
                for (int i = 0; i < 8; ++i) t[i] = __builtin_amdgcn_exp2f(t[i]);
#pragma unroll
                for (int i = 0; i < 8; ++i) t[i] = 1.f + t[i];
#pragma unroll
                for (int i = 0; i < 8; ++i) t[i] = __builtin_amdgcn_rcpf(t[i]);
#pragma unroll
                for (int i = 0; i < 8; ++i) t[i] = z[i] * t[i] * acc[ai][1][m][i >> 2][i & 3];
                u32x4 w; w.x = cvt_pk_bf16(t[0], t[1]); w.y = cvt_pk_bf16(t[2], t[3]); w.z = cvt_pk_bf16(t[4], t[5]); w.w = cvt_pk_bf16(t[6], t[7]);
                *(u32x4*)(ACT + (size_t)(row0 + ai * HALF + m * 16) * dff + ch0) = w;
            }
    }
};

template <class Epi, class Sched, bool ALIGN_EPI = false, bool SP2 = false>
__device__ __forceinline__ void gemm_phase(PG8_LAS unsigned char* lds, const Gemm g, const Sched& S, const Epi& E) {
    int tid_ = threadIdx.x; asm volatile("" : "+v"(tid_));
    const int tid = tid_, wid = __builtin_amdgcn_readfirstlane(tid >> 6), lane = tid & 63, wr = wid >> 2, wc = wid & 3, fr = lane & 15, fq = lane >> 4;
    unsigned voffA[2], voffB[2];
#pragma unroll
    for (int i = 0; i < 2; ++i) { int R, C; stage_rc(tid * 16 + i * 8192, R, C); const int Rb = Epi::PERM ? ((R & ~31) + perm32(R & 31)) : R;
        voffA[i] = (unsigned)(R * (g.tiledA ? BK : g.lda) + C) * 2u; voffB[i] = (unsigned)(Rb * (g.tiledB ? BK : g.ldb) + C) * 2u; }
    const size_t kstepA = g.tiledA ? (size_t)BM * BK * 2 : (size_t)(BK * 2), kstepB = g.tiledB ? (size_t)BM * BK * 2 : (size_t)(BK * 2);
    const size_t hstepA = (size_t)HALF * (g.tiledA ? BK : g.lda) * 2, hstepB = (size_t)HALF * (g.tiledB ? BK : g.ldb) * 2;
    const size_t tstepA = g.tiledA ? (size_t)(g.K / BK) * BM * BK * 2 : 2 * hstepA, tstepB = g.tiledB ? (size_t)(g.K / BK) * BM * BK * 2 : 2 * hstepB;
    const unsigned ldsw = (unsigned)wid * 1024u;
    const int aoff = lds_byte(wr * 64 + fr, fq * 8), boff = lds_byte(wc * 32 + fr, fq * 8);
#define PG8_SA(b, h) (((b) * 2 + (h)) * HTB)
#define PG8_SB(b, h) ((4 + (b) * 2 + (h)) * HTB)
#define PG8_STAGE(bufoff, gbase, voff) do { _Pragma("unroll") for (int _i = 0; _i < 2; ++_i) \
        __builtin_amdgcn_global_load_lds((const unsigned*)((const char*)(gbase) + (voff)[_i]), (PG8_LAS unsigned*)(lds + (bufoff) + ldsw + _i * 8192), 16, 0, 0); } while (0)
#define PG8_LDA(dst, b, h) do { _Pragma("unroll") for (int m = 0; m < 4; ++m) _Pragma("unroll") for (int k = 0; k < 2; ++k) dst[m][k] = *(const PG8_LAS bf16x8*)(lds + PG8_SA(b, h) + aoff + m * 2048 + k * 1024); } while (0)
#define PG8_LDB(dst, b, h) do { _Pragma("unroll") for (int n = 0; n < 2; ++n) _Pragma("unroll") for (int k = 0; k < 2; ++k) dst[n][k] = *(const PG8_LAS bf16x8*)(lds + PG8_SB(b, h) + boff + n * 2048 + k * 1024); } while (0)
#define PG8_MMA(ai, bj, At, Bt) do { __builtin_amdgcn_s_setprio(1); _Pragma("unroll") for (int m = 0; m < 4; ++m) _Pragma("unroll") for (int n = 0; n < 2; ++n) _Pragma("unroll") for (int k = 0; k < 2; ++k) \
        acc[ai][bj][m][n] = __builtin_amdgcn_mfma_f32_16x16x32_bf16(Bt[n][k], At[m][k], acc[ai][bj][m][n], 0, 0, 0); __builtin_amdgcn_s_setprio(0); } while (0)
#define PG8_WAIT_V(n) asm volatile("s_waitcnt vmcnt(" #n ")" ::: "memory")
#define PG8_WAIT_L(n) asm volatile("s_waitcnt lgkmcnt(" #n ")" ::: "memory")
#define PG8_BAR __builtin_amdgcn_s_barrier()
#define PG8_SCHED __builtin_amdgcn_sched_barrier(0)
    Unit cur, nxt; int ui = 0;
    if (!S.next(0, cur)) return;
    f32x4 acc[2][2][4][2];
#pragma unroll
    for (int a = 0; a < 2; ++a)
#pragma unroll
        for (int b = 0; b < 2; ++b)
#pragma unroll
            for (int m = 0; m < 4; ++m)
#pragma unroll
                for (int n = 0; n < 2; ++n) acc[a][b][m][n] = (f32x4){0.f, 0.f, 0.f, 0.f};
    bf16x8 At[4][2], B0[2][2], B1[2][2];
    const char* cA = (const char*)g.A + (size_t)cur.pm * tstepA + (size_t)cur.kt0 * kstepA; const char* cB = (const char*)g.Bt + (size_t)cur.pm * g.bpm + (size_t)cur.pn * tstepB + (size_t)cur.kt0 * kstepB;
    int nt = cur.nkt;
    S.a_ready(cur);
    if constexpr (SP2) {
        PG8_STAGE(PG8_SB(0, 0), cB, voffB); PG8_STAGE(PG8_SB(0, 1), cB + hstepB, voffB); PG8_STAGE(PG8_SA(0, 0), cA, voffA); PG8_STAGE(PG8_SA(0, 1), cA + hstepA, voffA);
        if (wr == 1) PG8_BAR;
        PG8_WAIT_V(2); PG8_BAR;
        PG8_STAGE(PG8_SB(1, 0), cB + kstepB, voffB); PG8_STAGE(PG8_SA(1, 0), cA + kstepA, voffA); PG8_STAGE(PG8_SB(1, 1), cB + hstepB + kstepB, voffB);
        PG8_WAIT_V(6); PG8_BAR;
    } else {
        PG8_STAGE(PG8_SB(0, 0), cB, voffB); PG8_STAGE(PG8_SA(0, 0), cA, voffA); PG8_STAGE(PG8_SB(0, 1), cB + hstepB, voffB); PG8_STAGE(PG8_SA(0, 1), cA + hstepA, voffA);
        if (wr == 1) PG8_BAR;
        PG8_WAIT_V(4); PG8_BAR;
        PG8_STAGE(PG8_SB(1, 0), cB + kstepB, voffB); PG8_STAGE(PG8_SA(1, 0), cA + kstepA, voffA); PG8_STAGE(PG8_SB(1, 1), cB + hstepB + kstepB, voffB);
        PG8_WAIT_V(6); PG8_BAR;
    }
    for (;;) {
        const bool has_next = S.next(ui + 1, nxt);
        const char* nA = has_next ? (const char*)g.A + (size_t)nxt.pm * tstepA + (size_t)nxt.kt0 * kstepA : cA; const char* nB = has_next ? (const char*)g.Bt + (size_t)nxt.pm * g.bpm + (size_t)nxt.pn * tstepB + (size_t)nxt.kt0 * kstepB : cB;
        for (int t = 0; t < nt; t += 2) {
            const bool last = (t == nt - 2);
            const char* a1 = cA + (size_t)(t + 1) * kstepA;
            const char* a2 = last ? nA : cA + (size_t)(t + 2) * kstepA; const char* b2 = last ? nB : cB + (size_t)(t + 2) * kstepB;
            const char* a3 = a2 + kstepA; const char* b3 = b2 + kstepB;
            if (last && has_next) S.a_ready(nxt);
            if constexpr (SP2) {
            PG8_LDB(B0, 0, 0); PG8_LDB(B1, 0, 1); PG8_SCHED; PG8_LDA(At, 0, 0); PG8_STAGE(PG8_SA(1, 1), a1 + hstepA, voffA);
            PG8_WAIT_V(8); PG8_WAIT_L(0); PG8_BAR; PG8_MMA(0, 0, At, B0); PG8_MMA(0, 1, At, B1); PG8_BAR; PG8_SCHED;
            PG8_LDA(At, 0, 1); PG8_STAGE(PG8_SB(0, 0), b2, voffB); PG8_STAGE(PG8_SB(0, 1), b2 + hstepB, voffB); PG8_STAGE(PG8_SA(0, 0), a2, voffA);
            PG8_WAIT_V(8); PG8_WAIT_L(0); PG8_BAR; PG8_MMA(1, 0, At, B0); PG8_MMA(1, 1, At, B1); PG8_BAR; PG8_SCHED;
            PG8_LDB(B0, 1, 0); PG8_LDB(B1, 1, 1); PG8_SCHED; PG8_LDA(At, 1, 0); PG8_STAGE(PG8_SA(0, 1), a2 + hstepA, voffA);
            PG8_WAIT_V(8); PG8_WAIT_L(0); PG8_BAR; PG8_MMA(0, 0, At, B0); PG8_MMA(0, 1, At, B1); PG8_BAR; PG8_SCHED;
            PG8_LDA(At, 1, 1); PG8_STAGE(PG8_SB(1, 0), b3, voffB); PG8_STAGE(PG8_SB(1, 1), b3 + hstepB, voffB); PG8_STAGE(PG8_SA(1, 0), a3, voffA);
            PG8_WAIT_V(8); PG8_WAIT_L(0); PG8_BAR; PG8_MMA(1, 0, At, B0); PG8_MMA(1, 1, At, B1); PG8_BAR; PG8_SCHED;
            } else {
            PG8_LDB(B0, 0, 0); PG8_SCHED; PG8_LDA(At, 0, 0); PG8_STAGE(PG8_SA(1, 1), a1 + hstepA, voffA);
            PG8_WAIT_L(8); PG8_BAR; PG8_WAIT_L(0); PG8_MMA(0, 0, At, B0); PG8_BAR; PG8_SCHED;
            PG8_LDB(B1, 0, 1); PG8_STAGE(PG8_SB(0, 0), b2, voffB);
            PG8_BAR; PG8_WAIT_L(0); PG8_MMA(0, 1, At, B1); PG8_BAR;
            PG8_LDA(At, 0, 1); PG8_STAGE(PG8_SA(0, 0), a2, voffA);
            PG8_BAR; PG8_WAIT_L(0); PG8_MMA(1, 0, At, B0); PG8_BAR; PG8_SCHED;
            PG8_STAGE(PG8_SB(0, 1), b2 + hstepB, voffB);
            PG8_WAIT_V(6); PG8_BAR; PG8_MMA(1, 1, At, B1); PG8_BAR;
            PG8_LDB(B0, 1, 0); PG8_SCHED; PG8_LDA(At, 1, 0); PG8_STAGE(PG8_SA(0, 1), a2 + hstepA, voffA);
            PG8_WAIT_L(8); PG8_BAR; PG8_WAIT_L(0); PG8_MMA(0, 0, At, B0); PG8_BAR; PG8_SCHED;
            PG8_LDB(B1, 1, 1); PG8_STAGE(PG8_SB(1, 0), b3, voffB);
            PG8_BAR; PG8_WAIT_L(0); PG8_MMA(0, 1, At, B1); PG8_BAR;
            PG8_LDA(At, 1, 1); PG8_STAGE(PG8_SA(1, 0), a3, voffA);
            PG8_BAR; PG8_WAIT_L(0); PG8_MMA(1, 0, At, B0); PG8_BAR; PG8_SCHED;
            PG8_STAGE(PG8_SB(1, 1), b3 + hstepB, voffB);
            PG8_WAIT_V(6); PG8_BAR; PG8_MMA(1, 1, At, B1); PG8_BAR;
            }
        }
        if constexpr (ALIGN_EPI) { if (wr == 0) PG8_BAR; }
        if constexpr (!Epi::AFTER_DRAIN) { E(acc, cur, wr, wc, fr, fq); S.done(cur); }
        if (!has_next) break;
#pragma unroll
        for (int a = 0; a < 2; ++a)
#pragma unroll
            for (int b = 0; b < 2; ++b)
#pragma unroll
                for (int m = 0; m < 4; ++m)
#pragma unroll
                    for (int n = 0; n < 2; ++n) acc[a][b][m][n] = (f32x4){0.f, 0.f, 0.f, 0.f};
        cur = nxt; cA = nA; cB = nB; nt = cur.nkt; ++ui;
        if constexpr (ALIGN_EPI) { if (wr == 1) PG8_BAR; }
    }
    PG8_WAIT_V(0);
    if constexpr (!ALIGN_EPI) { if (wr == 0) PG8_BAR; }
    PG8_BAR;
#undef PG8_SA
#undef PG8_SB
#undef PG8_STAGE
#undef PG8_LDA
#undef PG8_LDB
#undef PG8_MMA
#undef PG8_WAIT_V
#undef PG8_WAIT_L
#undef PG8_BAR
#undef PG8_SCHED
}
}

namespace att {
typedef unsigned short bf16;
constexpr int   D = 128, NW = 8, QBLK = 32, KVBLK = 64;
constexpr float SCALE = 0.088388347648318440f;
constexpr float THR = 8.f;
constexpr int LDQ = 1024, LDK = 256, LDO = 2560;
constexpr size_t SHM_V = KVBLK * D * 2, SHM_K = KVBLK * D * 2, SHM_ATTN = 2 * SHM_V + 2 * SHM_K + NW * 64 * 4;
using bf16x8 = __attribute__((ext_vector_type(8))) short;
using s16x4  = __attribute__((ext_vector_type(4))) short;
using f32x16 = __attribute__((ext_vector_type(16))) float;
using u32x4  = __attribute__((ext_vector_type(4))) unsigned;
#define KSWZ(row, colB) ((row) * 256 + ((colB) ^ (((row) & 7) << 4)))
#define SBAR() __builtin_amdgcn_sched_barrier(0)
__device__ __forceinline__ int crow(int r, int hi) { return (r & 3) + 8 * (r >> 2) + 4 * hi; }
__device__ __forceinline__ unsigned cvtpk(float lo, float hi) { unsigned r; asm volatile("v_cvt_pk_bf16_f32 %0, %1, %2" : "=v"(r) : "v"(lo), "v"(hi)); return r; }
__device__ __forceinline__ bf16x8 ld8(const bf16* p) { return *reinterpret_cast<const bf16x8*>(p); }

__device__ __forceinline__ void partialSM(f32x16& p0, f32x16& p1, float& m_reg, float& mn, float& alpha) {
  constexpr float C = SCALE * 1.4426950408889634f;
  float pmax = p0[0]; for (int r = 1; r < 16; ++r) pmax = fmaxf(pmax, p0[r]); for (int r = 0; r < 16; ++r) pmax = fmaxf(pmax, p1[r]);
  { auto rr = __builtin_amdgcn_permlane32_swap(__float_as_uint(pmax), __float_as_uint(pmax), false, false);
    pmax = fmaxf(__uint_as_float(rr[0]), __uint_as_float(rr[1])); }
  if (__builtin_expect(__all(pmax - m_reg <= THR / SCALE), 1)) { mn = m_reg; alpha = 1.f; }
  else { mn = fmaxf(m_reg, pmax); alpha = __builtin_amdgcn_exp2f((m_reg - mn) * C); m_reg = mn; }
  float mnC = -mn * C;
  for (int r = 0; r < 16; ++r) p0[r] = fmaf(p0[r], C, mnC); for (int r = 0; r < 16; ++r) p1[r] = fmaf(p1[r], C, mnC);
  for (int r = 0; r < 16; ++r) p0[r] = __builtin_amdgcn_exp2f(p0[r]);
}
__device__ __forceinline__ void finishSM(f32x16& p0, f32x16& p1, float alpha, float& l_reg, bf16x8& pa0, bf16x8& pa1, bf16x8& pa2, bf16x8& pa3) {
  for (int r = 0; r < 16; ++r) p1[r] = __builtin_amdgcn_exp2f(p1[r]);
  float ps = 0; for (int r = 0; r < 16; ++r) ps += p0[r]; for (int r = 0; r < 16; ++r) ps += p1[r];
  { auto rr = __builtin_amdgcn_permlane32_swap(__float_as_uint(ps), __float_as_uint(ps), false, false);
    ps = __uint_as_float(rr[0]) + __uint_as_float(rr[1]); }
  l_reg = l_reg * alpha + ps;
#define PK4(P, BASE, OUT) do { unsigned a0 = cvtpk(P[BASE + 0], P[BASE + 1]), a1 = cvtpk(P[BASE + 2], P[BASE + 3]);   \
    unsigned b0 = cvtpk(P[BASE + 4], P[BASE + 5]), b1 = cvtpk(P[BASE + 6], P[BASE + 7]);                              \
    auto r0 = __builtin_amdgcn_permlane32_swap(a0, b0, false, false); auto r1 = __builtin_amdgcn_permlane32_swap(a1, b1, false, false); \
    u32x4 w = {r0[0], r1[0], r0[1], r1[1]}; OUT = *reinterpret_cast<bf16x8*>(&w); } while (0)
  PK4(p0, 0, pa0); PK4(p0, 8, pa1); PK4(p1, 0, pa2); PK4(p1, 8, pa3);
#undef PK4
}
__device__ __forceinline__ void qkt(f32x16& p0, f32x16& p1, const bf16* Ks, const bf16x8* qr, int r32, int hi) {
  p0 = f32x16{}; p1 = f32x16{};
  for (int d0 = 0; d0 < 8; ++d0) { int cb = (d0 * 16 + hi * 8) * 2;
    bf16x8 b0 = *reinterpret_cast<const bf16x8*>((const char*)Ks + KSWZ(r32, cb));
    bf16x8 b1 = *reinterpret_cast<const bf16x8*>((const char*)Ks + KSWZ(32 + r32, cb));
    p0 = __builtin_amdgcn_mfma_f32_32x32x16_bf16(b0, qr[d0], p0, 0, 0, 0);
    p1 = __builtin_amdgcn_mfma_f32_32x32x16_bf16(b1, qr[d0], p1, 0, 0, 0); }
}
__device__ __forceinline__ int v_st(int k, int c) { const int kk = (k & ~0xC) | ((k & 4) << 1) | ((k & 8) >> 1); return ((kk >> 3) * 4 + (c >> 5)) * 512 + ((kk & 7) * 32 + (c & 31)) * 2; }
__device__ __forceinline__ int v_rd_base(int lane) { return ((lane & 3) << 3) | (((lane >> 2) & 3) << 6) | (((lane >> 4) & 1) << 5) | (((lane >> 5) & 1) << 8); }
constexpr int v_rd_off(int d0, int ks, int half) { return d0 * 512 + ks * 4096 + half * 2048; }
template <int OFF> __device__ __forceinline__ s16x4 tr_read(int vb) {
  s16x4 r; asm volatile("ds_read_b64_tr_b16 %0, %1 offset:%2" : "=&v"(r) : "v"(vb), "i"(OFF) : "memory"); return r;
}
template <int D0> __device__ __forceinline__ void pv_one(f32x16& od, int vb, bf16x8 pa0, bf16x8 pa1, bf16x8 pa2, bf16x8 pa3) {
  const s16x4 l0 = tr_read<v_rd_off(D0, 0, 0)>(vb), h0 = tr_read<v_rd_off(D0, 0, 1)>(vb), l1 = tr_read<v_rd_off(D0, 1, 0)>(vb), h1 = tr_read<v_rd_off(D0, 1, 1)>(vb);
  const s16x4 l2 = tr_read<v_rd_off(D0, 2, 0)>(vb), h2 = tr_read<v_rd_off(D0, 2, 1)>(vb), l3 = tr_read<v_rd_off(D0, 3, 0)>(vb), h3 = tr_read<v_rd_off(D0, 3, 1)>(vb);
  asm volatile("s_waitcnt lgkmcnt(0)" ::: "memory"); SBAR();
#define PK(L, H) (bf16x8){L[0], L[1], L[2], L[3], H[0], H[1], H[2], H[3]}
  od = __builtin_amdgcn_mfma_f32_32x32x16_bf16(pa0, PK(l0, h0), od, 0, 0, 0);
  od = __builtin_amdgcn_mfma_f32_32x32x16_bf16(pa1, PK(l1, h1), od, 0, 0, 0);
  od = __builtin_amdgcn_mfma_f32_32x32x16_bf16(pa2, PK(l2, h2), od, 0, 0, 0);
  od = __builtin_amdgcn_mfma_f32_32x32x16_bf16(pa3, PK(l3, h3), od, 0, 0, 0);
#undef PK
}
__device__ __forceinline__ void pv_d0(f32x16* o, int vb, bf16x8 pa0, bf16x8 pa1, bf16x8 pa2, bf16x8 pa3) {
  pv_one<0>(o[0], vb, pa0, pa1, pa2, pa3); pv_one<1>(o[1], vb, pa0, pa1, pa2, pa3); pv_one<2>(o[2], vb, pa0, pa1, pa2, pa3); pv_one<3>(o[3], vb, pa0, pa1, pa2, pa3);
}

__device__ __forceinline__ void attn_dense_body(const bf16* __restrict__ Qb, const bf16* __restrict__ Kh, const bf16* __restrict__ Vh,
                                                bf16* __restrict__ Ob, int seq, char* lds) {
  constexpr int SDEPTH = 2;
  int tid_ = threadIdx.x; asm volatile("" : "+v"(tid_));
  const int tid = tid_, wid = tid >> 6, lane = tid & 63, r32 = lane & 31, hi = lane >> 5;
  bf16* V_lds = (bf16*)lds; bf16* K_lds = (bf16*)(lds + 2 * SHM_V);
  float* ws = (float*)(lds + 2 * SHM_V + 2 * SHM_K) + wid * 64; float* li_l = ws; float* al_l = ws + 32;
  float m_reg = -1e30f, l_reg = 0; f32x16 o[4] = {}; bf16x8 qr[8];
  const bf16* Qw = Qb + (long)(wid * QBLK + r32) * LDQ + hi * 8;
#pragma unroll
  for (int d0 = 0; d0 < 8; ++d0) qr[d0] = ld8(Qw + d0 * 16);
  const int sr = tid >> 4, sc = (tid & 15) * 8, vst0 = v_st(sr, sc), vst1 = v_st(32 + sr, sc);
  const int vb0 = (int)(uintptr_t)V_lds + v_rd_base(lane);
  struct { bf16x8 vs0, vs1, ks0, ks1; } sr_[SDEPTH];
#define SLOAD(i, k0) do { sr_[i].vs0 = ld8(&Vh[(long)((k0) + sr) * LDK + sc]); sr_[i].vs1 = ld8(&Vh[(long)((k0) + 32 + sr) * LDK + sc]); \
    sr_[i].ks0 = ld8(&Kh[(long)((k0) + sr) * LDK + sc]); sr_[i].ks1 = ld8(&Kh[(long)((k0) + 32 + sr) * LDK + sc]); } while (0)
#define SWRITE(b, i) do { *(bf16x8*)((char*)V_lds + (b) * SHM_V + vst0) = sr_[i].vs0;          \
    *(bf16x8*)((char*)V_lds + (b) * SHM_V + vst1) = sr_[i].vs1; int kc = sc * 2;               \
    *(bf16x8*)((char*)K_lds + (b) * SHM_K + KSWZ(sr, kc)) = sr_[i].ks0;                       \
    *(bf16x8*)((char*)K_lds + (b) * SHM_K + KSWZ(32 + sr, kc)) = sr_[i].ks1; } while (0)
#define SWAIT() do { asm volatile("s_waitcnt vmcnt(4)" ::: "memory"); } while (0)
#define RESC(a) do { if (__any((a) < 1.f)) { if (hi == 0) al_l[r32] = (a); asm volatile("s_waitcnt lgkmcnt(0)" ::: "memory"); \
    for (int d = 0; d < 4; ++d) for (int r = 0; r < 16; ++r) o[d][r] *= al_l[crow(r, hi)]; } } while (0)
  f32x16 pA0, pA1, pB0, pB1; float mnA, mnB, alA, alB; bf16x8 pa0, pa1, pa2, pa3; const int NT = seq / KVBLK;
  constexpr int SE = 0, SO = SDEPTH - 1;
  SLOAD(SE, 0); asm volatile("s_waitcnt vmcnt(0)" ::: "memory"); SWRITE(0, SE); __syncthreads();
  qkt(pA0, pA1, K_lds, qr, r32, hi); partialSM(pA0, pA1, m_reg, mnA, alA);
  SLOAD(SO, KVBLK); if (2 < NT) SLOAD(SE, 2 * KVBLK);
  SWAIT(); SWRITE(1, SO); __syncthreads();
  for (int j = 1; j + 1 < NT; j += 2) {
    SBAR(); qkt(pB0, pB1, (bf16*)((char*)K_lds + SHM_K), qr, r32, hi);
    finishSM(pA0, pA1, alA, l_reg, pa0, pa1, pa2, pa3); SBAR();
    SLOAD(SO, (j + SDEPTH) * KVBLK); SBAR();
    pv_d0(o, vb0, pa0, pa1, pa2, pa3); partialSM(pB0, pB1, m_reg, mnB, alB);
    __syncthreads(); SWAIT(); SWRITE(0, SE);
    RESC(alB); __syncthreads();
    SBAR(); qkt(pA0, pA1, K_lds, qr, r32, hi);
    finishSM(pB0, pB1, alB, l_reg, pa0, pa1, pa2, pa3); SBAR();
    if (j + 3 < NT) SLOAD(SE, (j + 1 + SDEPTH) * KVBLK); SBAR();
    pv_d0(o, vb0 + (int)SHM_V, pa0, pa1, pa2, pa3); partialSM(pA0, pA1, m_reg, mnA, alA);
    __syncthreads(); SWAIT(); SWRITE(1, SO);
    RESC(alA); __syncthreads();
  }
  SBAR(); qkt(pB0, pB1, (bf16*)((char*)K_lds + SHM_K), qr, r32, hi);
  finishSM(pA0, pA1, alA, l_reg, pa0, pa1, pa2, pa3); SBAR();
  pv_d0(o, vb0, pa0, pa1, pa2, pa3); partialSM(pB0, pB1, m_reg, mnB, alB);
  __syncthreads(); RESC(alB);
  finishSM(pB0, pB1, alB, l_reg, pa0, pa1, pa2, pa3); SBAR();
  pv_d0(o, vb0 + (int)SHM_V, pa0, pa1, pa2, pa3);
  if (hi == 0) li_l[r32] = l_reg; asm volatile("s_waitcnt lgkmcnt(0)" ::: "memory");
  float rli[16];
#pragma unroll
  for (int r = 0; r < 16; ++r) rli[r] = __builtin_amdgcn_rcpf(li_l[crow(r, hi)]);
  bf16* Ow = Ob + (long)(wid * QBLK) * LDO;
  __syncthreads();
  char* ob = lds + wid * (32 * 272);
#pragma unroll
  for (int r = 0; r < 16; ++r) { const int orow = crow(r, hi);
#pragma unroll
    for (int d0 = 0; d0 < 4; ++d0) { const float val = o[d0][r] * rli[r]; *(bf16*)(ob + orow * 272 + (d0 * 32 + r32) * 2) = (bf16)(cvtpk(val, val) & 0xffffu); } }
#pragma unroll
  for (int i = 0; i < 8; ++i) { const int row = i * 4 + (lane >> 4), ch = lane & 15;
    const u32x4 v = *(const u32x4*)(ob + row * 272 + ch * 16);
    *(u32x4*)(Ow + (long)row * LDO + ch * 8) = v; }
  __syncthreads();
#undef SLOAD
#undef SWRITE
#undef SWAIT
#undef RESC
}
#undef KSWZ
#undef SBAR
}

constexpr int NWAVES = 8, NTHR = 512;
constexpr int DM = 2048, NB = 4, SEQ = 4096, DEPTH = 4, CTXL = 256;
constexpr int ML = NB * SEQ, MC = NB * CTXL, MT = ML + MC;
constexpr int SKV = CTXL + SEQ;
constexpr int INW_SRC = 4608, PW = 5120;
constexpr int PQ = 0, PK = 1024, PV = 1280, PFA = 1536, PFB = 2048, PCB = 2560, PCC = 3072, PCH = 3584, PGU = 4096, PGV = 4608;
constexpr int MIXW = 2560, MX_ATT = 0, MX_FOUR = 1024, MX_CONV = 1536, MX_GM = 2048;
constexpr int DFF = 5632, UPW = 2 * DFF;
constexpr int NMOD = 6 * DM;
constexpr float EPS = 1e-6f;

constexpr size_t al256(size_t x) { return (x + 255) / 256 * 256; }
constexpr size_t WS_CTL = 0, CTL_ZERO_BYTES = 1u << 20;
constexpr size_t WS_WIN  = CTL_ZERO_BYTES;
constexpr size_t WS_WOUT = WS_WIN  + (size_t)DEPTH * PW * DM * 2;
constexpr size_t WS_WUP  = WS_WOUT + (size_t)DEPTH * DM * MIXW * 2;
constexpr size_t WS_WDN  = WS_WUP  + (size_t)DEPTH * UPW * DM * 2;
constexpr size_t WS_FN   = WS_WDN  + (size_t)DEPTH * DM * DFF * 2;
constexpr size_t WS_A1   = WS_FN;
constexpr size_t WS_A2   = WS_A1   + (size_t)256 * 256 * 2;
constexpr size_t WS_F256 = WS_A2   + (size_t)16 * 256 * 512 * 2;
constexpr size_t WS_MODP = WS_F256 + (size_t)256 * 512 * 2;
constexpr size_t WS_MOD  = WS_MODP + (size_t)16 * DEPTH * 5 * NMOD * 4;
constexpr size_t WS_ROPE = WS_MOD  + (size_t)DEPTH * 5 * NMOD * 4;
constexpr size_t WS_X    = WS_ROPE + 64 * 32 * 8;
constexpr size_t WS_H    = WS_X    + (size_t)MT * DM * 2;
constexpr size_t WS_R    = WS_H    + (size_t)MT * DM * 2;
constexpr size_t WS_P    = WS_R;
constexpr size_t WS_MIX  = WS_P    + (size_t)MT * PW * 2;
constexpr size_t WS_T1T  = WS_MIX  + (size_t)MT * MIXW * 2;
constexpr size_t WS_T1TC = WS_T1T  + (size_t)2048 * 8192 * 2;
constexpr size_t WS_KB   = WS_T1TC + (size_t)2048 * 512 * 2;
constexpr size_t WS_VB   = WS_KB   + (size_t)NB * SKV * 256 * 2;
constexpr size_t WS_QB   = WS_VB   + (size_t)NB * SKV * 256 * 2;
constexpr size_t WS_UB   = WS_QB   + (size_t)MT * 1024 * 2;
constexpr size_t WS_V2B  = WS_UB   + (size_t)MT * 512 * 2;
constexpr size_t WS_S2IN = WS_V2B  + (size_t)MT * 512 * 2;
constexpr size_t WS_RA_END = WS_S2IN + (size_t)16 * 2048 * 512 * 2;
constexpr size_t WS_ACT  = WS_R;
constexpr size_t WS_ACT_END = WS_ACT + (size_t)MT * DFF * 2;
constexpr size_t WS_R_END = WS_RA_END > WS_ACT_END ? WS_RA_END : WS_ACT_END;
constexpr size_t WS_EDGE = WS_R_END;
constexpr size_t WS_XP   = WS_EDGE + (size_t)(MT / 256) * 6 * DFF * 4;
constexpr size_t WS_END  = WS_XP   + (size_t)4 * MC * DM * 4;
static_assert(WS_END <= 1600000000ull, "d_ws budget");
static_assert(WS_WIN % 256 == 0 && WS_FN % 256 == 0 && WS_X % 256 == 0 && WS_H % 256 == 0 && WS_P % 256 == 0 && WS_MIX % 256 == 0 && WS_T1T % 256 == 0 && WS_KB % 256 == 0 && WS_ACT % 256 == 0 && WS_MOD % 256 == 0, "alignment");
constexpr int CW_TMO = 0, CW_BAR = 4096;

constexpr int RING_BYTES = 131072;
constexpr int LDSCTL_OFF = RING_BYTES, MISC_OFF = LDSCTL_OFF + 320;
constexpr int XL_OFF = RING_BYTES + 1024;
constexpr int LDS_BYTES = 147456;

#define GAS __attribute__((address_space(1)))
#define LAS __attribute__((address_space(3)))
typedef unsigned short bf16;
typedef unsigned v4u __attribute__((ext_vector_type(4)));
typedef unsigned v2u __attribute__((ext_vector_type(2)));
typedef float f32x4 __attribute__((ext_vector_type(4)));
typedef float f32x2 __attribute__((ext_vector_type(2)));
#define RLX_AGENT __ATOMIC_RELAXED, __HIP_MEMORY_SCOPE_AGENT
#define LDS_WAIT() asm volatile("s_waitcnt lgkmcnt(0)" ::: "memory")
#define VM_WAIT() asm volatile("s_waitcnt vmcnt(0)" ::: "memory")
__device__ __forceinline__ unsigned pk2(float lo, float hi) { unsigned r; asm volatile("v_cvt_pk_bf16_f32 %0, %1, %2" : "=v"(r) : "v"(lo), "v"(hi)); return r; }
__device__ __forceinline__ float bflo(unsigned w) { return __uint_as_float(w << 16); }
__device__ __forceinline__ float bfhi(unsigned w) { return __uint_as_float(w & 0xffff0000u); }
__device__ __forceinline__ void unpack8(const v4u w, float (&x)[8]) { x[0] = bflo(w.x); x[1] = bfhi(w.x); x[2] = bflo(w.y); x[3] = bfhi(w.y); x[4] = bflo(w.z); x[5] = bfhi(w.z); x[6] = bflo(w.w); x[7] = bfhi(w.w); }
__device__ __forceinline__ v4u pack8(const float (&x)[8]) { v4u w; w.x = pk2(x[0], x[1]); w.y = pk2(x[2], x[3]); w.z = pk2(x[4], x[5]); w.w = pk2(x[6], x[7]); return w; }
__device__ __forceinline__ float wave_sum(float v) {
#pragma unroll
    for (int o = 1; o < 64; o <<= 1) v += __shfl_xor(v, o);
    return v;
}
__device__ __forceinline__ float gelu_tanh(float x) { const float y = 0.7978845608028654f * (x + 0.044715f * x * x * x); return 0.5f * x * (1.f + tanhf(y)); }

#define XB_TMO      128
#define XB_XCNT(j)  (256  + 64 * (j))
#define XB_XSUB(j)  (1280 + 64 * (j))
#define XB_XGEN(j)  (2304 + 64 * (j))
#define XB_TOP      3328
#define XB_TOPGEN   3392
#define XCD_BAR_WORDS 3456
#define XB_SPIN_CAP (1u << 18)
__device__ __forceinline__ unsigned xb_ld(unsigned* p)              { return __hip_atomic_load(p, __ATOMIC_RELAXED, __HIP_MEMORY_SCOPE_AGENT); }
__device__ __forceinline__ unsigned xb_add(unsigned* p, unsigned v) { return __hip_atomic_fetch_add(p, v, __ATOMIC_RELAXED, __HIP_MEMORY_SCOPE_AGENT); }
__device__ __forceinline__ unsigned xb_xcc_id() { return (unsigned)__builtin_amdgcn_s_getreg((3 << 11) | 20) & 0xFu; }
#define XB_SPIN(cond, bar) do { unsigned _sp = 0; while (cond) { __builtin_amdgcn_s_sleep(1); \
    if ((++_sp & 255u) == 0u) { if (xb_ld(&(bar)[XB_TMO])) break; if (_sp > XB_SPIN_CAP) { atomicAdd(&(bar)[XB_TMO], 1u); break; } } } } while (0)
struct XcdBarrier { unsigned* bar; unsigned x; volatile LAS unsigned* st; };
__device__ __forceinline__ XcdBarrier xcd_barrier_post(unsigned* bar, volatile LAS unsigned* st) {
    XcdBarrier b; b.bar = bar; b.x = xb_xcc_id(); b.st = st;
    if (threadIdx.x == 0) (void)xb_add(&bar[XB_XCNT(b.x)], 1u);
    return b;
}
__device__ __forceinline__ void xcd_barrier_complete(unsigned* bar, unsigned x, unsigned& nloc, unsigned& nx) {
    const unsigned G = gridDim.x * gridDim.y * gridDim.z;
    unsigned sum, cnt, mine, sp = 0u;
    for (;;) {
        sum = 0u; cnt = 0u; mine = 0u;
#pragma unroll
        for (unsigned j = 0; j < 16; ++j) { const unsigned c = xb_ld(&bar[XB_XCNT(j)]); sum += c; cnt += (c > 0u) ? 1u : 0u; mine = (j == x) ? c : mine; }
        if (sum == G) break;
        __builtin_amdgcn_s_sleep(1);
        if ((++sp & 255u) == 0u) { if (xb_ld(&bar[XB_TMO])) break; if (sp > XB_SPIN_CAP) { atomicAdd(&bar[XB_TMO], 1u); break; } }
    }
    nloc = mine > 0u ? mine : 1u; nx = cnt > 0u ? cnt : 1u;
}
__device__ __forceinline__ void xcd_barrier(const XcdBarrier& b) {
    asm volatile("s_waitcnt vmcnt(0)" ::: "memory");
    __syncthreads();
    if (threadIdx.x == 0) {
        unsigned* bar = b.bar;
        __builtin_amdgcn_s_waitcnt(0);
        unsigned nloc = b.st[0], nx = b.st[1];
        if (nloc == 0u) { xcd_barrier_complete(bar, b.x, nloc, nx); b.st[0] = nloc; b.st[1] = nx; }
        const unsigned old = xb_add(&bar[XB_XSUB(b.x)], 1u);
        const unsigned gen = old / nloc;
        if (old + 1u == (gen + 1u) * nloc) {
            __builtin_amdgcn_fence(__ATOMIC_RELEASE, "agent");
            asm volatile("s_waitcnt vmcnt(0)" ::: "memory");
            const unsigned og = xb_add(&bar[XB_TOP], 1u);
            const unsigned tg = og / nx;
            if (og + 1u == (tg + 1u) * nx) xb_add(&bar[XB_TOPGEN], 1u);
            else XB_SPIN(xb_ld(&bar[XB_TOPGEN]) == tg, bar);
            __builtin_amdgcn_fence(__ATOMIC_ACQUIRE, "agent");
            xb_add(&bar[XB_XGEN(b.x)], 1u);
            asm volatile("s_waitcnt vmcnt(0)" ::: "memory");
        } else {
            XB_SPIN(xb_ld(&bar[XB_XGEN(b.x)]) == gen, bar);
            __builtin_amdgcn_fence(__ATOMIC_ACQUIRE, "agent");
            asm volatile("s_waitcnt vmcnt(0)" ::: "memory");
        }
    }
    __syncthreads();
}

struct Args { const float* in[22]; float* out; unsigned char* ws; int ph_lo, ph_hi; };
enum { I_X = 0, I_C, I_CTX, I_CCTX, I_WMOD, I_BMOD, I_N1G, I_N2G, I_WIN, I_QG, I_KG, I_CONVW, I_LNG, I_LNB, I_GMWS, I_GMB, I_WOUT, I_WUP, I_FCW, I_FCB, I_WDN, I_FNG };

typedef const Args __attribute__((address_space(4)))* KArgs;
__device__ __forceinline__ KArgs kargs() { KArgs p = (KArgs)__builtin_amdgcn_kernarg_segment_ptr(); asm volatile("" : "+s"(p)); return p; }
struct Frame {
    LAS unsigned char* lds;
    int tid, lane, wave, G, bx, gw, ngw;
    unsigned char* ws;
};
__device__ __forceinline__ Frame make_frame(KArgs a) {
    extern __shared__ __attribute__((aligned(16))) unsigned char lds_[];
    Frame F; int t = threadIdx.x; asm volatile("" : "+v"(t));
    F.lds = (LAS unsigned char*)lds_; F.tid = t; F.lane = t & 63; F.wave = __builtin_amdgcn_readfirstlane(t >> 6);
    F.G = gridDim.x; F.bx = blockIdx.x; F.gw = F.bx * NWAVES + F.wave; F.ngw = F.G * NWAVES; F.ws = a->ws;
    return F;
}

__device__ __forceinline__ size_t toff(int n, int k, int K) { return ((size_t)(n >> 8) * (K >> 6) + (k >> 6)) * 16384 + (size_t)(n & 255) * 64 + (k & 63); }
__device__ __forceinline__ void transpose_item(const float* W, int ldw, int k0, int ns0, bf16* WT, int ldt, int nd0, LAS float* scr, int lane) {
    f32x4 v[8];
#pragma unroll
    for (int i = 0; i < 8; ++i) v[i] = *(const f32x4*)(W + (size_t)(k0 + i * 8 + (lane >> 3)) * ldw + ns0 + (lane & 7) * 4);
#pragma unroll
    for (int i = 0; i < 8; ++i) { LAS float* d = scr + (i * 8 + (lane >> 3)) * 33 + (lane & 7) * 4; d[0] = v[i].x; d[1] = v[i].y; d[2] = v[i].z; d[3] = v[i].w; }
    LDS_WAIT(); asm volatile("" ::: "memory");
    const int c = lane & 7;
#pragma unroll
    for (int j = 0; j < 4; ++j) { const int n = (lane >> 3) + 8 * j; const LAS float* s = scr + (8 * c) * 33 + n;
        v4u o; o.x = pk2(s[0 * 33], s[1 * 33]); o.y = pk2(s[2 * 33], s[3 * 33]); o.z = pk2(s[4 * 33], s[5 * 33]); o.w = pk2(s[6 * 33], s[7 * 33]);
        *(v4u*)(WT + toff(nd0 + n, k0 + 8 * c, ldt)) = o; }
    LDS_WAIT(); asm volatile("" ::: "memory");
}

__device__ __forceinline__ void p0a_prologue(KArgs a) {
    Frame F = make_frame(a); unsigned char* ws = F.ws;
    {
        LAS float* scr = (LAS float*)(F.lds + F.wave * 16384);
        constexpr int I_IN = 32 * 128, I_OUT = 40 * 64, I_UP = 32 * 352, I_DN = 88 * 64, I_L = I_IN + I_OUT + I_UP + I_DN;
        for (int it = F.gw; it < DEPTH * I_L; it += F.ngw) {
            const int l = it / I_L; int r = it % I_L;
            if (r < I_IN) { const int kb = r / 128, nb = r % 128; const int ns0 = nb < 48 ? nb * 32 : 2048 + (nb - 48) * 32; const int nd0 = nb < 48 ? ns0 : ns0 + 512;
                transpose_item(a->in[I_WIN] + (size_t)l * DM * INW_SRC, INW_SRC, kb * 64, ns0, (bf16*)(ws + WS_WIN) + (size_t)l * PW * DM, DM, nd0, scr, F.lane); continue; }
            r -= I_IN;
            if (r < I_OUT) { const int kb = r / 64, nb = r % 64;
                transpose_item(a->in[I_WOUT] + (size_t)l * MIXW * DM, DM, kb * 64, nb * 32, (bf16*)(ws + WS_WOUT) + (size_t)l * DM * MIXW, MIXW, nb * 32, scr, F.lane); continue; }
            r -= I_OUT;
            if (r < I_UP) { const int kb = r / 352, nb = r % 352; const int nd0 = nb * 32, ns0 = ((nd0 >> 7) & 1) * DFF + (nd0 >> 8) * 128 + (nd0 & 127);
                transpose_item(a->in[I_WUP] + (size_t)l * DM * UPW, UPW, kb * 64, ns0, (bf16*)(ws + WS_WUP) + (size_t)l * UPW * DM, DM, nb * 32, scr, F.lane); continue; }
            r -= I_UP;
            { const int kb = r / 64, nb = r % 64;
                transpose_item(a->in[I_WDN] + (size_t)l * DFF * DM, DM, kb * 64, nb * 32, (bf16*)(ws + WS_WDN) + (size_t)l * DM * DFF, DFF, nb * 32, scr, F.lane); }
        }
    }
    __syncthreads();
    {
        LAS float* sl = (LAS float*)F.lds;
        for (int i = F.tid; i < 5 * DM; i += NTHR) { const int v = i / DM, k = i % DM; const float cv = v < 4 ? a->in[I_C][v * DM + k] : a->in[I_CCTX][k]; sl[i] = cv / (1.f + expf(-cv)); }
        __syncthreads();
        float* MODP = (float*)(ws + WS_MODP);
        for (int it = F.gw; it < DEPTH * 16 * 48; it += F.ngw) {
            const int l = it / 768, r = it % 768, ks = r / 48, cg = r % 48;
            const float* wp = a->in[I_WMOD] + ((size_t)l * DM + ks * 128) * NMOD + cg * 256 + F.lane * 4;
            f32x4 acc[5];
#pragma unroll
            for (int v = 0; v < 5; ++v) acc[v] = (f32x4){0.f, 0.f, 0.f, 0.f};
            for (int k = 0; k < 128; k += 8) {
                f32x4 w[8];
#pragma unroll
                for (int u = 0; u < 8; ++u) w[u] = *(const f32x4*)(wp + (size_t)(k + u) * NMOD);
#pragma unroll
                for (int u = 0; u < 8; ++u)
#pragma unroll
                    for (int v = 0; v < 5; ++v) acc[v] += w[u] * sl[v * DM + ks * 128 + k + u];
            }
#pragma unroll
            for (int v = 0; v < 5; ++v) *(f32x4*)(MODP + ((size_t)ks * (DEPTH * 5) + l * 5 + v) * NMOD + cg * 256 + F.lane * 4) = acc[v];
        }
    }
    __syncthreads();
    {
        LAS float* T128 = (LAS float*)F.lds;
        LAS float* Wl = (LAS float*)(F.lds + 1024);
        if (F.tid < 128) T128[F.tid] = cospif((float)F.tid * (1.f / 64.f));
        __syncthreads();
        for (int it = F.bx; it < DEPTH * 4 * 64; it += F.G) {
            const int l = it / 256, g = (it / 64) % 4, kb = it % 64;
            for (int i = F.tid; i < 32 * 128; i += NTHR) { const int kk = i / 128, dd = i % 128; Wl[i] = a->in[I_WIN][((size_t)l * DM + kb * 32 + kk) * INW_SRC + 1536 + g * 128 + dd]; }
            __syncthreads();
            const int dout = F.tid & 127, cs = (F.tid >> 7) & 1, kg = F.tid >> 8;
            float acc[16];
#pragma unroll
            for (int kk = 0; kk < 16; ++kk) acc[kk] = 0.f;
            for (int dd = 0; dd < 128; ++dd) {
                const float tr = T128[(dout * dd - (cs ? 32 : 0)) & 127];
#pragma unroll
                for (int kk = 0; kk < 16; ++kk) acc[kk] += Wl[(kg * 16 + kk) * 128 + dd] * tr;
            }
            bf16* dst = (bf16*)(ws + WS_WIN) + (size_t)l * PW * DM + toff(PFA + cs * 512 + g * 128 + dout, kb * 32 + kg * 16, DM);
            v4u o0, o1; o0.x = pk2(acc[0], acc[1]); o0.y = pk2(acc[2], acc[3]); o0.z = pk2(acc[4], acc[5]); o0.w = pk2(acc[6], acc[7]);
            o1.x = pk2(acc[8], acc[9]); o1.y = pk2(acc[10], acc[11]); o1.z = pk2(acc[12], acc[13]); o1.w = pk2(acc[14], acc[15]);
            *(v4u*)dst = o0; *(v4u*)(dst + 8) = o1;
            __syncthreads();
        }
    }
    __syncthreads();
    {
        LAS float* T = (LAS float*)F.lds;
        for (int i = F.tid; i < 4096; i += NTHR) T[i] = cospif((float)i * (1.f / 2048.f));
        __syncthreads();
        bf16* A1 = (bf16*)(ws + WS_A1);
        for (int idx = F.bx * NTHR + F.tid; idx < 256 * 32; idx += F.G * NTHR) {
            const int m = idx >> 5, kk0 = (idx & 31) * 8; const int cho = m >> 7, k2 = (m & 127) >> 1, ro = m & 1; float x[8];
#pragma unroll
            for (int e2 = 0; e2 < 8; ++e2) { const int kk = kk0 + e2, chi = kk >> 7, ri = (kk >> 6) & 1, aa = kk & 63;
                const float cs_ = T[(64 * k2 * aa) & 4095], sn_ = T[(64 * k2 * aa - 1024) & 4095];
                const float v = ro == 0 ? (ri == 0 ? cs_ : -sn_) : (ri == 0 ? -sn_ : -cs_);
                x[e2] = (cho == chi) ? v : 0.f; }
            *(v4u*)(A1 + (size_t)m * 256 + kk0) = pack8(x);
        }
        bf16* A2 = (bf16*)(ws + WS_A2);
        for (int idx = F.bx * NTHR + F.tid; idx < 16 * 256 * 64; idx += F.G * NTHR) {
            const int kk0 = (idx & 63) * 8, m = (idx >> 6) & 255, q = idx >> 14; const int k2p = m >> 6, k1 = m & 63, k = 4 * q + k2p + 64 * k1; float x[8];
#pragma unroll
            for (int e2 = 0; e2 < 8; ++e2) { const int kk = kk0 + e2, k2pp = kk >> 7, ro = (kk >> 6) & 1, c = kk & 63;
                const float v = ro == 0 ? T[(k * c) & 4095] : T[(k * c - 1024) & 4095];
                x[e2] = (k2pp == k2p) ? v : 0.f; }
            *(v4u*)(A2 + ((size_t)q * 256 + m) * 512 + kk0) = pack8(x);
        }
        bf16* F2 = (bf16*)(ws + WS_F256);
        for (int k = F.bx; k < 256; k += F.G) {
            if (F.tid < 64) { const int j0 = F.tid * 8; const int cs = j0 >> 8, t0 = j0 & 255; float x[8];
#pragma unroll
                for (int e = 0; e < 8; ++e) { const int m = (16 * k * (t0 + e) - (cs ? 1024 : 0)) & 4095; const float v = T[m]; x[e] = cs ? -v : v; }
                *(v4u*)(F2 + (size_t)k * 512 + j0) = pack8(x); }
        }
    }
    if (F.bx == 0) {
        f32x2* ROPE = (f32x2*)(ws + WS_ROPE);
        for (int i = F.tid; i < 64 * 32; i += NTHR) { const int pos = i >> 5, ii = i & 31; const float freq = powf(10000.f, -(float)(2 * ii) / 64.f); const float ang = (float)pos * freq;
            ROPE[i] = (f32x2){cosf(ang), sinf(ang)}; }
    }
    __syncthreads();
}

__device__ __forceinline__ void p0b_modreduce(KArgs a) {
    Frame F = make_frame(a);
    const float* MODP = (const float*)(F.ws + WS_MODP); float* MOD = (float*)(F.ws + WS_MOD);
    for (int i = F.bx * NTHR + F.tid; i < DEPTH * 5 * (NMOD / 4); i += F.G * NTHR) {
        const int j4 = i % (NMOD / 4), lv = i / (NMOD / 4), l = lv / 5;
        f32x4 s = *(const f32x4*)(a->in[I_BMOD] + (size_t)l * NMOD + j4 * 4);
#pragma unroll
        for (int ks = 0; ks < 16; ++ks) s += *(const f32x4*)(MODP + ((size_t)ks * (DEPTH * 5) + lv) * NMOD + j4 * 4);
        *(f32x4*)(MOD + (size_t)lv * NMOD + j4 * 4) = s;
    }
}

__device__ __forceinline__ void norm_phase(KArgs a, int M, const float* g, const float* modl, int shoff, int scoff, bool fold, bool lat_in, bool ctx_in) {
    Frame F = make_frame(a);
    bf16* X = (bf16*)(F.ws + WS_X); bf16* H = (bf16*)(F.ws + WS_H); const float* XP = (const float*)(F.ws + WS_XP);
    for (int row = F.gw; row < M; row += F.ngw) {
        const int v = row < ML ? row >> 12 : 4;
        const float* sh = modl + (size_t)v * NMOD + shoff; const float* sc = modl + (size_t)v * NMOD + scoff;
        v4u* xr = (v4u*)(X + (size_t)row * DM) + F.lane;
        f32x4 x[4][2]; float ss = 0.f;
        if (row < ML ? lat_in : ctx_in) { const f32x4* xs = (const f32x4*)(row < ML ? a->in[I_X] + (size_t)row * DM : a->in[I_CTX] + (size_t)(row - ML) * DM) + 2 * F.lane;
#pragma unroll
            for (int j = 0; j < 4; ++j) { x[j][0] = xs[128 * j]; x[j][1] = xs[128 * j + 1]; } }
        else {
#pragma unroll
            for (int j = 0; j < 4; ++j) { const v4u w = xr[64 * j]; x[j][0] = (f32x4){bflo(w.x), bfhi(w.x), bflo(w.y), bfhi(w.y)}; x[j][1] = (f32x4){bflo(w.z), bfhi(w.z), bflo(w.w), bfhi(w.w)}; } }
        if (fold && row >= ML) {
#pragma unroll
            for (int ks = 0; ks < 4; ++ks) { const f32x4* pr = (const f32x4*)(XP + ((size_t)ks * MC + (row - ML)) * DM) + 2 * F.lane;
#pragma unroll
                for (int j = 0; j < 4; ++j) { x[j][0] += pr[128 * j]; x[j][1] += pr[128 * j + 1]; } }
#pragma unroll
            for (int j = 0; j < 4; ++j) { v4u w; w.x = pk2(x[j][0].x, x[j][0].y); w.y = pk2(x[j][0].z, x[j][0].w); w.z = pk2(x[j][1].x, x[j][1].y); w.w = pk2(x[j][1].z, x[j][1].w); xr[64 * j] = w; }
        }
#pragma unroll
        for (int j = 0; j < 4; ++j)
#pragma unroll
            for (int h = 0; h < 2; ++h) ss += (x[j][h].x * x[j][h].x + x[j][h].y * x[j][h].y) + (x[j][h].z * x[j][h].z + x[j][h].w * x[j][h].w);
        const float rstd = 1.0f / sqrtf(wave_sum(ss) * (1.f / DM) + EPS);
#pragma unroll
        for (int j = 0; j < 4; ++j) { const int col = F.lane * 8 + 512 * j; f32x4 y[2];
#pragma unroll
            for (int h = 0; h < 2; ++h) { const f32x4 gg = *(const f32x4*)(g + col + 4 * h), s1 = *(const f32x4*)(sc + col + 4 * h), s0 = *(const f32x4*)(sh + col + 4 * h);
                y[h] = x[j][h] * rstd * gg * (s1 + 1.0f) + s0; }
            v4u o; o.x = pk2(y[0].x, y[0].y); o.y = pk2(y[0].z, y[0].w); o.z = pk2(y[1].x, y[1].y); o.w = pk2(y[1].z, y[1].w);
            *(v4u*)(H + (size_t)row * DM + col) = o; }
    }
}

__device__ __forceinline__ void final_norm_phase(KArgs a, const float* g, float* out) {
    Frame F = make_frame(a);
    const bf16* X = (const bf16*)(F.ws + WS_X);
    for (int row = F.gw; row < ML; row += F.ngw) {
        const v2u* xr = (const v2u*)(X + (size_t)row * DM) + F.lane;
        f32x4 x[8]; float ss = 0.f;
#pragma unroll
        for (int j = 0; j < 8; ++j) { const v2u w = xr[64 * j]; x[j] = (f32x4){bflo(w.x), bfhi(w.x), bflo(w.y), bfhi(w.y)}; ss += (x[j].x * x[j].x + x[j].y * x[j].y) + (x[j].z * x[j].z + x[j].w * x[j].w); }
        const float rstd = 1.0f / sqrtf(wave_sum(ss) * (1.f / DM) + EPS);
#pragma unroll
        for (int j = 0; j < 8; ++j) { const int col = F.lane * 4 + 256 * j; const f32x4 gg = *(const f32x4*)(g + col);
            *(f32x4*)(out + (size_t)row * DM + col) = x[j] * rstd * gg; }
    }
}

__device__ __forceinline__ float gelu_fast(float x) { const float y = 1.5957691216057308f * (x + 0.044715f * x * x * x); return x * __builtin_amdgcn_rcpf(1.f + __expf(-y)); }

__device__ __forceinline__ void postA_phase(KArgs a, int l) {
    Frame F = make_frame(a); unsigned char* ws = F.ws;
    const bf16* P = (const bf16*)(ws + WS_P); bf16* MIX = (bf16*)(ws + WS_MIX); bf16* KB = (bf16*)(ws + WS_KB); bf16* VB = (bf16*)(ws + WS_VB);
    bf16* QB = (bf16*)(ws + WS_QB); bf16* UB = (bf16*)(ws + WS_UB); bf16* V2B = (bf16*)(ws + WS_V2B);
    const f32x4* ROPE4 = (const f32x4*)(ws + WS_ROPE);
    const int lane = F.lane, tid = F.tid;
    {
        const int hl = lane & 15, axis = hl >> 3, i0 = (lane & 3) * 8; const bool first = (lane & 7) < 4;
        float qg8[8], kg8[8], cw0[8], cw1[8], cw2[8], lg8[8], lb8[8];
        { const float* qg = a->in[I_QG] + l * 128 + hl * 8; const float* kg = a->in[I_KG] + l * 128 + hl * 8; const float* cw = a->in[I_CONVW] + (size_t)l * 3 * 512 + lane * 8;
          const float* lng = a->in[I_LNG] + l * 512 + lane * 8; const float* lnb = a->in[I_LNB] + l * 512 + lane * 8;
#pragma unroll
          for (int e = 0; e < 8; ++e) { qg8[e] = qg[e]; kg8[e] = kg[e]; cw0[e] = cw[e]; cw1[e] = cw[512 + e]; cw2[e] = cw[1024 + e]; lg8[e] = lng[e]; lb8[e] = lnb[e]; } }
        for (int row = F.gw; row < MT; row += F.ngw) {
            const bool is_ctx = row >= ML;
            const int b = is_ctx ? (row - ML) >> 8 : row >> 12, p = is_ctx ? (row - ML) & 255 : row & 4095, nseq = is_ctx ? CTXL : SEQ;
            const bool kv_only = is_ctx && (l == DEPTH - 1);
            const bf16* Pr = P + (size_t)row * PW;
            const int kvpos = is_ctx ? p : CTXL + p;
            const v4u rkv = *(const v4u*)(Pr + PK + lane * 8);
            f32x4 c4[4];
            if (!is_ctx) { const int posax = axis ? (p & 63) : (p >> 6);
#pragma unroll
                for (int e = 0; e < 4; ++e) c4[e] = ROPE4[posax * 16 + (i0 >> 1) + e]; }
            {
                float x[8]; unpack8(rkv, x); float ss = 0.f;
#pragma unroll
                for (int e = 0; e < 8; ++e) ss += x[e] * x[e];
                ss += __shfl_xor(ss, 1); ss += __shfl_xor(ss, 2); ss += __shfl_xor(ss, 4); ss += __shfl_xor(ss, 8);
                const float rstd = 1.0f / sqrtf(ss * (1.f / 128.f) + EPS);
                float y[8];
#pragma unroll
                for (int e = 0; e < 8; ++e) y[e] = x[e] * rstd * kg8[e];
                if (!is_ctx) {
#pragma unroll
                    for (int e = 0; e < 8; ++e) { const float pr = __shfl_xor(y[e], 4); const float cs_ = c4[e >> 1][(e & 1) * 2], sn_ = c4[e >> 1][(e & 1) * 2 + 1]; y[e] = first ? y[e] * cs_ - pr * sn_ : y[e] * cs_ + pr * sn_; } }
                if (lane < 32) *(v4u*)(KB + ((size_t)b * SKV + kvpos) * 256 + lane * 8) = pack8(y);
                else *(v4u*)(VB + ((size_t)b * SKV + kvpos) * 256 + (lane - 32) * 8) = rkv;
            }
            if (kv_only) continue;
            const v4u rq0 = *(const v4u*)(Pr + PQ + lane * 8), rq1 = *(const v4u*)(Pr + PQ + 512 + lane * 8);
            const v4u rcb = *(const v4u*)(Pr + PCB + lane * 8), rc0 = *(const v4u*)(Pr + PCC + lane * 8), rh0 = *(const v4u*)(Pr + PCH + lane * 8);
            const bool hp = p > 0, hn = p < nseq - 1;
            const bf16* Pm = hp ? Pr - PW : Pr; const bf16* Pn = hn ? Pr + PW : Pr;
            const v4u rcm = *(const v4u*)(Pm + PCC + lane * 8), rhm = *(const v4u*)(Pm + PCH + lane * 8), rcp = *(const v4u*)(Pn + PCC + lane * 8), rhp = *(const v4u*)(Pn + PCH + lane * 8);
            const v4u rgu = *(const v4u*)(Pr + PGU + lane * 8), rgv = *(const v4u*)(Pr + PGV + lane * 8);
#pragma unroll
            for (int part = 0; part < 2; ++part) {
                float x[8]; unpack8(part ? rq1 : rq0, x); float ss = 0.f;
#pragma unroll
                for (int e = 0; e < 8; ++e) ss += x[e] * x[e];
                ss += __shfl_xor(ss, 1); ss += __shfl_xor(ss, 2); ss += __shfl_xor(ss, 4); ss += __shfl_xor(ss, 8);
                const float rstd = 1.0f / sqrtf(ss * (1.f / 128.f) + EPS);
                float y[8];
#pragma unroll
                for (int e = 0; e < 8; ++e) y[e] = x[e] * rstd * qg8[e];
                if (!is_ctx) {
#pragma unroll
                    for (int e = 0; e < 8; ++e) { const float pr = __shfl_xor(y[e], 4); const float cs_ = c4[e >> 1][(e & 1) * 2], sn_ = c4[e >> 1][(e & 1) * 2 + 1]; y[e] = first ? y[e] * cs_ - pr * sn_ : y[e] * cs_ + pr * sn_; } }
                *(v4u*)(QB + (size_t)row * 1024 + part * 512 + lane * 8) = pack8(y);
            }
            {
                float cb[8], c0[8], h0[8], cm[8], hm[8], cp[8], hq[8], o[8];
                unpack8(rcb, cb); unpack8(rc0, c0); unpack8(rh0, h0); unpack8(rcm, cm); unpack8(rhm, hm); unpack8(rcp, cp); unpack8(rhp, hq);
                const float fp = hp ? 1.f : 0.f, fn = hn ? 1.f : 0.f;
#pragma unroll
                for (int e = 0; e < 8; ++e) o[e] = cb[e] * (cw0[e] * fp * (cm[e] * hm[e]) + cw1[e] * (c0[e] * h0[e]) + cw2[e] * fn * (cp[e] * hq[e]));
                *(v4u*)(MIX + (size_t)row * MIXW + MX_CONV + lane * 8) = pack8(o);
            }
            {
                float u[8], t[8]; unpack8(rgu, u); unpack8(rgv, t);
                float s = 0.f;
#pragma unroll
                for (int e = 0; e < 8; ++e) { u[e] = gelu_fast(u[e]); t[e] = gelu_fast(t[e]); s += t[e]; }
                const float mean = wave_sum(s) * (1.f / 512.f);
                float q = 0.f;
#pragma unroll
                for (int e = 0; e < 8; ++e) { t[e] -= mean; q += t[e] * t[e]; }
                const float rstd = 1.0f / sqrtf(wave_sum(q) * (1.f / 512.f) + EPS);
#pragma unroll
                for (int e = 0; e < 8; ++e) t[e] = t[e] * rstd * lg8[e] + lb8[e];
                *(v4u*)(UB + (size_t)row * 512 + lane * 8) = pack8(u); *(v4u*)(V2B + (size_t)row * 512 + lane * 8) = pack8(t);
            }
        }
    }
    {
        LAS unsigned* tb = (LAS unsigned*)F.lds;
        bf16* S1 = (bf16*)(ws + WS_T1T);
        for (int un = F.bx; un < 512; un += F.G) {
            const int ab = un >> 6, b = (un >> 4) & 3, slab = un & 15;
            const size_t rowb = (size_t)b * SEQ + (size_t)ab * 512;
#pragma unroll
            for (int it = 0; it < 4; ++it) {
                const int idx = tid + it * NTHR; const int j = idx & 3, c = (idx >> 2) & 63, c8 = idx >> 8;
                const bf16* src0 = P + (rowb + (size_t)(2 * j) * 64 + c) * PW + PFA + slab * 64 + c8 * 8;
                const v4u r0 = *(const v4u*)src0, r1 = *(const v4u*)(src0 + (size_t)64 * PW);
                const unsigned a0[4] = {r0.x, r0.y, r0.z, r0.w}, a1[4] = {r1.x, r1.y, r1.z, r1.w};
#pragma unroll
                for (int w = 0; w < 4; ++w) {
                    tb[((c8 * 8 + 2 * w) * 64 + c) * 4 + j]     = (a0[w] & 0xffffu) | (a1[w] << 16);
                    tb[((c8 * 8 + 2 * w + 1) * 64 + c) * 4 + j] = (a0[w] >> 16) | (a1[w] & 0xffff0000u);
                }
            }
            __syncthreads();
#pragma unroll
            for (int it = 0; it < 8; ++it) {
                const int idx = tid + it * NTHR; const int c = idx & 63, col = idx >> 6;
                const v4u o = *(const LAS v4u*)(tb + (col * 64 + c) * 4);
                const int gcol = slab * 64 + col, ri = gcol >> 9, n = b * 512 + (gcol & 511);
                *(v4u*)(S1 + ((((size_t)n * 32 + (c & 31)) * 2 + (c >> 5)) * 2 + ri) * 64 + ab * 8) = o;
            }
            __syncthreads();
        }
    }
    if (l < DEPTH - 1) {
        LAS unsigned* tb = (LAS unsigned*)F.lds;
        for (int un = F.bx; un < 32; un += F.G) {
            const int chc = un >> 2, slab = un & 3;
            const int b = chc >> 1, p0 = (chc & 1) * 128;
            const int row0 = ML + b * CTXL + p0;
            bf16* T1 = (bf16*)(ws + WS_T1TC);
#pragma unroll
            for (int it = 0; it < 4; ++it) {
                const int q = tid + it * NTHR;
                const int c8 = ((q >> 6) & 3) * 8 + (q & 7), rp = (q >> 8) * 8 + ((q >> 3) & 7);
                const v4u r0 = *(const v4u*)(P + (size_t)(row0 + 2 * rp) * PW + PFA + slab * 256 + c8 * 8);
                const v4u r1 = *(const v4u*)(P + (size_t)(row0 + 2 * rp + 1) * PW + PFA + slab * 256 + c8 * 8);
                const unsigned a0[4] = {r0.x, r0.y, r0.z, r0.w}, a1[4] = {r1.x, r1.y, r1.z, r1.w};
#pragma unroll
                for (int w = 0; w < 4; ++w) {
                    tb[(c8 * 8 + 2 * w) * 65 + rp]     = (a0[w] & 0xffffu) | (a1[w] << 16);
                    tb[(c8 * 8 + 2 * w + 1) * 65 + rp] = (a0[w] >> 16) | (a1[w] & 0xffff0000u);
                }
            }
            __syncthreads();
#pragma unroll
            for (int it = 0; it < 8; ++it) {
                const int idx = tid + it * NTHR; const int cc = idx >> 4, t8 = idx & 15;
                v4u o; o.x = tb[cc * 65 + t8 * 4]; o.y = tb[cc * 65 + t8 * 4 + 1]; o.z = tb[cc * 65 + t8 * 4 + 2]; o.w = tb[cc * 65 + t8 * 4 + 3];
                const int col = slab * 256 + cc, csn = col >> 9, gd = col & 511;
                *(v4u*)(T1 + (size_t)(b * 512 + gd) * 512 + csn * CTXL + p0 + t8 * 8) = o;
            }
            __syncthreads();
        }
    }
}

__device__ __forceinline__ void gate_phase(KArgs a, int l, int wg0, int nwg, int u_lo, int u_hi) {
    Frame F = make_frame(a); unsigned char* ws = F.ws;
    F.bx -= wg0; if (F.bx < 0 || F.bx >= nwg) return;
    const bf16* UB = (const bf16*)(ws + WS_UB); const bf16* V2B = (const bf16*)(ws + WS_V2B); bf16* MIX = (bf16*)(ws + WS_MIX);
    const float* gws = a->in[I_GMWS] + (size_t)l * 4 * 128 * 128; const float* gmb = a->in[I_GMB] + l * 4 * 128;
    const int tid = F.tid, lane = F.lane, r32 = lane & 31, hi = lane >> 5, gsel = F.wave >> 2, qb = F.wave & 3;
    for (int un = u_lo + F.bx; un < u_hi; un += nwg) {
        const int ch = un >> 1, gp = un & 1;
        const bool is_ctx = ch >= 128;
        const int b = is_ctx ? (ch - 128) >> 1 : ch >> 5;
        const int p0 = is_ctx ? ((ch - 128) & 1) * 128 : (ch & 31) * 128;
        const int row0 = is_ctx ? ML + b * CTXL + p0 : b * SEQ + p0;
#pragma unroll
        for (int it = 0; it < 8; ++it) { const int idx = tid + it * NTHR; const int gi = idx >> 11, pp = (idx >> 4) & 127, c8 = idx & 15;
            const v4u v = *(const v4u*)(V2B + (size_t)(row0 + pp) * 512 + (2 * gp + gi) * 128 + c8 * 8);
            *(LAS v4u*)(F.lds + (gi * 2 + (pp >> 6)) * 16384 + att::v_st(pp & 63, c8 * 8)) = v; }
        __syncthreads();
        const int g = 2 * gp + gsel;
        att::f32x16 o[4] = {};
#pragma unroll
        for (int kt = 0; kt < 2; ++kt) {
            const float* wrow = gws + ((size_t)g * 128 + 32 * qb + r32) * 128 + 64 * kt + 8 * hi;
            att::bf16x8 pa[4];
#pragma unroll
            for (int ks = 0; ks < 4; ++ks) { const f32x4 w0 = *(const f32x4*)(wrow + 16 * ks), w1 = *(const f32x4*)(wrow + 16 * ks + 4);
                v4u w; w.x = pk2(w0.x, w0.y); w.y = pk2(w0.z, w0.w); w.z = pk2(w1.x, w1.y); w.w = pk2(w1.z, w1.w); pa[ks] = *reinterpret_cast<att::bf16x8*>(&w); }
            const int vb = (int)(unsigned)(uintptr_t)(F.lds + (gsel * 2 + kt) * 16384) + att::v_rd_base(lane);
            att::pv_d0(o, vb, pa[0], pa[1], pa[2], pa[3]);
        }
        __syncthreads();
        { LAS unsigned char* ob = F.lds + F.wave * (32 * 272);
#pragma unroll
          for (int i = 0; i < 8; ++i) { const int row = i * 4 + (lane >> 4), chk = lane & 15;
              *(LAS v4u*)(ob + row * 272 + chk * 16) = *(const v4u*)(UB + (size_t)(row0 + 32 * qb + row) * 512 + g * 128 + chk * 8); }
#pragma unroll
          for (int r = 0; r < 16; ++r) { const int qq = att::crow(r, hi); const float bias = gmb[g * 128 + 32 * qb + qq];
#pragma unroll
              for (int d0 = 0; d0 < 4; ++d0) { LAS bf16* e = (LAS bf16*)(ob + qq * 272 + (d0 * 32 + r32) * 2);
                  const float u = __uint_as_float((unsigned)*e << 16); const float val = u * (o[d0][r] + bias); *e = (bf16)(pk2(val, val) & 0xffffu); } }
#pragma unroll
          for (int i = 0; i < 8; ++i) { const int row = i * 4 + (lane >> 4), chk = lane & 15;
              *(v4u*)(MIX + (size_t)(row0 + 32 * qb + row) * MIXW + MX_GM + g * 128 + chk * 8) = *(const LAS v4u*)(ob + row * 272 + chk * 16); }
        }
        __syncthreads();
    }
}

__device__ __forceinline__ void act_fix_phase(KArgs a, int l, int M) {
    Frame F = make_frame(a);
    const float* EDGE = (const float*)(F.ws + WS_EDGE); bf16* ACT = (bf16*)(F.ws + WS_ACT);
    const float* cw = a->in[I_FCW] + (size_t)l * 3 * DFF; const float* cb = a->in[I_FCB] + (size_t)l * DFF;
    constexpr int CG = DFF / 4;
    const int total = (M / 256) * 2 * CG;
    for (int idx = F.bx * NTHR + F.tid; idx < total; idx += F.G * NTHR) {
        const int c0 = (idx % CG) * 4, pw = idx / CG, which = pw & 1, pm = pw >> 1;
        const bool first = pm >= 64 || (pm & 15) == 0, last = pm >= 64 || (pm & 15) == 15;
        const float* e = EDGE + (size_t)pm * 6 * DFF + c0;
        f32x4 prev, cur, next, uu; const f32x4 zero = (f32x4){0.f, 0.f, 0.f, 0.f};
        if (which == 0) { prev = first ? zero : *(const f32x4*)(e - (size_t)6 * DFF + (size_t)3 * DFF); cur = *(const f32x4*)e; next = *(const f32x4*)(e + DFF); uu = *(const f32x4*)(e + (size_t)4 * DFF); }
        else { prev = *(const f32x4*)(e + (size_t)2 * DFF); cur = *(const f32x4*)(e + (size_t)3 * DFF); next = last ? zero : *(const f32x4*)(e + (size_t)6 * DFF); uu = *(const f32x4*)(e + (size_t)5 * DFF); }
        const f32x4 z = *(const f32x4*)(cw + c0) * prev + *(const f32x4*)(cw + DFF + c0) * cur + *(const f32x4*)(cw + 2 * DFF + c0) * next + *(const f32x4*)(cb + c0);
        float o[4];
#pragma unroll
        for (int j = 0; j < 4; ++j) o[j] = z[j] * __builtin_amdgcn_rcpf(1.f + __expf(-z[j])) * uu[j];
        v2u w; w.x = pk2(o[0], o[1]); w.y = pk2(o[2], o[3]);
        *(v2u*)(ACT + (size_t)(pm * 256 + (which ? 255 : 0)) * DFF + c0) = w;
    }
}

constexpr int PH_P0A = 0, PH_P0B = 1, PH_L0 = 2, PH_PER_LAYER = 10, PH_FINAL = PH_L0 + DEPTH * PH_PER_LAYER, N_PHASES = PH_FINAL + 1;

__device__ __forceinline__ void gemm_in_phase(KArgs a, int l) {
    unsigned char* ws = a->ws; extern __shared__ __attribute__((aligned(16))) unsigned char lds_[];
    pg8::Gemm g{(const bf16*)(ws + WS_H), (const bf16*)(ws + WS_WIN) + (size_t)l * PW * DM, MT, PW, DM, DM, DM, 0, 0, 1};
    pg8::StaticOrder S; S.init(MT, PW, gridDim.x, blockIdx.x, DM);
    pg8::EpiBf16 E{(bf16*)(ws + WS_P), PW};
    pg8::gemm_phase<pg8::EpiBf16, pg8::StaticOrder, true, true>((LAS unsigned char*)lds_, g, S, E);
}
__device__ __forceinline__ void gemm_in_probe(KArgs a, int l) {
    unsigned char* ws = a->ws; extern __shared__ __attribute__((aligned(16))) unsigned char lds_[];
    pg8::Gemm g{(const bf16*)(ws + WS_H), (const bf16*)(ws + WS_WIN) + (size_t)l * PW * DM, MT, PW, DM, DM, DM, 0, 0, 1};
    pg8::StaticOrder S; S.init(MT, PW, gridDim.x, blockIdx.x, DM);
    pg8::EpiNone E{};
    pg8::gemm_phase<pg8::EpiNone, pg8::StaticOrder, true, true>((LAS unsigned char*)lds_, g, S, E);
}
__device__ __forceinline__ void gemm_up_phase(KArgs a, int l, int M2) {
    unsigned char* ws = a->ws; extern __shared__ __attribute__((aligned(16))) unsigned char lds_[];
    pg8::Gemm g{(const bf16*)(ws + WS_H), (const bf16*)(ws + WS_WUP) + (size_t)l * UPW * DM, M2, UPW, DM, DM, DM, 0, 0, 1};
    pg8::StaticOrder S; S.init(M2, UPW, gridDim.x, blockIdx.x, DM);
    pg8::EpiUp E{(bf16*)(ws + WS_ACT), (float*)(ws + WS_EDGE), a->in[I_FCW] + (size_t)l * 3 * DFF, a->in[I_FCB] + (size_t)l * DFF, (LAS float*)((LAS unsigned char*)lds_ + XL_OFF), DFF};
    pg8::gemm_phase<pg8::EpiUp, pg8::StaticOrder, true, true>((LAS unsigned char*)lds_, g, S, E);
}
__device__ __forceinline__ void gemm_out_phase(KArgs a, int l, int M2) {
    unsigned char* ws = a->ws; extern __shared__ __attribute__((aligned(16))) unsigned char lds_[];
    pg8::Gemm g{(const bf16*)(ws + WS_MIX), (const bf16*)(ws + WS_WOUT) + (size_t)l * DM * MIXW, M2, DM, MIXW, MIXW, MIXW, 0, 0, 1};
    pg8::SplitOrder S; S.init(ML, (M2 - ML) / 256, DM, gridDim.x, blockIdx.x, MIXW);
    pg8::EpiResGate E{(bf16*)(ws + WS_X), (const float*)(ws + WS_MOD) + (size_t)l * 5 * NMOD, 2 * DM, (float*)(ws + WS_XP), l == 0 ? a->in[I_X] : (const float*)nullptr};
    pg8::gemm_phase<pg8::EpiResGate, pg8::SplitOrder, true, true>((LAS unsigned char*)lds_, g, S, E);
}
__device__ __forceinline__ void gemm_down_phase(KArgs a, int l, int M2) {
    unsigned char* ws = a->ws; extern __shared__ __attribute__((aligned(16))) unsigned char lds_[];
    pg8::Gemm g{(const bf16*)(ws + WS_ACT), (const bf16*)(ws + WS_WDN) + (size_t)l * DM * DFF, M2, DM, DFF, DFF, DFF, 0, 0, 1};
    pg8::SplitOrder S; S.init(ML, (M2 - ML) / 256, DM, gridDim.x, blockIdx.x, DFF);
    pg8::EpiResGate E{(bf16*)(ws + WS_X), (const float*)(ws + WS_MOD) + (size_t)l * 5 * NMOD, 5 * DM, (float*)(ws + WS_XP), (const float*)nullptr};
    pg8::gemm_phase<pg8::EpiResGate, pg8::SplitOrder, true, true>((LAS unsigned char*)lds_, g, S, E);
}
__device__ __forceinline__ void attn_phase(KArgs a, int l, int part, int wg0) {
    unsigned char* ws = a->ws; extern __shared__ __attribute__((aligned(16))) unsigned char lds_[];
    const bf16* QB = (const bf16*)(ws + WS_QB); const bf16* KB = (const bf16*)(ws + WS_KB); const bf16* VB = (const bf16*)(ws + WS_VB); bf16* MIX = (bf16*)(ws + WS_MIX);
    const int G = gridDim.x, bx = blockIdx.x;
    const int xcd = bx & 7, wq = bx >> 3;
    const int ulo = part ? 512 + ((bx - wg0 + G) % G) : bx, uhi = part ? ((l < DEPTH - 1) ? 544 : 0) : 512;
    for (int u = ulo; u < uhi; u += G) {
        int b, h, kvh, qrow, seq;
        if (u < 512) { const int i = u / G; const int j = (G == 256) ? wq + 32 * i : (u >> 3), x = (G == 256) ? xcd : (u & 7);
            b = x >> 1; kvh = x & 1; h = kvh * 4 + (j >> 4); qrow = b * SEQ + (j & 15) * 256; seq = SKV; }
        else { const int c = u - 512; b = c >> 3; h = c & 7; kvh = h >> 2; qrow = ML + b * CTXL; seq = CTXL; }
        att::attn_dense_body(QB + (size_t)qrow * 1024 + h * 128, KB + (size_t)b * SKV * 256 + kvh * 128, VB + (size_t)b * SKV * 256 + kvh * 128,
                             MIX + (size_t)qrow * MIXW + MX_ATT + h * 128, seq, (char*)lds_);
    }
}
__device__ __forceinline__ void dft1_phase(KArgs a, int l) {
    unsigned char* ws = a->ws; extern __shared__ __attribute__((aligned(16))) unsigned char lds_[];
    pg8::Gemm g{(const bf16*)(ws + WS_A1), (const bf16*)(ws + WS_T1T), 256, 65536, 256, 256, 256, 0};
    pg8::StaticOrder S; S.init(256, 65536, gridDim.x, blockIdx.x, 256);
    pg8::EpiS1 E{(bf16*)(ws + WS_S2IN)};
    pg8::gemm_phase<pg8::EpiS1, pg8::StaticOrder, true, true>((LAS unsigned char*)lds_, g, S, E);
}
__device__ __forceinline__ void dft2_phase(KArgs a, int l) {
    unsigned char* ws = a->ws; extern __shared__ __attribute__((aligned(16))) unsigned char lds_[];
    const int G = gridDim.x, bx = blockIdx.x;
    {
        pg8::Gemm g{(const bf16*)(ws + WS_A2), (const bf16*)(ws + WS_S2IN), 4096, 2048, 512, 512, 512, (size_t)2048 * 512 * 2};
        pg8::StaticOrder S; S.init(4096, 2048, G, (bx + G / 2) % G, 512);
        pg8::EpiS2 E{(bf16*)(ws + WS_MIX), 0.0013810679320049757f};
        pg8::gemm_phase<pg8::EpiS2, pg8::StaticOrder, true, true>((LAS unsigned char*)lds_, g, S, E);
    }
    if (l < DEPTH - 1) {
        pg8::Gemm g{(const bf16*)(ws + WS_F256), (const bf16*)(ws + WS_T1TC), CTXL, 2048, 512, 512, 512, 0};
        pg8::StaticOrder S; S.init(CTXL, 2048, G, (bx + G - 96) % G, 512);
        pg8::EpiDft E{(bf16*)(ws + WS_MIX), ML, CTXL, 0.005524271728019903f};
        pg8::gemm_phase<pg8::EpiDft, pg8::StaticOrder, true, true>((LAS unsigned char*)lds_, g, S, E);
    }
}

__global__ void __launch_bounds__(NTHR, 2) hybrid_fwd(Args args_by_value) {
    extern __shared__ __attribute__((aligned(16))) unsigned char lds[];
    (void)args_by_value;
    int lo, hi; unsigned* ctl;
    { KArgs a = kargs(); lo = a->ph_lo; hi = a->ph_hi; ctl = (unsigned*)(a->ws + WS_CTL); }
    volatile LAS unsigned* MISC = (volatile LAS unsigned*)((LAS unsigned char*)lds + MISC_OFF);
    for (int u = threadIdx.x; u < (LDS_BYTES - LDSCTL_OFF) / 4; u += NTHR) ((LAS unsigned*)((LAS unsigned char*)lds + LDSCTL_OFF))[u] = 0u;
    __syncthreads();
    XcdBarrier bar; bar.bar = ctl + CW_BAR; bar.x = 0; bar.st = nullptr;
    if (!MK_PER_PHASE) bar = xcd_barrier_post(ctl + CW_BAR, MISC + 8);
#define IN(k) (lo <= (k) && (k) < hi)
#define SEAM(k) do { if (IN((k) + 1)) { if (MK_PER_PHASE) { if (threadIdx.x == 0) __hip_atomic_store(ctl + CW_TMO, 0xBADBA0u, RLX_AGENT); } else { xcd_barrier(bar); if (DUP(8)) xcd_barrier(bar); } } } while (0)

    for (int rep = 0; rep < (DUP(13) ? 2 : 1); ++rep) {
    if (rep) xcd_barrier(bar);
    if (IN(PH_P0A)) { p0a_prologue(kargs()); if (DUP(0)) p0a_prologue(kargs()); SEAM(PH_P0A); }
    if (IN(PH_P0B)) { p0b_modreduce(kargs()); SEAM(PH_P0B); }

    for (int l = 0; l < DEPTH; ++l) {
        int ph = PH_L0 + l * PH_PER_LAYER;
        const int M2 = (l == DEPTH - 1) ? ML : MT;
#define PHASE(kbit, call) do { if (IN(ph)) { call; if (DUP(kbit)) { if (DUP(15) && !MK_PER_PHASE) xcd_barrier(bar); call; } SEAM(ph); } ++ph; } while (0)
#define MODL ((const float*)(kargs()->ws + WS_MOD) + (size_t)l * 5 * NMOD)
        PHASE(12, norm_phase(kargs(), MT, kargs()->in[I_N1G] + l * DM, MODL, 0 * DM, 1 * DM, l > 0, l == 0, l == 0));
        PHASE(2, gemm_in_phase(kargs(), l));
        if (DUP(11) && IN(ph)) { gemm_in_probe(kargs(), l); xcd_barrier(bar); }
        PHASE(9, postA_phase(kargs(), l));
        PHASE(3, { attn_phase(kargs(), l, 0, 0); dft1_phase(kargs(), l); gate_phase(kargs(), l, 0, (int)gridDim.x, 0, min((int)gridDim.x, (l == DEPTH - 1 ? 128 : 136) * 2)); });
        PHASE(6, { gate_phase(kargs(), l, 0, (int)gridDim.x / 2, (int)gridDim.x, (l == DEPTH - 1 ? 128 : 136) * 2); attn_phase(kargs(), l, 1, 16); dft2_phase(kargs(), l); });
        PHASE(14, gemm_out_phase(kargs(), l, M2));
        PHASE(12, norm_phase(kargs(), M2, kargs()->in[I_N2G] + l * DM, MODL, 3 * DM, 4 * DM, l < DEPTH - 1, false, l == 0));
        PHASE(5, gemm_up_phase(kargs(), l, M2));
        PHASE(10, act_fix_phase(kargs(), l, M2));
        PHASE(14, gemm_down_phase(kargs(), l, M2));
#undef MODL
#undef PHASE
    }
    if (IN(PH_FINAL)) { KArgs a = kargs(); final_norm_phase(a, a->in[I_FNG], a->out); }
    }
#undef IN
#undef SEAM
}

extern "C" void kernel_launch(void* const* d_in, const int* in_sizes, int n_in, void* d_out, int out_size, void* d_ws, size_t ws_size, hipStream_t stream) {
    static int grid = 0;
    if (grid == 0) {
        if (n_in != 22 || out_size != ML * DM || ws_size < WS_END) { fprintf(stderr, "kernel_launch: unexpected shapes: n_in %d out %d ws %zu (need %zu)\n", n_in, out_size, ws_size, (size_t)WS_END); grid = -1; return; }
        int dev = 0, cus = 0, per_cu = 0;
        if (hipGetDevice(&dev) != hipSuccess || hipDeviceGetAttribute(&cus, hipDeviceAttributeMultiprocessorCount, dev) != hipSuccess) { grid = -1; return; }
        if (hipFuncSetAttribute((const void*)hybrid_fwd, hipFuncAttributeMaxDynamicSharedMemorySize, LDS_BYTES) != hipSuccess) { fprintf(stderr, "kernel_launch: hipFuncSetAttribute failed\n"); grid = -1; return; }
        if (hipOccupancyMaxActiveBlocksPerMultiprocessor(&per_cu, (const void*)hybrid_fwd, NTHR, LDS_BYTES) != hipSuccess || per_cu < 1)
            fprintf(stderr, "kernel_launch: occupancy query reports %d workgroups per CU\n", per_cu);
        (void)hipGetLastError();
        grid = cus;
    }
    if (grid < 0) return;
    if (hipMemsetAsync((char*)d_ws + WS_CTL, 0, CTL_ZERO_BYTES, stream) != hipSuccess) return;
    Args a{};
    for (int i = 0; i < 22; ++i) a.in[i] = (const float*)d_in[i];
    a.out = (float*)d_out; a.ws = (unsigned char*)d_ws;
#if MK_PER_PHASE
    for (int ph = 0; ph < N_PHASES; ++ph) { a.ph_lo = ph; a.ph_hi = ph + 1; hipLaunchKernelGGL(hybrid_fwd, dim3(grid), dim3(NTHR), LDS_BYTES, stream, a); }
#else
    a.ph_lo = 0; a.ph_hi = N_PHASES;
    hipLaunchKernelGGL(hybrid_fwd, dim3(grid), dim3(NTHR), LDS_BYTES, stream, a);
#endif
    const hipError_t le = hipPeekAtLastError();
    if (le != hipSuccess) fprintf(stderr, "kernel_launch: launch failed: %s\n", hipGetErrorName(le));
}
```

```cpp
#include <hip/hip_runtime.h>
#include <cstdio>
#include <cstdint>

#ifndef DUPMASK
#define DUPMASK 0
#endif
#define DUP(k) ((DUPMASK >> (k)) & 1)
#ifndef MK_PER_PHASE
#define MK_PER_PHASE 0
#endif

namespace pg8 {
#define PG8_LAS __attribute__((address_space(3)))
typedef unsigned short bf16_t;
typedef short bf16x8 __attribute__((ext_vector_type(8)));
typedef float f32x4 __attribute__((ext_vector_type(4)));
typedef unsigned u32x4 __attribute__((ext_vector_type(4)));
constexpr int BM = 256, BK = 64, HALF = 128, HTB = HALF * BK * 2, STAGE_BYTES = 8 * HTB, NXCD = 8, WGM = 4;

__host__ __device__ __forceinline__ int lds_byte(int r, int c) { const int st = (r >> 4) * 2 + (c >> 5), rr = r & 15, cc = c & 31, ob = rr * 64 + cc * 2; return st * 1024 + (ob ^ (((ob >> 9) & 1) << 5)); }
__host__ __device__ __forceinline__ void stage_rc(int b, int& R, int& C) { const int st = b / 1024, sb = b % 1024, swz = sb ^ (((sb >> 9) & 1) << 5); R = (st >> 1) * 16 + swz / 64; C = (st & 1) * 32 + (swz % 64) / 2; }
__host__ __device__ __forceinline__ int perm32(int rho) { const int n = rho >> 4, i = rho & 15; return 8 * (i >> 2) + 4 * n + (i & 3); }

struct Unit { int pm, pn, kt0, nkt, split; };
struct Gemm { const bf16_t* A; const bf16_t* Bt; int M, N, K, lda, ldb; size_t bpm; int tiledA, tiledB; };

struct StaticOrder {
    int nM, nN, nwg, G, c, ntk;
    __host__ __device__ void init(int M, int N, int G_, int c_, int K) { nM = M / BM; nN = N / BM; nwg = nM * nN; G = G_; c = c_; ntk = K / BK; }
    __host__ __device__ bool next(int i, Unit& u) const {
        const long L = (long)i * G + c; if (L >= nwg) return false;
        return tile((int)L, u);
    }
    __host__ __device__ bool tile(int wgid, Unit& u) const {
        u.kt0 = 0; u.nkt = ntk; u.split = 0; { const int q = nwg / NXCD, r = nwg % NXCD, xcd = wgid % NXCD, off = wgid / NXCD; wgid = (xcd < r ? xcd * (q + 1) : r * (q + 1) + (xcd - r) * q) + off; }
        const int nig = WGM * nN, gid = wgid / nig, fm = gid * WGM, gsz = (nM - fm) < WGM ? (nM - fm) : WGM;
        u.pm = fm + ((wgid % nig) % gsz); u.pn = (wgid % nig) / gsz; return true;
    }
    __device__ __forceinline__ void a_ready(const Unit&) const {}
    __device__ __forceinline__ void done(const Unit&) const {}
};
struct SplitOrder {
    StaticOrder so; int xp, nsplit;
    __host__ __device__ void init(int Mfull, int xpanels, int N, int G_, int c_, int K) { so.init(Mfull, N, G_, c_, K); xp = xpanels; nsplit = xpanels * so.nN * 4; }
    __host__ __device__ bool next(int i, Unit& u) const {
        const int L = i * so.G + so.c; const bool full = L < so.nwg;
        Unit f; so.tile(full ? L : 0, f);
        const int q = L - so.nwg, ks = q & 3, t = q >> 2, qn = so.ntk / 4;
        u.pm = full ? f.pm : so.nM + t / so.nN; u.pn = full ? f.pn : t % so.nN; u.nkt = full ? f.nkt : qn; u.kt0 = full ? 0 : ks * qn; u.split = full ? 0 : 1;
        return full || q < nsplit;
    }
    __device__ __forceinline__ void a_ready(const Unit&) const {}
    __device__ __forceinline__ void done(const Unit&) const {}
};

__device__ __forceinline__ unsigned cvt_pk_bf16(float lo, float hi) { unsigned r; asm volatile("v_cvt_pk_bf16_f32 %0, %1, %2" : "=v"(r) : "v"(lo), "v"(hi)); return r; }

struct EpiNone {
    static constexpr bool PERM = true, AFTER_DRAIN = false;
    __device__ __forceinline__ void operator()(const f32x4 (&acc)[2][2][4][2], const Unit& u, int wr, int wc, int fr, int fq) const {
#pragma unroll
        for (int ai = 0; ai < 2; ++ai)
#pragma unroll
            for (int bj = 0; bj < 2; ++bj)
#pragma unroll
                for (int m = 0; m < 4; ++m)
#pragma unroll
                    for (int n = 0; n < 2; ++n) asm volatile("" :: "v"(acc[ai][bj][m][n]));
    }
};
struct EpiBf16 {
    static constexpr bool PERM = true, AFTER_DRAIN = false;
    bf16_t* O; int ldc;
    __device__ __forceinline__ void operator()(const f32x4 (&acc)[2][2][4][2], const Unit& u, int wr, int wc, int fr, int fq) const {
        const int row0 = u.pm * BM + wr * 64 + fr; const int col0 = u.pn * BM + wc * 32 + 8 * fq;
#pragma unroll
        for (int ai = 0; ai < 2; ++ai)
#pragma unroll
            for (int m = 0; m < 4; ++m) { bf16_t* rowp = O + (size_t)(row0 + ai * HALF + m * 16) * ldc + col0;
#pragma unroll
                for (int bj = 0; bj < 2; ++bj) { const f32x4 v0 = acc[ai][bj][m][0], v1 = acc[ai][bj][m][1];
                    u32x4 w; w.x = cvt_pk_bf16(v0[0], v0[1]); w.y = cvt_pk_bf16(v0[2], v0[3]); w.z = cvt_pk_bf16(v1[0], v1[1]); w.w = cvt_pk_bf16(v1[2], v1[3]);
                    *(u32x4*)(rowp + bj * HALF) = w; } }
    }
};
struct EpiDft {
    static constexpr bool PERM = true, AFTER_DRAIN = false;
    bf16_t* MIX; int rowbase, nper; float scale;
    __device__ __forceinline__ void operator()(const f32x4 (&acc)[2][2][4][2], const Unit& u, int wr, int wc, int fr, int fq) const {
        const int k0 = u.pm * BM + wr * 64 + fr; const int n0 = u.pn * BM + wc * 32 + 8 * fq;
#pragma unroll
        for (int ai = 0; ai < 2; ++ai)
#pragma unroll
            for (int m = 0; m < 4; ++m) { const int k = k0 + ai * HALF + m * 16;
#pragma unroll
                for (int bj = 0; bj < 2; ++bj) { const int n = n0 + bj * HALF; const int b = n >> 9, gd = n & 511;
                    const f32x4 v0 = acc[ai][bj][m][0] * scale, v1 = acc[ai][bj][m][1] * scale;
                    u32x4 w; w.x = cvt_pk_bf16(v0[0], v0[1]); w.y = cvt_pk_bf16(v0[2], v0[3]); w.z = cvt_pk_bf16(v1[0], v1[1]); w.w = cvt_pk_bf16(v1[2], v1[3]);
                    *(u32x4*)(MIX + (size_t)(rowbase + b * nper + k) * 2560 + 1024 + gd) = w; } }
    }
};

struct EpiS1 {
    static constexpr bool PERM = true, AFTER_DRAIN = false;
    bf16_t* S2;
    __device__ __forceinline__ void operator()(const f32x4 (&acc)[2][2][4][2], const Unit& u, int wr, int wc, int fr, int fq) const {
        const int m0 = wr * 64 + fr; const int n0 = u.pn * BM + wc * 32 + 8 * fq;
#pragma unroll
        for (int ai = 0; ai < 2; ++ai)
#pragma unroll
            for (int mm = 0; mm < 4; ++mm) { const int m = m0 + mm * 16; const int k2 = m >> 1, ro = m & 1;
#pragma unroll
                for (int bj = 0; bj < 2; ++bj) { const int np = n0 + bj * HALF; const int n = np >> 5, c = ai * 32 + (np & 31);
                    const f32x4 v0 = acc[ai][bj][mm][0], v1 = acc[ai][bj][mm][1];
                    u32x4 w; w.x = cvt_pk_bf16(v0[0], v0[1]); w.y = cvt_pk_bf16(v0[2], v0[3]); w.z = cvt_pk_bf16(v1[0], v1[1]); w.w = cvt_pk_bf16(v1[2], v1[3]);
                    *(u32x4*)(S2 + ((((size_t)(k2 >> 2) * 2048 + n) * 4 + (k2 & 3)) * 2 + ro) * 64 + c) = w; } }
    }
};
struct EpiS2 {
    static constexpr bool PERM = true, AFTER_DRAIN = false;
    bf16_t* MIX; float scale;
    __device__ __forceinline__ void operator()(const f32x4 (&acc)[2][2][4][2], const Unit& u, int wr, int wc, int fr, int fq) const {
        const int m0 = wr * 64 + fr; const int n0 = u.pn * BM + wc * 32 + 8 * fq;
#pragma unroll
        for (int ai = 0; ai < 2; ++ai)
#pragma unroll
            for (int mm = 0; mm < 4; ++mm) { const int m = ai * HALF + m0 + mm * 16; const int k = 4 * u.pm + (m >> 6) + 64 * (m & 63);
#pragma unroll
                for (int bj = 0; bj < 2; ++bj) { const int n = n0 + bj * HALF; const int b = n >> 9, gd = n & 511;
                    const f32x4 v0 = acc[ai][bj][mm][0] * scale, v1 = acc[ai][bj][mm][1] * scale;
                    u32x4 w; w.x = cvt_pk_bf16(v0[0], v0[1]); w.y = cvt_pk_bf16(v0[2], v0[3]); w.z = cvt_pk_bf16(v1[0], v1[1]); w.w = cvt_pk_bf16(v1[2], v1[3]);
                    *(u32x4*)(MIX + (size_t)(b * 4096 + k) * 2560 + 1024 + gd) = w; } }
    }
};
struct EpiResGate {
    static constexpr bool PERM = true, AFTER_DRAIN = false;
    bf16_t* X; const float* modl; int goff; float* XP; const float* basef;
    __device__ __forceinline__ void operator()(const f32x4 (&acc)[2][2][4][2], const Unit& u, int wr, int wc, int fr, int fq) const {
        const int row0 = u.pm * BM + wr * 64 + fr, col0 = u.pn * BM + wc * 32 + 8 * fq;
        const int v = u.pm < 64 ? (u.pm >> 4) : 4;
        const float* gate = modl + (size_t)v * 12288 + goff;
        f32x4 gv[2][2];
#pragma unroll
        for (int bj = 0; bj < 2; ++bj)
#pragma unroll
            for (int n = 0; n < 2; ++n) gv[bj][n] = *(const f32x4*)(gate + col0 + bj * HALF + n * 4);
#pragma unroll
        for (int ai = 0; ai < 2; ++ai)
#pragma unroll
            for (int m = 0; m < 4; ++m) { const size_t ro = (size_t)(row0 + ai * HALF + m * 16) * 2048 + col0;
#pragma unroll
                for (int bj = 0; bj < 2; ++bj) { const size_t o = ro + bj * HALF; const f32x4 d0 = gv[bj][0] * acc[ai][bj][m][0], d1 = gv[bj][1] * acc[ai][bj][m][1];
                    if (u.split) { float* xp = XP + ((size_t)(u.kt0 / u.nkt) * 1024 + (row0 + ai * HALF + m * 16 - 16384)) * 2048 + col0 + bj * HALF;
                        *(f32x4*)xp = d0; *(f32x4*)(xp + 4) = d1; }
                    else { f32x4 b0, b1;
                        if (basef) { b0 = *(const f32x4*)(basef + o); b1 = *(const f32x4*)(basef + o + 4); }
                        else { const u32x4 w = *(const u32x4*)(X + o);
                            b0 = (f32x4){__uint_as_float(w.x << 16), __uint_as_float(w.x & 0xffff0000u), __uint_as_float(w.y << 16), __uint_as_float(w.y & 0xffff0000u)};
                            b1 = (f32x4){__uint_as_float(w.z << 16), __uint_as_float(w.z & 0xffff0000u), __uint_as_float(w.w << 16), __uint_as_float(w.w & 0xffff0000u)}; }
                        const f32x4 x0 = b0 + d0, x1 = b1 + d1; u32x4 wo; wo.x = cvt_pk_bf16(x0[0], x0[1]); wo.y = cvt_pk_bf16(x0[2], x0[3]); wo.z = cvt_pk_bf16(x1[0], x1[1]); wo.w = cvt_pk_bf16(x1[2], x1[3]);
                        *(u32x4*)(X + o) = wo; } } }
    }
};


__device__ __forceinline__ float dpp_ror1(float x)  { return __builtin_bit_cast(float, __builtin_amdgcn_update_dpp(0, __builtin_bit_cast(int, x), 0x121, 0xF, 0xF, false)); }
__device__ __forceinline__ float dpp_ror15(float x) { return __builtin_bit_cast(float, __builtin_amdgcn_update_dpp(0, __builtin_bit_cast(int, x), 0x12F, 0xF, 0xF, false)); }
__device__ __forceinline__ f32x4 ror1v(const f32x4 v)  { return (f32x4){dpp_ror1(v[0]), dpp_ror1(v[1]), dpp_ror1(v[2]), dpp_ror1(v[3])}; }
__device__ __forceinline__ f32x4 ror15v(const f32x4 v) { return (f32x4){dpp_ror15(v[0]), dpp_ror15(v[1]), dpp_ror15(v[2]), dpp_ror15(v[3])}; }
struct EpiUp {
    static constexpr bool PERM = true, AFTER_DRAIN = false;
    bf16_t* ACT; float* EDGE; const float* cw; const float* cb; PG8_LAS float* xl; int dff;
    __device__ __forceinline__ void operator()(const f32x4 (&acc)[2][2][4][2], const Unit& u, int wr, int wc, int fr, int fq) const {
        const int ch0 = u.pn * 128 + wc * 32 + 8 * fq;
        f32x4 w0[2], w1[2], w2[2], bb[2];
#pragma unroll
        for (int n = 0; n < 2; ++n) { w0[n] = *(const f32x4*)(cw + ch0 + 4 * n); w1[n] = *(const f32x4*)(cw + dff + ch0 + 4 * n); w2[n] = *(const f32x4*)(cw + 2 * dff + ch0 + 4 * n); bb[n] = *(const f32x4*)(cb + ch0 + 4 * n); }
#pragma unroll
        for (int ai = 0; ai < 2; ++ai)
#pragma unroll
            for (int n = 0; n < 2; ++n) {
                if (fr == 0)  *(PG8_LAS f32x4*)(xl + ((((wr * 4 + wc) * 2 + ai) * 2 + 0) * 32) + 8 * fq + 4 * n) = acc[ai][0][0][n];
                if (fr == 15) *(PG8_LAS f32x4*)(xl + ((((wr * 4 + wc) * 2 + ai) * 2 + 1) * 32) + 8 * fq + 4 * n) = acc[ai][0][3][n];
            }
        { float* eg = EDGE + (size_t)u.pm * 6 * dff + ch0;
          if (wr == 0 && fr < 2) {
#pragma unroll
              for (int n = 0; n < 2; ++n) { *(f32x4*)(eg + (size_t)fr * dff + 4 * n) = acc[0][0][0][n]; if (fr == 0) *(f32x4*)(eg + (size_t)4 * dff + 4 * n) = acc[0][1][0][n]; } }
          if (wr == 1 && fr >= 14) {
#pragma unroll
              for (int n = 0; n < 2; ++n) { *(f32x4*)(eg + (size_t)(fr - 12) * dff + 4 * n) = acc[1][0][3][n]; if (fr == 15) *(f32x4*)(eg + (size_t)5 * dff + 4 * n) = acc[1][1][3][n]; } }
        }
        asm volatile("s_waitcnt lgkmcnt(0)" ::: "memory"); __builtin_amdgcn_s_barrier(); asm volatile("" ::: "memory");
        f32x4 pe[2][2], ne[2][2];
#pragma unroll
        for (int ai = 0; ai < 2; ++ai)
#pragma unroll
            for (int n = 0; n < 2; ++n) {
                const bool hp = (wr == 1) || (ai == 1), hn = (wr == 0) || (ai == 0);
                const int pai = (wr == 1) ? ai : ai - 1, nai = (wr == 0) ? ai : ai + 1;
                pe[ai][n] = hp ? *(const PG8_LAS f32x4*)(xl + (((((wr ^ 1) * 4 + wc) * 2 + pai) * 2 + 1) * 32) + 8 * fq + 4 * n) : (f32x4){0.f, 0.f, 0.f, 0.f};
                ne[ai][n] = hn ? *(const PG8_LAS f32x4*)(xl + (((((wr ^ 1) * 4 + wc) * 2 + nai) * 2 + 0) * 32) + 8 * fq + 4 * n) : (f32x4){0.f, 0.f, 0.f, 0.f};
            }
        const int row0 = u.pm * BM + wr * 64 + fr;
#pragma unroll
        for (int ai = 0; ai < 2; ++ai)
#pragma unroll
            for (int m = 0; m < 4; ++m) {
                float z[8], t[8];
#pragma unroll
                for (int n = 0; n < 2; ++n) {
                    const f32x4 g = acc[ai][0][m][n];
                    const f32x4 gp = (m > 0) ? acc[ai][0][m > 0 ? m - 1 : 0][n] : pe[ai][n];
                    const f32x4 gn = (m < 3) ? acc[ai][0][m < 3 ? m + 1 : 3][n] : ne[ai][n];
                    const f32x4 zz = w1[n] * g + bb[n];
#pragma unroll
                    for (int j = 0; j < 4; ++j) { float zj = zz[j];
                        if ((m == 0 || m == 3) && n == 0 && j == 0)
                            asm("s_nop 1\n\t"
                                "v_fmac_f32_dpp %0, %1, %4 row_shr:1 row_mask:0xf bank_mask:0xf\n\t"
                                "v_fmac_f32_dpp %0, %2, %4 row_shl:15 row_mask:0xf bank_mask:0xf\n\t"
                                "v_fmac_f32_dpp %0, %1, %5 row_shl:1 row_mask:0xf bank_mask:0xf\n\t"
                                "v_fmac_f32_dpp %0, %3, %5 row_shr:15 row_mask:0xf bank_mask:0xf"
                                : "+v"(zj) : "v"(g[j]), "v"(gp[j]), "v"(gn[j]), "v"(w0[n][j]), "v"(w2[n][j]));
                        else
                            asm("v_fmac_f32_dpp %0, %1, %4 row_shr:1 row_mask:0xf bank_mask:0xf\n\t"
                                "v_fmac_f32_dpp %0, %2, %4 row_shl:15 row_mask:0xf bank_mask:0xf\n\t"
                                "v_fmac_f32_dpp %0, %1, %5 row_shl:1 row_mask:0xf bank_mask:0xf\n\t"
                                "v_fmac_f32_dpp %0, %3, %5 row_shr:15 row_mask:0xf bank_mask:0xf"
                                : "+v"(zj) : "v"(g[j]), "v"(gp[j]), "v"(gn[j]), "v"(w0[n][j]), "v"(w2[n][j]));
                        z[n * 4 + j] = zj; }
                }
#pragma unroll
                for (int i = 0; i < 8; ++i) t[i] = -1.4426950408889634f * z[i];
#pragma unroll
                for (int i = 0; i < 8; ++i) t[i] = __builtin_amdgcn_exp2f(t[i]);
#pragma unroll
                for (int i = 0; i < 8; ++i) t[i] = 1.f + t[i];
#pragma unroll
                for (int i = 0; i < 8; ++i) t[i] = __builtin_amdgcn_rcpf(t[i]);
#pragma unroll
                for (int i = 0; i < 8; ++i) t[i] = z[i] * t[i] * acc[ai][1][m][i >> 2][i & 3];
                u32x4 w; w.x = cvt_pk_bf16(t[0], t[1]); w.y = cvt_pk_bf16(t[2], t[3]); w.z = cvt_pk_bf16(t[4], t[5]); w.w = cvt_pk_bf16(t[6], t[7]);
                *(u32x4*)(ACT + (size_t)(row0 + ai * HALF + m * 16) * dff + ch0) = w;
            }
    }
};

template <class Epi, class Sched, bool ALIGN_EPI = false, bool SP2 = false>
__device__ __forceinline__ void gemm_phase(PG8_LAS unsigned char* lds, const Gemm g, const Sched& S, const Epi& E) {
    int tid_ = threadIdx.x; asm volatile("" : "+v"(tid_));
    const int tid = tid_, wid = __builtin_amdgcn_readfirstlane(tid >> 6), lane = tid & 63, wr = wid >> 2, wc = wid & 3, fr = lane & 15, fq = lane >> 4;
    unsigned voffA[2], voffB[2];
#pragma unroll
    for (int i = 0; i < 2; ++i) { int R, C; stage_rc(tid * 16 + i * 8192, R, C); const int Rb = Epi::PERM ? ((R & ~31) + perm32(R & 31)) : R;
        voffA[i] = (unsigned)(R * (g.tiledA ? BK : g.lda) + C) * 2u; voffB[i] = (unsigned)(Rb * (g.tiledB ? BK : g.ldb) + C) * 2u; }
    const size_t kstepA = g.tiledA ? (size_t)BM * BK * 2 : (size_t)(BK * 2), kstepB = g.tiledB ? (size_t)BM * BK * 2 : (size_t)(BK * 2);
    const size_t hstepA = (size_t)HALF * (g.tiledA ? BK : g.lda) * 2, hstepB = (size_t)HALF * (g.tiledB ? BK : g.ldb) * 2;
    const size_t tstepA = g.tiledA ? (size_t)(g.K / BK) * BM * BK * 2 : 2 * hstepA, tstepB = g.tiledB ? (size_t)(g.K / BK) * BM * BK * 2 : 2 * hstepB;
    const unsigned ldsw = (unsigned)wid * 1024u;
    const int aoff = lds_byte(wr * 64 + fr, fq * 8), boff = lds_byte(wc * 32 + fr, fq * 8);
#define PG8_SA(b, h) (((b) * 2 + (h)) * HTB)
#define PG8_SB(b, h) ((4 + (b) * 2 + (h)) * HTB)
#define PG8_STAGE(bufoff, gbase, voff) do { _Pragma("unroll") for (int _i = 0; _i < 2; ++_i) \
        __builtin_amdgcn_global_load_lds((const unsigned*)((const char*)(gbase) + (voff)[_i]), (PG8_LAS unsigned*)(lds + (bufoff) + ldsw + _i * 8192), 16, 0, 0); } while (0)
#define PG8_LDA(dst, b, h) do { _Pragma("unroll") for (int m = 0; m < 4; ++m) _Pragma("unroll") for (int k = 0; k < 2; ++k) dst[m][k] = *(const PG8_LAS bf16x8*)(lds + PG8_SA(b, h) + aoff + m * 2048 + k * 1024); } while (0)
#define PG8_LDB(dst, b, h) do { _Pragma("unroll") for (int n = 0; n < 2; ++n) _Pragma("unroll") for (int k = 0; k < 2; ++k) dst[n][k] = *(const PG8_LAS bf16x8*)(lds + PG8_SB(b, h) + boff + n * 2048 + k * 1024); } while (0)
#define PG8_MMA(ai, bj, At, Bt) do { __builtin_amdgcn_s_setprio(1); _Pragma("unroll") for (int m = 0; m < 4; ++m) _Pragma("unroll") for (int n = 0; n < 2; ++n) _Pragma("unroll") for (int k = 0; k < 2; ++k) \
        acc[ai][bj][m][n] = __builtin_amdgcn_mfma_f32_16x16x32_bf16(Bt[n][k], At[m][k], acc[ai][bj][m][n], 0, 0, 0); __builtin_amdgcn_s_setprio(0); } while (0)
#define PG8_WAIT_V(n) asm volatile("s_waitcnt vmcnt(" #n ")" ::: "memory")
#define PG8_WAIT_L(n) asm volatile("s_waitcnt lgkmcnt(" #n ")" ::: "memory")
#define PG8_BAR __builtin_amdgcn_s_barrier()
#define PG8_SCHED __builtin_amdgcn_sched_barrier(0)
    Unit cur, nxt; int ui = 0;
    if (!S.next(0, cur)) return;
    f32x4 acc[2][2][4][2];
#pragma unroll
    for (int a = 0; a < 2; ++a)
#pragma unroll
        for (int b = 0; b < 2; ++b)
#pragma unroll
            for (int m = 0; m < 4; ++m)
#pragma unroll
                for (int n = 0; n < 2; ++n) acc[a][b][m][n] = (f32x4){0.f, 0.f, 0.f, 0.f};
    bf16x8 At[4][2], B0[2][2], B1[2][2];
    const char* cA = (const char*)g.A + (size_t)cur.pm * tstepA + (size_t)cur.kt0 * kstepA; const char* cB = (const char*)g.Bt + (size_t)cur.pm * g.bpm + (size_t)cur.pn * tstepB + (size_t)cur.kt0 * kstepB;
    int nt = cur.nkt;
    S.a_ready(cur);
    if constexpr (SP2) {
        PG8_STAGE(PG8_SB(0, 0), cB, voffB); PG8_STAGE(PG8_SB(0, 1), cB + hstepB, voffB); PG8_STAGE(PG8_SA(0, 0), cA, voffA); PG8_STAGE(PG8_SA(0, 1), cA + hstepA, voffA);
        if (wr == 1) PG8_BAR;
        PG8_WAIT_V(2); PG8_BAR;
        PG8_STAGE(PG8_SB(1, 0), cB + kstepB, voffB); PG8_STAGE(PG8_SA(1, 0), cA + kstepA, voffA); PG8_STAGE(PG8_SB(1, 1), cB + hstepB + kstepB, voffB);
        PG8_WAIT_V(6); PG8_BAR;
    } else {
        PG8_STAGE(PG8_SB(0, 0), cB, voffB); PG8_STAGE(PG8_SA(0, 0), cA, voffA); PG8_STAGE(PG8_SB(0, 1), cB + hstepB, voffB); PG8_STAGE(PG8_SA(0, 1), cA + hstepA, voffA);
        if (wr == 1) PG8_BAR;
        PG8_WAIT_V(4); PG8_BAR;
        PG8_STAGE(PG8_SB(1, 0), cB + kstepB, voffB); PG8_STAGE(PG8_SA(1, 0), cA + kstepA, voffA); PG8_STAGE(PG8_SB(1, 1), cB + hstepB + kstepB, voffB);
        PG8_WAIT_V(6); PG8_BAR;
    }
    for (;;) {
        const bool has_next = S.next(ui + 1, nxt);
        const char* nA = has_next ? (const char*)g.A + (size_t)nxt.pm * tstepA + (size_t)nxt.kt0 * kstepA : cA; const char* nB = has_next ? (const char*)g.Bt + (size_t)nxt.pm * g.bpm + (size_t)nxt.pn * tstepB + (size_t)nxt.kt0 * kstepB : cB;
        for (int t = 0; t < nt; t += 2) {
            const bool last = (t == nt - 2);
            const char* a1 = cA + (size_t)(t + 1) * kstepA;
            const char* a2 = last ? nA : cA + (size_t)(t + 2) * kstepA; const char* b2 = last ? nB : cB + (size_t)(t + 2) * kstepB;
            const char* a3 = a2 + kstepA; const char* b3 = b2 + kstepB;
            if (last && has_next) S.a_ready(nxt);
            if constexpr (SP2) {
            PG8_LDB(B0, 0, 0); PG8_LDB(B1, 0, 1); PG8_SCHED; PG8_LDA(At, 0, 0); PG8_STAGE(PG8_SA(1, 1), a1 + hstepA, voffA);
            PG8_WAIT_V(8); PG8_WAIT_L(0); PG8_BAR; PG8_MMA(0, 0, At, B0); PG8_MMA(0, 1, At, B1); PG8_BAR; PG8_SCHED;
            PG8_LDA(At, 0, 1); PG8_STAGE(PG8_SB(0, 0), b2, voffB); PG8_STAGE(PG8_SB(0, 1), b2 + hstepB, voffB); PG8_STAGE(PG8_SA(0, 0), a2, voffA);
            PG8_WAIT_V(8); PG8_WAIT_L(0); PG8_BAR; PG8_MMA(1, 0, At, B0); PG8_MMA(1, 1, At, B1); PG8_BAR; PG8_SCHED;
            PG8_LDB(B0, 1, 0); PG8_LDB(B1, 1, 1); PG8_SCHED; PG8_LDA(At, 1, 0); PG8_STAGE(PG8_SA(0, 1), a2 + hstepA, voffA);
            PG8_WAIT_V(8); PG8_WAIT_L(0); PG8_BAR; PG8_MMA(0, 0, At, B0); PG8_MMA(0, 1, At, B1); PG8_BAR; PG8_SCHED;
            PG8_LDA(At, 1, 1); PG8_STAGE(PG8_SB(1, 0), b3, voffB); PG8_STAGE(PG8_SB(1, 1), b3 + hstepB, voffB); PG8_STAGE(PG8_SA(1, 0), a3, voffA);
            PG8_WAIT_V(8); PG8_WAIT_L(0); PG8_BAR; PG8_MMA(1, 0, At, B0); PG8_MMA(1, 1, At, B1); PG8_BAR; PG8_SCHED;
            } else {
            PG8_LDB(B0, 0, 0); PG8_SCHED; PG8_LDA(At, 0, 0); PG8_STAGE(PG8_SA(1, 1), a1 + hstepA, voffA);
            PG8_WAIT_L(8); PG8_BAR; PG8_WAIT_L(0); PG8_MMA(0, 0, At, B0); PG8_BAR; PG8_SCHED;
            PG8_LDB(B1, 0, 1); PG8_STAGE(PG8_SB(0, 0), b2, voffB);
            PG8_BAR; PG8_WAIT_L(0); PG8_MMA(0, 1, At, B1); PG8_BAR;
            PG8_LDA(At, 0, 1); PG8_STAGE(PG8_SA(0, 0), a2, voffA);
            PG8_BAR; PG8_WAIT_L(0); PG8_MMA(1, 0, At, B0); PG8_BAR; PG8_SCHED;
            PG8_STAGE(PG8_SB(0, 1), b2 + hstepB, voffB);
            PG8_WAIT_V(6); PG8_BAR; PG8_MMA(1, 1, At, B1); PG8_BAR;
            PG8_LDB(B0, 1, 0); PG8_SCHED; PG8_LDA(At, 1, 0); PG8_STAGE(PG8_SA(0, 1), a2 + hstepA, voffA);
            PG8_WAIT_L(8); PG8_BAR; PG8_WAIT_L(0); PG8_MMA(0, 0, At, B0); PG8_BAR; PG8_SCHED;
            PG8_LDB(B1, 1, 1); PG8_STAGE(PG8_SB(1, 0), b3, voffB);
            PG8_BAR; PG8_WAIT_L(0); PG8_MMA(0, 1, At, B1); PG8_BAR;
            PG8_LDA(At, 1, 1); PG8_STAGE(PG8_SA(1, 0), a3, voffA);
            PG8_BAR; PG8_WAIT_L(0); PG8_MMA(1, 0, At, B0); PG8_BAR; PG8_SCHED;
            PG8_STAGE(PG8_SB(1, 1), b3 + hstepB, voffB);
            PG8_WAIT_V(6); PG8_BAR; PG8_MMA(1, 1, At, B1); PG8_BAR;
            }
        }
        if constexpr (ALIGN_EPI) { if (wr == 0) PG8_BAR; }
        if constexpr (!Epi::AFTER_DRAIN) { E(acc, cur, wr, wc, fr, fq); S.done(cur); }
        if (!has_next) break;
#pragma unroll
        for (int a = 0; a < 2; ++a)
#pragma unroll
            for (int b = 0; b < 2; ++b)
#pragma unroll
                for (int m = 0; m < 4; ++m)
#pragma unroll
                    for (int n = 0; n < 2; ++n) acc[a][b][m][n] = (f32x4){0.f, 0.f, 0.f, 0.f};
        cur = nxt; cA = nA; cB = nB; nt = cur.nkt; ++ui;
        if constexpr (ALIGN_EPI) { if (wr == 1) PG8_BAR; }
    }
    PG8_WAIT_V(0);
    if constexpr (!ALIGN_EPI) { if (wr == 0) PG8_BAR; }
    PG8_BAR;
#undef PG8_SA
#undef PG8_SB
#undef PG8_STAGE
#undef PG8_LDA
#undef PG8_LDB
#undef PG8_MMA
#undef PG8_WAIT_V
#undef PG8_WAIT_L
#undef PG8_BAR
#undef PG8_SCHED
}
}

namespace att {
typedef unsigned short bf16;
constexpr int   D = 128, NW = 8, QBLK = 32, KVBLK = 64;
constexpr float SCALE = 0.088388347648318440f;
constexpr float THR = 8.f;
constexpr int LDQ = 1024, LDK = 256, LDO = 2560;
constexpr size_t SHM_V = KVBLK * D * 2, SHM_K = KVBLK * D * 2, SHM_ATTN = 2 * SHM_V + 2 * SHM_K + NW * 64 * 4;
using bf16x8 = __attribute__((ext_vector_type(8))) short;
using s16x4  = __attribute__((ext_vector_type(4))) short;
using f32x16 = __attribute__((ext_vector_type(16))) float;
using u32x4  = __attribute__((ext_vector_type(4))) unsigned;
#define KSWZ(row, colB) ((row) * 256 + ((colB) ^ (((row) & 7) << 4)))
#define SBAR() __builtin_amdgcn_sched_barrier(0)
__device__ __forceinline__ int crow(int r, int hi) { return (r & 3) + 8 * (r >> 2) + 4 * hi; }
__device__ __forceinline__ unsigned cvtpk(float lo, float hi) { unsigned r; asm volatile("v_cvt_pk_bf16_f32 %0, %1, %2" : "=v"(r) : "v"(lo), "v"(hi)); return r; }
__device__ __forceinline__ bf16x8 ld8(const bf16* p) { return *reinterpret_cast<const bf16x8*>(p); }

__device__ __forceinline__ void partialSM(f32x16& p0, f32x16& p1, float& m_reg, float& mn, float& alpha) {
  constexpr float C = SCALE * 1.4426950408889634f;
  float pmax = p0[0]; for (int r = 1; r < 16; ++r) pmax = fmaxf(pmax, p0[r]); for (int r = 0; r < 16; ++r) pmax = fmaxf(pmax, p1[r]);
  { auto rr = __builtin_amdgcn_permlane32_swap(__float_as_uint(pmax), __float_as_uint(pmax), false, false);
    pmax = fmaxf(__uint_as_float(rr[0]), __uint_as_float(rr[1])); }
  if (__builtin_expect(__all(pmax - m_reg <= THR / SCALE), 1)) { mn = m_reg; alpha = 1.f; }
  else { mn = fmaxf(m_reg, pmax); alpha = __builtin_amdgcn_exp2f((m_reg - mn) * C); m_reg = mn; }
  float mnC = -mn * C;
  for (int r = 0; r < 16; ++r) p0[r] = fmaf(p0[r], C, mnC); for (int r = 0; r < 16; ++r) p1[r] = fmaf(p1[r], C, mnC);
  for (int r = 0; r < 16; ++r) p0[r] = __builtin_amdgcn_exp2f(p0[r]);
}
__device__ __forceinline__ void finishSM(f32x16& p0, f32x16& p1, float alpha, float& l_reg, bf16x8& pa0, bf16x8& pa1, bf16x8& pa2, bf16x8& pa3) {
  for (int r = 0; r < 16; ++r) p1[r] = __builtin_amdgcn_exp2f(p1[r]);
  float ps = 0; for (int r = 0; r < 16; ++r) ps += p0[r]; for (int r = 0; r < 16; ++r) ps += p1[r];
  { auto rr = __builtin_amdgcn_permlane32_swap(__float_as_uint(ps), __float_as_uint(ps), false, false);
    ps = __uint_as_float(rr[0]) + __uint_as_float(rr[1]); }
  l_reg = l_reg * alpha + ps;
#define PK4(P, BASE, OUT) do { unsigned a0 = cvtpk(P[BASE + 0], P[BASE + 1]), a1 = cvtpk(P[BASE + 2], P[BASE + 3]);   \
    unsigned b0 = cvtpk(P[BASE + 4], P[BASE + 5]), b1 = cvtpk(P[BASE + 6], P[BASE + 7]);                              \
    auto r0 = __builtin_amdgcn_permlane32_swap(a0, b0, false, false); auto r1 = __builtin_amdgcn_permlane32_swap(a1, b1, false, false); \
    u32x4 w = {r0[0], r1[0], r0[1], r1[1]}; OUT = *reinterpret_cast<bf16x8*>(&w); } while (0)
  PK4(p0, 0, pa0); PK4(p0, 8, pa1); PK4(p1, 0, pa2); PK4(p1, 8, pa3);
#undef PK4
}
__device__ __forceinline__ void qkt(f32x16& p0, f32x16& p1, const bf16* Ks, const bf16x8* qr, int r32, int hi) {
  p0 = f32x16{}; p1 = f32x16{};
  for (int d0 = 0; d0 < 8; ++d0) { int cb = (d0 * 16 + hi * 8) * 2;
    bf16x8 b0 = *reinterpret_cast<const bf16x8*>((const char*)Ks + KSWZ(r32, cb));
    bf16x8 b1 = *reinterpret_cast<const bf16x8*>((const char*)Ks + KSWZ(32 + r32, cb));
    p0 = __builtin_amdgcn_mfma_f32_32x32x16_bf16(b0, qr[d0], p0, 0, 0, 0);
    p1 = __builtin_amdgcn_mfma_f32_32x32x16_bf16(b1, qr[d0], p1, 0, 0, 0); }
}
__device__ __forceinline__ int v_st(int k, int c) { const int kk = (k & ~0xC) | ((k & 4) << 1) | ((k & 8) >> 1); return ((kk >> 3) * 4 + (c >> 5)) * 512 + ((kk & 7) * 32 + (c & 31)) * 2; }
__device__ __forceinline__ int v_rd_base(int lane) { return ((lane & 3) << 3) | (((lane >> 2) & 3) << 6) | (((lane >> 4) & 1) << 5) | (((lane >> 5) & 1) << 8); }
constexpr int v_rd_off(int d0, int ks, int half) { return d0 * 512 + ks * 4096 + half * 2048; }
template <int OFF> __device__ __forceinline__ s16x4 tr_read(int vb) {
  s16x4 r; asm volatile("ds_read_b64_tr_b16 %0, %1 offset:%2" : "=&v"(r) : "v"(vb), "i"(OFF) : "memory"); return r;
}
template <int D0> __device__ __forceinline__ void pv_one(f32x16& od, int vb, bf16x8 pa0, bf16x8 pa1, bf16x8 pa2, bf16x8 pa3) {
  const s16x4 l0 = tr_read<v_rd_off(D0, 0, 0)>(vb), h0 = tr_read<v_rd_off(D0, 0, 1)>(vb), l1 = tr_read<v_rd_off(D0, 1, 0)>(vb), h1 = tr_read<v_rd_off(D0, 1, 1)>(vb);
  const s16x4 l2 = tr_read<v_rd_off(D0, 2, 0)>(vb), h2 = tr_read<v_rd_off(D0, 2, 1)>(vb), l3 = tr_read<v_rd_off(D0, 3, 0)>(vb), h3 = tr_read<v_rd_off(D0, 3, 1)>(vb);
  asm volatile("s_waitcnt lgkmcnt(0)" ::: "memory"); SBAR();
#define PK(L, H) (bf16x8){L[0], L[1], L[2], L[3], H[0], H[1], H[2], H[3]}
  od = __builtin_amdgcn_mfma_f32_32x32x16_bf16(pa0, PK(l0, h0), od, 0, 0, 0);
  od = __builtin_amdgcn_mfma_f32_32x32x16_bf16(pa1, PK(l1, h1), od, 0, 0, 0);
  od = __builtin_amdgcn_mfma_f32_32x32x16_bf16(pa2, PK(l2, h2), od, 0, 0, 0);
  od = __builtin_amdgcn_mfma_f32_32x32x16_bf16(pa3, PK(l3, h3), od, 0, 0, 0);
#undef PK
}
__device__ __forceinline__ void pv_d0(f32x16* o, int vb, bf16x8 pa0, bf16x8 pa1, bf16x8 pa2, bf16x8 pa3) {
  pv_one<0>(o[0], vb, pa0, pa1, pa2, pa3); pv_one<1>(o[1], vb, pa0, pa1, pa2, pa3); pv_one<2>(o[2], vb, pa0, pa1, pa2, pa3); pv_one<3>(o[3], vb, pa0, pa1, pa2, pa3);
}

__device__ __forceinline__ void attn_dense_body(const bf16* __restrict__ Qb, const bf16* __restrict__ Kh, const bf16* __restrict__ Vh,
                                                bf16* __restrict__ Ob, int seq, char* lds) {
  constexpr int SDEPTH = 2;
  int tid_ = threadIdx.x; asm volatile("" : "+v"(tid_));
  const int tid = tid_, wid = tid >> 6, lane = tid & 63, r32 = lane & 31, hi = lane >> 5;
  bf16* V_lds = (bf16*)lds; bf16* K_lds = (bf16*)(lds + 2 * SHM_V);
  float* ws = (float*)(lds + 2 * SHM_V + 2 * SHM_K) + wid * 64; float* li_l = ws; float* al_l = ws + 32;
  float m_reg = -1e30f, l_reg = 0; f32x16 o[4] = {}; bf16x8 qr[8];
  const bf16* Qw = Qb + (long)(wid * QBLK + r32) * LDQ + hi * 8;
#pragma unroll
  for (int d0 = 0; d0 < 8; ++d0) qr[d0] = ld8(Qw + d0 * 16);
  const int sr = tid >> 4, sc = (tid & 15) * 8, vst0 = v_st(sr, sc), vst1 = v_st(32 + sr, sc);
  const int vb0 = (int)(uintptr_t)V_lds + v_rd_base(lane);
  struct { bf16x8 vs0, vs1, ks0, ks1; } sr_[SDEPTH];
#define SLOAD(i, k0) do { sr_[i].vs0 = ld8(&Vh[(long)((k0) + sr) * LDK + sc]); sr_[i].vs1 = ld8(&Vh[(long)((k0) + 32 + sr) * LDK + sc]); \
    sr_[i].ks0 = ld8(&Kh[(long)((k0) + sr) * LDK + sc]); sr_[i].ks1 = ld8(&Kh[(long)((k0) + 32 + sr) * LDK + sc]); } while (0)
#define SWRITE(b, i) do { *(bf16x8*)((char*)V_lds + (b) * SHM_V + vst0) = sr_[i].vs0;          \
    *(bf16x8*)((char*)V_lds + (b) * SHM_V + vst1) = sr_[i].vs1; int kc = sc * 2;               \
    *(bf16x8*)((char*)K_lds + (b) * SHM_K + KSWZ(sr, kc)) = sr_[i].ks0;                       \
    *(bf16x8*)((char*)K_lds + (b) * SHM_K + KSWZ(32 + sr, kc)) = sr_[i].ks1; } while (0)
#define SWAIT() do { asm volatile("s_waitcnt vmcnt(4)" ::: "memory"); } while (0)
#define RESC(a) do { if (__any((a) < 1.f)) { if (hi == 0) al_l[r32] = (a); asm volatile("s_waitcnt lgkmcnt(0)" ::: "memory"); \
    for (int d = 0; d < 4; ++d) for (int r = 0; r < 16; ++r) o[d][r] *= al_l[crow(r, hi)]; } } while (0)
  f32x16 pA0, pA1, pB0, pB1; float mnA, mnB, alA, alB; bf16x8 pa0, pa1, pa2, pa3; const int NT = seq / KVBLK;
  constexpr int SE = 0, SO = SDEPTH - 1;
  SLOAD(SE, 0); asm volatile("s_waitcnt vmcnt(0)" ::: "memory"); SWRITE(0, SE); __syncthreads();
  qkt(pA0, pA1, K_lds, qr, r32, hi); partialSM(pA0, pA1, m_reg, mnA, alA);
  SLOAD(SO, KVBLK); if (2 < NT) SLOAD(SE, 2 * KVBLK);
  SWAIT(); SWRITE(1, SO); __syncthreads();
  for (int j = 1; j + 1 < NT; j += 2) {
    SBAR(); qkt(pB0, pB1, (bf16*)((char*)K_lds + SHM_K), qr, r32, hi);
    finishSM(pA0, pA1, alA, l_reg, pa0, pa1, pa2, pa3); SBAR();
    SLOAD(SO, (j + SDEPTH) * KVBLK); SBAR();
    pv_d0(o, vb0, pa0, pa1, pa2, pa3); partialSM(pB0, pB1, m_reg, mnB, alB);
    __syncthreads(); SWAIT(); SWRITE(0, SE);
    RESC(alB); __syncthreads();
    SBAR(); qkt(pA0, pA1, K_lds, qr, r32, hi);
    finishSM(pB0, pB1, alB, l_reg, pa0, pa1, pa2, pa3); SBAR();
    if (j + 3 < NT) SLOAD(SE, (j + 1 + SDEPTH) * KVBLK); SBAR();
    pv_d0(o, vb0 + (int)SHM_V, pa0, pa1, pa2, pa3); partialSM(pA0, pA1, m_reg, mnA, alA);
    __syncthreads(); SWAIT(); SWRITE(1, SO);
    RESC(alA); __syncthreads();
  }
  SBAR(); qkt(pB0, pB1, (bf16*)((char*)K_lds + SHM_K), qr, r32, hi);
  finishSM(pA0, pA1, alA, l_reg, pa0, pa1, pa2, pa3); SBAR();
  pv_d0(o, vb0, pa0, pa1, pa2, pa3); partialSM(pB0, pB1, m_reg, mnB, alB);
  __syncthreads(); RESC(alB);
  finishSM(pB0, pB1, alB, l_reg, pa0, pa1, pa2, pa3); SBAR();
  pv_d0(o, vb0 + (int)SHM_V, pa0, pa1, pa2, pa3);
  if (hi == 0) li_l[r32] = l_reg; asm volatile("s_waitcnt lgkmcnt(0)" ::: "memory");
  float rli[16];
#pragma unroll
  for (int r = 0; r < 16; ++r) rli[r] = __builtin_amdgcn_rcpf(li_l[crow(r, hi)]);
  bf16* Ow = Ob + (long)(wid * QBLK) * LDO;
  __syncthreads();
  char* ob = lds + wid * (32 * 272);
#pragma unroll
  for (int r = 0; r < 16; ++r) { const int orow = crow(r, hi);
#pragma unroll
    for (int d0 = 0; d0 < 4; ++d0) { const float val = o[d0][r] * rli[r]; *(bf16*)(ob + orow * 272 + (d0 * 32 + r32) * 2) = (bf16)(cvtpk(val, val) & 0xffffu); } }
#pragma unroll
  for (int i = 0; i < 8; ++i) { const int row = i * 4 + (lane >> 4), ch = lane & 15;
    const u32x4 v = *(const u32x4*)(ob + row * 272 + ch * 16);
    *(u32x4*)(Ow + (long)row * LDO + ch * 8) = v; }
  __syncthreads();
#undef SLOAD
#undef SWRITE
#undef SWAIT
#undef RESC
}
#undef KSWZ
#undef SBAR
}

constexpr int NWAVES = 8, NTHR = 512;
constexpr int DM = 2048, NB = 4, SEQ = 4096, DEPTH = 4, CTXL = 256;
constexpr int ML = NB * SEQ, MC = NB * CTXL, MT = ML + MC;
constexpr int SKV = CTXL + SEQ;
constexpr int INW_SRC = 4608, PW = 5120;
constexpr int PQ = 0, PK = 1024, PV = 1280, PFA = 1536, PFB = 2048, PCB = 2560, PCC = 3072, PCH = 3584, PGU = 4096, PGV = 4608;
constexpr int MIXW = 2560, MX_ATT = 0, MX_FOUR = 1024, MX_CONV = 1536, MX_GM = 2048;
constexpr int DFF = 5632, UPW = 2 * DFF;
constexpr int NMOD = 6 * DM;
constexpr float EPS = 1e-6f;

constexpr size_t al256(size_t x) { return (x + 255) / 256 * 256; }
constexpr size_t WS_CTL = 0, CTL_ZERO_BYTES = 1u << 20;
constexpr size_t WS_WIN  = CTL_ZERO_BYTES;
constexpr size_t WS_WOUT = WS_WIN  + (size_t)DEPTH * PW * DM * 2;
constexpr size_t WS_WUP  = WS_WOUT + (size_t)DEPTH * DM * MIXW * 2;
constexpr size_t WS_WDN  = WS_WUP  + (size_t)DEPTH * UPW * DM * 2;
constexpr size_t WS_FN   = WS_WDN  + (size_t)DEPTH * DM * DFF * 2;
constexpr size_t WS_A1   = WS_FN;
constexpr size_t WS_A2   = WS_A1   + (size_t)256 * 256 * 2;
constexpr size_t WS_F256 = WS_A2   + (size_t)16 * 256 * 512 * 2;
constexpr size_t WS_MODP = WS_F256 + (size_t)256 * 512 * 2;
constexpr size_t WS_MOD  = WS_MODP + (size_t)16 * DEPTH * 5 * NMOD * 4;
constexpr size_t WS_ROPE = WS_MOD  + (size_t)DEPTH * 5 * NMOD * 4;
constexpr size_t WS_X    = WS_ROPE + 64 * 32 * 8;
constexpr size_t WS_H    = WS_X    + (size_t)MT * DM * 2;
constexpr size_t WS_R    = WS_H    + (size_t)MT * DM * 2;
constexpr size_t WS_P    = WS_R;
constexpr size_t WS_MIX  = WS_P    + (size_t)MT * PW * 2;
constexpr size_t WS_T1T  = WS_MIX  + (size_t)MT * MIXW * 2;
constexpr size_t WS_T1TC = WS_T1T  + (size_t)2048 * 8192 * 2;
constexpr size_t WS_KB   = WS_T1TC + (size_t)2048 * 512 * 2;
constexpr size_t WS_VB   = WS_KB   + (size_t)NB * SKV * 256 * 2;
constexpr size_t WS_QB   = WS_VB   + (size_t)NB * SKV * 256 * 2;
constexpr size_t WS_UB   = WS_QB   + (size_t)MT * 1024 * 2;
constexpr size_t WS_V2B  = WS_UB   + (size_t)MT * 512 * 2;
constexpr size_t WS_S2IN = WS_V2B  + (size_t)MT * 512 * 2;
constexpr size_t WS_RA_END = WS_S2IN + (size_t)16 * 2048 * 512 * 2;
constexpr size_t WS_ACT  = WS_R;
constexpr size_t WS_ACT_END = WS_ACT + (size_t)MT * DFF * 2;
constexpr size_t WS_R_END = WS_RA_END > WS_ACT_END ? WS_RA_END : WS_ACT_END;
constexpr size_t WS_EDGE = WS_R_END;
constexpr size_t WS_XP   = WS_EDGE + (size_t)(MT / 256) * 6 * DFF * 4;
constexpr size_t WS_END  = WS_XP   + (size_t)4 * MC * DM * 4;
static_assert(WS_END <= 1600000000ull, "d_ws budget");
static_assert(WS_WIN % 256 == 0 && WS_FN % 256 == 0 && WS_X % 256 == 0 && WS_H % 256 == 0 && WS_P % 256 == 0 && WS_MIX % 256 == 0 && WS_T1T % 256 == 0 && WS_KB % 256 == 0 && WS_ACT % 256 == 0 && WS_MOD % 256 == 0, "alignment");
constexpr int CW_TMO = 0, CW_BAR = 4096;

constexpr int RING_BYTES = 131072;
constexpr int LDSCTL_OFF = RING_BYTES, MISC_OFF = LDSCTL_OFF + 320;
constexpr int XL_OFF = RING_BYTES + 1024;
constexpr int LDS_BYTES = 147456;

#define GAS __attribute__((address_space(1)))
#define LAS __attribute__((address_space(3)))
typedef unsigned short bf16;
typedef unsigned v4u __attribute__((ext_vector_type(4)));
typedef unsigned v2u __attribute__((ext_vector_type(2)));
typedef float f32x4 __attribute__((ext_vector_type(4)));
typedef float f32x2 __attribute__((ext_vector_type(2)));
#define RLX_AGENT __ATOMIC_RELAXED, __HIP_MEMORY_SCOPE_AGENT
#define LDS_WAIT() asm volatile("s_waitcnt lgkmcnt(0)" ::: "memory")
#define VM_WAIT() asm volatile("s_waitcnt vmcnt(0)" ::: "memory")
__device__ __forceinline__ unsigned pk2(float lo, float hi) { unsigned r; asm volatile("v_cvt_pk_bf16_f32 %0, %1, %2" : "=v"(r) : "v"(lo), "v"(hi)); return r; }
__device__ __forceinline__ float bflo(unsigned w) { return __uint_as_float(w << 16); }
__device__ __forceinline__ float bfhi(unsigned w) { return __uint_as_float(w & 0xffff0000u); }
__device__ __forceinline__ void unpack8(const v4u w, float (&x)[8]) { x[0] = bflo(w.x); x[1] = bfhi(w.x); x[2] = bflo(w.y); x[3] = bfhi(w.y); x[4] = bflo(w.z); x[5] = bfhi(w.z); x[6] = bflo(w.w); x[7] = bfhi(w.w); }
__device__ __forceinline__ v4u pack8(const float (&x)[8]) { v4u w; w.x = pk2(x[0], x[1]); w.y = pk2(x[2], x[3]); w.z = pk2(x[4], x[5]); w.w = pk2(x[6], x[7]); return w; }
__device__ __forceinline__ float wave_sum(float v) {
#pragma unroll
    for (int o = 1; o < 64; o <<= 1) v += __shfl_xor(v, o);
    return v;
}
__device__ __forceinline__ float gelu_tanh(float x) { const float y = 0.7978845608028654f * (x + 0.044715f * x * x * x); return 0.5f * x * (1.f + tanhf(y)); }

#define XB_TMO      128
#define XB_XCNT(j)  (256  + 64 * (j))
#define XB_XSUB(j)  (1280 + 64 * (j))
#define XB_XGEN(j)  (2304 + 64 * (j))
#define XB_TOP      3328
#define XB_TOPGEN   3392
#define XCD_BAR_WORDS 3456
#define XB_SPIN_CAP (1u << 18)
__device__ __forceinline__ unsigned xb_ld(unsigned* p)              { return __hip_atomic_load(p, __ATOMIC_RELAXED, __HIP_MEMORY_SCOPE_AGENT); }
__device__ __forceinline__ unsigned xb_add(unsigned* p, unsigned v) { return __hip_atomic_fetch_add(p, v, __ATOMIC_RELAXED, __HIP_MEMORY_SCOPE_AGENT); }
__device__ __forceinline__ unsigned xb_xcc_id() { return (unsigned)__builtin_amdgcn_s_getreg((3 << 11) | 20) & 0xFu; }
#define XB_SPIN(cond, bar) do { unsigned _sp = 0; while (cond) { __builtin_amdgcn_s_sleep(1); \
    if ((++_sp & 255u) == 0u) { if (xb_ld(&(bar)[XB_TMO])) break; if (_sp > XB_SPIN_CAP) { atomicAdd(&(bar)[XB_TMO], 1u); break; } } } } while (0)
struct XcdBarrier { unsigned* bar; unsigned x; volatile LAS unsigned* st; };
__device__ __forceinline__ XcdBarrier xcd_barrier_post(unsigned* bar, volatile LAS unsigned* st) {
    XcdBarrier b; b.bar = bar; b.x = xb_xcc_id(); b.st = st;
    if (threadIdx.x == 0) (void)xb_add(&bar[XB_XCNT(b.x)], 1u);
    return b;
}
__device__ __forceinline__ void xcd_barrier_complete(unsigned* bar, unsigned x, unsigned& nloc, unsigned& nx) {
    const unsigned G = gridDim.x * gridDim.y * gridDim.z;
    unsigned sum, cnt, mine, sp = 0u;
    for (;;) {
        sum = 0u; cnt = 0u; mine = 0u;
#pragma unroll
        for (unsigned j = 0; j < 16; ++j) { const unsigned c = xb_ld(&bar[XB_XCNT(j)]); sum += c; cnt += (c > 0u) ? 1u : 0u; mine = (j == x) ? c : mine; }
        if (sum == G) break;
        __builtin_amdgcn_s_sleep(1);
        if ((++sp & 255u) == 0u) { if (xb_ld(&bar[XB_TMO])) break; if (sp > XB_SPIN_CAP) { atomicAdd(&bar[XB_TMO], 1u); break; } }
    }
    nloc = mine > 0u ? mine : 1u; nx = cnt > 0u ? cnt : 1u;
}
__device__ __forceinline__ void xcd_barrier(const XcdBarrier& b) {
    asm volatile("s_waitcnt vmcnt(0)" ::: "memory");
    __syncthreads();
    if (threadIdx.x == 0) {
        unsigned* bar = b.bar;
        __builtin_amdgcn_s_waitcnt(0);
        unsigned nloc = b.st[0], nx = b.st[1];
        if (nloc == 0u) { xcd_barrier_complete(bar, b.x, nloc, nx); b.st[0] = nloc; b.st[1] = nx; }
        const unsigned old = xb_add(&bar[XB_XSUB(b.x)], 1u);
        const unsigned gen = old / nloc;
        if (old + 1u == (gen + 1u) * nloc) {
            __builtin_amdgcn_fence(__ATOMIC_RELEASE, "agent");
            asm volatile("s_waitcnt vmcnt(0)" ::: "memory");
            const unsigned og = xb_add(&bar[XB_TOP], 1u);
            const unsigned tg = og / nx;
            if (og + 1u == (tg + 1u) * nx) xb_add(&bar[XB_TOPGEN], 1u);
            else XB_SPIN(xb_ld(&bar[XB_TOPGEN]) == tg, bar);
            __builtin_amdgcn_fence(__ATOMIC_ACQUIRE, "agent");
            xb_add(&bar[XB_XGEN(b.x)], 1u);
            asm volatile("s_waitcnt vmcnt(0)" ::: "memory");
        } else {
            XB_SPIN(xb_ld(&bar[XB_XGEN(b.x)]) == gen, bar);
            __builtin_amdgcn_fence(__ATOMIC_ACQUIRE, "agent");
            asm volatile("s_waitcnt vmcnt(0)" ::: "memory");
        }
    }
    __syncthreads();
}

struct Args { const float* in[22]; float* out; unsigned char* ws; int ph_lo, ph_hi; };
enum { I_X = 0, I_C, I_CTX, I_CCTX, I_WMOD, I_BMOD, I_N1G, I_N2G, I_WIN, I_QG, I_KG, I_CONVW, I_LNG, I_LNB, I_GMWS, I_GMB, I_WOUT, I_WUP, I_FCW, I_FCB, I_WDN, I_FNG };

typedef const Args __attribute__((address_space(4)))* KArgs;
__device__ __forceinline__ KArgs kargs() { KArgs p = (KArgs)__builtin_amdgcn_kernarg_segment_ptr(); asm volatile("" : "+s"(p)); return p; }
struct Frame {
    LAS unsigned char* lds;
    int tid, lane, wave, G, bx, gw, ngw;
    unsigned char* ws;
};
__device__ __forceinline__ Frame make_frame(KArgs a) {
    extern __shared__ __attribute__((aligned(16))) unsigned char lds_[];
    Frame F; int t = threadIdx.x; asm volatile("" : "+v"(t));
    F.lds = (LAS unsigned char*)lds_; F.tid = t; F.lane = t & 63; F.wave = __builtin_amdgcn_readfirstlane(t >> 6);
    F.G = gridDim.x; F.bx = blockIdx.x; F.gw = F.bx * NWAVES + F.wave; F.ngw = F.G * NWAVES; F.ws = a->ws;
    return F;
}

__device__ __forceinline__ size_t toff(int n, int k, int K) { return ((size_t)(n >> 8) * (K >> 6) + (k >> 6)) * 16384 + (size_t)(n & 255) * 64 + (k & 63); }
__device__ __forceinline__ void transpose_item(const float* W, int ldw, int k0, int ns0, bf16* WT, int ldt, int nd0, LAS float* scr, int lane) {
    f32x4 v[8];
#pragma unroll
    for (int i = 0; i < 8; ++i) v[i] = *(const f32x4*)(W + (size_t)(k0 + i * 8 + (lane >> 3)) * ldw + ns0 + (lane & 7) * 4);
#pragma unroll
    for (int i = 0; i < 8; ++i) { LAS float* d = scr + (i * 8 + (lane >> 3)) * 33 + (lane & 7) * 4; d[0] = v[i].x; d[1] = v[i].y; d[2] = v[i].z; d[3] = v[i].w; }
    LDS_WAIT(); asm volatile("" ::: "memory");
    const int c = lane & 7;
#pragma unroll
    for (int j = 0; j < 4; ++j) { const int n = (lane >> 3) + 8 * j; const LAS float* s = scr + (8 * c) * 33 + n;
        v4u o; o.x = pk2(s[0 * 33], s[1 * 33]); o.y = pk2(s[2 * 33], s[3 * 33]); o.z = pk2(s[4 * 33], s[5 * 33]); o.w = pk2(s[6 * 33], s[7 * 33]);
        *(v4u*)(WT + toff(nd0 + n, k0 + 8 * c, ldt)) = o; }
    LDS_WAIT(); asm volatile("" ::: "memory");
}

__device__ __forceinline__ void p0a_prologue(KArgs a) {
    Frame F = make_frame(a); unsigned char* ws = F.ws;
    {
        LAS float* scr = (LAS float*)(F.lds + F.wave * 16384);
        constexpr int I_IN = 32 * 128, I_OUT = 40 * 64, I_UP = 32 * 352, I_DN = 88 * 64, I_L = I_IN + I_OUT + I_UP + I_DN;
        for (int it = F.gw; it < DEPTH * I_L; it += F.ngw) {
            const int l = it / I_L; int r = it % I_L;
            if (r < I_IN) { const int kb = r / 128, nb = r % 128; const int ns0 = nb < 48 ? nb * 32 : 2048 + (nb - 48) * 32; const int nd0 = nb < 48 ? ns0 : ns0 + 512;
                transpose_item(a->in[I_WIN] + (size_t)l * DM * INW_SRC, INW_SRC, kb * 64, ns0, (bf16*)(ws + WS_WIN) + (size_t)l * PW * DM, DM, nd0, scr, F.lane); continue; }
            r -= I_IN;
            if (r < I_OUT) { const int kb = r / 64, nb = r % 64;
                transpose_item(a->in[I_WOUT] + (size_t)l * MIXW * DM, DM, kb * 64, nb * 32, (bf16*)(ws + WS_WOUT) + (size_t)l * DM * MIXW, MIXW, nb * 32, scr, F.lane); continue; }
            r -= I_OUT;
            if (r < I_UP) { const int kb = r / 352, nb = r % 352; const int nd0 = nb * 32, ns0 = ((nd0 >> 7) & 1) * DFF + (nd0 >> 8) * 128 + (nd0 & 127);
                transpose_item(a->in[I_WUP] + (size_t)l * DM * UPW, UPW, kb * 64, ns0, (bf16*)(ws + WS_WUP) + (size_t)l * UPW * DM, DM, nb * 32, scr, F.lane); continue; }
            r -= I_UP;
            { const int kb = r / 64, nb = r % 64;
                transpose_item(a->in[I_WDN] + (size_t)l * DFF * DM, DM, kb * 64, nb * 32, (bf16*)(ws + WS_WDN) + (size_t)l * DM * DFF, DFF, nb * 32, scr, F.lane); }
        }
    }
    __syncthreads();
    {
        LAS float* sl = (LAS float*)F.lds;
        for (int i = F.tid; i < 5 * DM; i += NTHR) { const int v = i / DM, k = i % DM; const float cv = v < 4 ? a->in[I_C][v * DM + k] : a->in[I_CCTX][k]; sl[i] = cv / (1.f + expf(-cv)); }
        __syncthreads();
        float* MODP = (float*)(ws + WS_MODP);
        for (int it = F.gw; it < DEPTH * 16 * 48; it += F.ngw) {
            const int l = it / 768, r = it % 768, ks = r / 48, cg = r % 48;
            const float* wp = a->in[I_WMOD] + ((size_t)l * DM + ks * 128) * NMOD + cg * 256 + F.lane * 4;
            f32x4 acc[5];
#pragma unroll
            for (int v = 0; v < 5; ++v) acc[v] = (f32x4){0.f, 0.f, 0.f, 0.f};
            for (int k = 0; k < 128; k += 8) {
                f32x4 w[8];
#pragma unroll
                for (int u = 0; u < 8; ++u) w[u] = *(const f32x4*)(wp + (size_t)(k + u) * NMOD);
#pragma unroll
                for (int u = 0; u < 8; ++u)
#pragma unroll
                    for (int v = 0; v < 5; ++v) acc[v] += w[u] * sl[v * DM + ks * 128 + k + u];
            }
#pragma unroll
            for (int v = 0; v < 5; ++v) *(f32x4*)(MODP + ((size_t)ks * (DEPTH * 5) + l * 5 + v) * NMOD + cg * 256 + F.lane * 4) = acc[v];
        }
    }
    __syncthreads();
    {
        LAS float* T128 = (LAS float*)F.lds;
        LAS float* Wl = (LAS float*)(F.lds + 1024);
        if (F.tid < 128) T128[F.tid] = cospif((float)F.tid * (1.f / 64.f));
        __syncthreads();
        for (int it = F.bx; it < DEPTH * 4 * 64; it += F.G) {
            const int l = it / 256, g = (it / 64) % 4, kb = it % 64;
            for (int i = F.tid; i < 32 * 128; i += NTHR) { const int kk = i / 128, dd = i % 128; Wl[dd * 36 + kk] = a->in[I_WIN][((size_t)l * DM + kb * 32 + kk) * INW_SRC + 1536 + g * 128 + dd]; }
            __syncthreads();
            const int dout = F.tid & 127, cs = (F.tid >> 7) & 1, kg = F.tid >> 8;
            float acc[16];
#pragma unroll
            for (int kk = 0; kk < 16; ++kk) acc[kk] = 0.f;
            for (int dd = 0; dd < 128; ++dd) {
                const float tr = T128[(dout * dd - (cs ? 32 : 0)) & 127];
#pragma unroll
                for (int q4 = 0; q4 < 4; ++q4) { const f32x4 w4 = *(const LAS f32x4*)(Wl + dd * 36 + kg * 16 + 4 * q4);
                    acc[4 * q4] += w4.x * tr; acc[4 * q4 + 1] += w4.y * tr; acc[4 * q4 + 2] += w4.z * tr; acc[4 * q4 + 3] += w4.w * tr; }
            }
            bf16* dst = (bf16*)(ws + WS_WIN) + (size_t)l * PW * DM + toff(PFA + cs * 512 + g * 128 + dout, kb * 32 + kg * 16, DM);
            v4u o0, o1; o0.x = pk2(acc[0], acc[1]); o0.y = pk2(acc[2], acc[3]); o0.z = pk2(acc[4], acc[5]); o0.w = pk2(acc[6], acc[7]);
            o1.x = pk2(acc[8], acc[9]); o1.y = pk2(acc[10], acc[11]); o1.z = pk2(acc[12], acc[13]); o1.w = pk2(acc[14], acc[15]);
            *(v4u*)dst = o0; *(v4u*)(dst + 8) = o1;
            __syncthreads();
        }
    }
    __syncthreads();
    {
        LAS float* T = (LAS float*)F.lds;
        for (int i = F.tid; i < 4096; i += NTHR) T[i] = cospif((float)i * (1.f / 2048.f));
        __syncthreads();
        bf16* A1 = (bf16*)(ws + WS_A1);
        for (int idx = F.bx * NTHR + F.tid; idx < 256 * 32; idx += F.G * NTHR) {
            const int m = idx >> 5, kk0 = (idx & 31) * 8; const int cho = m >> 7, k2 = (m & 127) >> 1, ro = m & 1; float x[8];
#pragma unroll
            for (int e2 = 0; e2 < 8; ++e2) { const int kk = kk0 + e2, chi = kk >> 7, ri = (kk >> 6) & 1, aa = kk & 63;
                const float cs_ = T[(64 * k2 * aa) & 4095], sn_ = T[(64 * k2 * aa - 1024) & 4095];
                const float v = ro == 0 ? (ri == 0 ? cs_ : -sn_) : (ri == 0 ? -sn_ : -cs_);
                x[e2] = (cho == chi) ? v : 0.f; }
            *(v4u*)(A1 + (size_t)m * 256 + kk0) = pack8(x);
        }
        bf16* A2 = (bf16*)(ws + WS_A2);
        for (int idx = F.bx * NTHR + F.tid; idx < 16 * 256 * 64; idx += F.G * NTHR) {
            const int kk0 = (idx & 63) * 8, m = (idx >> 6) & 255, q = idx >> 14; const int k2p = m >> 6, k1 = m & 63, k = 4 * q + k2p + 64 * k1; float x[8];
#pragma unroll
            for (int e2 = 0; e2 < 8; ++e2) { const int kk = kk0 + e2, k2pp = kk >> 7, ro = (kk >> 6) & 1, c = kk & 63;
                const float v = ro == 0 ? T[(k * c) & 4095] : T[(k * c - 1024) & 4095];
                x[e2] = (k2pp == k2p) ? v : 0.f; }
            *(v4u*)(A2 + ((size_t)q * 256 + m) * 512 + kk0) = pack8(x);
        }
        bf16* F2 = (bf16*)(ws + WS_F256);
        for (int k = F.bx; k < 256; k += F.G) {
            if (F.tid < 64) { const int j0 = F.tid * 8; const int cs = j0 >> 8, t0 = j0 & 255; float x[8];
#pragma unroll
                for (int e = 0; e < 8; ++e) { const int m = (16 * k * (t0 + e) - (cs ? 1024 : 0)) & 4095; const float v = T[m]; x[e] = cs ? -v : v; }
                *(v4u*)(F2 + (size_t)k * 512 + j0) = pack8(x); }
        }
    }
    if (F.bx == 0) {
        f32x2* ROPE = (f32x2*)(ws + WS_ROPE);
        for (int i = F.tid; i < 64 * 32; i += NTHR) { const int pos = i >> 5, ii = i & 31; const float freq = powf(10000.f, -(float)(2 * ii) / 64.f); const float ang = (float)pos * freq;
            ROPE[i] = (f32x2){cosf(ang), sinf(ang)}; }
    }
    __syncthreads();
}

__device__ __forceinline__ void p0b_modreduce(KArgs a) {
    Frame F = make_frame(a);
    const float* MODP = (const float*)(F.ws + WS_MODP); float* MOD = (float*)(F.ws + WS_MOD);
    for (int i = F.bx * NTHR + F.tid; i < DEPTH * 5 * (NMOD / 4); i += F.G * NTHR) {
        const int j4 = i % (NMOD / 4), lv = i / (NMOD / 4), l = lv / 5;
        f32x4 s = *(const f32x4*)(a->in[I_BMOD] + (size_t)l * NMOD + j4 * 4);
#pragma unroll
        for (int ks = 0; ks < 16; ++ks) s += *(const f32x4*)(MODP + ((size_t)ks * (DEPTH * 5) + lv) * NMOD + j4 * 4);
        *(f32x4*)(MOD + (size_t)lv * NMOD + j4 * 4) = s;
    }
}

__device__ __forceinline__ void norm_phase(KArgs a, int M, const float* g, const float* modl, int shoff, int scoff, bool fold, bool lat_in, bool ctx_in) {
    Frame F = make_frame(a);
    bf16* X = (bf16*)(F.ws + WS_X); bf16* H = (bf16*)(F.ws + WS_H); const float* XP = (const float*)(F.ws + WS_XP);
    for (int row = F.gw; row < M; row += F.ngw) {
        const int v = row < ML ? row >> 12 : 4;
        const float* sh = modl + (size_t)v * NMOD + shoff; const float* sc = modl + (size_t)v * NMOD + scoff;
        v4u* xr = (v4u*)(X + (size_t)row * DM) + F.lane;
        f32x4 x[4][2]; float ss = 0.f;
        if (row < ML ? lat_in : ctx_in) { const f32x4* xs = (const f32x4*)(row < ML ? a->in[I_X] + (size_t)row * DM : a->in[I_CTX] + (size_t)(row - ML) * DM) + 2 * F.lane;
#pragma unroll
            for (int j = 0; j < 4; ++j) { x[j][0] = xs[128 * j]; x[j][1] = xs[128 * j + 1]; } }
        else {
#pragma unroll
            for (int j = 0; j < 4; ++j) { const v4u w = xr[64 * j]; x[j][0] = (f32x4){bflo(w.x), bfhi(w.x), bflo(w.y), bfhi(w.y)}; x[j][1] = (f32x4){bflo(w.z), bfhi(w.z), bflo(w.w), bfhi(w.w)}; } }
        if (fold && row >= ML) {
#pragma unroll
            for (int ks = 0; ks < 4; ++ks) { const f32x4* pr = (const f32x4*)(XP + ((size_t)ks * MC + (row - ML)) * DM) + 2 * F.lane;
#pragma unroll
                for (int j = 0; j < 4; ++j) { x[j][0] += pr[128 * j]; x[j][1] += pr[128 * j + 1]; } }
#pragma unroll
            for (int j = 0; j < 4; ++j) { v4u w; w.x = pk2(x[j][0].x, x[j][0].y); w.y = pk2(x[j][0].z, x[j][0].w); w.z = pk2(x[j][1].x, x[j][1].y); w.w = pk2(x[j][1].z, x[j][1].w); xr[64 * j] = w; }
        }
#pragma unroll
        for (int j = 0; j < 4; ++j)
#pragma unroll
            for (int h = 0; h < 2; ++h) ss += (x[j][h].x * x[j][h].x + x[j][h].y * x[j][h].y) + (x[j][h].z * x[j][h].z + x[j][h].w * x[j][h].w);
        const float rstd = 1.0f / sqrtf(wave_sum(ss) * (1.f / DM) + EPS);
#pragma unroll
        for (int j = 0; j < 4; ++j) { const int col = F.lane * 8 + 512 * j; f32x4 y[2];
#pragma unroll
            for (int h = 0; h < 2; ++h) { const f32x4 gg = *(const f32x4*)(g + col + 4 * h), s1 = *(const f32x4*)(sc + col + 4 * h), s0 = *(const f32x4*)(sh + col + 4 * h);
                y[h] = x[j][h] * rstd * gg * (s1 + 1.0f) + s0; }
            v4u o; o.x = pk2(y[0].x, y[0].y); o.y = pk2(y[0].z, y[0].w); o.z = pk2(y[1].x, y[1].y); o.w = pk2(y[1].z, y[1].w);
            *(v4u*)(H + (size_t)row * DM + col) = o; }
    }
}

__device__ __forceinline__ void final_norm_phase(KArgs a, const float* g, float* out) {
    Frame F = make_frame(a);
    const bf16* X = (const bf16*)(F.ws + WS_X);
    for (int row = F.gw; row < ML; row += F.ngw) {
        const v4u* xr = (const v4u*)(X + (size_t)row * DM) + F.lane;
        f32x4 x[8]; float ss = 0.f;
#pragma unroll
        for (int j = 0; j < 4; ++j) { const v4u w = xr[64 * j]; x[2 * j] = (f32x4){bflo(w.x), bfhi(w.x), bflo(w.y), bfhi(w.y)}; x[2 * j + 1] = (f32x4){bflo(w.z), bfhi(w.z), bflo(w.w), bfhi(w.w)}; }
#pragma unroll
        for (int j = 0; j < 8; ++j) ss += (x[j].x * x[j].x + x[j].y * x[j].y) + (x[j].z * x[j].z + x[j].w * x[j].w);
        const float rstd = 1.0f / sqrtf(wave_sum(ss) * (1.f / DM) + EPS);
#pragma unroll
        for (int j = 0; j < 8; ++j) { const int col = F.lane * 8 + 512 * (j >> 1) + 4 * (j & 1); const f32x4 gg = *(const f32x4*)(g + col);
            *(f32x4*)(out + (size_t)row * DM + col) = x[j] * rstd * gg; }
    }
}

__device__ __forceinline__ float gelu_fast(float x) { const float y = 1.5957691216057308f * (x + 0.044715f * x * x * x); return x * __builtin_amdgcn_rcpf(1.f + __expf(-y)); }

__device__ __forceinline__ void postA_phase(KArgs a, int l) {
    Frame F = make_frame(a); unsigned char* ws = F.ws;
    const bf16* P = (const bf16*)(ws + WS_P); bf16* MIX = (bf16*)(ws + WS_MIX); bf16* KB = (bf16*)(ws + WS_KB); bf16* VB = (bf16*)(ws + WS_VB);
    bf16* QB = (bf16*)(ws + WS_QB); bf16* UB = (bf16*)(ws + WS_UB); bf16* V2B = (bf16*)(ws + WS_V2B);
    const f32x4* ROPE4 = (const f32x4*)(ws + WS_ROPE);
    const int lane = F.lane, tid = F.tid;
    {
        const int hl = lane & 15, axis = hl >> 3, i0 = (lane & 3) * 8; const bool first = (lane & 7) < 4;
        float qg8[8], kg8[8], cw0[8], cw1[8], cw2[8], lg8[8], lb8[8];
        { const float* qg = a->in[I_QG] + l * 128 + hl * 8; const float* kg = a->in[I_KG] + l * 128 + hl * 8; const float* cw = a->in[I_CONVW] + (size_t)l * 3 * 512 + lane * 8;
          const float* lng = a->in[I_LNG] + l * 512 + lane * 8; const float* lnb = a->in[I_LNB] + l * 512 + lane * 8;
#pragma unroll
          for (int e = 0; e < 8; ++e) { qg8[e] = qg[e]; kg8[e] = kg[e]; cw0[e] = cw[e]; cw1[e] = cw[512 + e]; cw2[e] = cw[1024 + e]; lg8[e] = lng[e]; lb8[e] = lnb[e]; } }
        for (int row = F.gw; row < MT; row += F.ngw) {
            const bool is_ctx = row >= ML;
            const int b = is_ctx ? (row - ML) >> 8 : row >> 12, p = is_ctx ? (row - ML) & 255 : row & 4095, nseq = is_ctx ? CTXL : SEQ;
            const bool kv_only = is_ctx && (l == DEPTH - 1);
            const bf16* Pr = P + (size_t)row * PW;
            const int kvpos = is_ctx ? p : CTXL + p;
            const v4u rkv = *(const v4u*)(Pr + PK + lane * 8);
            f32x4 c4[4];
            if (!is_ctx) { const int posax = axis ? (p & 63) : (p >> 6);
#pragma unroll
                for (int e = 0; e < 4; ++e) c4[e] = ROPE4[posax * 16 + (i0 >> 1) + e]; }
            {
                float x[8]; unpack8(rkv, x); float ss = 0.f;
#pragma unroll
                for (int e = 0; e < 8; ++e) ss += x[e] * x[e];
                ss += __shfl_xor(ss, 1); ss += __shfl_xor(ss, 2); ss += __shfl_xor(ss, 4); ss += __shfl_xor(ss, 8);
                const float rstd = 1.0f / sqrtf(ss * (1.f / 128.f) + EPS);
                float y[8];
#pragma unroll
                for (int e = 0; e < 8; ++e) y[e] = x[e] * rstd * kg8[e];
                if (!is_ctx) {
#pragma unroll
                    for (int e = 0; e < 8; ++e) { const float pr = __shfl_xor(y[e], 4); const float cs_ = c4[e >> 1][(e & 1) * 2], sn_ = c4[e >> 1][(e & 1) * 2 + 1]; y[e] = first ? y[e] * cs_ - pr * sn_ : y[e] * cs_ + pr * sn_; } }
                if (lane < 32) *(v4u*)(KB + ((size_t)b * SKV + kvpos) * 256 + lane * 8) = pack8(y);
                else *(v4u*)(VB + ((size_t)b * SKV + kvpos) * 256 + (lane - 32) * 8) = rkv;
            }
            if (kv_only) continue;
            const v4u rq0 = *(const v4u*)(Pr + PQ + lane * 8), rq1 = *(const v4u*)(Pr + PQ + 512 + lane * 8);
            const v4u rcb = *(const v4u*)(Pr + PCB + lane * 8), rc0 = *(const v4u*)(Pr + PCC + lane * 8), rh0 = *(const v4u*)(Pr + PCH + lane * 8);
            const bool hp = p > 0, hn = p < nseq - 1;
            const bf16* Pm = hp ? Pr - PW : Pr; const bf16* Pn = hn ? Pr + PW : Pr;
            const v4u rcm = *(const v4u*)(Pm + PCC + lane * 8), rhm = *(const v4u*)(Pm + PCH + lane * 8), rcp = *(const v4u*)(Pn + PCC + lane * 8), rhp = *(const v4u*)(Pn + PCH + lane * 8);
            const v4u rgu = *(const v4u*)(Pr + PGU + lane * 8), rgv = *(const v4u*)(Pr + PGV + lane * 8);
#pragma unroll
            for (int part = 0; part < 2; ++part) {
                float x[8]; unpack8(part ? rq1 : rq0, x); float ss = 0.f;
#pragma unroll
                for (int e = 0; e < 8; ++e) ss += x[e] * x[e];
                ss += __shfl_xor(ss, 1); ss += __shfl_xor(ss, 2); ss += __shfl_xor(ss, 4); ss += __shfl_xor(ss, 8);
                const float rstd = 1.0f / sqrtf(ss * (1.f / 128.f) + EPS);
                float y[8];
#pragma unroll
                for (int e = 0; e < 8; ++e) y[e] = x[e] * rstd * qg8[e];
                if (!is_ctx) {
#pragma unroll
                    for (int e = 0; e < 8; ++e) { const float pr = __shfl_xor(y[e], 4); const float cs_ = c4[e >> 1][(e & 1) * 2], sn_ = c4[e >> 1][(e & 1) * 2 + 1]; y[e] = first ? y[e] * cs_ - pr * sn_ : y[e] * cs_ + pr * sn_; } }
                *(v4u*)(QB + (size_t)row * 1024 + part * 512 + lane * 8) = pack8(y);
            }
            {
                float cb[8], c0[8], h0[8], cm[8], hm[8], cp[8], hq[8], o[8];
                unpack8(rcb, cb); unpack8(rc0, c0); unpack8(rh0, h0); unpack8(rcm, cm); unpack8(rhm, hm); unpack8(rcp, cp); unpack8(rhp, hq);
                const float fp = hp ? 1.f : 0.f, fn = hn ? 1.f : 0.f;
#pragma unroll
                for (int e = 0; e < 8; ++e) o[e] = cb[e] * (cw0[e] * fp * (cm[e] * hm[e]) + cw1[e] * (c0[e] * h0[e]) + cw2[e] * fn * (cp[e] * hq[e]));
                *(v4u*)(MIX + (size_t)row * MIXW + MX_CONV + lane * 8) = pack8(o);
            }
            {
                float u[8], t[8]; unpack8(rgu, u); unpack8(rgv, t);
                float s = 0.f;
#pragma unroll
                for (int e = 0; e < 8; ++e) { u[e] = gelu_fast(u[e]); t[e] = gelu_fast(t[e]); s += t[e]; }
                const float mean = wave_sum(s) * (1.f / 512.f);
                float q = 0.f;
#pragma unroll
                for (int e = 0; e < 8; ++e) { t[e] -= mean; q += t[e] * t[e]; }
                const float rstd = 1.0f / sqrtf(wave_sum(q) * (1.f / 512.f) + EPS);
#pragma unroll
                for (int e = 0; e < 8; ++e) t[e] = t[e] * rstd * lg8[e] + lb8[e];
                *(v4u*)(UB + (size_t)row * 512 + lane * 8) = pack8(u); *(v4u*)(V2B + (size_t)row * 512 + lane * 8) = pack8(t);
            }
        }
    }
    {
        LAS unsigned* tb = (LAS unsigned*)F.lds;
        bf16* S1 = (bf16*)(ws + WS_T1T);
        for (int un = F.bx; un < 512; un += F.G) {
            const int ab = un >> 6, b = (un >> 4) & 3, slab = un & 15;
            const size_t rowb = (size_t)b * SEQ + (size_t)ab * 512;
#pragma unroll
            for (int it = 0; it < 4; ++it) {
                const int idx = tid + it * NTHR; const int j = idx & 3, c = (idx >> 2) & 63, c8 = idx >> 8;
                const bf16* src0 = P + (rowb + (size_t)(2 * j) * 64 + c) * PW + PFA + slab * 64 + c8 * 8;
                const v4u r0 = *(const v4u*)src0, r1 = *(const v4u*)(src0 + (size_t)64 * PW);
                const unsigned a0[4] = {r0.x, r0.y, r0.z, r0.w}, a1[4] = {r1.x, r1.y, r1.z, r1.w};
#pragma unroll
                for (int w = 0; w < 4; ++w) {
                    tb[((c8 * 8 + 2 * w) * 64 + c) * 4 + j]     = (a0[w] & 0xffffu) | (a1[w] << 16);
                    tb[((c8 * 8 + 2 * w + 1) * 64 + c) * 4 + j] = (a0[w] >> 16) | (a1[w] & 0xffff0000u);
                }
            }
            __syncthreads();
#pragma unroll
            for (int it = 0; it < 8; ++it) {
                const int idx = tid + it * NTHR; const int c = idx & 63, col = idx >> 6;
                const v4u o = *(const LAS v4u*)(tb + (col * 64 + c) * 4);
                const int gcol = slab * 64 + col, ri = gcol >> 9, n = b * 512 + (gcol & 511);
                *(v4u*)(S1 + ((((size_t)n * 32 + (c & 31)) * 2 + (c >> 5)) * 2 + ri) * 64 + ab * 8) = o;
            }
            __syncthreads();
        }
    }
    if (l < DEPTH - 1) {
        LAS unsigned* tb = (LAS unsigned*)F.lds;
        for (int un = F.bx; un < 32; un += F.G) {
            const int chc = un >> 2, slab = un & 3;
            const int b = chc >> 1, p0 = (chc & 1) * 128;
            const int row0 = ML + b * CTXL + p0;
            bf16* T1 = (bf16*)(ws + WS_T1TC);
#pragma unroll
            for (int it = 0; it < 4; ++it) {
                const int q = tid + it * NTHR;
                const int c8 = ((q >> 6) & 3) * 8 + (q & 7), rp = (q >> 8) * 8 + ((q >> 3) & 7);
                const v4u r0 = *(const v4u*)(P + (size_t)(row0 + 2 * rp) * PW + PFA + slab * 256 + c8 * 8);
                const v4u r1 = *(const v4u*)(P + (size_t)(row0 + 2 * rp + 1) * PW + PFA + slab * 256 + c8 * 8);
                const unsigned a0[4] = {r0.x, r0.y, r0.z, r0.w}, a1[4] = {r1.x, r1.y, r1.z, r1.w};
#pragma unroll
                for (int w = 0; w < 4; ++w) {
                    tb[(c8 * 8 + 2 * w) * 65 + rp]     = (a0[w] & 0xffffu) | (a1[w] << 16);
                    tb[(c8 * 8 + 2 * w + 1) * 65 + rp] = (a0[w] >> 16) | (a1[w] & 0xffff0000u);
                }
            }
            __syncthreads();
#pragma unroll
            for (int it = 0; it < 8; ++it) {
                const int idx = tid + it * NTHR; const int cc = idx >> 4, t8 = idx & 15;
                v4u o; o.x = tb[cc * 65 + t8 * 4]; o.y = tb[cc * 65 + t8 * 4 + 1]; o.z = tb[cc * 65 + t8 * 4 + 2]; o.w = tb[cc * 65 + t8 * 4 + 3];
                const int col = slab * 256 + cc, csn = col >> 9, gd = col & 511;
                *(v4u*)(T1 + (size_t)(b * 512 + gd) * 512 + csn * CTXL + p0 + t8 * 8) = o;
            }
            __syncthreads();
        }
    }
}

__device__ __forceinline__ void gate_phase(KArgs a, int l, int wg0, int nwg, int u_lo, int u_hi) {
    Frame F = make_frame(a); unsigned char* ws = F.ws;
    F.bx -= wg0; if (F.bx < 0 || F.bx >= nwg) return;
    const bf16* UB = (const bf16*)(ws + WS_UB); const bf16* V2B = (const bf16*)(ws + WS_V2B); bf16* MIX = (bf16*)(ws + WS_MIX);
    const float* gws = a->in[I_GMWS] + (size_t)l * 4 * 128 * 128; const float* gmb = a->in[I_GMB] + l * 4 * 128;
    const int tid = F.tid, lane = F.lane, r32 = lane & 31, hi = lane >> 5, gsel = F.wave >> 2, qb = F.wave & 3;
    for (int un = u_lo + F.bx; un < u_hi; un += nwg) {
        const int ch = un >> 1, gp = un & 1;
        const bool is_ctx = ch >= 128;
        const int b = is_ctx ? (ch - 128) >> 1 : ch >> 5;
        const int p0 = is_ctx ? ((ch - 128) & 1) * 128 : (ch & 31) * 128;
        const int row0 = is_ctx ? ML + b * CTXL + p0 : b * SEQ + p0;
#pragma unroll
        for (int it = 0; it < 8; ++it) { const int idx = tid + it * NTHR; const int gi = idx >> 11, pp = (idx >> 4) & 127, c8 = idx & 15;
            const v4u v = *(const v4u*)(V2B + (size_t)(row0 + pp) * 512 + (2 * gp + gi) * 128 + c8 * 8);
            *(LAS v4u*)(F.lds + (gi * 2 + (pp >> 6)) * 16384 + att::v_st(pp & 63, c8 * 8)) = v; }
        __syncthreads();
        const int g = 2 * gp + gsel;
        att::f32x16 o[4] = {};
#pragma unroll
        for (int kt = 0; kt < 2; ++kt) {
            const float* wrow = gws + ((size_t)g * 128 + 32 * qb + r32) * 128 + 64 * kt + 8 * hi;
            att::bf16x8 pa[4];
#pragma unroll
            for (int ks = 0; ks < 4; ++ks) { const f32x4 w0 = *(const f32x4*)(wrow + 16 * ks), w1 = *(const f32x4*)(wrow + 16 * ks + 4);
                v4u w; w.x = pk2(w0.x, w0.y); w.y = pk2(w0.z, w0.w); w.z = pk2(w1.x, w1.y); w.w = pk2(w1.z, w1.w); pa[ks] = *reinterpret_cast<att::bf16x8*>(&w); }
            const int vb = (int)(unsigned)(uintptr_t)(F.lds + (gsel * 2 + kt) * 16384) + att::v_rd_base(lane);
            att::pv_d0(o, vb, pa[0], pa[1], pa[2], pa[3]);
        }
        __syncthreads();
        { LAS unsigned char* ob = F.lds + F.wave * (32 * 272);
#pragma unroll
          for (int i = 0; i < 8; ++i) { const int row = i * 4 + (lane >> 4), chk = lane & 15;
              *(LAS v4u*)(ob + row * 272 + chk * 16) = *(const v4u*)(UB + (size_t)(row0 + 32 * qb + row) * 512 + g * 128 + chk * 8); }
#pragma unroll
          for (int r = 0; r < 16; ++r) { const int qq = att::crow(r, hi); const float bias = gmb[g * 128 + 32 * qb + qq];
#pragma unroll
              for (int d0 = 0; d0 < 4; ++d0) { LAS bf16* e = (LAS bf16*)(ob + qq * 272 + (d0 * 32 + r32) * 2);
                  const float u = __uint_as_float((unsigned)*e << 16); const float val = u * (o[d0][r] + bias); *e = (bf16)(pk2(val, val) & 0xffffu); } }
#pragma unroll
          for (int i = 0; i < 8; ++i) { const int row = i * 4 + (lane >> 4), chk = lane & 15;
              *(v4u*)(MIX + (size_t)(row0 + 32 * qb + row) * MIXW + MX_GM + g * 128 + chk * 8) = *(const LAS v4u*)(ob + row * 272 + chk * 16); }
        }
        __syncthreads();
    }
}

__device__ __forceinline__ void act_fix_phase(KArgs a, int l, int M) {
    Frame F = make_frame(a);
    const float* EDGE = (const float*)(F.ws + WS_EDGE); bf16* ACT = (bf16*)(F.ws + WS_ACT);
    const float* cw = a->in[I_FCW] + (size_t)l * 3 * DFF; const float* cb = a->in[I_FCB] + (size_t)l * DFF;
    constexpr int CG = DFF / 4;
    const int total = (M / 256) * 2 * CG;
    for (int idx = F.bx * NTHR + F.tid; idx < total; idx += F.G * NTHR) {
        const int c0 = (idx % CG) * 4, pw = idx / CG, which = pw & 1, pm = pw >> 1;
        const bool first = pm >= 64 || (pm & 15) == 0, last = pm >= 64 || (pm & 15) == 15;
        const float* e = EDGE + (size_t)pm * 6 * DFF + c0;
        f32x4 prev, cur, next, uu; const f32x4 zero = (f32x4){0.f, 0.f, 0.f, 0.f};
        if (which == 0) { prev = first ? zero : *(const f32x4*)(e - (size_t)6 * DFF + (size_t)3 * DFF); cur = *(const f32x4*)e; next = *(const f32x4*)(e + DFF); uu = *(const f32x4*)(e + (size_t)4 * DFF); }
        else { prev = *(const f32x4*)(e + (size_t)2 * DFF); cur = *(const f32x4*)(e + (size_t)3 * DFF); next = last ? zero : *(const f32x4*)(e + (size_t)6 * DFF); uu = *(const f32x4*)(e + (size_t)5 * DFF); }
        const f32x4 z = *(const f32x4*)(cw + c0) * prev + *(const f32x4*)(cw + DFF + c0) * cur + *(const f32x4*)(cw + 2 * DFF + c0) * next + *(const f32x4*)(cb + c0);
        float o[4];
#pragma unroll
        for (int j = 0; j < 4; ++j) o[j] = z[j] * __builtin_amdgcn_rcpf(1.f + __expf(-z[j])) * uu[j];
        v2u w; w.x = pk2(o[0], o[1]); w.y = pk2(o[2], o[3]);
        *(v2u*)(ACT + (size_t)(pm * 256 + (which ? 255 : 0)) * DFF + c0) = w;
    }
}

constexpr int PH_P0A = 0, PH_P0B = 1, PH_L0 = 2, PH_PER_LAYER = 10, PH_FINAL = PH_L0 + DEPTH * PH_PER_LAYER, N_PHASES = PH_FINAL + 1;

__device__ __forceinline__ void gemm_in_phase(KArgs a, int l) {
    unsigned char* ws = a->ws; extern __shared__ __attribute__((aligned(16))) unsigned char lds_[];
    pg8::Gemm g{(const bf16*)(ws + WS_H), (const bf16*)(ws + WS_WIN) + (size_t)l * PW * DM, MT, PW, DM, DM, DM, 0, 0, 1};
    pg8::StaticOrder S; S.init(MT, PW, gridDim.x, blockIdx.x, DM);
    pg8::EpiBf16 E{(bf16*)(ws + WS_P), PW};
    pg8::gemm_phase<pg8::EpiBf16, pg8::StaticOrder, true, true>((LAS unsigned char*)lds_, g, S, E);
}
__device__ __forceinline__ void gemm_in_probe(KArgs a, int l) {
    unsigned char* ws = a->ws; extern __shared__ __attribute__((aligned(16))) unsigned char lds_[];
    pg8::Gemm g{(const bf16*)(ws + WS_H), (const bf16*)(ws + WS_WIN) + (size_t)l * PW * DM, MT, PW, DM, DM, DM, 0, 0, 1};
    pg8::StaticOrder S; S.init(MT, PW, gridDim.x, blockIdx.x, DM);
    pg8::EpiNone E{};
    pg8::gemm_phase<pg8::EpiNone, pg8::StaticOrder, true, true>((LAS unsigned char*)lds_, g, S, E);
}
__device__ __forceinline__ void gemm_up_phase(KArgs a, int l, int M2) {
    unsigned char* ws = a->ws; extern __shared__ __attribute__((aligned(16))) unsigned char lds_[];
    pg8::Gemm g{(const bf16*)(ws + WS_H), (const bf16*)(ws + WS_WUP) + (size_t)l * UPW * DM, M2, UPW, DM, DM, DM, 0, 0, 1};
    pg8::StaticOrder S; S.init(M2, UPW, gridDim.x, blockIdx.x, DM);
    pg8::EpiUp E{(bf16*)(ws + WS_ACT), (float*)(ws + WS_EDGE), a->in[I_FCW] + (size_t)l * 3 * DFF, a->in[I_FCB] + (size_t)l * DFF, (LAS float*)((LAS unsigned char*)lds_ + XL_OFF), DFF};
    pg8::gemm_phase<pg8::EpiUp, pg8::StaticOrder, true, true>((LAS unsigned char*)lds_, g, S, E);
}
__device__ __forceinline__ void gemm_out_phase(KArgs a, int l, int M2) {
    unsigned char* ws = a->ws; extern __shared__ __attribute__((aligned(16))) unsigned char lds_[];
    pg8::Gemm g{(const bf16*)(ws + WS_MIX), (const bf16*)(ws + WS_WOUT) + (size_t)l * DM * MIXW, M2, DM, MIXW, MIXW, MIXW, 0, 0, 1};
    pg8::SplitOrder S; S.init(ML, (M2 - ML) / 256, DM, gridDim.x, blockIdx.x, MIXW);
    pg8::EpiResGate E{(bf16*)(ws + WS_X), (const float*)(ws + WS_MOD) + (size_t)l * 5 * NMOD, 2 * DM, (float*)(ws + WS_XP), l == 0 ? a->in[I_X] : (const float*)nullptr};
    pg8::gemm_phase<pg8::EpiResGate, pg8::SplitOrder, true, true>((LAS unsigned char*)lds_, g, S, E);
}
__device__ __forceinline__ void gemm_down_phase(KArgs a, int l, int M2) {
    unsigned char* ws = a->ws; extern __shared__ __attribute__((aligned(16))) unsigned char lds_[];
    pg8::Gemm g{(const bf16*)(ws + WS_ACT), (const bf16*)(ws + WS_WDN) + (size_t)l * DM * DFF, M2, DM, DFF, DFF, DFF, 0, 0, 1};
    pg8::SplitOrder S; S.init(ML, (M2 - ML) / 256, DM, gridDim.x, blockIdx.x, DFF);
    pg8::EpiResGate E{(bf16*)(ws + WS_X), (const float*)(ws + WS_MOD) + (size_t)l * 5 * NMOD, 5 * DM, (float*)(ws + WS_XP), (const float*)nullptr};
    pg8::gemm_phase<pg8::EpiResGate, pg8::SplitOrder, true, true>((LAS unsigned char*)lds_, g, S, E);
}
__device__ __forceinline__ void attn_phase(KArgs a, int l, int part, int wg0) {
    unsigned char* ws = a->ws; extern __shared__ __attribute__((aligned(16))) unsigned char lds_[];
    const bf16* QB = (const bf16*)(ws + WS_QB); const bf16* KB = (const bf16*)(ws + WS_KB); const bf16* VB = (const bf16*)(ws + WS_VB); bf16* MIX = (bf16*)(ws + WS_MIX);
    const int G = gridDim.x, bx = blockIdx.x;
    const int xcd = bx & 7, wq = bx >> 3;
    const int ulo = part ? 512 + ((bx - wg0 + G) % G) : bx, uhi = part ? ((l < DEPTH - 1) ? 544 : 0) : 512;
    for (int u = ulo; u < uhi; u += G) {
        int b, h, kvh, qrow, seq;
        if (u < 512) { const int i = u / G; const int j = (G == 256) ? wq + 32 * i : (u >> 3), x = (G == 256) ? xcd : (u & 7);
            b = x >> 1; kvh = x & 1; h = kvh * 4 + (j >> 4); qrow = b * SEQ + (j & 15) * 256; seq = SKV; }
        else { const int c = u - 512; b = c >> 3; h = c & 7; kvh = h >> 2; qrow = ML + b * CTXL; seq = CTXL; }
        att::attn_dense_body(QB + (size_t)qrow * 1024 + h * 128, KB + (size_t)b * SKV * 256 + kvh * 128, VB + (size_t)b * SKV * 256 + kvh * 128,
                             MIX + (size_t)qrow * MIXW + MX_ATT + h * 128, seq, (char*)lds_);
    }
}
__device__ __forceinline__ void dft1_phase(KArgs a, int l) {
    unsigned char* ws = a->ws; extern __shared__ __attribute__((aligned(16))) unsigned char lds_[];
    pg8::Gemm g{(const bf16*)(ws + WS_A1), (const bf16*)(ws + WS_T1T), 256, 65536, 256, 256, 256, 0};
    pg8::StaticOrder S; S.init(256, 65536, gridDim.x, blockIdx.x, 256);
    pg8::EpiS1 E{(bf16*)(ws + WS_S2IN)};
    pg8::gemm_phase<pg8::EpiS1, pg8::StaticOrder, true, true>((LAS unsigned char*)lds_, g, S, E);
}
__device__ __forceinline__ void dft2_phase(KArgs a, int l) {
    unsigned char* ws = a->ws; extern __shared__ __attribute__((aligned(16))) unsigned char lds_[];
    const int G = gridDim.x, bx = blockIdx.x;
    {
        pg8::Gemm g{(const bf16*)(ws + WS_A2), (const bf16*)(ws + WS_S2IN), 4096, 2048, 512, 512, 512, (size_t)2048 * 512 * 2};
        pg8::StaticOrder S; S.init(4096, 2048, G, (bx + G / 2) % G, 512);
        pg8::EpiS2 E{(bf16*)(ws + WS_MIX), 0.0013810679320049757f};
        pg8::gemm_phase<pg8::EpiS2, pg8::StaticOrder, true, true>((LAS unsigned char*)lds_, g, S, E);
    }
    if (l < DEPTH - 1) {
        pg8::Gemm g{(const bf16*)(ws + WS_F256), (const bf16*)(ws + WS_T1TC), CTXL, 2048, 512, 512, 512, 0};
        pg8::StaticOrder S; S.init(CTXL, 2048, G, (bx + G - 96) % G, 512);
        pg8::EpiDft E{(bf16*)(ws + WS_MIX), ML, CTXL, 0.005524271728019903f};
        pg8::gemm_phase<pg8::EpiDft, pg8::StaticOrder, true, true>((LAS unsigned char*)lds_, g, S, E);
    }
}

__global__ void __launch_bounds__(NTHR, 2) hybrid_fwd(Args args_by_value) {
    extern __shared__ __attribute__((aligned(16))) unsigned char lds[];
    (void)args_by_value;
    int lo, hi; unsigned* ctl;
    { KArgs a = kargs(); lo = a->ph_lo; hi = a->ph_hi; ctl = (unsigned*)(a->ws + WS_CTL); }
    volatile LAS unsigned* MISC = (volatile LAS unsigned*)((LAS unsigned char*)lds + MISC_OFF);
    for (int u = threadIdx.x; u < (LDS_BYTES - LDSCTL_OFF) / 4; u += NTHR) ((LAS unsigned*)((LAS unsigned char*)lds + LDSCTL_OFF))[u] = 0u;
    __syncthreads();
    XcdBarrier bar; bar.bar = ctl + CW_BAR; bar.x = 0; bar.st = nullptr;
    if (!MK_PER_PHASE) bar = xcd_barrier_post(ctl + CW_BAR, MISC + 8);
#define IN(k) (lo <= (k) && (k) < hi)
#define SEAM(k) do { if (IN((k) + 1)) { if (MK_PER_PHASE) { if (threadIdx.x == 0) __hip_atomic_store(ctl + CW_TMO, 0xBADBA0u, RLX_AGENT); } else { xcd_barrier(bar); if (DUP(8)) xcd_barrier(bar); } } } while (0)

    for (int rep = 0; rep < (DUP(13) ? 2 : 1); ++rep) {
    if (rep) xcd_barrier(bar);
    if (IN(PH_P0A)) { p0a_prologue(kargs()); if (DUP(0)) p0a_prologue(kargs()); SEAM(PH_P0A); }
    if (IN(PH_P0B)) { p0b_modreduce(kargs()); SEAM(PH_P0B); }

    for (int l = 0; l < DEPTH; ++l) {
        int ph = PH_L0 + l * PH_PER_LAYER;
        const int M2 = (l == DEPTH - 1) ? ML : MT;
#define PHASE(kbit, call) do { if (IN(ph)) { call; if (DUP(kbit)) { if (DUP(15) && !MK_PER_PHASE) xcd_barrier(bar); call; } SEAM(ph); } ++ph; } while (0)
#define MODL ((const float*)(kargs()->ws + WS_MOD) + (size_t)l * 5 * NMOD)
        PHASE(12, norm_phase(kargs(), MT, kargs()->in[I_N1G] + l * DM, MODL, 0 * DM, 1 * DM, l > 0, l == 0, l == 0));
        PHASE(2, gemm_in_phase(kargs(), l));
        if (DUP(11) && IN(ph)) { gemm_in_probe(kargs(), l); xcd_barrier(bar); }
        PHASE(9, postA_phase(kargs(), l));
        PHASE(3, { attn_phase(kargs(), l, 0, 0); dft1_phase(kargs(), l); gate_phase(kargs(), l, 0, (int)gridDim.x, 0, min((int)gridDim.x, (l == DEPTH - 1 ? 128 : 136) * 2)); });
        PHASE(6, { gate_phase(kargs(), l, 0, (int)gridDim.x / 2, (int)gridDim.x, (l == DEPTH - 1 ? 128 : 136) * 2); attn_phase(kargs(), l, 1, 16); dft2_phase(kargs(), l); });
        PHASE(14, gemm_out_phase(kargs(), l, M2));
        PHASE(12, norm_phase(kargs(), M2, kargs()->in[I_N2G] + l * DM, MODL, 3 * DM, 4 * DM, l < DEPTH - 1, false, l == 0));
        PHASE(5, gemm_up_phase(kargs(), l, M2));
        PHASE(10, act_fix_phase(kargs(), l, M2));
        PHASE(14, gemm_down_phase(kargs(), l, M2));
#undef MODL
#undef PHASE
    }
    if (IN(PH_FINAL)) { KArgs a = kargs(); final_norm_phase(a, a->in[I_FNG], a->out); }
    }
#undef IN
#undef SEAM
}

extern "C" void kernel_launch(void* const* d_in, const int* in_sizes, int n_in, void* d_out, int out_size, void* d_ws, size_t ws_size, hipStream_t stream) {
    static int grid = 0;
    if (grid == 0) {
        if (n_in != 22 || out_size != ML * DM || ws_size < WS_END) { fprintf(stderr, "kernel_launch: unexpected shapes: n_in %d out %d ws %zu (need %zu)\n", n_in, out_size, ws_size, (size_t)WS_END); grid = -1; return; }
        int dev = 0, cus = 0, per_cu = 0;
        if (hipGetDevice(&dev) != hipSuccess || hipDeviceGetAttribute(&cus, hipDeviceAttributeMultiprocessorCount, dev) != hipSuccess) { grid = -1; return; }
        if (hipFuncSetAttribute((const void*)hybrid_fwd, hipFuncAttributeMaxDynamicSharedMemorySize, LDS_BYTES) != hipSuccess) { fprintf(stderr, "kernel_launch: hipFuncSetAttribute failed\n"); grid = -1; return; }
        if (hipOccupancyMaxActiveBlocksPerMultiprocessor(&per_cu, (const void*)hybrid_fwd, NTHR, LDS_BYTES) != hipSuccess || per_cu < 1)
            fprintf(stderr, "kernel_launch: occupancy query reports %d workgroups per CU\n", per_cu);
        (void)hipGetLastError();
        grid = cus;
    }
    if (grid < 0) return;
    if (hipMemsetAsync((char*)d_ws + WS_CTL, 0, CTL_ZERO_BYTES, stream) != hipSuccess) return;
    Args a{};
    for (int i = 0; i < 22; ++i) a.in[i] = (const float*)d_in[i];
    a.out = (float*)d_out; a.ws = (unsigned char*)d_ws;
#if MK_PER_PHASE
    for (int ph = 0; ph < N_PHASES; ++ph) { a.ph_lo = ph; a.ph_hi = ph + 1; hipLaunchKernelGGL(hybrid_fwd, dim3(grid), dim3(NTHR), LDS_BYTES, stream, a); }
#else
    a.ph_lo = 0; a.ph_hi = N_PHASES;
    hipLaunchKernelGGL(hybrid_fwd, dim3(grid), dim3(NTHR), LDS_BYTES, stream, a);
#endif
    const hipError_t le = hipPeekAtLastError();
    if (le != hipSuccess) fprintf(stderr, "kernel_launch: launch failed: %s\n", hipGetErrorName(le));
}
```

```cpp
#include <hip/hip_runtime.h>
#include <cstdio>
#include <cstdint>

#ifndef DUPMASK
#define DUPMASK 0
#endif
#define DUP(k) ((DUPMASK >> (k)) & 1)
#ifndef MK_PER_PHASE
#define MK_PER_PHASE 0
#endif

namespace pg8 {
#define PG8_LAS __attribute__((address_space(3)))
typedef unsigned short bf16_t;
typedef short bf16x8 __attribute__((ext_vector_type(8)));
typedef float f32x4 __attribute__((ext_vector_type(4)));
typedef unsigned u32x4 __attribute__((ext_vector_type(4)));
constexpr int BM = 256, BK = 64, HALF = 128, HTB = HALF * BK * 2, STAGE_BYTES = 8 * HTB, NXCD = 8, WGM = 4;

__host__ __device__ __forceinline__ int lds_byte(int r, int c) { const int st = (r >> 4) * 2 + (c >> 5), rr = r & 15, cc = c & 31, ob = rr * 64 + cc * 2; return st * 1024 + (ob ^ (((ob >> 9) & 1) << 5)); }
__host__ __device__ __forceinline__ void stage_rc(int b, int& R, int& C) { const int st = b / 1024, sb = b % 1024, swz = sb ^ (((sb >> 9) & 1) << 5); R = (st >> 1) * 16 + swz / 64; C = (st & 1) * 32 + (swz % 64) / 2; }
__host__ __device__ __forceinline__ int perm32(int rho) { const int n = rho >> 4, i = rho & 15; return 8 * (i >> 2) + 4 * n + (i & 3); }

struct Unit { int pm, pn, kt0, nkt, split; };
struct Gemm { const bf16_t* A; const bf16_t* Bt; int M, N, K, lda, ldb; size_t bpm; int tiledA, tiledB; };

struct StaticOrder {
    int nM, nN, nwg, G, c, ntk;
    __host__ __device__ void init(int M, int N, int G_, int c_, int K) { nM = M / BM; nN = N / BM; nwg = nM * nN; G = G_; c = c_; ntk = K / BK; }
    __host__ __device__ bool next(int i, Unit& u) const {
        const long L = (long)i * G + c; if (L >= nwg) return false;
        return tile((int)L, u);
    }
    __host__ __device__ bool tile(int wgid, Unit& u) const {
        u.kt0 = 0; u.nkt = ntk; u.split = 0; { const int q = nwg / NXCD, r = nwg % NXCD, xcd = wgid % NXCD, off = wgid / NXCD; wgid = (xcd < r ? xcd * (q + 1) : r * (q + 1) + (xcd - r) * q) + off; }
        const int nig = WGM * nN, gid = wgid / nig, fm = gid * WGM, gsz = (nM - fm) < WGM ? (nM - fm) : WGM;
        u.pm = fm + ((wgid % nig) % gsz); u.pn = (wgid % nig) / gsz; return true;
    }
    __device__ __forceinline__ void a_ready(const Unit&) const {}
    __device__ __forceinline__ void done(const Unit&) const {}
};
struct SplitOrder {
    StaticOrder so; int xp, nsplit;
    __host__ __device__ void init(int Mfull, int xpanels, int N, int G_, int c_, int K) { so.init(Mfull, N, G_, c_, K); xp = xpanels; nsplit = xpanels * so.nN * 4; }
    __host__ __device__ bool next(int i, Unit& u) const {
        const int L = i * so.G + so.c; const bool full = L < so.nwg;
        Unit f; so.tile(full ? L : 0, f);
        const int q = L - so.nwg, ks = q & 3, t = q >> 2, qn = so.ntk / 4;
        u.pm = full ? f.pm : so.nM + t / so.nN; u.pn = full ? f.pn : t % so.nN; u.nkt = full ? f.nkt : qn; u.kt0 = full ? 0 : ks * qn; u.split = full ? 0 : 1;
        return full || q < nsplit;
    }
    __device__ __forceinline__ void a_ready(const Unit&) const {}
    __device__ __forceinline__ void done(const Unit&) const {}
};

__device__ __forceinline__ unsigned cvt_pk_bf16(float lo, float hi) { unsigned r; asm volatile("v_cvt_pk_bf16_f32 %0, %1, %2" : "=v"(r) : "v"(lo), "v"(hi)); return r; }

struct EpiNone {
    static constexpr bool PERM = true, AFTER_DRAIN = false;
    __device__ __forceinline__ void operator()(const f32x4 (&acc)[2][2][4][2], const Unit& u, int wr, int wc, int fr, int fq) const {
#pragma unroll
        for (int ai = 0; ai < 2; ++ai)
#pragma unroll
            for (int bj = 0; bj < 2; ++bj)
#pragma unroll
                for (int m = 0; m < 4; ++m)
#pragma unroll
                    for (int n = 0; n < 2; ++n) asm volatile("" :: "v"(acc[ai][bj][m][n]));
    }
};
struct EpiBf16 {
    static constexpr bool PERM = true, AFTER_DRAIN = false;
    bf16_t* O; int ldc;
    __device__ __forceinline__ void operator()(const f32x4 (&acc)[2][2][4][2], const Unit& u, int wr, int wc, int fr, int fq) const {
        const int row0 = u.pm * BM + wr * 64 + fr; const int col0 = u.pn * BM + wc * 32 + 8 * fq;
#pragma unroll
        for (int ai = 0; ai < 2; ++ai)
#pragma unroll
            for (int m = 0; m < 4; ++m) { bf16_t* rowp = O + (size_t)(row0 + ai * HALF + m * 16) * ldc + col0;
#pragma unroll
                for (int bj = 0; bj < 2; ++bj) { const f32x4 v0 = acc[ai][bj][m][0], v1 = acc[ai][bj][m][1];
                    u32x4 w; w.x = cvt_pk_bf16(v0[0], v0[1]); w.y = cvt_pk_bf16(v0[2], v0[3]); w.z = cvt_pk_bf16(v1[0], v1[1]); w.w = cvt_pk_bf16(v1[2], v1[3]);
                    *(u32x4*)(rowp + bj * HALF) = w; } }
    }
};
struct EpiDft {
    static constexpr bool PERM = true, AFTER_DRAIN = false;
    bf16_t* MIX; int rowbase, nper; float scale;
    __device__ __forceinline__ void operator()(const f32x4 (&acc)[2][2][4][2], const Unit& u, int wr, int wc, int fr, int fq) const {
        const int k0 = u.pm * BM + wr * 64 + fr; const int n0 = u.pn * BM + wc * 32 + 8 * fq;
#pragma unroll
        for (int ai = 0; ai < 2; ++ai)
#pragma unroll
            for (int m = 0; m < 4; ++m) { const int k = k0 + ai * HALF + m * 16;
#pragma unroll
                for (int bj = 0; bj < 2; ++bj) { const int n = n0 + bj * HALF; const int b = n >> 9, gd = n & 511;
                    const f32x4 v0 = acc[ai][bj][m][0] * scale, v1 = acc[ai][bj][m][1] * scale;
                    u32x4 w; w.x = cvt_pk_bf16(v0[0], v0[1]); w.y = cvt_pk_bf16(v0[2], v0[3]); w.z = cvt_pk_bf16(v1[0], v1[1]); w.w = cvt_pk_bf16(v1[2], v1[3]);
                    *(u32x4*)(MIX + (size_t)(rowbase + b * nper + k) * 2560 + 1024 + gd) = w; } }
    }
};

struct EpiS1 {
    static constexpr bool PERM = true, AFTER_DRAIN = false;
    bf16_t* S2;
    __device__ __forceinline__ void operator()(const f32x4 (&acc)[2][2][4][2], const Unit& u, int wr, int wc, int fr, int fq) const {
        const int m0 = wr * 64 + fr; const int n0 = u.pn * BM + wc * 32 + 8 * fq;
#pragma unroll
        for (int ai = 0; ai < 2; ++ai)
#pragma unroll
            for (int mm = 0; mm < 4; ++mm) { const int m = m0 + mm * 16; const int k2 = m >> 1, ro = m & 1;
#pragma unroll
                for (int bj = 0; bj < 2; ++bj) { const int np = n0 + bj * HALF; const int n = np >> 5, c = ai * 32 + (np & 31);
                    const f32x4 v0 = acc[ai][bj][mm][0], v1 = acc[ai][bj][mm][1];
                    u32x4 w; w.x = cvt_pk_bf16(v0[0], v0[1]); w.y = cvt_pk_bf16(v0[2], v0[3]); w.z = cvt_pk_bf16(v1[0], v1[1]); w.w = cvt_pk_bf16(v1[2], v1[3]);
                    *(u32x4*)(S2 + ((((size_t)(k2 >> 2) * 2048 + n) * 4 + (k2 & 3)) * 2 + ro) * 64 + c) = w; } }
    }
};
struct EpiS2 {
    static constexpr bool PERM = true, AFTER_DRAIN = false;
    bf16_t* MIX; float scale;
    __device__ __forceinline__ void operator()(const f32x4 (&acc)[2][2][4][2], const Unit& u, int wr, int wc, int fr, int fq) const {
        const int m0 = wr * 64 + fr; const int n0 = u.pn * BM + wc * 32 + 8 * fq;
#pragma unroll
        for (int ai = 0; ai < 2; ++ai)
#pragma unroll
            for (int mm = 0; mm < 4; ++mm) { const int m = ai * HALF + m0 + mm * 16; const int k = 4 * u.pm + (m >> 6) + 64 * (m & 63);
#pragma unroll
                for (int bj = 0; bj < 2; ++bj) { const int n = n0 + bj * HALF; const int b = n >> 9, gd = n & 511;
                    const f32x4 v0 = acc[ai][bj][mm][0] * scale, v1 = acc[ai][bj][mm][1] * scale;
                    u32x4 w; w.x = cvt_pk_bf16(v0[0], v0[1]); w.y = cvt_pk_bf16(v0[2], v0[3]); w.z = cvt_pk_bf16(v1[0], v1[1]); w.w = cvt_pk_bf16(v1[2], v1[3]);
                    *(u32x4*)(MIX + (size_t)(b * 4096 + k) * 2560 + 1024 + gd) = w; } }
    }
};
struct EpiResGate {
    static constexpr bool PERM = true, AFTER_DRAIN = false;
    bf16_t* X; const float* modl; int goff; float* XP; const float* basef;
    __device__ __forceinline__ void operator()(const f32x4 (&acc)[2][2][4][2], const Unit& u, int wr, int wc, int fr, int fq) const {
        const int row0 = u.pm * BM + wr * 64 + fr, col0 = u.pn * BM + wc * 32 + 8 * fq;
        const int v = u.pm < 64 ? (u.pm >> 4) : 4;
        const float* gate = modl + (size_t)v * 12288 + goff;
        f32x4 gv[2][2];
#pragma unroll
        for (int bj = 0; bj < 2; ++bj)
#pragma unroll
            for (int n = 0; n < 2; ++n) gv[bj][n] = *(const f32x4*)(gate + col0 + bj * HALF + n * 4);
#pragma unroll
        for (int ai = 0; ai < 2; ++ai)
#pragma unroll
            for (int m = 0; m < 4; ++m) { const size_t ro = (size_t)(row0 + ai * HALF + m * 16) * 2048 + col0;
#pragma unroll
                for (int bj = 0; bj < 2; ++bj) { const size_t o = ro + bj * HALF; const f32x4 d0 = gv[bj][0] * acc[ai][bj][m][0], d1 = gv[bj][1] * acc[ai][bj][m][1];
                    if (u.split) { float* xp = XP + ((size_t)(u.kt0 / u.nkt) * 1024 + (row0 + ai * HALF + m * 16 - 16384)) * 2048 + col0 + bj * HALF;
                        *(f32x4*)xp = d0; *(f32x4*)(xp + 4) = d1; }
                    else { f32x4 b0, b1;
                        if (basef) { b0 = *(const f32x4*)(basef + o); b1 = *(const f32x4*)(basef + o + 4); }
                        else { const u32x4 w = *(const u32x4*)(X + o);
                            b0 = (f32x4){__uint_as_float(w.x << 16), __uint_as_float(w.x & 0xffff0000u), __uint_as_float(w.y << 16), __uint_as_float(w.y & 0xffff0000u)};
                            b1 = (f32x4){__uint_as_float(w.z << 16), __uint_as_float(w.z & 0xffff0000u), __uint_as_float(w.w << 16), __uint_as_float(w.w & 0xffff0000u)}; }
                        const f32x4 x0 = b0 + d0, x1 = b1 + d1; u32x4 wo; wo.x = cvt_pk_bf16(x0[0], x0[1]); wo.y = cvt_pk_bf16(x0[2], x0[3]); wo.z = cvt_pk_bf16(x1[0], x1[1]); wo.w = cvt_pk_bf16(x1[2], x1[3]);
                        *(u32x4*)(X + o) = wo; } } }
    }
};


__device__ __forceinline__ float dpp_ror1(float x)  { return __builtin_bit_cast(float, __builtin_amdgcn_update_dpp(0, __builtin_bit_cast(int, x), 0x121, 0xF, 0xF, false)); }
__device__ __forceinline__ float dpp_ror15(float x) { return __builtin_bit_cast(float, __builtin_amdgcn_update_dpp(0, __builtin_bit_cast(int, x), 0x12F, 0xF, 0xF, false)); }
__device__ __forceinline__ f32x4 ror1v(const f32x4 v)  { return (f32x4){dpp_ror1(v[0]), dpp_ror1(v[1]), dpp_ror1(v[2]), dpp_ror1(v[3])}; }
__device__ __forceinline__ f32x4 ror15v(const f32x4 v) { return (f32x4){dpp_ror15(v[0]), dpp_ror15(v[1]), dpp_ror15(v[2]), dpp_ror15(v[3])}; }
struct EpiUp {
    static constexpr bool PERM = true, AFTER_DRAIN = false;
    bf16_t* ACT; float* EDGE; const float* cw; const float* cb; PG8_LAS float* xl; int dff;
    __device__ __forceinline__ void operator()(const f32x4 (&acc)[2][2][4][2], const Unit& u, int wr, int wc, int fr, int fq) const {
        const int ch0 = u.pn * 128 + wc * 32 + 8 * fq;
        f32x4 w0[2], w1[2], w2[2], bb[2];
#pragma unroll
        for (int n = 0; n < 2; ++n) { w0[n] = *(const f32x4*)(cw + ch0 + 4 * n); w1[n] = *(const f32x4*)(cw + dff + ch0 + 4 * n); w2[n] = *(const f32x4*)(cw + 2 * dff + ch0 + 4 * n); bb[n] = *(const f32x4*)(cb + ch0 + 4 * n); }
#pragma unroll
        for (int ai = 0; ai < 2; ++ai)
#pragma unroll
            for (int n = 0; n < 2; ++n) {
                if (fr == 0)  *(PG8_LAS f32x4*)(xl + ((((wr * 4 + wc) * 2 + ai) * 2 + 0) * 32) + 8 * fq + 4 * n) = acc[ai][0][0][n];
                if (fr == 15) *(PG8_LAS f32x4*)(xl + ((((wr * 4 + wc) * 2 + ai) * 2 + 1) * 32) + 8 * fq + 4 * n) = acc[ai][0][3][n];
            }
        { float* eg = EDGE + (size_t)u.pm * 6 * dff + ch0;
          if (wr == 0 && fr < 2) {
#pragma unroll
              for (int n = 0; n < 2; ++n) { *(f32x4*)(eg + (size_t)fr * dff + 4 * n) = acc[0][0][0][n]; if (fr == 0) *(f32x4*)(eg + (size_t)4 * dff + 4 * n) = acc[0][1][0][n]; } }
          if (wr == 1 && fr >= 14) {
#pragma unroll
              for (int n = 0; n < 2; ++n) { *(f32x4*)(eg + (size_t)(fr - 12) * dff + 4 * n) = acc[1][0][3][n]; if (fr == 15) *(f32x4*)(eg + (size_t)5 * dff + 4 * n) = acc[1][1][3][n]; } }
        }
        asm volatile("s_waitcnt lgkmcnt(0)" ::: "memory"); __builtin_amdgcn_s_barrier(); asm volatile("" ::: "memory");
        f32x4 pe[2][2], ne[2][2];
#pragma unroll
        for (int ai = 0; ai < 2; ++ai)
#pragma unroll
            for (int n = 0; n < 2; ++n) {
                const bool hp = (wr == 1) || (ai == 1), hn = (wr == 0) || (ai == 0);
                const int pai = (wr == 1) ? ai : ai - 1, nai = (wr == 0) ? ai : ai + 1;
                pe[ai][n] = hp ? *(const PG8_LAS f32x4*)(xl + (((((wr ^ 1) * 4 + wc) * 2 + pai) * 2 + 1) * 32) + 8 * fq + 4 * n) : (f32x4){0.f, 0.f, 0.f, 0.f};
                ne[ai][n] = hn ? *(const PG8_LAS f32x4*)(xl + (((((wr ^ 1) * 4 + wc) * 2 + nai) * 2 + 0) * 32) + 8 * fq + 4 * n) : (f32x4){0.f, 0.f, 0.f, 0.f};
            }
        const int row0 = u.pm * BM + wr * 64 + fr;
#pragma unroll
        for (int ai = 0; ai < 2; ++ai)
#pragma unroll
            for (int m = 0; m < 4; ++m) {
                float z[8], t[8];
#pragma unroll
                for (int n = 0; n < 2; ++n) {
                    const f32x4 g = acc[ai][0][m][n];
                    const f32x4 gp = (m > 0) ? acc[ai][0][m > 0 ? m - 1 : 0][n] : pe[ai][n];
                    const f32x4 gn = (m < 3) ? acc[ai][0][m < 3 ? m + 1 : 3][n] : ne[ai][n];
                    const f32x4 zz = w1[n] * g + bb[n];
#pragma unroll
                    for (int j = 0; j < 4; ++j) { float zj = zz[j];
                        if ((m == 0 || m == 3) && n == 0 && j == 0)
                            asm("s_nop 1\n\t"
                                "v_fmac_f32_dpp %0, %1, %4 row_shr:1 row_mask:0xf bank_mask:0xf\n\t"
                                "v_fmac_f32_dpp %0, %2, %4 row_shl:15 row_mask:0xf bank_mask:0xf\n\t"
                                "v_fmac_f32_dpp %0, %1, %5 row_shl:1 row_mask:0xf bank_mask:0xf\n\t"
                                "v_fmac_f32_dpp %0, %3, %5 row_shr:15 row_mask:0xf bank_mask:0xf"
                                : "+v"(zj) : "v"(g[j]), "v"(gp[j]), "v"(gn[j]), "v"(w0[n][j]), "v"(w2[n][j]));
                        else
                            asm("v_fmac_f32_dpp %0, %1, %4 row_shr:1 row_mask:0xf bank_mask:0xf\n\t"
                                "v_fmac_f32_dpp %0, %2, %4 row_shl:15 row_mask:0xf bank_mask:0xf\n\t"
                                "v_fmac_f32_dpp %0, %1, %5 row_shl:1 row_mask:0xf bank_mask:0xf\n\t"
                                "v_fmac_f32_dpp %0, %3, %5 row_shr:15 row_mask:0xf bank_mask:0xf"
                                : "+v"(zj) : "v"(g[j]), "v"(gp[j]), "v"(gn[j]), "v"(w0[n][j]), "v"(w2[n][j]));
                        z[n * 4 + j] = zj; }
                }
#pragma unroll
                for (int i = 0; i < 8; ++i) t[i] = -1.4426950408889634f * z[i];
#pragma unroll
                for (int i = 0; i < 8; ++i) t[i] = __builtin_amdgcn_exp2f(t[i]);
#pragma unroll
                for (int i = 0; i < 8; ++i) t[i] = 1.f + t[i];
#pragma unroll
                for (int i = 0; i < 8; ++i) t[i] = __builtin_amdgcn_rcpf(t[i]);
#pragma unroll
                for (int i = 0; i < 8; ++i) t[i] = z[i] * t[i] * acc[ai][1][m][i >> 2][i & 3];
                u32x4 w; w.x = cvt_pk_bf16(t[0], t[1]); w.y = cvt_pk_bf16(t[2], t[3]); w.z = cvt_pk_bf16(t[4], t[5]); w.w = cvt_pk_bf16(t[6], t[7]);
                *(u32x4*)(ACT + (size_t)(row0 + ai * HALF + m * 16) * dff + ch0) = w;
            }
    }
};

template <class Epi, class Sched, bool ALIGN_EPI = false, bool SP2 = false>
__device__ __forceinline__ void gemm_phase(PG8_LAS unsigned char* lds, const Gemm g, const Sched& S, const Epi& E) {
    int tid_ = threadIdx.x; asm volatile("" : "+v"(tid_));
    const int tid = tid_, wid = __builtin_amdgcn_readfirstlane(tid >> 6), lane = tid & 63, wr = wid >> 2, wc = wid & 3, fr = lane & 15, fq = lane >> 4;
    unsigned voffA[2], voffB[2];
#pragma unroll
    for (int i = 0; i < 2; ++i) { int R, C; stage_rc(tid * 16 + i * 8192, R, C); const int Rb = Epi::PERM ? ((R & ~31) + perm32(R & 31)) : R;
        voffA[i] = (unsigned)(R * (g.tiledA ? BK : g.lda) + C) * 2u; voffB[i] = (unsigned)(Rb * (g.tiledB ? BK : g.ldb) + C) * 2u; }
    const size_t kstepA = g.tiledA ? (size_t)BM * BK * 2 : (size_t)(BK * 2), kstepB = g.tiledB ? (size_t)BM * BK * 2 : (size_t)(BK * 2);
    const size_t hstepA = (size_t)HALF * (g.tiledA ? BK : g.lda) * 2, hstepB = (size_t)HALF * (g.tiledB ? BK : g.ldb) * 2;
    const size_t tstepA = g.tiledA ? (size_t)(g.K / BK) * BM * BK * 2 : 2 * hstepA, tstepB = g.tiledB ? (size_t)(g.K / BK) * BM * BK * 2 : 2 * hstepB;
    const unsigned ldsw = (unsigned)wid * 1024u;
    const int aoff = lds_byte(wr * 64 + fr, fq * 8), boff = lds_byte(wc * 32 + fr, fq * 8);
#define PG8_SA(b, h) (((b) * 2 + (h)) * HTB)
#define PG8_SB(b, h) ((4 + (b) * 2 + (h)) * HTB)
#define PG8_STAGE(bufoff, gbase, voff) do { _Pragma("unroll") for (int _i = 0; _i < 2; ++_i) \
        __builtin_amdgcn_global_load_lds((const unsigned*)((const char*)(gbase) + (voff)[_i]), (PG8_LAS unsigned*)(lds + (bufoff) + ldsw + _i * 8192), 16, 0, 0); } while (0)
#define PG8_LDA(dst, b, h) do { _Pragma("unroll") for (int m = 0; m < 4; ++m) _Pragma("unroll") for (int k = 0; k < 2; ++k) dst[m][k] = *(const PG8_LAS bf16x8*)(lds + PG8_SA(b, h) + aoff + m * 2048 + k * 1024); } while (0)
#define PG8_LDB(dst, b, h) do { _Pragma("unroll") for (int n = 0; n < 2; ++n) _Pragma("unroll") for (int k = 0; k < 2; ++k) dst[n][k] = *(const PG8_LAS bf16x8*)(lds + PG8_SB(b, h) + boff + n * 2048 + k * 1024); } while (0)
#define PG8_MMA(ai, bj, At, Bt) do { __builtin_amdgcn_s_setprio(1); _Pragma("unroll") for (int m = 0; m < 4; ++m) _Pragma("unroll") for (int n = 0; n < 2; ++n) _Pragma("unroll") for (int k = 0; k < 2; ++k) \
        acc[ai][bj][m][n] = __builtin_amdgcn_mfma_f32_16x16x32_bf16(Bt[n][k], At[m][k], acc[ai][bj][m][n], 0, 0, 0); __builtin_amdgcn_s_setprio(0); } while (0)
#define PG8_WAIT_V(n) asm volatile("s_waitcnt vmcnt(" #n ")" ::: "memory")
#define PG8_WAIT_L(n) asm volatile("s_waitcnt lgkmcnt(" #n ")" ::: "memory")
#define PG8_BAR __builtin_amdgcn_s_barrier()
#define PG8_SCHED __builtin_amdgcn_sched_barrier(0)
    Unit cur, nxt; int ui = 0;
    if (!S.next(0, cur)) return;
    f32x4 acc[2][2][4][2];
#pragma unroll
    for (int a = 0; a < 2; ++a)
#pragma unroll
        for (int b = 0; b < 2; ++b)
#pragma unroll
            for (int m = 0; m < 4; ++m)
#pragma unroll
                for (int n = 0; n < 2; ++n) acc[a][b][m][n] = (f32x4){0.f, 0.f, 0.f, 0.f};
    bf16x8 At[4][2], B0[2][2], B1[2][2];
    const char* cA = (const char*)g.A + (size_t)cur.pm * tstepA + (size_t)cur.kt0 * kstepA; const char* cB = (const char*)g.Bt + (size_t)cur.pm * g.bpm + (size_t)cur.pn * tstepB + (size_t)cur.kt0 * kstepB;
    int nt = cur.nkt;
    S.a_ready(cur);
    if constexpr (SP2) {
        PG8_STAGE(PG8_SB(0, 0), cB, voffB); PG8_STAGE(PG8_SB(0, 1), cB + hstepB, voffB); PG8_STAGE(PG8_SA(0, 0), cA, voffA); PG8_STAGE(PG8_SA(0, 1), cA + hstepA, voffA);
        if (wr == 1) PG8_BAR;
        PG8_WAIT_V(2); PG8_BAR;
        PG8_STAGE(PG8_SB(1, 0), cB + kstepB, voffB); PG8_STAGE(PG8_SA(1, 0), cA + kstepA, voffA); PG8_STAGE(PG8_SB(1, 1), cB + hstepB + kstepB, voffB);
        PG8_WAIT_V(6); PG8_BAR;
    } else {
        PG8_STAGE(PG8_SB(0, 0), cB, voffB); PG8_STAGE(PG8_SA(0, 0), cA, voffA); PG8_STAGE(PG8_SB(0, 1), cB + hstepB, voffB); PG8_STAGE(PG8_SA(0, 1), cA + hstepA, voffA);
        if (wr == 1) PG8_BAR;
        PG8_WAIT_V(4); PG8_BAR;
        PG8_STAGE(PG8_SB(1, 0), cB + kstepB, voffB); PG8_STAGE(PG8_SA(1, 0), cA + kstepA, voffA); PG8_STAGE(PG8_SB(1, 1), cB + hstepB + kstepB, voffB);
        PG8_WAIT_V(6); PG8_BAR;
    }
    for (;;) {
        const bool has_next = S.next(ui + 1, nxt);
        const char* nA = has_next ? (const char*)g.A + (size_t)nxt.pm * tstepA + (size_t)nxt.kt0 * kstepA : cA; const char* nB = has_next ? (const char*)g.Bt + (size_t)nxt.pm * g.bpm + (size_t)nxt.pn * tstepB + (size_t)nxt.kt0 * kstepB : cB;
        for (int t = 0; t < nt; t += 2) {
            const bool last = (t == nt - 2);
            const char* a1 = cA + (size_t)(t + 1) * kstepA;
            const char* a2 = last ? nA : cA + (size_t)(t + 2) * kstepA; const char* b2 = last ? nB : cB + (size_t)(t + 2) * kstepB;
            const char* a3 = a2 + kstepA; const char* b3 = b2 + kstepB;
            if (last && has_next) S.a_ready(nxt);
            if constexpr (SP2) {
            PG8_LDB(B0, 0, 0); PG8_LDB(B1, 0, 1); PG8_SCHED; PG8_LDA(At, 0, 0); PG8_STAGE(PG8_SA(1, 1), a1 + hstepA, voffA);
            PG8_WAIT_V(8); PG8_WAIT_L(0); PG8_BAR; PG8_MMA(0, 0, At, B0); PG8_MMA(0, 1, At, B1); PG8_BAR; PG8_SCHED;
            PG8_LDA(At, 0, 1); PG8_STAGE(PG8_SB(0, 0), b2, voffB); PG8_STAGE(PG8_SB(0, 1), b2 + hstepB, voffB); PG8_STAGE(PG8_SA(0, 0), a2, voffA);
            PG8_WAIT_V(8); PG8_WAIT_L(0); PG8_BAR; PG8_MMA(1, 0, At, B0); PG8_MMA(1, 1, At, B1); PG8_BAR; PG8_SCHED;
            PG8_LDB(B0, 1, 0); PG8_LDB(B1, 1, 1); PG8_SCHED; PG8_LDA(At, 1, 0); PG8_STAGE(PG8_SA(0, 1), a2 + hstepA, voffA);
            PG8_WAIT_V(8); PG8_WAIT_L(0); PG8_BAR; PG8_MMA(0, 0, At, B0); PG8_MMA(0, 1, At, B1); PG8_BAR; PG8_SCHED;
            PG8_LDA(At, 1, 1); PG8_STAGE(PG8_SB(1, 0), b3, voffB); PG8_STAGE(PG8_SB(1, 1), b3 + hstepB, voffB); PG8_STAGE(PG8_SA(1, 0), a3, voffA);
            PG8_WAIT_V(8); PG8_WAIT_L(0); PG8_BAR; PG8_MMA(1, 0, At, B0); PG8_MMA(1, 1, At, B1); PG8_BAR; PG8_SCHED;
            } else {
            PG8_LDB(B0, 0, 0); PG8_SCHED; PG8_LDA(At, 0, 0); PG8_STAGE(PG8_SA(1, 1), a1 + hstepA, voffA);
            PG8_WAIT_L(8); PG8_BAR; PG8_WAIT_L(0); PG8_MMA(0, 0, At, B0); PG8_BAR; PG8_SCHED;
            PG8_LDB(B1, 0, 1); PG8_STAGE(PG8_SB(0, 0), b2, voffB);
            PG8_BAR; PG8_WAIT_L(0); PG8_MMA(0, 1, At, B1); PG8_BAR;
            PG8_LDA(At, 0, 1); PG8_STAGE(PG8_SA(0, 0), a2, voffA);
            PG8_BAR; PG8_WAIT_L(0); PG8_MMA(1, 0, At, B0); PG8_BAR; PG8_SCHED;
            PG8_STAGE(PG8_SB(0, 1), b2 + hstepB, voffB);
            PG8_WAIT_V(6); PG8_BAR; PG8_MMA(1, 1, At, B1); PG8_BAR;
            PG8_LDB(B0, 1, 0); PG8_SCHED; PG8_LDA(At, 1, 0); PG8_STAGE(PG8_SA(0, 1), a2 + hstepA, voffA);
            PG8_WAIT_L(8); PG8_BAR; PG8_WAIT_L(0); PG8_MMA(0, 0, At, B0); PG8_BAR; PG8_SCHED;
            PG8_LDB(B1, 1, 1); PG8_STAGE(PG8_SB(1, 0), b3, voffB);
            PG8_BAR; PG8_WAIT_L(0); PG8_MMA(0, 1, At, B1); PG8_BAR;
            PG8_LDA(At, 1, 1); PG8_STAGE(PG8_SA(1, 0), a3, voffA);
            PG8_BAR; PG8_WAIT_L(0); PG8_MMA(1, 0, At, B0); PG8_BAR; PG8_SCHED;
            PG8_STAGE(PG8_SB(1, 1), b3 + hstepB, voffB);
            PG8_WAIT_V(6); PG8_BAR; PG8_MMA(1, 1, At, B1); PG8_BAR;
            }
        }
        if constexpr (ALIGN_EPI) { if (wr == 0) PG8_BAR; }
        if constexpr (!Epi::AFTER_DRAIN) { E(acc, cur, wr, wc, fr, fq); S.done(cur); }
        if (!has_next) break;
#pragma unroll
        for (int a = 0; a < 2; ++a)
#pragma unroll
            for (int b = 0; b < 2; ++b)
#pragma unroll
                for (int m = 0; m < 4; ++m)
#pragma unroll
                    for (int n = 0; n < 2; ++n) acc[a][b][m][n] = (f32x4){0.f, 0.f, 0.f, 0.f};
        cur = nxt; cA = nA; cB = nB; nt = cur.nkt; ++ui;
        if constexpr (ALIGN_EPI) { if (wr == 1) PG8_BAR; }
    }
    PG8_WAIT_V(0);
    if constexpr (!ALIGN_EPI) { if (wr == 0) PG8_BAR; }
    PG8_BAR;
#undef PG8_SA
#undef PG8_SB
#undef PG8_STAGE
#undef PG8_LDA
#undef PG8_LDB
#undef PG8_MMA
#undef PG8_WAIT_V
#undef PG8_WAIT_L
#undef PG8_BAR
#undef PG8_SCHED
}
}

namespace att {
typedef unsigned short bf16;
constexpr int   D = 128, NW = 8, QBLK = 32, KVBLK = 64;
constexpr float SCALE = 0.088388347648318440f;
constexpr float THR = 8.f;
constexpr int LDQ = 1024, LDK = 256, LDO = 2560;
constexpr size_t SHM_V = KVBLK * D * 2, SHM_K = KVBLK * D * 2, SHM_ATTN = 2 * SHM_V + 2 * SHM_K + NW * 64 * 4;
using bf16x8 = __attribute__((ext_vector_type(8))) short;
using s16x4  = __attribute__((ext_vector_type(4))) short;
using f32x16 = __attribute__((ext_vector_type(16))) float;
using u32x4  = __attribute__((ext_vector_type(4))) unsigned;
#define KSWZ(row, colB) ((row) * 256 + ((colB) ^ (((row) & 7) << 4)))
#define SBAR() __builtin_amdgcn_sched_barrier(0)
__device__ __forceinline__ int crow(int r, int hi) { return (r & 3) + 8 * (r >> 2) + 4 * hi; }
__device__ __forceinline__ unsigned cvtpk(float lo, float hi) { unsigned r; asm volatile("v_cvt_pk_bf16_f32 %0, %1, %2" : "=v"(r) : "v"(lo), "v"(hi)); return r; }
__device__ __forceinline__ bf16x8 ld8(const bf16* p) { return *reinterpret_cast<const bf16x8*>(p); }

__device__ __forceinline__ void partialSM(f32x16& p0, f32x16& p1, float& m_reg, float& mn, float& alpha) {
  constexpr float C = SCALE * 1.4426950408889634f;
  float pmax = p0[0]; for (int r = 1; r < 16; ++r) pmax = fmaxf(pmax, p0[r]); for (int r = 0; r < 16; ++r) pmax = fmaxf(pmax, p1[r]);
  { auto rr = __builtin_amdgcn_permlane32_swap(__float_as_uint(pmax), __float_as_uint(pmax), false, false);
    pmax = fmaxf(__uint_as_float(rr[0]), __uint_as_float(rr[1])); }
  if (__builtin_expect(__all(pmax - m_reg <= THR / SCALE), 1)) { mn = m_reg; alpha = 1.f; }
  else { mn = fmaxf(m_reg, pmax); alpha = __builtin_amdgcn_exp2f((m_reg - mn) * C); m_reg = mn; }
  float mnC = -mn * C;
  for (int r = 0; r < 16; ++r) p0[r] = fmaf(p0[r], C, mnC); for (int r = 0; r < 16; ++r) p1[r] = fmaf(p1[r], C, mnC);
  for (int r = 0; r < 16; ++r) p0[r] = __builtin_amdgcn_exp2f(p0[r]);
}
__device__ __forceinline__ void finishSM(f32x16& p0, f32x16& p1, float alpha, float& l_reg, bf16x8& pa0, bf16x8& pa1, bf16x8& pa2, bf16x8& pa3) {
  for (int r = 0; r < 16; ++r) p1[r] = __builtin_amdgcn_exp2f(p1[r]);
  float ps = 0; for (int r = 0; r < 16; ++r) ps += p0[r]; for (int r = 0; r < 16; ++r) ps += p1[r];
  { auto rr = __builtin_amdgcn_permlane32_swap(__float_as_uint(ps), __float_as_uint(ps), false, false);
    ps = __uint_as_float(rr[0]) + __uint_as_float(rr[1]); }
  l_reg = l_reg * alpha + ps;
#define PK4(P, BASE, OUT) do { unsigned a0 = cvtpk(P[BASE + 0], P[BASE + 1]), a1 = cvtpk(P[BASE + 2], P[BASE + 3]);   \
    unsigned b0 = cvtpk(P[BASE + 4], P[BASE + 5]), b1 = cvtpk(P[BASE + 6], P[BASE + 7]);                              \
    auto r0 = __builtin_amdgcn_permlane32_swap(a0, b0, false, false); auto r1 = __builtin_amdgcn_permlane32_swap(a1, b1, false, false); \
    u32x4 w = {r0[0], r1[0], r0[1], r1[1]}; OUT = *reinterpret_cast<bf16x8*>(&w); } while (0)
  PK4(p0, 0, pa0); PK4(p0, 8, pa1); PK4(p1, 0, pa2); PK4(p1, 8, pa3);
#undef PK4
}
__device__ __forceinline__ void qkt(f32x16& p0, f32x16& p1, const bf16* Ks, const bf16x8* qr, int r32, int hi) {
  p0 = f32x16{}; p1 = f32x16{};
  for (int d0 = 0; d0 < 8; ++d0) { int cb = (d0 * 16 + hi * 8) * 2;
    bf16x8 b0 = *reinterpret_cast<const bf16x8*>((const char*)Ks + KSWZ(r32, cb));
    bf16x8 b1 = *reinterpret_cast<const bf16x8*>((const char*)Ks + KSWZ(32 + r32, cb));
    p0 = __builtin_amdgcn_mfma_f32_32x32x16_bf16(b0, qr[d0], p0, 0, 0, 0);
    p1 = __builtin_amdgcn_mfma_f32_32x32x16_bf16(b1, qr[d0], p1, 0, 0, 0); }
}
__device__ __forceinline__ int v_st(int k, int c) { const int kk = (k & ~0xC) | ((k & 4) << 1) | ((k & 8) >> 1); return ((kk >> 3) * 4 + (c >> 5)) * 512 + ((kk & 7) * 32 + (c & 31)) * 2; }
__device__ __forceinline__ int v_rd_base(int lane) { return ((lane & 3) << 3) | (((lane >> 2) & 3) << 6) | (((lane >> 4) & 1) << 5) | (((lane >> 5) & 1) << 8); }
constexpr int v_rd_off(int d0, int ks, int half) { return d0 * 512 + ks * 4096 + half * 2048; }
template <int OFF> __device__ __forceinline__ s16x4 tr_read(int vb) {
  s16x4 r; asm volatile("ds_read_b64_tr_b16 %0, %1 offset:%2" : "=&v"(r) : "v"(vb), "i"(OFF) : "memory"); return r;
}
template <int D0> __device__ __forceinline__ void pv_one(f32x16& od, int vb, bf16x8 pa0, bf16x8 pa1, bf16x8 pa2, bf16x8 pa3) {
  const s16x4 l0 = tr_read<v_rd_off(D0, 0, 0)>(vb), h0 = tr_read<v_rd_off(D0, 0, 1)>(vb), l1 = tr_read<v_rd_off(D0, 1, 0)>(vb), h1 = tr_read<v_rd_off(D0, 1, 1)>(vb);
  const s16x4 l2 = tr_read<v_rd_off(D0, 2, 0)>(vb), h2 = tr_read<v_rd_off(D0, 2, 1)>(vb), l3 = tr_read<v_rd_off(D0, 3, 0)>(vb), h3 = tr_read<v_rd_off(D0, 3, 1)>(vb);
  asm volatile("s_waitcnt lgkmcnt(0)" ::: "memory"); SBAR();
#define PK(L, H) (bf16x8){L[0], L[1], L[2], L[3], H[0], H[1], H[2], H[3]}
  od = __builtin_amdgcn_mfma_f32_32x32x16_bf16(pa0, PK(l0, h0), od, 0, 0, 0);
  od = __builtin_amdgcn_mfma_f32_32x32x16_bf16(pa1, PK(l1, h1), od, 0, 0, 0);
  od = __builtin_amdgcn_mfma_f32_32x32x16_bf16(pa2, PK(l2, h2), od, 0, 0, 0);
  od = __builtin_amdgcn_mfma_f32_32x32x16_bf16(pa3, PK(l3, h3), od, 0, 0, 0);
#undef PK
}
__device__ __forceinline__ void pv_d0(f32x16* o, int vb, bf16x8 pa0, bf16x8 pa1, bf16x8 pa2, bf16x8 pa3) {
  pv_one<0>(o[0], vb, pa0, pa1, pa2, pa3); pv_one<1>(o[1], vb, pa0, pa1, pa2, pa3); pv_one<2>(o[2], vb, pa0, pa1, pa2, pa3); pv_one<3>(o[3], vb, pa0, pa1, pa2, pa3);
}

__device__ __forceinline__ void attn_dense_body(const bf16* __restrict__ Qb, const bf16* __restrict__ Kh, const bf16* __restrict__ Vh,
                                                bf16* __restrict__ Ob, int seq, char* lds) {
  constexpr int SDEPTH = 2;
  int tid_ = threadIdx.x; asm volatile("" : "+v"(tid_));
  const int tid = tid_, wid = tid >> 6, lane = tid & 63, r32 = lane & 31, hi = lane >> 5;
  bf16* V_lds = (bf16*)lds; bf16* K_lds = (bf16*)(lds + 2 * SHM_V);
  float* ws = (float*)(lds + 2 * SHM_V + 2 * SHM_K) + wid * 64; float* li_l = ws; float* al_l = ws + 32;
  float m_reg = -1e30f, l_reg = 0; f32x16 o[4] = {}; bf16x8 qr[8];
  const bf16* Qw = Qb + (long)(wid * QBLK + r32) * LDQ + hi * 8;
#pragma unroll
  for (int d0 = 0; d0 < 8; ++d0) qr[d0] = ld8(Qw + d0 * 16);
  const int sr = tid >> 4, sc = (tid & 15) * 8, vst0 = v_st(sr, sc), vst1 = v_st(32 + sr, sc);
  const int vb0 = (int)(uintptr_t)V_lds + v_rd_base(lane);
  struct { bf16x8 vs0, vs1, ks0, ks1; } sr_[SDEPTH];
#define SLOAD(i, k0) do { sr_[i].vs0 = ld8(&Vh[(long)((k0) + sr) * LDK + sc]); sr_[i].vs1 = ld8(&Vh[(long)((k0) + 32 + sr) * LDK + sc]); \
    sr_[i].ks0 = ld8(&Kh[(long)((k0) + sr) * LDK + sc]); sr_[i].ks1 = ld8(&Kh[(long)((k0) + 32 + sr) * LDK + sc]); } while (0)
#define SWRITE(b, i) do { *(bf16x8*)((char*)V_lds + (b) * SHM_V + vst0) = sr_[i].vs0;          \
    *(bf16x8*)((char*)V_lds + (b) * SHM_V + vst1) = sr_[i].vs1; int kc = sc * 2;               \
    *(bf16x8*)((char*)K_lds + (b) * SHM_K + KSWZ(sr, kc)) = sr_[i].ks0;                       \
    *(bf16x8*)((char*)K_lds + (b) * SHM_K + KSWZ(32 + sr, kc)) = sr_[i].ks1; } while (0)
#define SWAIT() do { asm volatile("s_waitcnt vmcnt(4)" ::: "memory"); } while (0)
#define RESC(a) do { if (__any((a) < 1.f)) { if (hi == 0) al_l[r32] = (a); asm volatile("s_waitcnt lgkmcnt(0)" ::: "memory"); \
    for (int d = 0; d < 4; ++d) for (int r = 0; r < 16; ++r) o[d][r] *= al_l[crow(r, hi)]; } } while (0)
  f32x16 pA0, pA1, pB0, pB1; float mnA, mnB, alA, alB; bf16x8 pa0, pa1, pa2, pa3; const int NT = seq / KVBLK;
  constexpr int SE = 0, SO = SDEPTH - 1;
  SLOAD(SE, 0); asm volatile("s_waitcnt vmcnt(0)" ::: "memory"); SWRITE(0, SE); __syncthreads();
  qkt(pA0, pA1, K_lds, qr, r32, hi); partialSM(pA0, pA1, m_reg, mnA, alA);
  SLOAD(SO, KVBLK); if (2 < NT) SLOAD(SE, 2 * KVBLK);
  SWAIT(); SWRITE(1, SO); __syncthreads();
  for (int j = 1; j + 1 < NT; j += 2) {
    SBAR(); qkt(pB0, pB1, (bf16*)((char*)K_lds + SHM_K), qr, r32, hi);
    finishSM(pA0, pA1, alA, l_reg, pa0, pa1, pa2, pa3); SBAR();
    SLOAD(SO, (j + SDEPTH) * KVBLK); SBAR();
    pv_d0(o, vb0, pa0, pa1, pa2, pa3); partialSM(pB0, pB1, m_reg, mnB, alB);
    __syncthreads(); SWAIT(); SWRITE(0, SE);
    RESC(alB); __syncthreads();
    SBAR(); qkt(pA0, pA1, K_lds, qr, r32, hi);
    finishSM(pB0, pB1, alB, l_reg, pa0, pa1, pa2, pa3); SBAR();
    if (j + 3 < NT) SLOAD(SE, (j + 1 + SDEPTH) * KVBLK); SBAR();
    pv_d0(o, vb0 + (int)SHM_V, pa0, pa1, pa2, pa3); partialSM(pA0, pA1, m_reg, mnA, alA);
    __syncthreads(); SWAIT(); SWRITE(1, SO);
    RESC(alA); __syncthreads();
  }
  SBAR(); qkt(pB0, pB1, (bf16*)((char*)K_lds + SHM_K), qr, r32, hi);
  finishSM(pA0, pA1, alA, l_reg, pa0, pa1, pa2, pa3); SBAR();
  pv_d0(o, vb0, pa0, pa1, pa2, pa3); partialSM(pB0, pB1, m_reg, mnB, alB);
  __syncthreads(); RESC(alB);
  finishSM(pB0, pB1, alB, l_reg, pa0, pa1, pa2, pa3); SBAR();
  pv_d0(o, vb0 + (int)SHM_V, pa0, pa1, pa2, pa3);
  if (hi == 0) li_l[r32] = l_reg; asm volatile("s_waitcnt lgkmcnt(0)" ::: "memory");
  float rli[16];
#pragma unroll
  for (int r = 0; r < 16; ++r) rli[r] = __builtin_amdgcn_rcpf(li_l[crow(r, hi)]);
  bf16* Ow = Ob + (long)(wid * QBLK) * LDO;
  __syncthreads();
  char* ob = lds + wid * (32 * 272);
#pragma unroll
  for (int r = 0; r < 16; ++r) { const int orow = crow(r, hi);
#pragma unroll
    for (int d0 = 0; d0 < 4; ++d0) { const float val = o[d0][r] * rli[r]; *(bf16*)(ob + orow * 272 + (d0 * 32 + r32) * 2) = (bf16)(cvtpk(val, val) & 0xffffu); } }
#pragma unroll
  for (int i = 0; i < 8; ++i) { const int row = i * 4 + (lane >> 4), ch = lane & 15;
    const u32x4 v = *(const u32x4*)(ob + row * 272 + ch * 16);
    *(u32x4*)(Ow + (long)row * LDO + ch * 8) = v; }
  __syncthreads();
#undef SLOAD
#undef SWRITE
#undef SWAIT
#undef RESC
}
#undef KSWZ
#undef SBAR
}

constexpr int NWAVES = 8, NTHR = 512;
constexpr int DM = 2048, NB = 4, SEQ = 4096, DEPTH = 4, CTXL = 256;
constexpr int ML = NB * SEQ, MC = NB * CTXL, MT = ML + MC;
constexpr int SKV = CTXL + SEQ;
constexpr int INW_SRC = 4608, PW = 5120;
constexpr int PQ = 0, PK = 1024, PV = 1280, PFA = 1536, PFB = 2048, PCB = 2560, PCC = 3072, PCH = 3584, PGU = 4096, PGV = 4608;
constexpr int MIXW = 2560, MX_ATT = 0, MX_FOUR = 1024, MX_CONV = 1536, MX_GM = 2048;
constexpr int DFF = 5632, UPW = 2 * DFF;
constexpr int NMOD = 6 * DM;
constexpr float EPS = 1e-6f;

constexpr size_t al256(size_t x) { return (x + 255) / 256 * 256; }
constexpr size_t WS_CTL = 0, CTL_ZERO_BYTES = 1u << 20;
constexpr size_t WS_WIN  = CTL_ZERO_BYTES;
constexpr size_t WS_WOUT = WS_WIN  + (size_t)DEPTH * PW * DM * 2;
constexpr size_t WS_WUP  = WS_WOUT + (size_t)DEPTH * DM * MIXW * 2;
constexpr size_t WS_WDN  = WS_WUP  + (size_t)DEPTH * UPW * DM * 2;
constexpr size_t WS_FN   = WS_WDN  + (size_t)DEPTH * DM * DFF * 2;
constexpr size_t WS_A1   = WS_FN;
constexpr size_t WS_A2   = WS_A1   + (size_t)256 * 256 * 2;
constexpr size_t WS_F256 = WS_A2   + (size_t)16 * 256 * 512 * 2;
constexpr size_t WS_MODP = WS_F256 + (size_t)256 * 512 * 2;
constexpr size_t WS_MOD  = WS_MODP + (size_t)16 * DEPTH * 5 * NMOD * 4;
constexpr size_t WS_ROPE = WS_MOD  + (size_t)DEPTH * 5 * NMOD * 4;
constexpr size_t WS_X    = WS_ROPE + 64 * 32 * 8;
constexpr size_t WS_H    = WS_X    + (size_t)MT * DM * 2;
constexpr size_t WS_R    = WS_H    + (size_t)MT * DM * 2;
constexpr size_t WS_P    = WS_R;
constexpr size_t WS_MIX  = WS_P    + (size_t)MT * PW * 2;
constexpr size_t WS_T1T  = WS_MIX  + (size_t)MT * MIXW * 2;
constexpr size_t WS_T1TC = WS_T1T  + (size_t)2048 * 8192 * 2;
constexpr size_t WS_KB   = WS_T1TC + (size_t)2048 * 512 * 2;
constexpr size_t WS_VB   = WS_KB   + (size_t)NB * SKV * 256 * 2;
constexpr size_t WS_QB   = WS_VB   + (size_t)NB * SKV * 256 * 2;
constexpr size_t WS_UB   = WS_QB   + (size_t)MT * 1024 * 2;
constexpr size_t WS_V2B  = WS_UB   + (size_t)MT * 512 * 2;
constexpr size_t WS_S2IN = WS_V2B  + (size_t)MT * 512 * 2;
constexpr size_t WS_RA_END = WS_S2IN + (size_t)16 * 2048 * 512 * 2;
constexpr size_t WS_ACT  = WS_R;
constexpr size_t WS_ACT_END = WS_ACT + (size_t)MT * DFF * 2;
constexpr size_t WS_R_END = WS_RA_END > WS_ACT_END ? WS_RA_END : WS_ACT_END;
constexpr size_t WS_EDGE = WS_R_END;
constexpr size_t WS_XP   = WS_EDGE + (size_t)(MT / 256) * 6 * DFF * 4;
constexpr size_t WS_END  = WS_XP   + (size_t)4 * MC * DM * 4;
static_assert(WS_END <= 1600000000ull, "d_ws budget");
static_assert(WS_WIN % 256 == 0 && WS_FN % 256 == 0 && WS_X % 256 == 0 && WS_H % 256 == 0 && WS_P % 256 == 0 && WS_MIX % 256 == 0 && WS_T1T % 256 == 0 && WS_KB % 256 == 0 && WS_ACT % 256 == 0 && WS_MOD % 256 == 0, "alignment");
constexpr int CW_TMO = 0, CW_BAR = 4096;

constexpr int RING_BYTES = 131072;
constexpr int LDSCTL_OFF = RING_BYTES, MISC_OFF = LDSCTL_OFF + 320;
constexpr int XL_OFF = RING_BYTES + 1024;
constexpr int LDS_BYTES = 147456;

#define GAS __attribute__((address_space(1)))
#define LAS __attribute__((address_space(3)))
typedef unsigned short bf16;
typedef unsigned v4u __attribute__((ext_vector_type(4)));
typedef unsigned v2u __attribute__((ext_vector_type(2)));
typedef float f32x4 __attribute__((ext_vector_type(4)));
typedef float f32x2 __attribute__((ext_vector_type(2)));
#define RLX_AGENT __ATOMIC_RELAXED, __HIP_MEMORY_SCOPE_AGENT
#define LDS_WAIT() asm volatile("s_waitcnt lgkmcnt(0)" ::: "memory")
#define VM_WAIT() asm volatile("s_waitcnt vmcnt(0)" ::: "memory")
__device__ __forceinline__ unsigned pk2(float lo, float hi) { unsigned r; asm volatile("v_cvt_pk_bf16_f32 %0, %1, %2" : "=v"(r) : "v"(lo), "v"(hi)); return r; }
__device__ __forceinline__ float bflo(unsigned w) { return __uint_as_float(w << 16); }
__device__ __forceinline__ float bfhi(unsigned w) { return __uint_as_float(w & 0xffff0000u); }
__device__ __forceinline__ void unpack8(const v4u w, float (&x)[8]) { x[0] = bflo(w.x); x[1] = bfhi(w.x); x[2] = bflo(w.y); x[3] = bfhi(w.y); x[4] = bflo(w.z); x[5] = bfhi(w.z); x[6] = bflo(w.w); x[7] = bfhi(w.w); }
__device__ __forceinline__ v4u pack8(const float (&x)[8]) { v4u w; w.x = pk2(x[0], x[1]); w.y = pk2(x[2], x[3]); w.z = pk2(x[4], x[5]); w.w = pk2(x[6], x[7]); return w; }
__device__ __forceinline__ float wave_sum(float v) {
#pragma unroll
    for (int o = 1; o < 64; o <<= 1) v += __shfl_xor(v, o);
    return v;
}
__device__ __forceinline__ float gelu_tanh(float x) { const float y = 0.7978845608028654f * (x + 0.044715f * x * x * x); return 0.5f * x * (1.f + tanhf(y)); }

#define XB_TMO      128
#define XB_XCNT(j)  (256  + 64 * (j))
#define XB_XSUB(j)  (1280 + 64 * (j))
#define XB_XGEN(j)  (2304 + 64 * (j))
#define XB_TOP      3328
#define XB_TOPGEN   3392
#define XCD_BAR_WORDS 3456
#define XB_SPIN_CAP (1u << 18)
__device__ __forceinline__ unsigned xb_ld(unsigned* p)              { return __hip_atomic_load(p, __ATOMIC_RELAXED, __HIP_MEMORY_SCOPE_AGENT); }
__device__ __forceinline__ unsigned xb_add(unsigned* p, unsigned v) { return __hip_atomic_fetch_add(p, v, __ATOMIC_RELAXED, __HIP_MEMORY_SCOPE_AGENT); }
__device__ __forceinline__ unsigned xb_xcc_id() { return (unsigned)__builtin_amdgcn_s_getreg((3 << 11) | 20) & 0xFu; }
#define XB_SPIN(cond, bar) do { unsigned _sp = 0; while (cond) { __builtin_amdgcn_s_sleep(1); \
    if ((++_sp & 255u) == 0u) { if (xb_ld(&(bar)[XB_TMO])) break; if (_sp > XB_SPIN_CAP) { atomicAdd(&(bar)[XB_TMO], 1u); break; } } } } while (0)
struct XcdBarrier { unsigned* bar; unsigned x; volatile LAS unsigned* st; };
__device__ __forceinline__ XcdBarrier xcd_barrier_post(unsigned* bar, volatile LAS unsigned* st) {
    XcdBarrier b; b.bar = bar; b.x = xb_xcc_id(); b.st = st;
    if (threadIdx.x == 0) (void)xb_add(&bar[XB_XCNT(b.x)], 1u);
    return b;
}
__device__ __forceinline__ void xcd_barrier_complete(unsigned* bar, unsigned x, unsigned& nloc, unsigned& nx) {
    const unsigned G = gridDim.x * gridDim.y * gridDim.z;
    unsigned sum, cnt, mine, sp = 0u;
    for (;;) {
        sum = 0u; cnt = 0u; mine = 0u;
#pragma unroll
        for (unsigned j = 0; j < 16; ++j) { const unsigned c = xb_ld(&bar[XB_XCNT(j)]); sum += c; cnt += (c > 0u) ? 1u : 0u; mine = (j == x) ? c : mine; }
        if (sum == G) break;
        __builtin_amdgcn_s_sleep(1);
        if ((++sp & 255u) == 0u) { if (xb_ld(&bar[XB_TMO])) break; if (sp > XB_SPIN_CAP) { atomicAdd(&bar[XB_TMO], 1u); break; } }
    }
    nloc = mine > 0u ? mine : 1u; nx = cnt > 0u ? cnt : 1u;
}
__device__ __forceinline__ void xcd_barrier(const XcdBarrier& b) {
    asm volatile("s_waitcnt vmcnt(0)" ::: "memory");
    __syncthreads();
    if (threadIdx.x == 0) {
        unsigned* bar = b.bar;
        __builtin_amdgcn_s_waitcnt(0);
        unsigned nloc = b.st[0], nx = b.st[1];
        if (nloc == 0u) { xcd_barrier_complete(bar, b.x, nloc, nx); b.st[0] = nloc; b.st[1] = nx; }
        const unsigned old = xb_add(&bar[XB_XSUB(b.x)], 1u);
        const unsigned gen = old / nloc;
        if (old + 1u == (gen + 1u) * nloc) {
            __builtin_amdgcn_fence(__ATOMIC_RELEASE, "agent");
            asm volatile("s_waitcnt vmcnt(0)" ::: "memory");
            const unsigned og = xb_add(&bar[XB_TOP], 1u);
            const unsigned tg = og / nx;
            if (og + 1u == (tg + 1u) * nx) xb_add(&bar[XB_TOPGEN], 1u);
            else XB_SPIN(xb_ld(&bar[XB_TOPGEN]) == tg, bar);
            __builtin_amdgcn_fence(__ATOMIC_ACQUIRE, "agent");
            xb_add(&bar[XB_XGEN(b.x)], 1u);
            asm volatile("s_waitcnt vmcnt(0)" ::: "memory");
        } else {
            XB_SPIN(xb_ld(&bar[XB_XGEN(b.x)]) == gen, bar);
            __builtin_amdgcn_fence(__ATOMIC_ACQUIRE, "agent");
            asm volatile("s_waitcnt vmcnt(0)" ::: "memory");
        }
    }
    __syncthreads();
}

struct Args { const float* in[22]; float* out; unsigned char* ws; int ph_lo, ph_hi; };
enum { I_X = 0, I_C, I_CTX, I_CCTX, I_WMOD, I_BMOD, I_N1G, I_N2G, I_WIN, I_QG, I_KG, I_CONVW, I_LNG, I_LNB, I_GMWS, I_GMB, I_WOUT, I_WUP, I_FCW, I_FCB, I_WDN, I_FNG };

typedef const Args __attribute__((address_space(4)))* KArgs;
__device__ __forceinline__ KArgs kargs() { KArgs p = (KArgs)__builtin_amdgcn_kernarg_segment_ptr(); asm volatile("" : "+s"(p)); return p; }
struct Frame {
    LAS unsigned char* lds;
    int tid, lane, wave, G, bx, gw, ngw;
    unsigned char* ws;
};
__device__ __forceinline__ Frame make_frame(KArgs a) {
    extern __shared__ __attribute__((aligned(16))) unsigned char lds_[];
    Frame F; int t = threadIdx.x; asm volatile("" : "+v"(t));
    F.lds = (LAS unsigned char*)lds_; F.tid = t; F.lane = t & 63; F.wave = __builtin_amdgcn_readfirstlane(t >> 6);
    F.G = gridDim.x; F.bx = blockIdx.x; F.gw = F.bx * NWAVES + F.wave; F.ngw = F.G * NWAVES; F.ws = a->ws;
    return F;
}

__device__ __forceinline__ size_t toff(int n, int k, int K) { return ((size_t)(n >> 8) * (K >> 6) + (k >> 6)) * 16384 + (size_t)(n & 255) * 64 + (k & 63); }
__device__ __forceinline__ void transpose_item(const float* W, int ldw, int k0, int ns0, bf16* WT, int ldt, int nd0, LAS float* scr, int lane) {
    f32x4 v[8];
#pragma unroll
    for (int i = 0; i < 8; ++i) v[i] = *(const f32x4*)(W + (size_t)(k0 + i * 8 + (lane >> 3)) * ldw + ns0 + (lane & 7) * 4);
#pragma unroll
    for (int i = 0; i < 8; ++i) { LAS float* d = scr + (i * 8 + (lane >> 3)) * 33 + (lane & 7) * 4; d[0] = v[i].x; d[1] = v[i].y; d[2] = v[i].z; d[3] = v[i].w; }
    LDS_WAIT(); asm volatile("" ::: "memory");
    const int c = lane & 7;
#pragma unroll
    for (int j = 0; j < 4; ++j) { const int n = (lane >> 3) + 8 * j; const LAS float* s = scr + (8 * c) * 33 + n;
        v4u o; o.x = pk2(s[0 * 33], s[1 * 33]); o.y = pk2(s[2 * 33], s[3 * 33]); o.z = pk2(s[4 * 33], s[5 * 33]); o.w = pk2(s[6 * 33], s[7 * 33]);
        *(v4u*)(WT + toff(nd0 + n, k0 + 8 * c, ldt)) = o; }
    LDS_WAIT(); asm volatile("" ::: "memory");
}

__device__ __forceinline__ void p0a_prologue(KArgs a) {
    Frame F = make_frame(a); unsigned char* ws = F.ws;
    {
        LAS float* scr = (LAS float*)(F.lds + F.wave * 16384);
        constexpr int I_IN = 32 * 128, I_OUT = 40 * 64, I_UP = 32 * 352, I_DN = 88 * 64, I_L = I_IN + I_OUT + I_UP + I_DN;
        for (int it = F.gw; it < DEPTH * I_L; it += F.ngw) {
            const int l = it / I_L; int r = it % I_L;
            if (r < I_IN) { const int kb = r / 128, nb = r % 128; const int ns0 = nb < 48 ? nb * 32 : 2048 + (nb - 48) * 32; const int nd0 = nb < 48 ? ns0 : ns0 + 512;
                transpose_item(a->in[I_WIN] + (size_t)l * DM * INW_SRC, INW_SRC, kb * 64, ns0, (bf16*)(ws + WS_WIN) + (size_t)l * PW * DM, DM, nd0, scr, F.lane); continue; }
            r -= I_IN;
            if (r < I_OUT) { const int kb = r / 64, nb = r % 64;
                transpose_item(a->in[I_WOUT] + (size_t)l * MIXW * DM, DM, kb * 64, nb * 32, (bf16*)(ws + WS_WOUT) + (size_t)l * DM * MIXW, MIXW, nb * 32, scr, F.lane); continue; }
            r -= I_OUT;
            if (r < I_UP) { const int kb = r / 352, nb = r % 352; const int nd0 = nb * 32, ns0 = ((nd0 >> 7) & 1) * DFF + (nd0 >> 8) * 128 + (nd0 & 127);
                transpose_item(a->in[I_WUP] + (size_t)l * DM * UPW, UPW, kb * 64, ns0, (bf16*)(ws + WS_WUP) + (size_t)l * UPW * DM, DM, nb * 32, scr, F.lane); continue; }
            r -= I_UP;
            { const int kb = r / 64, nb = r % 64;
                transpose_item(a->in[I_WDN] + (size_t)l * DFF * DM, DM, kb * 64, nb * 32, (bf16*)(ws + WS_WDN) + (size_t)l * DM * DFF, DFF, nb * 32, scr, F.lane); }
        }
    }
    __syncthreads();
    {
        LAS float* sl = (LAS float*)F.lds;
        for (int i = F.tid; i < 5 * DM; i += NTHR) { const int v = i / DM, k = i % DM; const float cv = v < 4 ? a->in[I_C][v * DM + k] : a->in[I_CCTX][k]; sl[i] = cv / (1.f + expf(-cv)); }
        __syncthreads();
        float* MODP = (float*)(ws + WS_MODP);
        for (int it = F.gw; it < DEPTH * 16 * 48; it += F.ngw) {
            const int l = it / 768, r = it % 768, ks = r / 48, cg = r % 48;
            const float* wp = a->in[I_WMOD] + ((size_t)l * DM + ks * 128) * NMOD + cg * 256 + F.lane * 4;
            f32x4 acc[5];
#pragma unroll
            for (int v = 0; v < 5; ++v) acc[v] = (f32x4){0.f, 0.f, 0.f, 0.f};
            for (int k = 0; k < 128; k += 8) {
                f32x4 w[8];
#pragma unroll
                for (int u = 0; u < 8; ++u) w[u] = *(const f32x4*)(wp + (size_t)(k + u) * NMOD);
#pragma unroll
                for (int u = 0; u < 8; ++u)
#pragma unroll
                    for (int v = 0; v < 5; ++v) acc[v] += w[u] * sl[v * DM + ks * 128 + k + u];
            }
#pragma unroll
            for (int v = 0; v < 5; ++v) *(f32x4*)(MODP + ((size_t)ks * (DEPTH * 5) + l * 5 + v) * NMOD + cg * 256 + F.lane * 4) = acc[v];
        }
    }
    __syncthreads();
    {
        LAS float* T128 = (LAS float*)F.lds;
        LAS float* Wl = (LAS float*)(F.lds + 1024);
        if (F.tid < 128) T128[F.tid] = cospif((float)F.tid * (1.f / 64.f));
        __syncthreads();
        for (int it = F.bx; it < DEPTH * 4 * 64; it += F.G) {
            const int l = it / 256, g = (it / 64) % 4, kb = it % 64;
            for (int i = F.tid; i < 32 * 128; i += NTHR) { const int kk = i / 128, dd = i % 128; Wl[dd * 36 + kk] = a->in[I_WIN][((size_t)l * DM + kb * 32 + kk) * INW_SRC + 1536 + g * 128 + dd]; }
            __syncthreads();
            const int dout = F.tid & 127, cs = (F.tid >> 7) & 1, kg = F.tid >> 8;
            float acc[16];
#pragma unroll
            for (int kk = 0; kk < 16; ++kk) acc[kk] = 0.f;
            for (int dd = 0; dd < 128; ++dd) {
                const float tr = T128[(dout * dd - (cs ? 32 : 0)) & 127];
#pragma unroll
                for (int q4 = 0; q4 < 4; ++q4) { const f32x4 w4 = *(const LAS f32x4*)(Wl + dd * 36 + kg * 16 + 4 * q4);
                    acc[4 * q4] += w4.x * tr; acc[4 * q4 + 1] += w4.y * tr; acc[4 * q4 + 2] += w4.z * tr; acc[4 * q4 + 3] += w4.w * tr; }
            }
            bf16* dst = (bf16*)(ws + WS_WIN) + (size_t)l * PW * DM + toff(PFA + cs * 512 + g * 128 + dout, kb * 32 + kg * 16, DM);
            v4u o0, o1; o0.x = pk2(acc[0], acc[1]); o0.y = pk2(acc[2], acc[3]); o0.z = pk2(acc[4], acc[5]); o0.w = pk2(acc[6], acc[7]);
            o1.x = pk2(acc[8], acc[9]); o1.y = pk2(acc[10], acc[11]); o1.z = pk2(acc[12], acc[13]); o1.w = pk2(acc[14], acc[15]);
            *(v4u*)dst = o0; *(v4u*)(dst + 8) = o1;
            __syncthreads();
        }
    }
    __syncthreads();
    {
        LAS float* T = (LAS float*)F.lds;
        for (int i = F.tid; i < 4096; i += NTHR) T[i] = cospif((float)i * (1.f / 2048.f));
        __syncthreads();
        bf16* A1 = (bf16*)(ws + WS_A1);
        for (int idx = F.bx * NTHR + F.tid; idx < 256 * 32; idx += F.G * NTHR) {
            const int m = idx >> 5, kk0 = (idx & 31) * 8; const int cho = m >> 7, k2 = (m & 127) >> 1, ro = m & 1; float x[8];
#pragma unroll
            for (int e2 = 0; e2 < 8; ++e2) { const int kk = kk0 + e2, chi = kk >> 7, ri = (kk >> 6) & 1, aa = kk & 63;
                const float cs_ = T[(64 * k2 * aa) & 4095], sn_ = T[(64 * k2 * aa - 1024) & 4095];
                const float v = ro == 0 ? (ri == 0 ? cs_ : -sn_) : (ri == 0 ? -sn_ : -cs_);
                x[e2] = (cho == chi) ? v : 0.f; }
            *(v4u*)(A1 + (size_t)m * 256 + kk0) = pack8(x);
        }
        bf16* A2 = (bf16*)(ws + WS_A2);
        for (int idx = F.bx * NTHR + F.tid; idx < 16 * 256 * 64; idx += F.G * NTHR) {
            const int kk0 = (idx & 63) * 8, m = (idx >> 6) & 255, q = idx >> 14; const int k2p = m >> 6, k1 = m & 63, k = 4 * q + k2p + 64 * k1; float x[8];
#pragma unroll
            for (int e2 = 0; e2 < 8; ++e2) { const int kk = kk0 + e2, k2pp = kk >> 7, ro = (kk >> 6) & 1, c = kk & 63;
                const float v = ro == 0 ? T[(k * c) & 4095] : T[(k * c - 1024) & 4095];
                x[e2] = (k2pp == k2p) ? v : 0.f; }
            *(v4u*)(A2 + ((size_t)q * 256 + m) * 512 + kk0) = pack8(x);
        }
        bf16* F2 = (bf16*)(ws + WS_F256);
        for (int k = F.bx; k < 256; k += F.G) {
            if (F.tid < 64) { const int j0 = F.tid * 8; const int cs = j0 >> 8, t0 = j0 & 255; float x[8];
#pragma unroll
                for (int e = 0; e < 8; ++e) { const int m = (16 * k * (t0 + e) - (cs ? 1024 : 0)) & 4095; const float v = T[m]; x[e] = cs ? -v : v; }
                *(v4u*)(F2 + (size_t)k * 512 + j0) = pack8(x); }
        }
    }
    if (F.bx == 0) {
        f32x2* ROPE = (f32x2*)(ws + WS_ROPE);
        for (int i = F.tid; i < 64 * 32; i += NTHR) { const int pos = i >> 5, ii = i & 31; const float freq = powf(10000.f, -(float)(2 * ii) / 64.f); const float ang = (float)pos * freq;
            ROPE[i] = (f32x2){cosf(ang), sinf(ang)}; }
    }
    __syncthreads();
}

__device__ __forceinline__ void p0b_modreduce(KArgs a) {
    Frame F = make_frame(a);
    const float* MODP = (const float*)(F.ws + WS_MODP); float* MOD = (float*)(F.ws + WS_MOD);
    for (int i = F.bx * NTHR + F.tid; i < DEPTH * 5 * (NMOD / 4); i += F.G * NTHR) {
        const int j4 = i % (NMOD / 4), lv = i / (NMOD / 4), l = lv / 5;
        f32x4 s = *(const f32x4*)(a->in[I_BMOD] + (size_t)l * NMOD + j4 * 4);
#pragma unroll
        for (int ks = 0; ks < 16; ++ks) s += *(const f32x4*)(MODP + ((size_t)ks * (DEPTH * 5) + lv) * NMOD + j4 * 4);
        *(f32x4*)(MOD + (size_t)lv * NMOD + j4 * 4) = s;
    }
}

__device__ __forceinline__ void norm_phase(KArgs a, int M, const float* g, const float* modl, int shoff, int scoff, bool fold, bool lat_in, bool ctx_in) {
    Frame F = make_frame(a);
    bf16* X = (bf16*)(F.ws + WS_X); bf16* H = (bf16*)(F.ws + WS_H); const float* XP = (const float*)(F.ws + WS_XP);
    for (int row = F.gw; row < M; row += F.ngw) {
        const int v = row < ML ? row >> 12 : 4;
        const float* sh = modl + (size_t)v * NMOD + shoff; const float* sc = modl + (size_t)v * NMOD + scoff;
        v4u* xr = (v4u*)(X + (size_t)row * DM) + F.lane;
        f32x4 x[4][2]; float ss = 0.f;
        if (row < ML ? lat_in : ctx_in) { const f32x4* xs = (const f32x4*)(row < ML ? a->in[I_X] + (size_t)row * DM : a->in[I_CTX] + (size_t)(row - ML) * DM) + 2 * F.lane;
#pragma unroll
            for (int j = 0; j < 4; ++j) { x[j][0] = xs[128 * j]; x[j][1] = xs[128 * j + 1]; } }
        else {
#pragma unroll
            for (int j = 0; j < 4; ++j) { const v4u w = xr[64 * j]; x[j][0] = (f32x4){bflo(w.x), bfhi(w.x), bflo(w.y), bfhi(w.y)}; x[j][1] = (f32x4){bflo(w.z), bfhi(w.z), bflo(w.w), bfhi(w.w)}; } }
        if (fold && row >= ML) {
#pragma unroll
            for (int ks = 0; ks < 4; ++ks) { const f32x4* pr = (const f32x4*)(XP + ((size_t)ks * MC + (row - ML)) * DM) + 2 * F.lane;
#pragma unroll
                for (int j = 0; j < 4; ++j) { x[j][0] += pr[128 * j]; x[j][1] += pr[128 * j + 1]; } }
#pragma unroll
            for (int j = 0; j < 4; ++j) { v4u w; w.x = pk2(x[j][0].x, x[j][0].y); w.y = pk2(x[j][0].z, x[j][0].w); w.z = pk2(x[j][1].x, x[j][1].y); w.w = pk2(x[j][1].z, x[j][1].w); xr[64 * j] = w; }
        }
#pragma unroll
        for (int j = 0; j < 4; ++j)
#pragma unroll
            for (int h = 0; h < 2; ++h) ss += (x[j][h].x * x[j][h].x + x[j][h].y * x[j][h].y) + (x[j][h].z * x[j][h].z + x[j][h].w * x[j][h].w);
        const float rstd = 1.0f / sqrtf(wave_sum(ss) * (1.f / DM) + EPS);
#pragma unroll
        for (int j = 0; j < 4; ++j) { const int col = F.lane * 8 + 512 * j; f32x4 y[2];
#pragma unroll
            for (int h = 0; h < 2; ++h) { const f32x4 gg = *(const f32x4*)(g + col + 4 * h), s1 = *(const f32x4*)(sc + col + 4 * h), s0 = *(const f32x4*)(sh + col + 4 * h);
                y[h] = x[j][h] * rstd * gg * (s1 + 1.0f) + s0; }
            v4u o; o.x = pk2(y[0].x, y[0].y); o.y = pk2(y[0].z, y[0].w); o.z = pk2(y[1].x, y[1].y); o.w = pk2(y[1].z, y[1].w);
            *(v4u*)(H + (size_t)row * DM + col) = o; }
    }
}

__device__ __forceinline__ void final_norm_phase(KArgs a, const float* g, float* out) {
    Frame F = make_frame(a);
    const bf16* X = (const bf16*)(F.ws + WS_X);
    for (int row = F.gw; row < ML; row += F.ngw) {
        const v4u* xr = (const v4u*)(X + (size_t)row * DM) + F.lane;
        f32x4 x[8]; float ss = 0.f;
#pragma unroll
        for (int j = 0; j < 4; ++j) { const v4u w = xr[64 * j]; x[2 * j] = (f32x4){bflo(w.x), bfhi(w.x), bflo(w.y), bfhi(w.y)}; x[2 * j + 1] = (f32x4){bflo(w.z), bfhi(w.z), bflo(w.w), bfhi(w.w)}; }
#pragma unroll
        for (int j = 0; j < 8; ++j) ss += (x[j].x * x[j].x + x[j].y * x[j].y) + (x[j].z * x[j].z + x[j].w * x[j].w);
        const float rstd = 1.0f / sqrtf(wave_sum(ss) * (1.f / DM) + EPS);
#pragma unroll
        for (int j = 0; j < 8; ++j) { const int col = F.lane * 8 + 512 * (j >> 1) + 4 * (j & 1); const f32x4 gg = *(const f32x4*)(g + col);
            *(f32x4*)(out + (size_t)row * DM + col) = x[j] * rstd * gg; }
    }
}

__device__ __forceinline__ float gelu_fast(float x) { const float y = 1.5957691216057308f * (x + 0.044715f * x * x * x); return x * __builtin_amdgcn_rcpf(1.f + __expf(-y)); }

__device__ __forceinline__ void postA_phase(KArgs a, int l) {
    Frame F = make_frame(a); unsigned char* ws = F.ws;
    const bf16* P = (const bf16*)(ws + WS_P); bf16* MIX = (bf16*)(ws + WS_MIX); bf16* KB = (bf16*)(ws + WS_KB); bf16* VB = (bf16*)(ws + WS_VB);
    bf16* QB = (bf16*)(ws + WS_QB); bf16* UB = (bf16*)(ws + WS_UB); bf16* V2B = (bf16*)(ws + WS_V2B);
    const f32x4* ROPE4 = (const f32x4*)(ws + WS_ROPE);
    const int lane = F.lane, tid = F.tid;
    {
        const int hl = lane & 15, axis = hl >> 3, i0 = (lane & 3) * 8; const bool first = (lane & 7) < 4;
        float qg8[8], kg8[8], cw0[8], cw1[8], cw2[8], lg8[8], lb8[8];
        { const float* qg = a->in[I_QG] + l * 128 + hl * 8; const float* kg = a->in[I_KG] + l * 128 + hl * 8; const float* cw = a->in[I_CONVW] + (size_t)l * 3 * 512 + lane * 8;
          const float* lng = a->in[I_LNG] + l * 512 + lane * 8; const float* lnb = a->in[I_LNB] + l * 512 + lane * 8;
#pragma unroll
          for (int e = 0; e < 8; ++e) { qg8[e] = qg[e]; kg8[e] = kg[e]; cw0[e] = cw[e]; cw1[e] = cw[512 + e]; cw2[e] = cw[1024 + e]; lg8[e] = lng[e]; lb8[e] = lnb[e]; } }
        for (int row = F.gw; row < MT; row += F.ngw) {
            const bool is_ctx = row >= ML;
            const int b = is_ctx ? (row - ML) >> 8 : row >> 12, p = is_ctx ? (row - ML) & 255 : row & 4095, nseq = is_ctx ? CTXL : SEQ;
            const bool kv_only = is_ctx && (l == DEPTH - 1);
            const bf16* Pr = P + (size_t)row * PW;
            const int kvpos = is_ctx ? p : CTXL + p;
            const v4u rkv = *(const v4u*)(Pr + PK + lane * 8);
            f32x4 c4[4];
            if (!is_ctx) { const int posax = axis ? (p & 63) : (p >> 6);
#pragma unroll
                for (int e = 0; e < 4; ++e) c4[e] = ROPE4[posax * 16 + (i0 >> 1) + e]; }
            {
                float x[8]; unpack8(rkv, x); float ss = 0.f;
#pragma unroll
                for (int e = 0; e < 8; ++e) ss += x[e] * x[e];
                ss += __shfl_xor(ss, 1); ss += __shfl_xor(ss, 2); ss += __shfl_xor(ss, 4); ss += __shfl_xor(ss, 8);
                const float rstd = 1.0f / sqrtf(ss * (1.f / 128.f) + EPS);
                float y[8];
#pragma unroll
                for (int e = 0; e < 8; ++e) y[e] = x[e] * rstd * kg8[e];
                if (!is_ctx) {
#pragma unroll
                    for (int e = 0; e < 8; ++e) { const float pr = __shfl_xor(y[e], 4); const float cs_ = c4[e >> 1][(e & 1) * 2], sn_ = c4[e >> 1][(e & 1) * 2 + 1]; y[e] = first ? y[e] * cs_ - pr * sn_ : y[e] * cs_ + pr * sn_; } }
                if (lane < 32) *(v4u*)(KB + ((size_t)b * SKV + kvpos) * 256 + lane * 8) = pack8(y);
                else *(v4u*)(VB + ((size_t)b * SKV + kvpos) * 256 + (lane - 32) * 8) = rkv;
            }
            if (kv_only) continue;
            const v4u rq0 = *(const v4u*)(Pr + PQ + lane * 8), rq1 = *(const v4u*)(Pr + PQ + 512 + lane * 8);
            const v4u rcb = *(const v4u*)(Pr + PCB + lane * 8), rc0 = *(const v4u*)(Pr + PCC + lane * 8), rh0 = *(const v4u*)(Pr + PCH + lane * 8);
            const bool hp = p > 0, hn = p < nseq - 1;
            const bf16* Pm = hp ? Pr - PW : Pr; const bf16* Pn = hn ? Pr + PW : Pr;
            const v4u rcm = *(const v4u*)(Pm + PCC + lane * 8), rhm = *(const v4u*)(Pm + PCH + lane * 8), rcp = *(const v4u*)(Pn + PCC + lane * 8), rhp = *(const v4u*)(Pn + PCH + lane * 8);
            const v4u rgu = *(const v4u*)(Pr + PGU + lane * 8), rgv = *(const v4u*)(Pr + PGV + lane * 8);
#pragma unroll
            for (int part = 0; part < 2; ++part) {
                float x[8]; unpack8(part ? rq1 : rq0, x); float ss = 0.f;
#pragma unroll
                for (int e = 0; e < 8; ++e) ss += x[e] * x[e];
                ss += __shfl_xor(ss, 1); ss += __shfl_xor(ss, 2); ss += __shfl_xor(ss, 4); ss += __shfl_xor(ss, 8);
                const float rstd = 1.0f / sqrtf(ss * (1.f / 128.f) + EPS);
                float y[8];
#pragma unroll
                for (int e = 0; e < 8; ++e) y[e] = x[e] * rstd * qg8[e];
                if (!is_ctx) {
#pragma unroll
                    for (int e = 0; e < 8; ++e) { const float pr = __shfl_xor(y[e], 4); const float cs_ = c4[e >> 1][(e & 1) * 2], sn_ = c4[e >> 1][(e & 1) * 2 + 1]; y[e] = first ? y[e] * cs_ - pr * sn_ : y[e] * cs_ + pr * sn_; } }
                *(v4u*)(QB + (size_t)row * 1024 + part * 512 + lane * 8) = pack8(y);
            }
            {
                float cb[8], c0[8], h0[8], cm[8], hm[8], cp[8], hq[8], o[8];
                unpack8(rcb, cb); unpack8(rc0, c0); unpack8(rh0, h0); unpack8(rcm, cm); unpack8(rhm, hm); unpack8(rcp, cp); unpack8(rhp, hq);
                const float fp = hp ? 1.f : 0.f, fn = hn ? 1.f : 0.f;
#pragma unroll
                for (int e = 0; e < 8; ++e) o[e] = cb[e] * (cw0[e] * fp * (cm[e] * hm[e]) + cw1[e] * (c0[e] * h0[e]) + cw2[e] * fn * (cp[e] * hq[e]));
                *(v4u*)(MIX + (size_t)row * MIXW + MX_CONV + lane * 8) = pack8(o);
            }
            {
                float u[8], t[8]; unpack8(rgu, u); unpack8(rgv, t);
                float s = 0.f;
#pragma unroll
                for (int e = 0; e < 8; ++e) { u[e] = gelu_fast(u[e]); t[e] = gelu_fast(t[e]); s += t[e]; }
                const float mean = wave_sum(s) * (1.f / 512.f);
                float q = 0.f;
#pragma unroll
                for (int e = 0; e < 8; ++e) { t[e] -= mean; q += t[e] * t[e]; }
                const float rstd = 1.0f / sqrtf(wave_sum(q) * (1.f / 512.f) + EPS);
#pragma unroll
                for (int e = 0; e < 8; ++e) t[e] = t[e] * rstd * lg8[e] + lb8[e];
                *(v4u*)(UB + (size_t)row * 512 + lane * 8) = pack8(u); *(v4u*)(V2B + (size_t)row * 512 + lane * 8) = pack8(t);
            }
        }
    }
    {
        LAS unsigned* tb = (LAS unsigned*)F.lds;
        bf16* S1 = (bf16*)(ws + WS_T1T);
        for (int un = F.bx; un < 512; un += F.G) {
            const int ab = un >> 6, b = (un >> 4) & 3, slab = un & 15;
            const size_t rowb = (size_t)b * SEQ + (size_t)ab * 512;
#pragma unroll
            for (int it = 0; it < 4; ++it) {
                const int idx = tid + it * NTHR; const int j = it, c8 = idx & 7, c = (idx >> 3) & 63;
                const bf16* src0 = P + (rowb + (size_t)(2 * j) * 64 + c) * PW + PFA + slab * 64 + c8 * 8;
                const v4u r0 = *(const v4u*)src0, r1 = *(const v4u*)(src0 + (size_t)64 * PW);
                const unsigned a0[4] = {r0.x, r0.y, r0.z, r0.w}, a1[4] = {r1.x, r1.y, r1.z, r1.w};
                const int js = j ^ (c8 & 3);
#pragma unroll
                for (int w = 0; w < 4; ++w) {
                    tb[((c8 * 8 + 2 * w) * 64 + c) * 4 + js]     = (a0[w] & 0xffffu) | (a1[w] << 16);
                    tb[((c8 * 8 + 2 * w + 1) * 64 + c) * 4 + js] = (a0[w] >> 16) | (a1[w] & 0xffff0000u);
                }
            }
            __syncthreads();
#pragma unroll
            for (int it = 0; it < 8; ++it) {
                const int idx = tid + it * NTHR; const int c = idx & 63, col = idx >> 6;
                const v4u oo = *(const LAS v4u*)(tb + (col * 64 + c) * 4); const unsigned od[4] = {oo.x, oo.y, oo.z, oo.w};
                v4u o; o.x = od[0 ^ (it & 3)]; o.y = od[1 ^ (it & 3)]; o.z = od[2 ^ (it & 3)]; o.w = od[3 ^ (it & 3)];
                const int gcol = slab * 64 + col, ri = gcol >> 9, n = b * 512 + (gcol & 511);
                *(v4u*)(S1 + ((((size_t)n * 32 + (c & 31)) * 2 + (c >> 5)) * 2 + ri) * 64 + ab * 8) = o;
            }
            __syncthreads();
        }
    }
    if (l < DEPTH - 1) {
        LAS unsigned* tb = (LAS unsigned*)F.lds;
        for (int un = F.bx; un < 32; un += F.G) {
            const int chc = un >> 2, slab = un & 3;
            const int b = chc >> 1, p0 = (chc & 1) * 128;
            const int row0 = ML + b * CTXL + p0;
            bf16* T1 = (bf16*)(ws + WS_T1TC);
#pragma unroll
            for (int it = 0; it < 4; ++it) {
                const int q = tid + it * NTHR;
                const int c8 = ((q >> 6) & 3) * 8 + (q & 7), rp = (q >> 8) * 8 + ((q >> 3) & 7);
                const v4u r0 = *(const v4u*)(P + (size_t)(row0 + 2 * rp) * PW + PFA + slab * 256 + c8 * 8);
                const v4u r1 = *(const v4u*)(P + (size_t)(row0 + 2 * rp + 1) * PW + PFA + slab * 256 + c8 * 8);
                const unsigned a0[4] = {r0.x, r0.y, r0.z, r0.w}, a1[4] = {r1.x, r1.y, r1.z, r1.w};
#pragma unroll
                for (int w = 0; w < 4; ++w) {
                    tb[(c8 * 8 + 2 * w) * 65 + rp]     = (a0[w] & 0xffffu) | (a1[w] << 16);
                    tb[(c8 * 8 + 2 * w + 1) * 65 + rp] = (a0[w] >> 16) | (a1[w] & 0xffff0000u);
                }
            }
            __syncthreads();
#pragma unroll
            for (int it = 0; it < 8; ++it) {
                const int idx = tid + it * NTHR; const int cc = idx >> 4, t8 = idx & 15;
                v4u o; o.x = tb[cc * 65 + t8 * 4]; o.y = tb[cc * 65 + t8 * 4 + 1]; o.z = tb[cc * 65 + t8 * 4 + 2]; o.w = tb[cc * 65 + t8 * 4 + 3];
                const int col = slab * 256 + cc, csn = col >> 9, gd = col & 511;
                *(v4u*)(T1 + (size_t)(b * 512 + gd) * 512 + csn * CTXL + p0 + t8 * 8) = o;
            }
            __syncthreads();
        }
    }
}

__device__ __forceinline__ void gate_phase(KArgs a, int l, int wg0, int nwg, int u_lo, int u_hi) {
    Frame F = make_frame(a); unsigned char* ws = F.ws;
    F.bx -= wg0; if (F.bx < 0 || F.bx >= nwg) return;
    const bf16* UB = (const bf16*)(ws + WS_UB); const bf16* V2B = (const bf16*)(ws + WS_V2B); bf16* MIX = (bf16*)(ws + WS_MIX);
    const float* gws = a->in[I_GMWS] + (size_t)l * 4 * 128 * 128; const float* gmb = a->in[I_GMB] + l * 4 * 128;
    const int tid = F.tid, lane = F.lane, r32 = lane & 31, hi = lane >> 5, gsel = F.wave >> 2, qb = F.wave & 3;
    for (int un = u_lo + F.bx; un < u_hi; un += nwg) {
        const int ch = un >> 1, gp = un & 1;
        const bool is_ctx = ch >= 128;
        const int b = is_ctx ? (ch - 128) >> 1 : ch >> 5;
        const int p0 = is_ctx ? ((ch - 128) & 1) * 128 : (ch & 31) * 128;
        const int row0 = is_ctx ? ML + b * CTXL + p0 : b * SEQ + p0;
#pragma unroll
        for (int it = 0; it < 8; ++it) { const int idx = tid + it * NTHR; const int gi = idx >> 11, pp = (idx >> 4) & 127, c8 = idx & 15;
            const v4u v = *(const v4u*)(V2B + (size_t)(row0 + pp) * 512 + (2 * gp + gi) * 128 + c8 * 8);
            *(LAS v4u*)(F.lds + (gi * 2 + (pp >> 6)) * 16384 + att::v_st(pp & 63, c8 * 8)) = v; }
        __syncthreads();
        const int g = 2 * gp + gsel;
        att::f32x16 o[4] = {};
#pragma unroll
        for (int kt = 0; kt < 2; ++kt) {
            const float* wrow = gws + ((size_t)g * 128 + 32 * qb + r32) * 128 + 64 * kt + 8 * hi;
            att::bf16x8 pa[4];
#pragma unroll
            for (int ks = 0; ks < 4; ++ks) { const f32x4 w0 = *(const f32x4*)(wrow + 16 * ks), w1 = *(const f32x4*)(wrow + 16 * ks + 4);
                v4u w; w.x = pk2(w0.x, w0.y); w.y = pk2(w0.z, w0.w); w.z = pk2(w1.x, w1.y); w.w = pk2(w1.z, w1.w); pa[ks] = *reinterpret_cast<att::bf16x8*>(&w); }
            const int vb = (int)(unsigned)(uintptr_t)(F.lds + (gsel * 2 + kt) * 16384) + att::v_rd_base(lane);
            att::pv_d0(o, vb, pa[0], pa[1], pa[2], pa[3]);
        }
        __syncthreads();
        { LAS unsigned char* ob = F.lds + F.wave * (32 * 272);
#pragma unroll
          for (int i = 0; i < 8; ++i) { const int row = i * 4 + (lane >> 4), chk = lane & 15;
              *(LAS v4u*)(ob + row * 272 + chk * 16) = *(const v4u*)(UB + (size_t)(row0 + 32 * qb + row) * 512 + g * 128 + chk * 8); }
#pragma unroll
          for (int r = 0; r < 16; ++r) { const int qq = att::crow(r, hi); const float bias = gmb[g * 128 + 32 * qb + qq];
#pragma unroll
              for (int d0 = 0; d0 < 4; ++d0) { LAS bf16* e = (LAS bf16*)(ob + qq * 272 + (d0 * 32 + r32) * 2);
                  const float u = __uint_as_float((unsigned)*e << 16); const float val = u * (o[d0][r] + bias); *e = (bf16)(pk2(val, val) & 0xffffu); } }
#pragma unroll
          for (int i = 0; i < 8; ++i) { const int row = i * 4 + (lane >> 4), chk = lane & 15;
              *(v4u*)(MIX + (size_t)(row0 + 32 * qb + row) * MIXW + MX_GM + g * 128 + chk * 8) = *(const LAS v4u*)(ob + row * 272 + chk * 16); }
        }
        __syncthreads();
    }
}

__device__ __forceinline__ void act_fix_phase(KArgs a, int l, int M) {
    Frame F = make_frame(a);
    const float* EDGE = (const float*)(F.ws + WS_EDGE); bf16* ACT = (bf16*)(F.ws + WS_ACT);
    const float* cw = a->in[I_FCW] + (size_t)l * 3 * DFF; const float* cb = a->in[I_FCB] + (size_t)l * DFF;
    constexpr int CG = DFF / 4;
    const int total = (M / 256) * 2 * CG;
    for (int idx = F.bx * NTHR + F.tid; idx < total; idx += F.G * NTHR) {
        const int c0 = (idx % CG) * 4, pw = idx / CG, which = pw & 1, pm = pw >> 1;
        const bool first = pm >= 64 || (pm & 15) == 0, last = pm >= 64 || (pm & 15) == 15;
        const float* e = EDGE + (size_t)pm * 6 * DFF + c0;
        f32x4 prev, cur, next, uu; const f32x4 zero = (f32x4){0.f, 0.f, 0.f, 0.f};
        if (which == 0) { prev = first ? zero : *(const f32x4*)(e - (size_t)6 * DFF + (size_t)3 * DFF); cur = *(const f32x4*)e; next = *(const f32x4*)(e + DFF); uu = *(const f32x4*)(e + (size_t)4 * DFF); }
        else { prev = *(const f32x4*)(e + (size_t)2 * DFF); cur = *(const f32x4*)(e + (size_t)3 * DFF); next = last ? zero : *(const f32x4*)(e + (size_t)6 * DFF); uu = *(const f32x4*)(e + (size_t)5 * DFF); }
        const f32x4 z = *(const f32x4*)(cw + c0) * prev + *(const f32x4*)(cw + DFF + c0) * cur + *(const f32x4*)(cw + 2 * DFF + c0) * next + *(const f32x4*)(cb + c0);
        float o[4];
#pragma unroll
        for (int j = 0; j < 4; ++j) o[j] = z[j] * __builtin_amdgcn_rcpf(1.f + __expf(-z[j])) * uu[j];
        v2u w; w.x = pk2(o[0], o[1]); w.y = pk2(o[2], o[3]);
        *(v2u*)(ACT + (size_t)(pm * 256 + (which ? 255 : 0)) * DFF + c0) = w;
    }
}

constexpr int PH_P0A = 0, PH_P0B = 1, PH_L0 = 2, PH_PER_LAYER = 10, PH_FINAL = PH_L0 + DEPTH * PH_PER_LAYER, N_PHASES = PH_FINAL + 1;

__device__ __forceinline__ void gemm_in_phase(KArgs a, int l) {
    unsigned char* ws = a->ws; extern __shared__ __attribute__((aligned(16))) unsigned char lds_[];
    pg8::Gemm g{(const bf16*)(ws + WS_H), (const bf16*)(ws + WS_WIN) + (size_t)l * PW * DM, MT, PW, DM, DM, DM, 0, 0, 1};
    pg8::StaticOrder S; S.init(MT, PW, gridDim.x, blockIdx.x, DM);
    pg8::EpiBf16 E{(bf16*)(ws + WS_P), PW};
    pg8::gemm_phase<pg8::EpiBf16, pg8::StaticOrder, true, true>((LAS unsigned char*)lds_, g, S, E);
}
__device__ __forceinline__ void gemm_in_probe(KArgs a, int l) {
    unsigned char* ws = a->ws; extern __shared__ __attribute__((aligned(16))) unsigned char lds_[];
    pg8::Gemm g{(const bf16*)(ws + WS_H), (const bf16*)(ws + WS_WIN) + (size_t)l * PW * DM, MT, PW, DM, DM, DM, 0, 0, 1};
    pg8::StaticOrder S; S.init(MT, PW, gridDim.x, blockIdx.x, DM);
    pg8::EpiNone E{};
    pg8::gemm_phase<pg8::EpiNone, pg8::StaticOrder, true, true>((LAS unsigned char*)lds_, g, S, E);
}
__device__ __forceinline__ void gemm_up_phase(KArgs a, int l, int M2) {
    unsigned char* ws = a->ws; extern __shared__ __attribute__((aligned(16))) unsigned char lds_[];
    pg8::Gemm g{(const bf16*)(ws + WS_H), (const bf16*)(ws + WS_WUP) + (size_t)l * UPW * DM, M2, UPW, DM, DM, DM, 0, 0, 1};
    pg8::StaticOrder S; S.init(M2, UPW, gridDim.x, blockIdx.x, DM);
    pg8::EpiUp E{(bf16*)(ws + WS_ACT), (float*)(ws + WS_EDGE), a->in[I_FCW] + (size_t)l * 3 * DFF, a->in[I_FCB] + (size_t)l * DFF, (LAS float*)((LAS unsigned char*)lds_ + XL_OFF), DFF};
    pg8::gemm_phase<pg8::EpiUp, pg8::StaticOrder, true, true>((LAS unsigned char*)lds_, g, S, E);
}
__device__ __forceinline__ void gemm_out_phase(KArgs a, int l, int M2) {
    unsigned char* ws = a->ws; extern __shared__ __attribute__((aligned(16))) unsigned char lds_[];
    pg8::Gemm g{(const bf16*)(ws + WS_MIX), (const bf16*)(ws + WS_WOUT) + (size_t)l * DM * MIXW, M2, DM, MIXW, MIXW, MIXW, 0, 0, 1};
    pg8::SplitOrder S; S.init(ML, (M2 - ML) / 256, DM, gridDim.x, blockIdx.x, MIXW);
    pg8::EpiResGate E{(bf16*)(ws + WS_X), (const float*)(ws + WS_MOD) + (size_t)l * 5 * NMOD, 2 * DM, (float*)(ws + WS_XP), l == 0 ? a->in[I_X] : (const float*)nullptr};
    pg8::gemm_phase<pg8::EpiResGate, pg8::SplitOrder, true, true>((LAS unsigned char*)lds_, g, S, E);
}
__device__ __forceinline__ void gemm_down_phase(KArgs a, int l, int M2) {
    unsigned char* ws = a->ws; extern __shared__ __attribute__((aligned(16))) unsigned char lds_[];
    pg8::Gemm g{(const bf16*)(ws + WS_ACT), (const bf16*)(ws + WS_WDN) + (size_t)l * DM * DFF, M2, DM, DFF, DFF, DFF, 0, 0, 1};
    pg8::SplitOrder S; S.init(ML, (M2 - ML) / 256, DM, gridDim.x, blockIdx.x, DFF);
    pg8::EpiResGate E{(bf16*)(ws + WS_X), (const float*)(ws + WS_MOD) + (size_t)l * 5 * NMOD, 5 * DM, (float*)(ws + WS_XP), (const float*)nullptr};
    pg8::gemm_phase<pg8::EpiResGate, pg8::SplitOrder, true, true>((LAS unsigned char*)lds_, g, S, E);
}
__device__ __forceinline__ void attn_phase(KArgs a, int l, int part, int wg0) {
    unsigned char* ws = a->ws; extern __shared__ __attribute__((aligned(16))) unsigned char lds_[];
    const bf16* QB = (const bf16*)(ws + WS_QB); const bf16* KB = (const bf16*)(ws + WS_KB); const bf16* VB = (const bf16*)(ws + WS_VB); bf16* MIX = (bf16*)(ws + WS_MIX);
    const int G = gridDim.x, bx = blockIdx.x;
    const int xcd = bx & 7, wq = bx >> 3;
    const int ulo = part ? 512 + ((bx - wg0 + G) % G) : bx, uhi = part ? ((l < DEPTH - 1) ? 544 : 0) : 512;
    for (int u = ulo; u < uhi; u += G) {
        int b, h, kvh, qrow, seq;
        if (u < 512) { const int i = u / G; const int j = (G == 256) ? wq + 32 * i : (u >> 3), x = (G == 256) ? xcd : (u & 7);
            b = x >> 1; kvh = x & 1; h = kvh * 4 + (j >> 4); qrow = b * SEQ + (j & 15) * 256; seq = SKV; }
        else { const int c = u - 512; b = c >> 3; h = c & 7; kvh = h >> 2; qrow = ML + b * CTXL; seq = CTXL; }
        att::attn_dense_body(QB + (size_t)qrow * 1024 + h * 128, KB + (size_t)b * SKV * 256 + kvh * 128, VB + (size_t)b * SKV * 256 + kvh * 128,
                             MIX + (size_t)qrow * MIXW + MX_ATT + h * 128, seq, (char*)lds_);
    }
}
__device__ __forceinline__ void dft1_phase(KArgs a, int l) {
    unsigned char* ws = a->ws; extern __shared__ __attribute__((aligned(16))) unsigned char lds_[];
    pg8::Gemm g{(const bf16*)(ws + WS_A1), (const bf16*)(ws + WS_T1T), 256, 65536, 256, 256, 256, 0};
    pg8::StaticOrder S; S.init(256, 65536, gridDim.x, blockIdx.x, 256);
    pg8::EpiS1 E{(bf16*)(ws + WS_S2IN)};
    pg8::gemm_phase<pg8::EpiS1, pg8::StaticOrder, true, true>((LAS unsigned char*)lds_, g, S, E);
}
__device__ __forceinline__ void dft2_phase(KArgs a, int l) {
    unsigned char* ws = a->ws; extern __shared__ __attribute__((aligned(16))) unsigned char lds_[];
    const int G = gridDim.x, bx = blockIdx.x;
    {
        pg8::Gemm g{(const bf16*)(ws + WS_A2), (const bf16*)(ws + WS_S2IN), 4096, 2048, 512, 512, 512, (size_t)2048 * 512 * 2};
        pg8::StaticOrder S; S.init(4096, 2048, G, (bx + G / 2) % G, 512);
        pg8::EpiS2 E{(bf16*)(ws + WS_MIX), 0.0013810679320049757f};
        pg8::gemm_phase<pg8::EpiS2, pg8::StaticOrder, true, true>((LAS unsigned char*)lds_, g, S, E);
    }
    if (l < DEPTH - 1) {
        pg8::Gemm g{(const bf16*)(ws + WS_F256), (const bf16*)(ws + WS_T1TC), CTXL, 2048, 512, 512, 512, 0};
        pg8::StaticOrder S; S.init(CTXL, 2048, G, (bx + G - 96) % G, 512);
        pg8::EpiDft E{(bf16*)(ws + WS_MIX), ML, CTXL, 0.005524271728019903f};
        pg8::gemm_phase<pg8::EpiDft, pg8::StaticOrder, true, true>((LAS unsigned char*)lds_, g, S, E);
    }
}

__global__ void __launch_bounds__(NTHR, 2) hybrid_fwd(Args args_by_value) {
    extern __shared__ __attribute__((aligned(16))) unsigned char lds[];
    (void)args_by_value;
    int lo, hi; unsigned* ctl;
    { KArgs a = kargs(); lo = a->ph_lo; hi = a->ph_hi; ctl = (unsigned*)(a->ws + WS_CTL); }
    volatile LAS unsigned* MISC = (volatile LAS unsigned*)((LAS unsigned char*)lds + MISC_OFF);
    for (int u = threadIdx.x; u < (LDS_BYTES - LDSCTL_OFF) / 4; u += NTHR) ((LAS unsigned*)((LAS unsigned char*)lds + LDSCTL_OFF))[u] = 0u;
    __syncthreads();
    XcdBarrier bar; bar.bar = ctl + CW_BAR; bar.x = 0; bar.st = nullptr;
    if (!MK_PER_PHASE) bar = xcd_barrier_post(ctl + CW_BAR, MISC + 8);
#define IN(k) (lo <= (k) && (k) < hi)
#define SEAM(k) do { if (IN((k) + 1)) { if (MK_PER_PHASE) { if (threadIdx.x == 0) __hip_atomic_store(ctl + CW_TMO, 0xBADBA0u, RLX_AGENT); } else { xcd_barrier(bar); if (DUP(8)) xcd_barrier(bar); } } } while (0)

    for (int rep = 0; rep < (DUP(13) ? 2 : 1); ++rep) {
    if (rep) xcd_barrier(bar);
    if (IN(PH_P0A)) { p0a_prologue(kargs()); if (DUP(0)) p0a_prologue(kargs()); SEAM(PH_P0A); }
    if (IN(PH_P0B)) { p0b_modreduce(kargs()); SEAM(PH_P0B); }

    for (int l = 0; l < DEPTH; ++l) {
        int ph = PH_L0 + l * PH_PER_LAYER;
        const int M2 = (l == DEPTH - 1) ? ML : MT;
#define PHASE(kbit, call) do { if (IN(ph)) { call; if (DUP(kbit)) { if (DUP(15) && !MK_PER_PHASE) xcd_barrier(bar); call; } SEAM(ph); } ++ph; } while (0)
#define MODL ((const float*)(kargs()->ws + WS_MOD) + (size_t)l * 5 * NMOD)
        PHASE(12, norm_phase(kargs(), MT, kargs()->in[I_N1G] + l * DM, MODL, 0 * DM, 1 * DM, l > 0, l == 0, l == 0));
        PHASE(2, gemm_in_phase(kargs(), l));
        if (DUP(11) && IN(ph)) { gemm_in_probe(kargs(), l); xcd_barrier(bar); }
        PHASE(9, postA_phase(kargs(), l));
        PHASE(3, { attn_phase(kargs(), l, 0, 0); dft1_phase(kargs(), l); gate_phase(kargs(), l, 0, (int)gridDim.x, 0, min((int)gridDim.x, (l == DEPTH - 1 ? 128 : 136) * 2)); });
        PHASE(6, { gate_phase(kargs(), l, 0, (int)gridDim.x / 2, (int)gridDim.x, (l == DEPTH - 1 ? 128 : 136) * 2); attn_phase(kargs(), l, 1, 16); dft2_phase(kargs(), l); });
        PHASE(14, gemm_out_phase(kargs(), l, M2));
        PHASE(12, norm_phase(kargs(), M2, kargs()->in[I_N2G] + l * DM, MODL, 3 * DM, 4 * DM, l < DEPTH - 1, false, l == 0));
        PHASE(5, gemm_up_phase(kargs(), l, M2));
        PHASE(10, act_fix_phase(kargs(), l, M2));
        PHASE(14, gemm_down_phase(kargs(), l, M2));
#undef MODL
#undef PHASE
    }
    if (IN(PH_FINAL)) { KArgs a = kargs(); final_norm_phase(a, a->in[I_FNG], a->out); }
    }
#undef IN
#undef SEAM
}

extern "C" void kernel_launch(void* const* d_in, const int* in_sizes, int n_in, void* d_out, int out_size, void* d_ws, size_t ws_size, hipStream_t stream) {
    static int grid = 0;
    if (grid == 0) {
        if (n_in != 22 || out_size != ML * DM || ws_size < WS_END) { fprintf(stderr, "kernel_launch: unexpected shapes: n_in %d out %d ws %zu (need %zu)\n", n_in, out_size, ws_size, (size_t)WS_END); grid = -1; return; }
        int dev = 0, cus = 0, per_cu = 0;
        if (hipGetDevice(&dev) != hipSuccess || hipDeviceGetAttribute(&cus, hipDeviceAttributeMultiprocessorCount, dev) != hipSuccess) { grid = -1; return; }
        if (hipFuncSetAttribute((const void*)hybrid_fwd, hipFuncAttributeMaxDynamicSharedMemorySize, LDS_BYTES) != hipSuccess) { fprintf(stderr, "kernel_launch: hipFuncSetAttribute failed\n"); grid = -1; return; }
        if (hipOccupancyMaxActiveBlocksPerMultiprocessor(&per_cu, (const void*)hybrid_fwd, NTHR, LDS_BYTES) != hipSuccess || per_cu < 1)
            fprintf(stderr, "kernel_launch: occupancy query reports %d workgroups per CU\n", per_cu);
        (void)hipGetLastError();
        grid = cus;
    }
    if (grid < 0) return;
    if (hipMemsetAsync((char*)d_ws + WS_CTL, 0, CTL_ZERO_BYTES, stream) != hipSuccess) return;
    Args a{};
    for (int i = 0; i < 22; ++i) a.in[i] = (const float*)d_in[i];
    a.out = (float*)d_out; a.ws = (unsigned char*)d_ws;
#if MK_PER_PHASE
    for (int ph = 0; ph < N_PHASES; ++ph) { a.ph_lo = ph; a.ph_hi = ph + 1; hipLaunchKernelGGL(hybrid_fwd, dim3(grid), dim3(NTHR), LDS_BYTES, stream, a); }
#else
    a.ph_lo = 0; a.ph_hi = N_PHASES;
    hipLaunchKernelGGL(hybrid_fwd, dim3(grid), dim3(NTHR), LDS_BYTES, stream, a);
#endif
    const hipError_t le = hipPeekAtLastError();
    if (le != hipSuccess) fprintf(stderr, "kernel_launch: launch failed: %s\n", hipGetErrorName(le));
}
```

```cpp
#include <hip/hip_runtime.h>
#include <cstdio>
#include <cstdint>

#ifndef DUPMASK
#define DUPMASK 0
#endif
#define DUP(k) ((DUPMASK >> (k)) & 1)
#ifndef MK_PER_PHASE
#define MK_PER_PHASE 0
#endif

namespace pg8 {
#define PG8_LAS __attribute__((address_space(3)))
typedef unsigned short bf16_t;
typedef short bf16x8 __attribute__((ext_vector_type(8)));
typedef float f32x4 __attribute__((ext_vector_type(4)));
typedef unsigned u32x4 __attribute__((ext_vector_type(4)));
constexpr int BM = 256, BK = 64, HALF = 128, HTB = HALF * BK * 2, STAGE_BYTES = 8 * HTB, NXCD = 8, WGM = 4;

__host__ __device__ __forceinline__ int lds_byte(int r, int c) { const int st = (r >> 4) * 2 + (c >> 5), rr = r & 15, cc = c & 31, ob = rr * 64 + cc * 2; return st * 1024 + (ob ^ (((ob >> 9) & 1) << 5)); }
__host__ __device__ __forceinline__ void stage_rc(int b, int& R, int& C) { const int st = b / 1024, sb = b % 1024, swz = sb ^ (((sb >> 9) & 1) << 5); R = (st >> 1) * 16 + swz / 64; C = (st & 1) * 32 + (swz % 64) / 2; }
__host__ __device__ __forceinline__ int perm32(int rho) { const int n = rho >> 4, i = rho & 15; return 8 * (i >> 2) + 4 * n + (i & 3); }

struct Unit { int pm, pn, kt0, nkt, split; };
struct Gemm { const bf16_t* A; const bf16_t* Bt; int M, N, K, lda, ldb; size_t bpm; int tiledA, tiledB; };

struct StaticOrder {
    int nM, nN, nwg, G, c, ntk;
    __host__ __device__ void init(int M, int N, int G_, int c_, int K) { nM = M / BM; nN = N / BM; nwg = nM * nN; G = G_; c = c_; ntk = K / BK; }
    __host__ __device__ bool next(int i, Unit& u) const {
        const long L = (long)i * G + c; if (L >= nwg) return false;
        return tile((int)L, u);
    }
    __host__ __device__ bool tile(int wgid, Unit& u) const {
        u.kt0 = 0; u.nkt = ntk; u.split = 0; { const int q = nwg / NXCD, r = nwg % NXCD, xcd = wgid % NXCD, off = wgid / NXCD; wgid = (xcd < r ? xcd * (q + 1) : r * (q + 1) + (xcd - r) * q) + off; }
        const int nig = WGM * nN, gid = wgid / nig, fm = gid * WGM, gsz = (nM - fm) < WGM ? (nM - fm) : WGM;
        u.pm = fm + ((wgid % nig) % gsz); u.pn = (wgid % nig) / gsz; return true;
    }
    __device__ __forceinline__ void a_ready(const Unit&) const {}
    __device__ __forceinline__ void done(const Unit&) const {}
};
struct SplitOrder {
    StaticOrder so; int xp, nsplit;
    __host__ __device__ void init(int Mfull, int xpanels, int N, int G_, int c_, int K) { so.init(Mfull, N, G_, c_, K); xp = xpanels; nsplit = xpanels * so.nN * 4; }
    __host__ __device__ bool next(int i, Unit& u) const {
        const int L = i * so.G + so.c; const bool full = L < so.nwg;
        Unit f; so.tile(full ? L : 0, f);
        const int q = L - so.nwg, ks = q & 3, t = q >> 2, qn = so.ntk / 4;
        u.pm = full ? f.pm : so.nM + t / so.nN; u.pn = full ? f.pn : t % so.nN; u.nkt = full ? f.nkt : qn; u.kt0 = full ? 0 : ks * qn; u.split = full ? 0 : 1;
        return full || q < nsplit;
    }
    __device__ __forceinline__ void a_ready(const Unit&) const {}
    __device__ __forceinline__ void done(const Unit&) const {}
};

__device__ __forceinline__ unsigned cvt_pk_bf16(float lo, float hi) { unsigned r; asm volatile("v_cvt_pk_bf16_f32 %0, %1, %2" : "=v"(r) : "v"(lo), "v"(hi)); return r; }

struct EpiNone {
    static constexpr bool PERM = true, AFTER_DRAIN = false;
    __device__ __forceinline__ void operator()(const f32x4 (&acc)[2][2][4][2], const Unit& u, int wr, int wc, int fr, int fq) const {
#pragma unroll
        for (int ai = 0; ai < 2; ++ai)
#pragma unroll
            for (int bj = 0; bj < 2; ++bj)
#pragma unroll
                for (int m = 0; m < 4; ++m)
#pragma unroll
                    for (int n = 0; n < 2; ++n) asm volatile("" :: "v"(acc[ai][bj][m][n]));
    }
};
struct EpiBf16 {
    static constexpr bool PERM = true, AFTER_DRAIN = false;
    bf16_t* O; int ldc;
    __device__ __forceinline__ void operator()(const f32x4 (&acc)[2][2][4][2], const Unit& u, int wr, int wc, int fr, int fq) const {
        const int row0 = u.pm * BM + wr * 64 + fr; const int col0 = u.pn * BM + wc * 32 + 8 * fq;
#pragma unroll
        for (int ai = 0; ai < 2; ++ai)
#pragma unroll
            for (int m = 0; m < 4; ++m) { bf16_t* rowp = O + (size_t)(row0 + ai * HALF + m * 16) * ldc + col0;
#pragma unroll
                for (int bj = 0; bj < 2; ++bj) { const f32x4 v0 = acc[ai][bj][m][0], v1 = acc[ai][bj][m][1];
                    u32x4 w; w.x = cvt_pk_bf16(v0[0], v0[1]); w.y = cvt_pk_bf16(v0[2], v0[3]); w.z = cvt_pk_bf16(v1[0], v1[1]); w.w = cvt_pk_bf16(v1[2], v1[3]);
                    *(u32x4*)(rowp + bj * HALF) = w; } }
    }
};
struct EpiDft {
    static constexpr bool PERM = true, AFTER_DRAIN = false;
    bf16_t* MIX; int rowbase, nper; float scale;
    __device__ __forceinline__ void operator()(const f32x4 (&acc)[2][2][4][2], const Unit& u, int wr, int wc, int fr, int fq) const {
        const int k0 = u.pm * BM + wr * 64 + fr; const int n0 = u.pn * BM + wc * 32 + 8 * fq;
#pragma unroll
        for (int ai = 0; ai < 2; ++ai)
#pragma unroll
            for (int m = 0; m < 4; ++m) { const int k = k0 + ai * HALF + m * 16;
#pragma unroll
                for (int bj = 0; bj < 2; ++bj) { const int n = n0 + bj * HALF; const int b = n >> 9, gd = n & 511;
                    const f32x4 v0 = acc[ai][bj][m][0] * scale, v1 = acc[ai][bj][m][1] * scale;
                    u32x4 w; w.x = cvt_pk_bf16(v0[0], v0[1]); w.y = cvt_pk_bf16(v0[2], v0[3]); w.z = cvt_pk_bf16(v1[0], v1[1]); w.w = cvt_pk_bf16(v1[2], v1[3]);
                    *(u32x4*)(MIX + (size_t)(rowbase + b * nper + k) * 2560 + 1024 + gd) = w; } }
    }
};

struct EpiS1 {
    static constexpr bool PERM = true, AFTER_DRAIN = false;
    bf16_t* S2;
    __device__ __forceinline__ void operator()(const f32x4 (&acc)[2][2][4][2], const Unit& u, int wr, int wc, int fr, int fq) const {
        const int m0 = wr * 64 + fr; const int n0 = u.pn * BM + wc * 32 + 8 * fq;
#pragma unroll
        for (int ai = 0; ai < 2; ++ai)
#pragma unroll
            for (int mm = 0; mm < 4; ++mm) { const int m = m0 + mm * 16; const int k2 = m >> 1, ro = m & 1;
#pragma unroll
                for (int bj = 0; bj < 2; ++bj) { const int np = n0 + bj * HALF; const int n = np >> 5, c = ai * 32 + (np & 31);
                    const f32x4 v0 = acc[ai][bj][mm][0], v1 = acc[ai][bj][mm][1];
                    u32x4 w; w.x = cvt_pk_bf16(v0[0], v0[1]); w.y = cvt_pk_bf16(v0[2], v0[3]); w.z = cvt_pk_bf16(v1[0], v1[1]); w.w = cvt_pk_bf16(v1[2], v1[3]);
                    *(u32x4*)(S2 + ((((size_t)(k2 >> 2) * 2048 + n) * 4 + (k2 & 3)) * 2 + ro) * 64 + c) = w; } }
    }
};
struct EpiS2 {
    static constexpr bool PERM = true, AFTER_DRAIN = false;
    bf16_t* MIX; float scale;
    __device__ __forceinline__ void operator()(const f32x4 (&acc)[2][2][4][2], const Unit& u, int wr, int wc, int fr, int fq) const {
        const int m0 = wr * 64 + fr; const int n0 = u.pn * BM + wc * 32 + 8 * fq;
#pragma unroll
        for (int ai = 0; ai < 2; ++ai)
#pragma unroll
            for (int mm = 0; mm < 4; ++mm) { const int m = ai * HALF + m0 + mm * 16; const int k = 4 * u.pm + (m >> 6) + 64 * (m & 63);
#pragma unroll
                for (int bj = 0; bj < 2; ++bj) { const int n = n0 + bj * HALF; const int b = n >> 9, gd = n & 511;
                    const f32x4 v0 = acc[ai][bj][mm][0] * scale, v1 = acc[ai][bj][mm][1] * scale;
                    u32x4 w; w.x = cvt_pk_bf16(v0[0], v0[1]); w.y = cvt_pk_bf16(v0[2], v0[3]); w.z = cvt_pk_bf16(v1[0], v1[1]); w.w = cvt_pk_bf16(v1[2], v1[3]);
                    *(u32x4*)(MIX + (size_t)(b * 4096 + k) * 2560 + 1024 + gd) = w; } }
    }
};
struct EpiResGate {
    static constexpr bool PERM = true, AFTER_DRAIN = false;
    bf16_t* X; const float* modl; int goff; float* XP; const float* basef;
    __device__ __forceinline__ void operator()(const f32x4 (&acc)[2][2][4][2], const Unit& u, int wr, int wc, int fr, int fq) const {
        const int row0 = u.pm * BM + wr * 64 + fr, col0 = u.pn * BM + wc * 32 + 8 * fq;
        const int v = u.pm < 64 ? (u.pm >> 4) : 4;
        const float* gate = modl + (size_t)v * 12288 + goff;
        f32x4 gv[2][2];
#pragma unroll
        for (int bj = 0; bj < 2; ++bj)
#pragma unroll
            for (int n = 0; n < 2; ++n) gv[bj][n] = *(const f32x4*)(gate + col0 + bj * HALF + n * 4);
#pragma unroll
        for (int ai = 0; ai < 2; ++ai)
#pragma unroll
            for (int m = 0; m < 4; ++m) { const size_t ro = (size_t)(row0 + ai * HALF + m * 16) * 2048 + col0;
#pragma unroll
                for (int bj = 0; bj < 2; ++bj) { const size_t o = ro + bj * HALF; const f32x4 d0 = gv[bj][0] * acc[ai][bj][m][0], d1 = gv[bj][1] * acc[ai][bj][m][1];
                    if (u.split) { float* xp = XP + ((size_t)(u.kt0 / u.nkt) * 1024 + (row0 + ai * HALF + m * 16 - 16384)) * 2048 + col0 + bj * HALF;
                        *(f32x4*)xp = d0; *(f32x4*)(xp + 4) = d1; }
                    else { f32x4 b0, b1;
                        if (basef) { b0 = *(const f32x4*)(basef + o); b1 = *(const f32x4*)(basef + o + 4); }
                        else { const u32x4 w = *(const u32x4*)(X + o);
                            b0 = (f32x4){__uint_as_float(w.x << 16), __uint_as_float(w.x & 0xffff0000u), __uint_as_float(w.y << 16), __uint_as_float(w.y & 0xffff0000u)};
                            b1 = (f32x4){__uint_as_float(w.z << 16), __uint_as_float(w.z & 0xffff0000u), __uint_as_float(w.w << 16), __uint_as_float(w.w & 0xffff0000u)}; }
                        const f32x4 x0 = b0 + d0, x1 = b1 + d1; u32x4 wo; wo.x = cvt_pk_bf16(x0[0], x0[1]); wo.y = cvt_pk_bf16(x0[2], x0[3]); wo.z = cvt_pk_bf16(x1[0], x1[1]); wo.w = cvt_pk_bf16(x1[2], x1[3]);
                        *(u32x4*)(X + o) = wo; } } }
    }
};


__device__ __forceinline__ float dpp_ror1(float x)  { return __builtin_bit_cast(float, __builtin_amdgcn_update_dpp(0, __builtin_bit_cast(int, x), 0x121, 0xF, 0xF, false)); }
__device__ __forceinline__ float dpp_ror15(float x) { return __builtin_bit_cast(float, __builtin_amdgcn_update_dpp(0, __builtin_bit_cast(int, x), 0x12F, 0xF, 0xF, false)); }
__device__ __forceinline__ f32x4 ror1v(const f32x4 v)  { return (f32x4){dpp_ror1(v[0]), dpp_ror1(v[1]), dpp_ror1(v[2]), dpp_ror1(v[3])}; }
__device__ __forceinline__ f32x4 ror15v(const f32x4 v) { return (f32x4){dpp_ror15(v[0]), dpp_ror15(v[1]), dpp_ror15(v[2]), dpp_ror15(v[3])}; }
struct EpiUp {
    static constexpr bool PERM = true, AFTER_DRAIN = false;
    bf16_t* ACT; float* EDGE; const float* cw; const float* cb; PG8_LAS float* xl; int dff;
    __device__ __forceinline__ void operator()(const f32x4 (&acc)[2][2][4][2], const Unit& u, int wr, int wc, int fr, int fq) const {
        const int ch0 = u.pn * 128 + wc * 32 + 8 * fq;
        f32x4 w0[2], w1[2], w2[2], bb[2];
#pragma unroll
        for (int n = 0; n < 2; ++n) { w0[n] = *(const f32x4*)(cw + ch0 + 4 * n); w1[n] = *(const f32x4*)(cw + dff + ch0 + 4 * n); w2[n] = *(const f32x4*)(cw + 2 * dff + ch0 + 4 * n); bb[n] = *(const f32x4*)(cb + ch0 + 4 * n); }
#pragma unroll
        for (int ai = 0; ai < 2; ++ai)
#pragma unroll
            for (int n = 0; n < 2; ++n) {
                if (fr == 0)  *(PG8_LAS f32x4*)(xl + ((((wr * 4 + wc) * 2 + ai) * 2 + 0) * 32) + 8 * fq + 4 * n) = acc[ai][0][0][n];
                if (fr == 15) *(PG8_LAS f32x4*)(xl + ((((wr * 4 + wc) * 2 + ai) * 2 + 1) * 32) + 8 * fq + 4 * n) = acc[ai][0][3][n];
            }
        { float* eg = EDGE + (size_t)u.pm * 6 * dff + ch0;
          if (wr == 0 && fr < 2) {
#pragma unroll
              for (int n = 0; n < 2; ++n) { *(f32x4*)(eg + (size_t)fr * dff + 4 * n) = acc[0][0][0][n]; if (fr == 0) *(f32x4*)(eg + (size_t)4 * dff + 4 * n) = acc[0][1][0][n]; } }
          if (wr == 1 && fr >= 14) {
#pragma unroll
              for (int n = 0; n < 2; ++n) { *(f32x4*)(eg + (size_t)(fr - 12) * dff + 4 * n) = acc[1][0][3][n]; if (fr == 15) *(f32x4*)(eg + (size_t)5 * dff + 4 * n) = acc[1][1][3][n]; } }
        }
        asm volatile("s_waitcnt lgkmcnt(0)" ::: "memory"); __builtin_amdgcn_s_barrier(); asm volatile("" ::: "memory");
        f32x4 pe[2][2], ne[2][2];
#pragma unroll
        for (int ai = 0; ai < 2; ++ai)
#pragma unroll
            for (int n = 0; n < 2; ++n) {
                const bool hp = (wr == 1) || (ai == 1), hn = (wr == 0) || (ai == 0);
                const int pai = (wr == 1) ? ai : ai - 1, nai = (wr == 0) ? ai : ai + 1;
                pe[ai][n] = hp ? *(const PG8_LAS f32x4*)(xl + (((((wr ^ 1) * 4 + wc) * 2 + pai) * 2 + 1) * 32) + 8 * fq + 4 * n) : (f32x4){0.f, 0.f, 0.f, 0.f};
                ne[ai][n] = hn ? *(const PG8_LAS f32x4*)(xl + (((((wr ^ 1) * 4 + wc) * 2 + nai) * 2 + 0) * 32) + 8 * fq + 4 * n) : (f32x4){0.f, 0.f, 0.f, 0.f};
            }
        const int row0 = u.pm * BM + wr * 64 + fr;
#pragma unroll
        for (int ai = 0; ai < 2; ++ai)
#pragma unroll
            for (int m = 0; m < 4; ++m) {
                float z[8], t[8];
#pragma unroll
                for (int n = 0; n < 2; ++n) {
                    const f32x4 g = acc[ai][0][m][n];
                    const f32x4 gp = (m > 0) ? acc[ai][0][m > 0 ? m - 1 : 0][n] : pe[ai][n];
                    const f32x4 gn = (m < 3) ? acc[ai][0][m < 3 ? m + 1 : 3][n] : ne[ai][n];
                    const f32x4 zz = w1[n] * g + bb[n];
#pragma unroll
                    for (int j = 0; j < 4; ++j) { float zj = zz[j];
                        if ((m == 0 || m == 3) && n == 0 && j == 0)
                            asm("s_nop 1\n\t"
                                "v_fmac_f32_dpp %0, %1, %4 row_shr:1 row_mask:0xf bank_mask:0xf\n\t"
                                "v_fmac_f32_dpp %0, %2, %4 row_shl:15 row_mask:0xf bank_mask:0xf\n\t"
                                "v_fmac_f32_dpp %0, %1, %5 row_shl:1 row_mask:0xf bank_mask:0xf\n\t"
                                "v_fmac_f32_dpp %0, %3, %5 row_shr:15 row_mask:0xf bank_mask:0xf"
                                : "+v"(zj) : "v"(g[j]), "v"(gp[j]), "v"(gn[j]), "v"(w0[n][j]), "v"(w2[n][j]));
                        else
                            asm("v_fmac_f32_dpp %0, %1, %4 row_shr:1 row_mask:0xf bank_mask:0xf\n\t"
                                "v_fmac_f32_dpp %0, %2, %4 row_shl:15 row_mask:0xf bank_mask:0xf\n\t"
                                "v_fmac_f32_dpp %0, %1, %5 row_shl:1 row_mask:0xf bank_mask:0xf\n\t"
                                "v_fmac_f32_dpp %0, %3, %5 row_shr:15 row_mask:0xf bank_mask:0xf"
                                : "+v"(zj) : "v"(g[j]), "v"(gp[j]), "v"(gn[j]), "v"(w0[n][j]), "v"(w2[n][j]));
                        z[n * 4 + j] = zj; }
                }
#pragma unroll
                for (int i = 0; i < 8; ++i) t[i] = -1.4426950408889634f * z[i];
#pragma unroll
                for (int i = 0; i < 8; ++i) t[i] = __builtin_amdgcn_exp2f(t[i]);
#pragma unroll
                for (int i = 0; i < 8; ++i) t[i] = 1.f + t[i];
#pragma unroll
                for (int i = 0; i < 8; ++i) t[i] = __builtin_amdgcn_rcpf(t[i]);
#pragma unroll
                for (int i = 0; i < 8; ++i) t[i] = z[i] * t[i] * acc[ai][1][m][i >> 2][i & 3];
                u32x4 w; w.x = cvt_pk_bf16(t[0], t[1]); w.y = cvt_pk_bf16(t[2], t[3]); w.z = cvt_pk_bf16(t[4], t[5]); w.w = cvt_pk_bf16(t[6], t[7]);
                *(u32x4*)(ACT + (size_t)(row0 + ai * HALF + m * 16) * dff + ch0) = w;
            }
    }
};

template <class Epi, class Sched, bool ALIGN_EPI = false, bool SP2 = false>
__device__ __forceinline__ void gemm_phase(PG8_LAS unsigned char* lds, const Gemm g, const Sched& S, const Epi& E) {
    int tid_ = threadIdx.x; asm volatile("" : "+v"(tid_));
    const int tid = tid_, wid = __builtin_amdgcn_readfirstlane(tid >> 6), lane = tid & 63, wr = wid >> 2, wc = wid & 3, fr = lane & 15, fq = lane >> 4;
    unsigned voffA[2], voffB[2];
#pragma unroll
    for (int i = 0; i < 2; ++i) { int R, C; stage_rc(tid * 16 + i * 8192, R, C); const int Rb = Epi::PERM ? ((R & ~31) + perm32(R & 31)) : R;
        voffA[i] = (unsigned)(R * (g.tiledA ? BK : g.lda) + C) * 2u; voffB[i] = (unsigned)(Rb * (g.tiledB ? BK : g.ldb) + C) * 2u; }
    const size_t kstepA = g.tiledA ? (size_t)BM * BK * 2 : (size_t)(BK * 2), kstepB = g.tiledB ? (size_t)BM * BK * 2 : (size_t)(BK * 2);
    const size_t hstepA = (size_t)HALF * (g.tiledA ? BK : g.lda) * 2, hstepB = (size_t)HALF * (g.tiledB ? BK : g.ldb) * 2;
    const size_t tstepA = g.tiledA ? (size_t)(g.K / BK) * BM * BK * 2 : 2 * hstepA, tstepB = g.tiledB ? (size_t)(g.K / BK) * BM * BK * 2 : 2 * hstepB;
    const unsigned ldsw = (unsigned)wid * 1024u;
    const int aoff = lds_byte(wr * 64 + fr, fq * 8), boff = lds_byte(wc * 32 + fr, fq * 8);
#define PG8_SA(b, h) (((b) * 2 + (h)) * HTB)
#define PG8_SB(b, h) ((4 + (b) * 2 + (h)) * HTB)
#define PG8_STAGE(bufoff, gbase, voff) do { _Pragma("unroll") for (int _i = 0; _i < 2; ++_i) \
        __builtin_amdgcn_global_load_lds((const unsigned*)((const char*)(gbase) + (voff)[_i]), (PG8_LAS unsigned*)(lds + (bufoff) + ldsw + _i * 8192), 16, 0, 0); } while (0)
#define PG8_LDA(dst, b, h) do { _Pragma("unroll") for (int m = 0; m < 4; ++m) _Pragma("unroll") for (int k = 0; k < 2; ++k) dst[m][k] = *(const PG8_LAS bf16x8*)(lds + PG8_SA(b, h) + aoff + m * 2048 + k * 1024); } while (0)
#define PG8_LDB(dst, b, h) do { _Pragma("unroll") for (int n = 0; n < 2; ++n) _Pragma("unroll") for (int k = 0; k < 2; ++k) dst[n][k] = *(const PG8_LAS bf16x8*)(lds + PG8_SB(b, h) + boff + n * 2048 + k * 1024); } while (0)
#define PG8_MMA(ai, bj, At, Bt) do { __builtin_amdgcn_s_setprio(1); _Pragma("unroll") for (int m = 0; m < 4; ++m) _Pragma("unroll") for (int n = 0; n < 2; ++n) _Pragma("unroll") for (int k = 0; k < 2; ++k) \
        acc[ai][bj][m][n] = __builtin_amdgcn_mfma_f32_16x16x32_bf16(Bt[n][k], At[m][k], acc[ai][bj][m][n], 0, 0, 0); __builtin_amdgcn_s_setprio(0); } while (0)
#define PG8_WAIT_V(n) asm volatile("s_waitcnt vmcnt(" #n ")" ::: "memory")
#define PG8_WAIT_L(n) asm volatile("s_waitcnt lgkmcnt(" #n ")" ::: "memory")
#define PG8_BAR __builtin_amdgcn_s_barrier()
#define PG8_SCHED __builtin_amdgcn_sched_barrier(0)
    Unit cur, nxt; int ui = 0;
    if (!S.next(0, cur)) return;
    f32x4 acc[2][2][4][2];
#pragma unroll
    for (int a = 0; a < 2; ++a)
#pragma unroll
        for (int b = 0; b < 2; ++b)
#pragma unroll
            for (int m = 0; m < 4; ++m)
#pragma unroll
                for (int n = 0; n < 2; ++n) acc[a][b][m][n] = (f32x4){0.f, 0.f, 0.f, 0.f};
    bf16x8 At[4][2], B0[2][2], B1[2][2];
    const char* cA = (const char*)g.A + (size_t)cur.pm * tstepA + (size_t)cur.kt0 * kstepA; const char* cB = (const char*)g.Bt + (size_t)cur.pm * g.bpm + (size_t)cur.pn * tstepB + (size_t)cur.kt0 * kstepB;
    int nt = cur.nkt;
    S.a_ready(cur);
    if constexpr (SP2) {
        PG8_STAGE(PG8_SB(0, 0), cB, voffB); PG8_STAGE(PG8_SB(0, 1), cB + hstepB, voffB); PG8_STAGE(PG8_SA(0, 0), cA, voffA); PG8_STAGE(PG8_SA(0, 1), cA + hstepA, voffA);
        if (wr == 1) PG8_BAR;
        PG8_WAIT_V(2); PG8_BAR;
        PG8_STAGE(PG8_SB(1, 0), cB + kstepB, voffB); PG8_STAGE(PG8_SA(1, 0), cA + kstepA, voffA); PG8_STAGE(PG8_SB(1, 1), cB + hstepB + kstepB, voffB);
        PG8_WAIT_V(6); PG8_BAR;
    } else {
        PG8_STAGE(PG8_SB(0, 0), cB, voffB); PG8_STAGE(PG8_SA(0, 0), cA, voffA); PG8_STAGE(PG8_SB(0, 1), cB + hstepB, voffB); PG8_STAGE(PG8_SA(0, 1), cA + hstepA, voffA);
        if (wr == 1) PG8_BAR;
        PG8_WAIT_V(4); PG8_BAR;
        PG8_STAGE(PG8_SB(1, 0), cB + kstepB, voffB); PG8_STAGE(PG8_SA(1, 0), cA + kstepA, voffA); PG8_STAGE(PG8_SB(1, 1), cB + hstepB + kstepB, voffB);
        PG8_WAIT_V(6); PG8_BAR;
    }
    for (;;) {
        const bool has_next = S.next(ui + 1, nxt);
        const char* nA = has_next ? (const char*)g.A + (size_t)nxt.pm * tstepA + (size_t)nxt.kt0 * kstepA : cA; const char* nB = has_next ? (const char*)g.Bt + (size_t)nxt.pm * g.bpm + (size_t)nxt.pn * tstepB + (size_t)nxt.kt0 * kstepB : cB;
        for (int t = 0; t < nt; t += 2) {
            const bool last = (t == nt - 2);
            const char* a1 = cA + (size_t)(t + 1) * kstepA;
            const char* a2 = last ? nA : cA + (size_t)(t + 2) * kstepA; const char* b2 = last ? nB : cB + (size_t)(t + 2) * kstepB;
            const char* a3 = a2 + kstepA; const char* b3 = b2 + kstepB;
            if (last && has_next) S.a_ready(nxt);
            if constexpr (SP2) {
            PG8_LDB(B0, 0, 0); PG8_LDB(B1, 0, 1); PG8_SCHED; PG8_LDA(At, 0, 0); PG8_STAGE(PG8_SA(1, 1), a1 + hstepA, voffA);
            PG8_WAIT_V(8); PG8_WAIT_L(0); PG8_BAR; PG8_MMA(0, 0, At, B0); PG8_MMA(0, 1, At, B1); PG8_BAR; PG8_SCHED;
            PG8_LDA(At, 0, 1); PG8_STAGE(PG8_SB(0, 0), b2, voffB); PG8_STAGE(PG8_SB(0, 1), b2 + hstepB, voffB); PG8_STAGE(PG8_SA(0, 0), a2, voffA);
            PG8_WAIT_V(8); PG8_WAIT_L(0); PG8_BAR; PG8_MMA(1, 0, At, B0); PG8_MMA(1, 1, At, B1); PG8_BAR; PG8_SCHED;
            PG8_LDB(B0, 1, 0); PG8_LDB(B1, 1, 1); PG8_SCHED; PG8_LDA(At, 1, 0); PG8_STAGE(PG8_SA(0, 1), a2 + hstepA, voffA);
            PG8_WAIT_V(8); PG8_WAIT_L(0); PG8_BAR; PG8_MMA(0, 0, At, B0); PG8_MMA(0, 1, At, B1); PG8_BAR; PG8_SCHED;
            PG8_LDA(At, 1, 1); PG8_STAGE(PG8_SB(1, 0), b3, voffB); PG8_STAGE(PG8_SB(1, 1), b3 + hstepB, voffB); PG8_STAGE(PG8_SA(1, 0), a3, voffA);
            PG8_WAIT_V(8); PG8_WAIT_L(0); PG8_BAR; PG8_MMA(1, 0, At, B0); PG8_MMA(1, 1, At, B1); PG8_BAR; PG8_SCHED;
            } else {
            PG8_LDB(B0, 0, 0); PG8_SCHED; PG8_LDA(At, 0, 0); PG8_STAGE(PG8_SA(1, 1), a1 + hstepA, voffA);
            PG8_WAIT_L(8); PG8_BAR; PG8_WAIT_L(0); PG8_MMA(0, 0, At, B0); PG8_BAR; PG8_SCHED;
            PG8_LDB(B1, 0, 1); PG8_STAGE(PG8_SB(0, 0), b2, voffB);
            PG8_BAR; PG8_WAIT_L(0); PG8_MMA(0, 1, At, B1); PG8_BAR;
            PG8_LDA(At, 0, 1); PG8_STAGE(PG8_SA(0, 0), a2, voffA);
            PG8_BAR; PG8_WAIT_L(0); PG8_MMA(1, 0, At, B0); PG8_BAR; PG8_SCHED;
            PG8_STAGE(PG8_SB(0, 1), b2 + hstepB, voffB);
            PG8_WAIT_V(6); PG8_BAR; PG8_MMA(1, 1, At, B1); PG8_BAR;
            PG8_LDB(B0, 1, 0); PG8_SCHED; PG8_LDA(At, 1, 0); PG8_STAGE(PG8_SA(0, 1), a2 + hstepA, voffA);
            PG8_WAIT_L(8); PG8_BAR; PG8_WAIT_L(0); PG8_MMA(0, 0, At, B0); PG8_BAR; PG8_SCHED;
            PG8_LDB(B1, 1, 1); PG8_STAGE(PG8_SB(1, 0), b3, voffB);
            PG8_BAR; PG8_WAIT_L(0); PG8_MMA(0, 1, At, B1); PG8_BAR;
            PG8_LDA(At, 1, 1); PG8_STAGE(PG8_SA(1, 0), a3, voffA);
            PG8_BAR; PG8_WAIT_L(0); PG8_MMA(1, 0, At, B0); PG8_BAR; PG8_SCHED;
            PG8_STAGE(PG8_SB(1, 1), b3 + hstepB, voffB);
            PG8_WAIT_V(6); PG8_BAR; PG8_MMA(1, 1, At, B1); PG8_BAR;
            }
        }
        if constexpr (ALIGN_EPI) { if (wr == 0) PG8_BAR; }
        if constexpr (!Epi::AFTER_DRAIN) { E(acc, cur, wr, wc, fr, fq); S.done(cur); }
        if (!has_next) break;
#pragma unroll
        for (int a = 0; a < 2; ++a)
#pragma unroll
            for (int b = 0; b < 2; ++b)
#pragma unroll
                for (int m = 0; m < 4; ++m)
#pragma unroll
                    for (int n = 0; n < 2; ++n) acc[a][b][m][n] = (f32x4){0.f, 0.f, 0.f, 0.f};
        cur = nxt; cA = nA; cB = nB; nt = cur.nkt; ++ui;
        if constexpr (ALIGN_EPI) { if (wr == 1) PG8_BAR; }
    }
    PG8_WAIT_V(0);
    if constexpr (!ALIGN_EPI) { if (wr == 0) PG8_BAR; }
    PG8_BAR;
#undef PG8_SA
#undef PG8_SB
#undef PG8_STAGE
#undef PG8_LDA
#undef PG8_LDB
#undef PG8_MMA
#undef PG8_WAIT_V
#undef PG8_WAIT_L
#undef PG8_BAR
#undef PG8_SCHED
}
}

namespace att {
typedef unsigned short bf16;
constexpr int   D = 128, NW = 8, QBLK = 32, KVBLK = 64;
constexpr float SCALE = 0.088388347648318440f;
constexpr float THR = 8.f;
constexpr int LDQ = 1024, LDK = 256, LDO = 2560;
constexpr size_t SHM_V = KVBLK * D * 2, SHM_K = KVBLK * D * 2, SHM_ATTN = 2 * SHM_V + 2 * SHM_K + NW * 64 * 4;
using bf16x8 = __attribute__((ext_vector_type(8))) short;
using s16x4  = __attribute__((ext_vector_type(4))) short;
using f32x16 = __attribute__((ext_vector_type(16))) float;
using u32x4  = __attribute__((ext_vector_type(4))) unsigned;
#define KSWZ(row, colB) ((row) * 256 + ((colB) ^ (((row) & 7) << 4)))
#define SBAR() __builtin_amdgcn_sched_barrier(0)
__device__ __forceinline__ int crow(int r, int hi) { return (r & 3) + 8 * (r >> 2) + 4 * hi; }
__device__ __forceinline__ unsigned cvtpk(float lo, float hi) { unsigned r; asm volatile("v_cvt_pk_bf16_f32 %0, %1, %2" : "=v"(r) : "v"(lo), "v"(hi)); return r; }
__device__ __forceinline__ bf16x8 ld8(const bf16* p) { return *reinterpret_cast<const bf16x8*>(p); }

__device__ __forceinline__ void partialSM(f32x16& p0, f32x16& p1, float& m_reg, float& mn, float& alpha) {
  constexpr float C = SCALE * 1.4426950408889634f;
  float pmax = p0[0]; for (int r = 1; r < 16; ++r) pmax = fmaxf(pmax, p0[r]); for (int r = 0; r < 16; ++r) pmax = fmaxf(pmax, p1[r]);
  { auto rr = __builtin_amdgcn_permlane32_swap(__float_as_uint(pmax), __float_as_uint(pmax), false, false);
    pmax = fmaxf(__uint_as_float(rr[0]), __uint_as_float(rr[1])); }
  if (__builtin_expect(__all(pmax - m_reg <= THR / SCALE), 1)) { mn = m_reg; alpha = 1.f; }
  else { mn = fmaxf(m_reg, pmax); alpha = __builtin_amdgcn_exp2f((m_reg - mn) * C); m_reg = mn; }
  float mnC = -mn * C;
  for (int r = 0; r < 16; ++r) p0[r] = fmaf(p0[r], C, mnC); for (int r = 0; r < 16; ++r) p1[r] = fmaf(p1[r], C, mnC);
  for (int r = 0; r < 16; ++r) p0[r] = __builtin_amdgcn_exp2f(p0[r]);
}
__device__ __forceinline__ void finishSM(f32x16& p0, f32x16& p1, float alpha, float& l_reg, bf16x8& pa0, bf16x8& pa1, bf16x8& pa2, bf16x8& pa3) {
  for (int r = 0; r < 16; ++r) p1[r] = __builtin_amdgcn_exp2f(p1[r]);
  float ps = 0; for (int r = 0; r < 16; ++r) ps += p0[r]; for (int r = 0; r < 16; ++r) ps += p1[r];
  { auto rr = __builtin_amdgcn_permlane32_swap(__float_as_uint(ps), __float_as_uint(ps), false, false);
    ps = __uint_as_float(rr[0]) + __uint_as_float(rr[1]); }
  l_reg = l_reg * alpha + ps;
#define PK4(P, BASE, OUT) do { unsigned a0 = cvtpk(P[BASE + 0], P[BASE + 1]), a1 = cvtpk(P[BASE + 2], P[BASE + 3]);   \
    unsigned b0 = cvtpk(P[BASE + 4], P[BASE + 5]), b1 = cvtpk(P[BASE + 6], P[BASE + 7]);                              \
    auto r0 = __builtin_amdgcn_permlane32_swap(a0, b0, false, false); auto r1 = __builtin_amdgcn_permlane32_swap(a1, b1, false, false); \
    u32x4 w = {r0[0], r1[0], r0[1], r1[1]}; OUT = *reinterpret_cast<bf16x8*>(&w); } while (0)
  PK4(p0, 0, pa0); PK4(p0, 8, pa1); PK4(p1, 0, pa2); PK4(p1, 8, pa3);
#undef PK4
}
__device__ __forceinline__ void qkt(f32x16& p0, f32x16& p1, const bf16* Ks, const bf16x8* qr, int r32, int hi) {
  p0 = f32x16{}; p1 = f32x16{};
  for (int d0 = 0; d0 < 8; ++d0) { int cb = (d0 * 16 + hi * 8) * 2;
    bf16x8 b0 = *reinterpret_cast<const bf16x8*>((const char*)Ks + KSWZ(r32, cb));
    bf16x8 b1 = *reinterpret_cast<const bf16x8*>((const char*)Ks + KSWZ(32 + r32, cb));
    p0 = __builtin_amdgcn_mfma_f32_32x32x16_bf16(b0, qr[d0], p0, 0, 0, 0);
    p1 = __builtin_amdgcn_mfma_f32_32x32x16_bf16(b1, qr[d0], p1, 0, 0, 0); }
}
__device__ __forceinline__ int v_st(int k, int c) { const int kk = (k & ~0xC) | ((k & 4) << 1) | ((k & 8) >> 1); return ((kk >> 3) * 4 + (c >> 5)) * 512 + ((kk & 7) * 32 + (c & 31)) * 2; }
__device__ __forceinline__ int v_rd_base(int lane) { return ((lane & 3) << 3) | (((lane >> 2) & 3) << 6) | (((lane >> 4) & 1) << 5) | (((lane >> 5) & 1) << 8); }
constexpr int v_rd_off(int d0, int ks, int half) { return d0 * 512 + ks * 4096 + half * 2048; }
template <int OFF> __device__ __forceinline__ s16x4 tr_read(int vb) {
  s16x4 r; asm volatile("ds_read_b64_tr_b16 %0, %1 offset:%2" : "=&v"(r) : "v"(vb), "i"(OFF) : "memory"); return r;
}
template <int D0> __device__ __forceinline__ void pv_one(f32x16& od, int vb, bf16x8 pa0, bf16x8 pa1, bf16x8 pa2, bf16x8 pa3) {
  const s16x4 l0 = tr_read<v_rd_off(D0, 0, 0)>(vb), h0 = tr_read<v_rd_off(D0, 0, 1)>(vb), l1 = tr_read<v_rd_off(D0, 1, 0)>(vb), h1 = tr_read<v_rd_off(D0, 1, 1)>(vb);
  const s16x4 l2 = tr_read<v_rd_off(D0, 2, 0)>(vb), h2 = tr_read<v_rd_off(D0, 2, 1)>(vb), l3 = tr_read<v_rd_off(D0, 3, 0)>(vb), h3 = tr_read<v_rd_off(D0, 3, 1)>(vb);
  asm volatile("s_waitcnt lgkmcnt(0)" ::: "memory"); SBAR();
#define PK(L, H) (bf16x8){L[0], L[1], L[2], L[3], H[0], H[1], H[2], H[3]}
  od = __builtin_amdgcn_mfma_f32_32x32x16_bf16(pa0, PK(l0, h0), od, 0, 0, 0);
  od = __builtin_amdgcn_mfma_f32_32x32x16_bf16(pa1, PK(l1, h1), od, 0, 0, 0);
  od = __builtin_amdgcn_mfma_f32_32x32x16_bf16(pa2, PK(l2, h2), od, 0, 0, 0);
  od = __builtin_amdgcn_mfma_f32_32x32x16_bf16(pa3, PK(l3, h3), od, 0, 0, 0);
#undef PK
}
__device__ __forceinline__ void pv_d0(f32x16* o, int vb, bf16x8 pa0, bf16x8 pa1, bf16x8 pa2, bf16x8 pa3) {
  pv_one<0>(o[0], vb, pa0, pa1, pa2, pa3); pv_one<1>(o[1], vb, pa0, pa1, pa2, pa3); pv_one<2>(o[2], vb, pa0, pa1, pa2, pa3); pv_one<3>(o[3], vb, pa0, pa1, pa2, pa3);
}

__device__ __forceinline__ void attn_dense_body(const bf16* __restrict__ Qb, const bf16* __restrict__ Kh, const bf16* __restrict__ Vh,
                                                bf16* __restrict__ Ob, int seq, char* lds) {
  constexpr int SDEPTH = 2;
  int tid_ = threadIdx.x; asm volatile("" : "+v"(tid_));
  const int tid = tid_, wid = tid >> 6, lane = tid & 63, r32 = lane & 31, hi = lane >> 5;
  bf16* V_lds = (bf16*)lds; bf16* K_lds = (bf16*)(lds + 2 * SHM_V);
  float* ws = (float*)(lds + 2 * SHM_V + 2 * SHM_K) + wid * 64; float* li_l = ws; float* al_l = ws + 32;
  float m_reg = -1e30f, l_reg = 0; f32x16 o[4] = {}; bf16x8 qr[8];
  const bf16* Qw = Qb + (long)(wid * QBLK + r32) * LDQ + hi * 8;
#pragma unroll
  for (int d0 = 0; d0 < 8; ++d0) qr[d0] = ld8(Qw + d0 * 16);
  const int sr = tid >> 4, sc = (tid & 15) * 8, vst0 = v_st(sr, sc), vst1 = v_st(32 + sr, sc);
  const int vb0 = (int)(uintptr_t)V_lds + v_rd_base(lane);
  struct { bf16x8 vs0, vs1, ks0, ks1; } sr_[SDEPTH];
#define SLOAD(i, k0) do { sr_[i].vs0 = ld8(&Vh[(long)((k0) + sr) * LDK + sc]); sr_[i].vs1 = ld8(&Vh[(long)((k0) + 32 + sr) * LDK + sc]); \
    sr_[i].ks0 = ld8(&Kh[(long)((k0) + sr) * LDK + sc]); sr_[i].ks1 = ld8(&Kh[(long)((k0) + 32 + sr) * LDK + sc]); } while (0)
#define SWRITE(b, i) do { *(bf16x8*)((char*)V_lds + (b) * SHM_V + vst0) = sr_[i].vs0;          \
    *(bf16x8*)((char*)V_lds + (b) * SHM_V + vst1) = sr_[i].vs1; int kc = sc * 2;               \
    *(bf16x8*)((char*)K_lds + (b) * SHM_K + KSWZ(sr, kc)) = sr_[i].ks0;                       \
    *(bf16x8*)((char*)K_lds + (b) * SHM_K + KSWZ(32 + sr, kc)) = sr_[i].ks1; } while (0)
#define SWAIT() do { asm volatile("s_waitcnt vmcnt(4)" ::: "memory"); } while (0)
#define RESC(a) do { if (__any((a) < 1.f)) { if (hi == 0) al_l[r32] = (a); asm volatile("s_waitcnt lgkmcnt(0)" ::: "memory"); \
    for (int d = 0; d < 4; ++d) for (int r = 0; r < 16; ++r) o[d][r] *= al_l[crow(r, hi)]; } } while (0)
  f32x16 pA0, pA1, pB0, pB1; float mnA, mnB, alA, alB; bf16x8 pa0, pa1, pa2, pa3; const int NT = seq / KVBLK;
  constexpr int SE = 0, SO = SDEPTH - 1;
  SLOAD(SE, 0); asm volatile("s_waitcnt vmcnt(0)" ::: "memory"); SWRITE(0, SE); __syncthreads();
  qkt(pA0, pA1, K_lds, qr, r32, hi); partialSM(pA0, pA1, m_reg, mnA, alA);
  SLOAD(SO, KVBLK); if (2 < NT) SLOAD(SE, 2 * KVBLK);
  SWAIT(); SWRITE(1, SO); __syncthreads();
  for (int j = 1; j + 1 < NT; j += 2) {
    SBAR(); qkt(pB0, pB1, (bf16*)((char*)K_lds + SHM_K), qr, r32, hi);
    finishSM(pA0, pA1, alA, l_reg, pa0, pa1, pa2, pa3); SBAR();
    SLOAD(SO, (j + SDEPTH) * KVBLK); SBAR();
    pv_d0(o, vb0, pa0, pa1, pa2, pa3); partialSM(pB0, pB1, m_reg, mnB, alB);
    __syncthreads(); SWAIT(); SWRITE(0, SE);
    RESC(alB); __syncthreads();
    SBAR(); qkt(pA0, pA1, K_lds, qr, r32, hi);
    finishSM(pB0, pB1, alB, l_reg, pa0, pa1, pa2, pa3); SBAR();
    if (j + 3 < NT) SLOAD(SE, (j + 1 + SDEPTH) * KVBLK); SBAR();
    pv_d0(o, vb0 + (int)SHM_V, pa0, pa1, pa2, pa3); partialSM(pA0, pA1, m_reg, mnA, alA);
    __syncthreads(); SWAIT(); SWRITE(1, SO);
    RESC(alA); __syncthreads();
  }
  SBAR(); qkt(pB0, pB1, (bf16*)((char*)K_lds + SHM_K), qr, r32, hi);
  finishSM(pA0, pA1, alA, l_reg, pa0, pa1, pa2, pa3); SBAR();
  pv_d0(o, vb0, pa0, pa1, pa2, pa3); partialSM(pB0, pB1, m_reg, mnB, alB);
  __syncthreads(); RESC(alB);
  finishSM(pB0, pB1, alB, l_reg, pa0, pa1, pa2, pa3); SBAR();
  pv_d0(o, vb0 + (int)SHM_V, pa0, pa1, pa2, pa3);
  if (hi == 0) li_l[r32] = l_reg; asm volatile("s_waitcnt lgkmcnt(0)" ::: "memory");
  float rli[16];
#pragma unroll
  for (int r = 0; r < 16; ++r) rli[r] = __builtin_amdgcn_rcpf(li_l[crow(r, hi)]);
  bf16* Ow = Ob + (long)(wid * QBLK) * LDO;
  __syncthreads();
  char* ob = lds + wid * (32 * 272);
#pragma unroll
  for (int r = 0; r < 16; ++r) { const int orow = crow(r, hi);
#pragma unroll
    for (int d0 = 0; d0 < 4; ++d0) { const float val = o[d0][r] * rli[r]; *(bf16*)(ob + orow * 272 + (d0 * 32 + r32) * 2) = (bf16)(cvtpk(val, val) & 0xffffu); } }
#pragma unroll
  for (int i = 0; i < 8; ++i) { const int row = i * 4 + (lane >> 4), ch = lane & 15;
    const u32x4 v = *(const u32x4*)(ob + row * 272 + ch * 16);
    *(u32x4*)(Ow + (long)row * LDO + ch * 8) = v; }
  __syncthreads();
#undef SLOAD
#undef SWRITE
#undef SWAIT
#undef RESC
}
#undef KSWZ
#undef SBAR
}

constexpr int NWAVES = 8, NTHR = 512;
constexpr int DM = 2048, NB = 4, SEQ = 4096, DEPTH = 4, CTXL = 256;
constexpr int ML = NB * SEQ, MC = NB * CTXL, MT = ML + MC;
constexpr int SKV = CTXL + SEQ;
constexpr int INW_SRC = 4608, PW = 5120;
constexpr int PQ = 0, PK = 1024, PV = 1280, PFA = 1536, PFB = 2048, PCB = 2560, PCC = 3072, PCH = 3584, PGU = 4096, PGV = 4608;
constexpr int MIXW = 2560, MX_ATT = 0, MX_FOUR = 1024, MX_CONV = 1536, MX_GM = 2048;
constexpr int DFF = 5632, UPW = 2 * DFF;
constexpr int NMOD = 6 * DM;
constexpr float EPS = 1e-6f;

constexpr size_t al256(size_t x) { return (x + 255) / 256 * 256; }
constexpr size_t WS_CTL = 0, CTL_ZERO_BYTES = 1u << 20;
constexpr size_t WS_WIN  = CTL_ZERO_BYTES;
constexpr size_t WS_WOUT = WS_WIN  + (size_t)DEPTH * PW * DM * 2;
constexpr size_t WS_WUP  = WS_WOUT + (size_t)DEPTH * DM * MIXW * 2;
constexpr size_t WS_WDN  = WS_WUP  + (size_t)DEPTH * UPW * DM * 2;
constexpr size_t WS_FN   = WS_WDN  + (size_t)DEPTH * DM * DFF * 2;
constexpr size_t WS_A1   = WS_FN;
constexpr size_t WS_A2   = WS_A1   + (size_t)256 * 256 * 2;
constexpr size_t WS_F256 = WS_A2   + (size_t)16 * 256 * 512 * 2;
constexpr size_t WS_MODP = WS_F256 + (size_t)256 * 512 * 2;
constexpr size_t WS_MOD  = WS_MODP + (size_t)16 * DEPTH * 5 * NMOD * 4;
constexpr size_t WS_ROPE = WS_MOD  + (size_t)DEPTH * 5 * NMOD * 4;
constexpr size_t WS_MODG = WS_ROPE + 64 * 32 * 8;
constexpr size_t WS_X    = WS_MODG + (size_t)DEPTH * 2 * 5 * DM * 4;
constexpr size_t WS_H    = WS_X    + (size_t)MT * DM * 2;
constexpr size_t WS_R    = WS_H    + (size_t)MT * DM * 2;
constexpr size_t WS_P    = WS_R;
constexpr size_t WS_MIX  = WS_P    + (size_t)MT * PW * 2;
constexpr size_t WS_T1T  = WS_MIX  + (size_t)MT * MIXW * 2;
constexpr size_t WS_T1TC = WS_T1T  + (size_t)2048 * 8192 * 2;
constexpr size_t WS_KB   = WS_T1TC + (size_t)2048 * 512 * 2;
constexpr size_t WS_VB   = WS_KB   + (size_t)NB * SKV * 256 * 2;
constexpr size_t WS_QB   = WS_VB   + (size_t)NB * SKV * 256 * 2;
constexpr size_t WS_UB   = WS_QB   + (size_t)MT * 1024 * 2;
constexpr size_t WS_V2B  = WS_UB   + (size_t)MT * 512 * 2;
constexpr size_t WS_S2IN = WS_V2B  + (size_t)MT * 512 * 2;
constexpr size_t WS_RA_END = WS_S2IN + (size_t)16 * 2048 * 512 * 2;
constexpr size_t WS_ACT  = WS_R;
constexpr size_t WS_ACT_END = WS_ACT + (size_t)MT * DFF * 2;
constexpr size_t WS_R_END = WS_RA_END > WS_ACT_END ? WS_RA_END : WS_ACT_END;
constexpr size_t WS_EDGE = WS_R_END;
constexpr size_t WS_XP   = WS_EDGE + (size_t)(MT / 256) * 6 * DFF * 4;
constexpr size_t WS_END  = WS_XP   + (size_t)4 * MC * DM * 4;
static_assert(WS_END <= 1600000000ull, "d_ws budget");
static_assert(WS_WIN % 256 == 0 && WS_FN % 256 == 0 && WS_X % 256 == 0 && WS_H % 256 == 0 && WS_P % 256 == 0 && WS_MIX % 256 == 0 && WS_T1T % 256 == 0 && WS_KB % 256 == 0 && WS_ACT % 256 == 0 && WS_MOD % 256 == 0, "alignment");
constexpr int CW_TMO = 0, CW_BAR = 4096;

constexpr int RING_BYTES = 131072;
constexpr int LDSCTL_OFF = RING_BYTES, MISC_OFF = LDSCTL_OFF + 320;
constexpr int XL_OFF = RING_BYTES + 1024;
constexpr int LDS_BYTES = 147456;

#define GAS __attribute__((address_space(1)))
#define LAS __attribute__((address_space(3)))
typedef unsigned short bf16;
typedef unsigned v4u __attribute__((ext_vector_type(4)));
typedef unsigned v2u __attribute__((ext_vector_type(2)));
typedef float f32x4 __attribute__((ext_vector_type(4)));
typedef float f32x2 __attribute__((ext_vector_type(2)));
#define RLX_AGENT __ATOMIC_RELAXED, __HIP_MEMORY_SCOPE_AGENT
#define LDS_WAIT() asm volatile("s_waitcnt lgkmcnt(0)" ::: "memory")
#define VM_WAIT() asm volatile("s_waitcnt vmcnt(0)" ::: "memory")
__device__ __forceinline__ unsigned pk2(float lo, float hi) { unsigned r; asm volatile("v_cvt_pk_bf16_f32 %0, %1, %2" : "=v"(r) : "v"(lo), "v"(hi)); return r; }
__device__ __forceinline__ float bflo(unsigned w) { return __uint_as_float(w << 16); }
__device__ __forceinline__ float bfhi(unsigned w) { return __uint_as_float(w & 0xffff0000u); }
__device__ __forceinline__ void unpack8(const v4u w, float (&x)[8]) { x[0] = bflo(w.x); x[1] = bfhi(w.x); x[2] = bflo(w.y); x[3] = bfhi(w.y); x[4] = bflo(w.z); x[5] = bfhi(w.z); x[6] = bflo(w.w); x[7] = bfhi(w.w); }
__device__ __forceinline__ v4u pack8(const float (&x)[8]) { v4u w; w.x = pk2(x[0], x[1]); w.y = pk2(x[2], x[3]); w.z = pk2(x[4], x[5]); w.w = pk2(x[6], x[7]); return w; }
__device__ __forceinline__ float wave_sum(float v) {
#pragma unroll
    for (int o = 1; o < 64; o <<= 1) v += __shfl_xor(v, o);
    return v;
}
__device__ __forceinline__ float gelu_tanh(float x) { const float y = 0.7978845608028654f * (x + 0.044715f * x * x * x); return 0.5f * x * (1.f + tanhf(y)); }

#define XB_TMO      128
#define XB_XCNT(j)  (256  + 64 * (j))
#define XB_XSUB(j)  (1280 + 64 * (j))
#define XB_XGEN(j)  (2304 + 64 * (j))
#define XB_TOP      3328
#define XB_TOPGEN   3392
#define XCD_BAR_WORDS 3456
#define XB_SPIN_CAP (1u << 18)
__device__ __forceinline__ unsigned xb_ld(unsigned* p)              { return __hip_atomic_load(p, __ATOMIC_RELAXED, __HIP_MEMORY_SCOPE_AGENT); }
__device__ __forceinline__ unsigned xb_add(unsigned* p, unsigned v) { return __hip_atomic_fetch_add(p, v, __ATOMIC_RELAXED, __HIP_MEMORY_SCOPE_AGENT); }
__device__ __forceinline__ unsigned xb_xcc_id() { return (unsigned)__builtin_amdgcn_s_getreg((3 << 11) | 20) & 0xFu; }
#define XB_SPIN(cond, bar) do { unsigned _sp = 0; while (cond) { __builtin_amdgcn_s_sleep(1); \
    if ((++_sp & 255u) == 0u) { if (xb_ld(&(bar)[XB_TMO])) break; if (_sp > XB_SPIN_CAP) { atomicAdd(&(bar)[XB_TMO], 1u); break; } } } } while (0)
struct XcdBarrier { unsigned* bar; unsigned x; volatile LAS unsigned* st; };
__device__ __forceinline__ XcdBarrier xcd_barrier_post(unsigned* bar, volatile LAS unsigned* st) {
    XcdBarrier b; b.bar = bar; b.x = xb_xcc_id(); b.st = st;
    if (threadIdx.x == 0) (void)xb_add(&bar[XB_XCNT(b.x)], 1u);
    return b;
}
__device__ __forceinline__ void xcd_barrier_complete(unsigned* bar, unsigned x, unsigned& nloc, unsigned& nx) {
    const unsigned G = gridDim.x * gridDim.y * gridDim.z;
    unsigned sum, cnt, mine, sp = 0u;
    for (;;) {
        sum = 0u; cnt = 0u; mine = 0u;
#pragma unroll
        for (unsigned j = 0; j < 16; ++j) { const unsigned c = xb_ld(&bar[XB_XCNT(j)]); sum += c; cnt += (c > 0u) ? 1u : 0u; mine = (j == x) ? c : mine; }
        if (sum == G) break;
        __builtin_amdgcn_s_sleep(1);
        if ((++sp & 255u) == 0u) { if (xb_ld(&bar[XB_TMO])) break; if (sp > XB_SPIN_CAP) { atomicAdd(&bar[XB_TMO], 1u); break; } }
    }
    nloc = mine > 0u ? mine : 1u; nx = cnt > 0u ? cnt : 1u;
}
__device__ __forceinline__ void xcd_barrier(const XcdBarrier& b) {
    asm volatile("s_waitcnt vmcnt(0)" ::: "memory");
    __syncthreads();
    if (threadIdx.x == 0) {
        unsigned* bar = b.bar;
        __builtin_amdgcn_s_waitcnt(0);
        unsigned nloc = b.st[0], nx = b.st[1];
        if (nloc == 0u) { xcd_barrier_complete(bar, b.x, nloc, nx); b.st[0] = nloc; b.st[1] = nx; }
        const unsigned old = xb_add(&bar[XB_XSUB(b.x)], 1u);
        const unsigned gen = old / nloc;
        if (old + 1u == (gen + 1u) * nloc) {
            __builtin_amdgcn_fence(__ATOMIC_RELEASE, "agent");
            asm volatile("s_waitcnt vmcnt(0)" ::: "memory");
            const unsigned og = xb_add(&bar[XB_TOP], 1u);
            const unsigned tg = og / nx;
            if (og + 1u == (tg + 1u) * nx) xb_add(&bar[XB_TOPGEN], 1u);
            else XB_SPIN(xb_ld(&bar[XB_TOPGEN]) == tg, bar);
            __builtin_amdgcn_fence(__ATOMIC_ACQUIRE, "agent");
            xb_add(&bar[XB_XGEN(b.x)], 1u);
            asm volatile("s_waitcnt vmcnt(0)" ::: "memory");
        } else {
            XB_SPIN(xb_ld(&bar[XB_XGEN(b.x)]) == gen, bar);
            __builtin_amdgcn_fence(__ATOMIC_ACQUIRE, "agent");
            asm volatile("s_waitcnt vmcnt(0)" ::: "memory");
        }
    }
    __syncthreads();
}

struct Args { const float* in[22]; float* out; unsigned char* ws; int ph_lo, ph_hi; };
enum { I_X = 0, I_C, I_CTX, I_CCTX, I_WMOD, I_BMOD, I_N1G, I_N2G, I_WIN, I_QG, I_KG, I_CONVW, I_LNG, I_LNB, I_GMWS, I_GMB, I_WOUT, I_WUP, I_FCW, I_FCB, I_WDN, I_FNG };

typedef const Args __attribute__((address_space(4)))* KArgs;
__device__ __forceinline__ KArgs kargs() { KArgs p = (KArgs)__builtin_amdgcn_kernarg_segment_ptr(); asm volatile("" : "+s"(p)); return p; }
struct Frame {
    LAS unsigned char* lds;
    int tid, lane, wave, G, bx, gw, ngw;
    unsigned char* ws;
};
__device__ __forceinline__ Frame make_frame(KArgs a) {
    extern __shared__ __attribute__((aligned(16))) unsigned char lds_[];
    Frame F; int t = threadIdx.x; asm volatile("" : "+v"(t));
    F.lds = (LAS unsigned char*)lds_; F.tid = t; F.lane = t & 63; F.wave = __builtin_amdgcn_readfirstlane(t >> 6);
    F.G = gridDim.x; F.bx = blockIdx.x; F.gw = F.bx * NWAVES + F.wave; F.ngw = F.G * NWAVES; F.ws = a->ws;
    return F;
}

__device__ __forceinline__ size_t toff(int n, int k, int K) { return ((size_t)(n >> 8) * (K >> 6) + (k >> 6)) * 16384 + (size_t)(n & 255) * 64 + (k & 63); }
__device__ __forceinline__ void transpose_item(const float* W, int ldw, int k0, int ns0, bf16* WT, int ldt, int nd0, LAS float* scr, int lane) {
    f32x4 v[8];
#pragma unroll
    for (int i = 0; i < 8; ++i) v[i] = *(const f32x4*)(W + (size_t)(k0 + i * 8 + (lane >> 3)) * ldw + ns0 + (lane & 7) * 4);
#pragma unroll
    for (int i = 0; i < 8; ++i) { LAS float* d = scr + (i * 8 + (lane >> 3)) * 33 + (lane & 7) * 4; d[0] = v[i].x; d[1] = v[i].y; d[2] = v[i].z; d[3] = v[i].w; }
    LDS_WAIT(); asm volatile("" ::: "memory");
    const int c = lane & 7;
#pragma unroll
    for (int j = 0; j < 4; ++j) { const int n = (lane >> 3) + 8 * j; const LAS float* s = scr + (8 * c) * 33 + n;
        v4u o; o.x = pk2(s[0 * 33], s[1 * 33]); o.y = pk2(s[2 * 33], s[3 * 33]); o.z = pk2(s[4 * 33], s[5 * 33]); o.w = pk2(s[6 * 33], s[7 * 33]);
        *(v4u*)(WT + toff(nd0 + n, k0 + 8 * c, ldt)) = o; }
    LDS_WAIT(); asm volatile("" ::: "memory");
}

__device__ __forceinline__ void p0a_prologue(KArgs a) {
    Frame F = make_frame(a); unsigned char* ws = F.ws;
    {
        LAS float* scr = (LAS float*)(F.lds + F.wave * 16384);
        constexpr int I_IN = 32 * 128, I_OUT = 40 * 64, I_UP = 32 * 352, I_DN = 88 * 64, I_L = I_IN + I_OUT + I_UP + I_DN;
        for (int it = F.gw; it < DEPTH * I_L; it += F.ngw) {
            const int l = it / I_L; int r = it % I_L;
            if (r < I_IN) { const int kb = r / 128, nb = r % 128; const int ns0 = nb < 48 ? nb * 32 : 2048 + (nb - 48) * 32; const int nd0 = nb < 48 ? ns0 : ns0 + 512;
                transpose_item(a->in[I_WIN] + (size_t)l * DM * INW_SRC, INW_SRC, kb * 64, ns0, (bf16*)(ws + WS_WIN) + (size_t)l * PW * DM, DM, nd0, scr, F.lane); continue; }
            r -= I_IN;
            if (r < I_OUT) { const int kb = r / 64, nb = r % 64;
                transpose_item(a->in[I_WOUT] + (size_t)l * MIXW * DM, DM, kb * 64, nb * 32, (bf16*)(ws + WS_WOUT) + (size_t)l * DM * MIXW, MIXW, nb * 32, scr, F.lane); continue; }
            r -= I_OUT;
            if (r < I_UP) { const int kb = r / 352, nb = r % 352; const int nd0 = nb * 32, ns0 = ((nd0 >> 7) & 1) * DFF + (nd0 >> 8) * 128 + (nd0 & 127);
                transpose_item(a->in[I_WUP] + (size_t)l * DM * UPW, UPW, kb * 64, ns0, (bf16*)(ws + WS_WUP) + (size_t)l * UPW * DM, DM, nb * 32, scr, F.lane); continue; }
            r -= I_UP;
            { const int kb = r / 64, nb = r % 64;
                transpose_item(a->in[I_WDN] + (size_t)l * DFF * DM, DM, kb * 64, nb * 32, (bf16*)(ws + WS_WDN) + (size_t)l * DM * DFF, DFF, nb * 32, scr, F.lane); }
        }
    }
    __syncthreads();
    {
        LAS float* sl = (LAS float*)F.lds;
        for (int i = F.tid; i < 5 * DM; i += NTHR) { const int v = i / DM, k = i % DM; const float cv = v < 4 ? a->in[I_C][v * DM + k] : a->in[I_CCTX][k]; sl[i] = cv / (1.f + expf(-cv)); }
        __syncthreads();
        float* MODP = (float*)(ws + WS_MODP);
        for (int it = F.gw; it < DEPTH * 16 * 48; it += F.ngw) {
            const int l = it / 768, r = it % 768, ks = r / 48, cg = r % 48;
            const float* wp = a->in[I_WMOD] + ((size_t)l * DM + ks * 128) * NMOD + cg * 256 + F.lane * 4;
            f32x4 acc[5];
#pragma unroll
            for (int v = 0; v < 5; ++v) acc[v] = (f32x4){0.f, 0.f, 0.f, 0.f};
            for (int k = 0; k < 128; k += 8) {
                f32x4 w[8];
#pragma unroll
                for (int u = 0; u < 8; ++u) w[u] = *(const f32x4*)(wp + (size_t)(k + u) * NMOD);
#pragma unroll
                for (int u = 0; u < 8; ++u)
#pragma unroll
                    for (int v = 0; v < 5; ++v) acc[v] += w[u] * sl[v * DM + ks * 128 + k + u];
            }
#pragma unroll
            for (int v = 0; v < 5; ++v) *(f32x4*)(MODP + ((size_t)ks * (DEPTH * 5) + l * 5 + v) * NMOD + cg * 256 + F.lane * 4) = acc[v];
        }
    }
    __syncthreads();
    {
        LAS float* T128 = (LAS float*)F.lds;
        LAS float* Wl = (LAS float*)(F.lds + 1024);
        if (F.tid < 128) T128[F.tid] = cospif((float)F.tid * (1.f / 64.f));
        __syncthreads();
        for (int it = F.bx; it < DEPTH * 4 * 64; it += F.G) {
            const int l = it / 256, g = (it / 64) % 4, kb = it % 64;
            for (int i = F.tid; i < 32 * 128; i += NTHR) { const int kk = i / 128, dd = i % 128; Wl[dd * 36 + kk] = a->in[I_WIN][((size_t)l * DM + kb * 32 + kk) * INW_SRC + 1536 + g * 128 + dd]; }
            __syncthreads();
            const int dout = F.tid & 127, cs = (F.tid >> 7) & 1, kg = F.tid >> 8;
            float acc[16];
#pragma unroll
            for (int kk = 0; kk < 16; ++kk) acc[kk] = 0.f;
            for (int dd = 0; dd < 128; ++dd) {
                const float tr = T128[(dout * dd - (cs ? 32 : 0)) & 127];
#pragma unroll
                for (int q4 = 0; q4 < 4; ++q4) { const f32x4 w4 = *(const LAS f32x4*)(Wl + dd * 36 + kg * 16 + 4 * q4);
                    acc[4 * q4] += w4.x * tr; acc[4 * q4 + 1] += w4.y * tr; acc[4 * q4 + 2] += w4.z * tr; acc[4 * q4 + 3] += w4.w * tr; }
            }
            bf16* dst = (bf16*)(ws + WS_WIN) + (size_t)l * PW * DM + toff(PFA + cs * 512 + g * 128 + dout, kb * 32 + kg * 16, DM);
            v4u o0, o1; o0.x = pk2(acc[0], acc[1]); o0.y = pk2(acc[2], acc[3]); o0.z = pk2(acc[4], acc[5]); o0.w = pk2(acc[6], acc[7]);
            o1.x = pk2(acc[8], acc[9]); o1.y = pk2(acc[10], acc[11]); o1.z = pk2(acc[12], acc[13]); o1.w = pk2(acc[14], acc[15]);
            *(v4u*)dst = o0; *(v4u*)(dst + 8) = o1;
            __syncthreads();
        }
    }
    __syncthreads();
    {
        LAS float* T = (LAS float*)F.lds;
        for (int i = F.tid; i < 4096; i += NTHR) T[i] = cospif((float)i * (1.f / 2048.f));
        __syncthreads();
        bf16* A1 = (bf16*)(ws + WS_A1);
        for (int idx = F.bx * NTHR + F.tid; idx < 256 * 32; idx += F.G * NTHR) {
            const int m = idx >> 5, kk0 = (idx & 31) * 8; const int cho = m >> 7, k2 = (m & 127) >> 1, ro = m & 1; float x[8];
#pragma unroll
            for (int e2 = 0; e2 < 8; ++e2) { const int kk = kk0 + e2, chi = kk >> 7, ri = (kk >> 6) & 1, aa = kk & 63;
                const float cs_ = T[(64 * k2 * aa) & 4095], sn_ = T[(64 * k2 * aa - 1024) & 4095];
                const float v = ro == 0 ? (ri == 0 ? cs_ : -sn_) : (ri == 0 ? -sn_ : -cs_);
                x[e2] = (cho == chi) ? v : 0.f; }
            *(v4u*)(A1 + (size_t)m * 256 + kk0) = pack8(x);
        }
        bf16* A2 = (bf16*)(ws + WS_A2);
        for (int idx = F.bx * NTHR + F.tid; idx < 16 * 256 * 64; idx += F.G * NTHR) {
            const int kk0 = (idx & 63) * 8, m = (idx >> 6) & 255, q = idx >> 14; const int k2p = m >> 6, k1 = m & 63, k = 4 * q + k2p + 64 * k1; float x[8];
#pragma unroll
            for (int e2 = 0; e2 < 8; ++e2) { const int kk = kk0 + e2, k2pp = kk >> 7, ro = (kk >> 6) & 1, c = kk & 63;
                const float v = ro == 0 ? T[(k * c) & 4095] : T[(k * c - 1024) & 4095];
                x[e2] = (k2pp == k2p) ? v : 0.f; }
            *(v4u*)(A2 + ((size_t)q * 256 + m) * 512 + kk0) = pack8(x);
        }
        bf16* F2 = (bf16*)(ws + WS_F256);
        for (int k = F.bx; k < 256; k += F.G) {
            if (F.tid < 64) { const int j0 = F.tid * 8; const int cs = j0 >> 8, t0 = j0 & 255; float x[8];
#pragma unroll
                for (int e = 0; e < 8; ++e) { const int m = (16 * k * (t0 + e) - (cs ? 1024 : 0)) & 4095; const float v = T[m]; x[e] = cs ? -v : v; }
                *(v4u*)(F2 + (size_t)k * 512 + j0) = pack8(x); }
        }
    }
    if (F.bx == 0) {
        f32x2* ROPE = (f32x2*)(ws + WS_ROPE);
        for (int i = F.tid; i < 64 * 32; i += NTHR) { const int pos = i >> 5, ii = i & 31; const float freq = powf(10000.f, -(float)(2 * ii) / 64.f); const float ang = (float)pos * freq;
            ROPE[i] = (f32x2){cosf(ang), sinf(ang)}; }
    }
    __syncthreads();
}

__device__ __forceinline__ void p0b_modreduce(KArgs a) {
    Frame F = make_frame(a);
    const float* MODP = (const float*)(F.ws + WS_MODP); float* MOD = (float*)(F.ws + WS_MOD);
    for (int i = F.bx * NTHR + F.tid; i < DEPTH * 5 * (NMOD / 4); i += F.G * NTHR) {
        const int j4 = i % (NMOD / 4), lv = i / (NMOD / 4), l = lv / 5;
        f32x4 s = *(const f32x4*)(a->in[I_BMOD] + (size_t)l * NMOD + j4 * 4);
#pragma unroll
        for (int ks = 0; ks < 16; ++ks) s += *(const f32x4*)(MODP + ((size_t)ks * (DEPTH * 5) + lv) * NMOD + j4 * 4);
        *(f32x4*)(MOD + (size_t)lv * NMOD + j4 * 4) = s;
        { const int chunk = (j4 * 4) / DM, col = (j4 * 4) % DM, v = lv % 5;
          if (chunk == 1 || chunk == 4) { const int which = chunk == 4; const f32x4 gg = *(const f32x4*)((which ? a->in[I_N2G] : a->in[I_N1G]) + l * DM + col);
              *(f32x4*)((float*)(F.ws + WS_MODG) + ((size_t)(l * 2 + which) * 5 + v) * DM + col) = gg * (s + 1.0f); } }
    }
}

__device__ __forceinline__ void norm_phase(KArgs a, int M, const float* g, const float* modl, int shoff, int scoff, bool fold, bool lat_in, bool ctx_in) {
    Frame F = make_frame(a);
    bf16* X = (bf16*)(F.ws + WS_X); bf16* H = (bf16*)(F.ws + WS_H); const float* XP = (const float*)(F.ws + WS_XP);
    for (int row = F.gw; row < M; row += F.ngw) {
        const int v = row < ML ? row >> 12 : 4;
        const float* sh = modl + (size_t)v * NMOD + shoff;
        v4u* xr = (v4u*)(X + (size_t)row * DM) + F.lane;
        f32x4 x[4][2]; float ss = 0.f;
        if (row < ML ? lat_in : ctx_in) { const f32x4* xs = (const f32x4*)(row < ML ? a->in[I_X] + (size_t)row * DM : a->in[I_CTX] + (size_t)(row - ML) * DM) + 2 * F.lane;
#pragma unroll
            for (int j = 0; j < 4; ++j) { x[j][0] = xs[128 * j]; x[j][1] = xs[128 * j + 1]; } }
        else {
#pragma unroll
            for (int j = 0; j < 4; ++j) { const v4u w = xr[64 * j]; x[j][0] = (f32x4){bflo(w.x), bfhi(w.x), bflo(w.y), bfhi(w.y)}; x[j][1] = (f32x4){bflo(w.z), bfhi(w.z), bflo(w.w), bfhi(w.w)}; } }
        if (fold && row >= ML) {
#pragma unroll
            for (int ks = 0; ks < 4; ++ks) { const f32x4* pr = (const f32x4*)(XP + ((size_t)ks * MC + (row - ML)) * DM) + 2 * F.lane;
#pragma unroll
                for (int j = 0; j < 4; ++j) { x[j][0] += pr[128 * j]; x[j][1] += pr[128 * j + 1]; } }
#pragma unroll
            for (int j = 0; j < 4; ++j) { v4u w; w.x = pk2(x[j][0].x, x[j][0].y); w.y = pk2(x[j][0].z, x[j][0].w); w.z = pk2(x[j][1].x, x[j][1].y); w.w = pk2(x[j][1].z, x[j][1].w); xr[64 * j] = w; }
        }
#pragma unroll
        for (int j = 0; j < 4; ++j)
#pragma unroll
            for (int h = 0; h < 2; ++h) ss += (x[j][h].x * x[j][h].x + x[j][h].y * x[j][h].y) + (x[j][h].z * x[j][h].z + x[j][h].w * x[j][h].w);
        const float rstd = 1.0f / sqrtf(wave_sum(ss) * (1.f / DM) + EPS);
#pragma unroll
        for (int j = 0; j < 4; ++j) { const int col = F.lane * 8 + 512 * j; f32x4 y[2];
#pragma unroll
            for (int h = 0; h < 2; ++h) { const f32x4 gg = *(const f32x4*)(g + (size_t)v * DM + col + 4 * h), s0 = *(const f32x4*)(sh + col + 4 * h);
                y[h] = x[j][h] * rstd * gg + s0; }
            v4u o; o.x = pk2(y[0].x, y[0].y); o.y = pk2(y[0].z, y[0].w); o.z = pk2(y[1].x, y[1].y); o.w = pk2(y[1].z, y[1].w);
            *(v4u*)(H + (size_t)row * DM + col) = o; }
    }
}

__device__ __forceinline__ void final_norm_phase(KArgs a, const float* g, float* out) {
    Frame F = make_frame(a);
    const bf16* X = (const bf16*)(F.ws + WS_X);
    for (int row = F.gw; row < ML; row += F.ngw) {
        const v4u* xr = (const v4u*)(X + (size_t)row * DM) + F.lane;
        f32x4 x[8]; float ss = 0.f;
#pragma unroll
        for (int j = 0; j < 4; ++j) { const v4u w = xr[64 * j]; x[2 * j] = (f32x4){bflo(w.x), bfhi(w.x), bflo(w.y), bfhi(w.y)}; x[2 * j + 1] = (f32x4){bflo(w.z), bfhi(w.z), bflo(w.w), bfhi(w.w)}; }
#pragma unroll
        for (int j = 0; j < 8; ++j) ss += (x[j].x * x[j].x + x[j].y * x[j].y) + (x[j].z * x[j].z + x[j].w * x[j].w);
        const float rstd = 1.0f / sqrtf(wave_sum(ss) * (1.f / DM) + EPS);
#pragma unroll
        for (int j = 0; j < 8; ++j) { const int col = F.lane * 8 + 512 * (j >> 1) + 4 * (j & 1); const f32x4 gg = *(const f32x4*)(g + col);
            *(f32x4*)(out + (size_t)row * DM + col) = x[j] * rstd * gg; }
    }
}

__device__ __forceinline__ float gelu_fast(float x) { const float y = 1.5957691216057308f * (x + 0.044715f * x * x * x); return x * __builtin_amdgcn_rcpf(1.f + __expf(-y)); }

__device__ __forceinline__ void postA_phase(KArgs a, int l) {
    Frame F = make_frame(a); unsigned char* ws = F.ws;
    const bf16* P = (const bf16*)(ws + WS_P); bf16* MIX = (bf16*)(ws + WS_MIX); bf16* KB = (bf16*)(ws + WS_KB); bf16* VB = (bf16*)(ws + WS_VB);
    bf16* QB = (bf16*)(ws + WS_QB); bf16* UB = (bf16*)(ws + WS_UB); bf16* V2B = (bf16*)(ws + WS_V2B);
    const f32x4* ROPE4 = (const f32x4*)(ws + WS_ROPE);
    const int lane = F.lane, tid = F.tid;
    {
        const int hl = lane & 15, axis = hl >> 3, i0 = (lane & 3) * 8; const bool first = (lane & 7) < 4;
        float qg8[8], kg8[8], cw0[8], cw1[8], cw2[8], lg8[8], lb8[8];
        { const float* qg = a->in[I_QG] + l * 128 + hl * 8; const float* kg = a->in[I_KG] + l * 128 + hl * 8; const float* cw = a->in[I_CONVW] + (size_t)l * 3 * 512 + lane * 8;
          const float* lng = a->in[I_LNG] + l * 512 + lane * 8; const float* lnb = a->in[I_LNB] + l * 512 + lane * 8;
#pragma unroll
          for (int e = 0; e < 8; ++e) { qg8[e] = qg[e]; kg8[e] = kg[e]; cw0[e] = cw[e]; cw1[e] = cw[512 + e]; cw2[e] = cw[1024 + e]; lg8[e] = lng[e]; lb8[e] = lnb[e]; } }
        for (int row = F.gw; row < MT; row += F.ngw) {
            const bool is_ctx = row >= ML;
            const int b = is_ctx ? (row - ML) >> 8 : row >> 12, p = is_ctx ? (row - ML) & 255 : row & 4095, nseq = is_ctx ? CTXL : SEQ;
            const bool kv_only = is_ctx && (l == DEPTH - 1);
            const bf16* Pr = P + (size_t)row * PW;
            const int kvpos = is_ctx ? p : CTXL + p;
            const v4u rkv = *(const v4u*)(Pr + PK + lane * 8);
            f32x4 c4[4];
            if (!is_ctx) { const int posax = axis ? (p & 63) : (p >> 6);
#pragma unroll
                for (int e = 0; e < 4; ++e) c4[e] = ROPE4[posax * 16 + (i0 >> 1) + e]; }
            {
                float x[8]; unpack8(rkv, x); float ss = 0.f;
#pragma unroll
                for (int e = 0; e < 8; ++e) ss += x[e] * x[e];
                ss += __shfl_xor(ss, 1); ss += __shfl_xor(ss, 2); ss += __shfl_xor(ss, 4); ss += __shfl_xor(ss, 8);
                const float rstd = 1.0f / sqrtf(ss * (1.f / 128.f) + EPS);
                float y[8];
#pragma unroll
                for (int e = 0; e < 8; ++e) y[e] = x[e] * rstd * kg8[e];
                if (!is_ctx) {
#pragma unroll
                    for (int e = 0; e < 8; ++e) { const float pr = __shfl_xor(y[e], 4); const float cs_ = c4[e >> 1][(e & 1) * 2], sn_ = c4[e >> 1][(e & 1) * 2 + 1]; y[e] = first ? y[e] * cs_ - pr * sn_ : y[e] * cs_ + pr * sn_; } }
                if (lane < 32) *(v4u*)(KB + ((size_t)b * SKV + kvpos) * 256 + lane * 8) = pack8(y);
                else *(v4u*)(VB + ((size_t)b * SKV + kvpos) * 256 + (lane - 32) * 8) = rkv;
            }
            if (kv_only) continue;
            const v4u rq0 = *(const v4u*)(Pr + PQ + lane * 8), rq1 = *(const v4u*)(Pr + PQ + 512 + lane * 8);
            const v4u rcb = *(const v4u*)(Pr + PCB + lane * 8), rc0 = *(const v4u*)(Pr + PCC + lane * 8), rh0 = *(const v4u*)(Pr + PCH + lane * 8);
            const bool hp = p > 0, hn = p < nseq - 1;
            const bf16* Pm = hp ? Pr - PW : Pr; const bf16* Pn = hn ? Pr + PW : Pr;
            const v4u rcm = *(const v4u*)(Pm + PCC + lane * 8), rhm = *(const v4u*)(Pm + PCH + lane * 8), rcp = *(const v4u*)(Pn + PCC + lane * 8), rhp = *(const v4u*)(Pn + PCH + lane * 8);
            const v4u rgu = *(const v4u*)(Pr + PGU + lane * 8), rgv = *(const v4u*)(Pr + PGV + lane * 8);
#pragma unroll
            for (int part = 0; part < 2; ++part) {
                float x[8]; unpack8(part ? rq1 : rq0, x); float ss = 0.f;
#pragma unroll
                for (int e = 0; e < 8; ++e) ss += x[e] * x[e];
                ss += __shfl_xor(ss, 1); ss += __shfl_xor(ss, 2); ss += __shfl_xor(ss, 4); ss += __shfl_xor(ss, 8);
                const float rstd = 1.0f / sqrtf(ss * (1.f / 128.f) + EPS);
                float y[8];
#pragma unroll
                for (int e = 0; e < 8; ++e) y[e] = x[e] * rstd * qg8[e];
                if (!is_ctx) {
#pragma unroll
                    for (int e = 0; e < 8; ++e) { const float pr = __shfl_xor(y[e], 4); const float cs_ = c4[e >> 1][(e & 1) * 2], sn_ = c4[e >> 1][(e & 1) * 2 + 1]; y[e] = first ? y[e] * cs_ - pr * sn_ : y[e] * cs_ + pr * sn_; } }
                *(v4u*)(QB + (size_t)row * 1024 + part * 512 + lane * 8) = pack8(y);
            }
            {
                float cb[8], c0[8], h0[8], cm[8], hm[8], cp[8], hq[8], o[8];
                unpack8(rcb, cb); unpack8(rc0, c0); unpack8(rh0, h0); unpack8(rcm, cm); unpack8(rhm, hm); unpack8(rcp, cp); unpack8(rhp, hq);
                const float fp = hp ? 1.f : 0.f, fn = hn ? 1.f : 0.f;
#pragma unroll
                for (int e = 0; e < 8; ++e) o[e] = cb[e] * (cw0[e] * fp * (cm[e] * hm[e]) + cw1[e] * (c0[e] * h0[e]) + cw2[e] * fn * (cp[e] * hq[e]));
                *(v4u*)(MIX + (size_t)row * MIXW + MX_CONV + lane * 8) = pack8(o);
            }
            {
                float u[8], t[8]; unpack8(rgu, u); unpack8(rgv, t);
                float s = 0.f;
#pragma unroll
                for (int e = 0; e < 8; ++e) { u[e] = gelu_fast(u[e]); t[e] = gelu_fast(t[e]); s += t[e]; }
                const float mean = wave_sum(s) * (1.f / 512.f);
                float q = 0.f;
#pragma unroll
                for (int e = 0; e < 8; ++e) { t[e] -= mean; q += t[e] * t[e]; }
                const float rstd = 1.0f / sqrtf(wave_sum(q) * (1.f / 512.f) + EPS);
#pragma unroll
                for (int e = 0; e < 8; ++e) t[e] = t[e] * rstd * lg8[e] + lb8[e];
                *(v4u*)(UB + (size_t)row * 512 + lane * 8) = pack8(u); *(v4u*)(V2B + (size_t)row * 512 + lane * 8) = pack8(t);
            }
        }
    }
    {
        LAS unsigned* tb = (LAS unsigned*)F.lds;
        bf16* S1 = (bf16*)(ws + WS_T1T);
        for (int un = F.bx; un < 512; un += F.G) {
            const int ab = un >> 6, b = (un >> 4) & 3, slab = un & 15;
            const size_t rowb = (size_t)b * SEQ + (size_t)ab * 512;
#pragma unroll
            for (int it = 0; it < 4; ++it) {
                const int idx = tid + it * NTHR; const int j = it, c8 = idx & 7, c = (idx >> 3) & 63;
                const bf16* src0 = P + (rowb + (size_t)(2 * j) * 64 + c) * PW + PFA + slab * 64 + c8 * 8;
                const v4u r0 = *(const v4u*)src0, r1 = *(const v4u*)(src0 + (size_t)64 * PW);
                const unsigned a0[4] = {r0.x, r0.y, r0.z, r0.w}, a1[4] = {r1.x, r1.y, r1.z, r1.w};
                const int js = j ^ (c8 & 3);
#pragma unroll
                for (int w = 0; w < 4; ++w) {
                    tb[((c8 * 8 + 2 * w) * 64 + c) * 4 + js]     = (a0[w] & 0xffffu) | (a1[w] << 16);
                    tb[((c8 * 8 + 2 * w + 1) * 64 + c) * 4 + js] = (a0[w] >> 16) | (a1[w] & 0xffff0000u);
                }
            }
            __syncthreads();
#pragma unroll
            for (int it = 0; it < 8; ++it) {
                const int idx = tid + it * NTHR; const int c = idx & 63, col = idx >> 6;
                const v4u oo = *(const LAS v4u*)(tb + (col * 64 + c) * 4); const unsigned od[4] = {oo.x, oo.y, oo.z, oo.w};
                v4u o; o.x = od[0 ^ (it & 3)]; o.y = od[1 ^ (it & 3)]; o.z = od[2 ^ (it & 3)]; o.w = od[3 ^ (it & 3)];
                const int gcol = slab * 64 + col, ri = gcol >> 9, n = b * 512 + (gcol & 511);
                *(v4u*)(S1 + ((((size_t)n * 32 + (c & 31)) * 2 + (c >> 5)) * 2 + ri) * 64 + ab * 8) = o;
            }
            __syncthreads();
        }
    }
    if (l < DEPTH - 1) {
        LAS unsigned* tb = (LAS unsigned*)F.lds;
        for (int un = F.bx; un < 32; un += F.G) {
            const int chc = un >> 2, slab = un & 3;
            const int b = chc >> 1, p0 = (chc & 1) * 128;
            const int row0 = ML + b * CTXL + p0;
            bf16* T1 = (bf16*)(ws + WS_T1TC);
#pragma unroll
            for (int it = 0; it < 4; ++it) {
                const int q = tid + it * NTHR;
                const int c8 = ((q >> 6) & 3) * 8 + (q & 7), rp = (q >> 8) * 8 + ((q >> 3) & 7);
                const v4u r0 = *(const v4u*)(P + (size_t)(row0 + 2 * rp) * PW + PFA + slab * 256 + c8 * 8);
                const v4u r1 = *(const v4u*)(P + (size_t)(row0 + 2 * rp + 1) * PW + PFA + slab * 256 + c8 * 8);
                const unsigned a0[4] = {r0.x, r0.y, r0.z, r0.w}, a1[4] = {r1.x, r1.y, r1.z, r1.w};
#pragma unroll
                for (int w = 0; w < 4; ++w) {
                    tb[(c8 * 8 + 2 * w) * 65 + rp]     = (a0[w] & 0xffffu) | (a1[w] << 16);
                    tb[(c8 * 8 + 2 * w + 1) * 65 + rp] = (a0[w] >> 16) | (a1[w] & 0xffff0000u);
                }
            }
            __syncthreads();
#pragma unroll
            for (int it = 0; it < 8; ++it) {
                const int idx = tid + it * NTHR; const int cc = idx >> 4, t8 = idx & 15;
                v4u o; o.x = tb[cc * 65 + t8 * 4]; o.y = tb[cc * 65 + t8 * 4 + 1]; o.z = tb[cc * 65 + t8 * 4 + 2]; o.w = tb[cc * 65 + t8 * 4 + 3];
                const int col = slab * 256 + cc, csn = col >> 9, gd = col & 511;
                *(v4u*)(T1 + (size_t)(b * 512 + gd) * 512 + csn * CTXL + p0 + t8 * 8) = o;
            }
            __syncthreads();
        }
    }
}

__device__ __forceinline__ void gate_phase(KArgs a, int l, int wg0, int nwg, int u_lo, int u_hi) {
    Frame F = make_frame(a); unsigned char* ws = F.ws;
    F.bx -= wg0; if (F.bx < 0 || F.bx >= nwg) return;
    const bf16* UB = (const bf16*)(ws + WS_UB); const bf16* V2B = (const bf16*)(ws + WS_V2B); bf16* MIX = (bf16*)(ws + WS_MIX);
    const float* gws = a->in[I_GMWS] + (size_t)l * 4 * 128 * 128; const float* gmb = a->in[I_GMB] + l * 4 * 128;
    const int tid = F.tid, lane = F.lane, r32 = lane & 31, hi = lane >> 5, gsel = F.wave >> 2, qb = F.wave & 3;
    for (int un = u_lo + F.bx; un < u_hi; un += nwg) {
        const int ch = un >> 1, gp = un & 1;
        const bool is_ctx = ch >= 128;
        const int b = is_ctx ? (ch - 128) >> 1 : ch >> 5;
        const int p0 = is_ctx ? ((ch - 128) & 1) * 128 : (ch & 31) * 128;
        const int row0 = is_ctx ? ML + b * CTXL + p0 : b * SEQ + p0;
#pragma unroll
        for (int it = 0; it < 8; ++it) { const int idx = tid + it * NTHR; const int gi = idx >> 11, pp = (idx >> 4) & 127, c8 = idx & 15;
            const v4u v = *(const v4u*)(V2B + (size_t)(row0 + pp) * 512 + (2 * gp + gi) * 128 + c8 * 8);
            *(LAS v4u*)(F.lds + (gi * 2 + (pp >> 6)) * 16384 + att::v_st(pp & 63, c8 * 8)) = v; }
        __syncthreads();
        const int g = 2 * gp + gsel;
        att::f32x16 o[4] = {};
#pragma unroll
        for (int kt = 0; kt < 2; ++kt) {
            const float* wrow = gws + ((size_t)g * 128 + 32 * qb + r32) * 128 + 64 * kt + 8 * hi;
            att::bf16x8 pa[4];
#pragma unroll
            for (int ks = 0; ks < 4; ++ks) { const f32x4 w0 = *(const f32x4*)(wrow + 16 * ks), w1 = *(const f32x4*)(wrow + 16 * ks + 4);
                v4u w; w.x = pk2(w0.x, w0.y); w.y = pk2(w0.z, w0.w); w.z = pk2(w1.x, w1.y); w.w = pk2(w1.z, w1.w); pa[ks] = *reinterpret_cast<att::bf16x8*>(&w); }
            const int vb = (int)(unsigned)(uintptr_t)(F.lds + (gsel * 2 + kt) * 16384) + att::v_rd_base(lane);
            att::pv_d0(o, vb, pa[0], pa[1], pa[2], pa[3]);
        }
        __syncthreads();
        { LAS unsigned char* ob = F.lds + F.wave * (32 * 272);
#pragma unroll
          for (int i = 0; i < 8; ++i) { const int row = i * 4 + (lane >> 4), chk = lane & 15;
              *(LAS v4u*)(ob + row * 272 + chk * 16) = *(const v4u*)(UB + (size_t)(row0 + 32 * qb + row) * 512 + g * 128 + chk * 8); }
#pragma unroll
          for (int r = 0; r < 16; ++r) { const int qq = att::crow(r, hi); const float bias = gmb[g * 128 + 32 * qb + qq];
#pragma unroll
              for (int d0 = 0; d0 < 4; ++d0) { LAS bf16* e = (LAS bf16*)(ob + qq * 272 + (d0 * 32 + r32) * 2);
                  const float u = __uint_as_float((unsigned)*e << 16); const float val = u * (o[d0][r] + bias); *e = (bf16)(pk2(val, val) & 0xffffu); } }
#pragma unroll
          for (int i = 0; i < 8; ++i) { const int row = i * 4 + (lane >> 4), chk = lane & 15;
              *(v4u*)(MIX + (size_t)(row0 + 32 * qb + row) * MIXW + MX_GM + g * 128 + chk * 8) = *(const LAS v4u*)(ob + row * 272 + chk * 16); }
        }
        __syncthreads();
    }
}

__device__ __forceinline__ void act_fix_phase(KArgs a, int l, int M) {
    Frame F = make_frame(a);
    const float* EDGE = (const float*)(F.ws + WS_EDGE); bf16* ACT = (bf16*)(F.ws + WS_ACT);
    const float* cw = a->in[I_FCW] + (size_t)l * 3 * DFF; const float* cb = a->in[I_FCB] + (size_t)l * DFF;
    constexpr int CG = DFF / 4;
    const int total = (M / 256) * 2 * CG;
    for (int idx = F.bx * NTHR + F.tid; idx < total; idx += F.G * NTHR) {
        const int c0 = (idx % CG) * 4, pw = idx / CG, which = pw & 1, pm = pw >> 1;
        const bool first = pm >= 64 || (pm & 15) == 0, last = pm >= 64 || (pm & 15) == 15;
        const float* e = EDGE + (size_t)pm * 6 * DFF + c0;
        f32x4 prev, cur, next, uu; const f32x4 zero = (f32x4){0.f, 0.f, 0.f, 0.f};
        if (which == 0) { prev = first ? zero : *(const f32x4*)(e - (size_t)6 * DFF + (size_t)3 * DFF); cur = *(const f32x4*)e; next = *(const f32x4*)(e + DFF); uu = *(const f32x4*)(e + (size_t)4 * DFF); }
        else { prev = *(const f32x4*)(e + (size_t)2 * DFF); cur = *(const f32x4*)(e + (size_t)3 * DFF); next = last ? zero : *(const f32x4*)(e + (size_t)6 * DFF); uu = *(const f32x4*)(e + (size_t)5 * DFF); }
        const f32x4 z = *(const f32x4*)(cw + c0) * prev + *(const f32x4*)(cw + DFF + c0) * cur + *(const f32x4*)(cw + 2 * DFF + c0) * next + *(const f32x4*)(cb + c0);
        float o[4];
#pragma unroll
        for (int j = 0; j < 4; ++j) o[j] = z[j] * __builtin_amdgcn_rcpf(1.f + __expf(-z[j])) * uu[j];
        v2u w; w.x = pk2(o[0], o[1]); w.y = pk2(o[2], o[3]);
        *(v2u*)(ACT + (size_t)(pm * 256 + (which ? 255 : 0)) * DFF + c0) = w;
    }
}

constexpr int PH_P0A = 0, PH_P0B = 1, PH_L0 = 2, PH_PER_LAYER = 10, PH_FINAL = PH_L0 + DEPTH * PH_PER_LAYER, N_PHASES = PH_FINAL + 1;

__device__ __forceinline__ void gemm_in_phase(KArgs a, int l) {
    unsigned char* ws = a->ws; extern __shared__ __attribute__((aligned(16))) unsigned char lds_[];
    pg8::Gemm g{(const bf16*)(ws + WS_H), (const bf16*)(ws + WS_WIN) + (size_t)l * PW * DM, MT, PW, DM, DM, DM, 0, 0, 1};
    pg8::StaticOrder S; S.init(MT, PW, gridDim.x, blockIdx.x, DM);
    pg8::EpiBf16 E{(bf16*)(ws + WS_P), PW};
    pg8::gemm_phase<pg8::EpiBf16, pg8::StaticOrder, true, true>((LAS unsigned char*)lds_, g, S, E);
}
__device__ __forceinline__ void gemm_in_probe(KArgs a, int l) {
    unsigned char* ws = a->ws; extern __shared__ __attribute__((aligned(16))) unsigned char lds_[];
    pg8::Gemm g{(const bf16*)(ws + WS_H), (const bf16*)(ws + WS_WIN) + (size_t)l * PW * DM, MT, PW, DM, DM, DM, 0, 0, 1};
    pg8::StaticOrder S; S.init(MT, PW, gridDim.x, blockIdx.x, DM);
    pg8::EpiNone E{};
    pg8::gemm_phase<pg8::EpiNone, pg8::StaticOrder, true, true>((LAS unsigned char*)lds_, g, S, E);
}
__device__ __forceinline__ void gemm_up_phase(KArgs a, int l, int M2) {
    unsigned char* ws = a->ws; extern __shared__ __attribute__((aligned(16))) unsigned char lds_[];
    pg8::Gemm g{(const bf16*)(ws + WS_H), (const bf16*)(ws + WS_WUP) + (size_t)l * UPW * DM, M2, UPW, DM, DM, DM, 0, 0, 1};
    pg8::StaticOrder S; S.init(M2, UPW, gridDim.x, blockIdx.x, DM);
    pg8::EpiUp E{(bf16*)(ws + WS_ACT), (float*)(ws + WS_EDGE), a->in[I_FCW] + (size_t)l * 3 * DFF, a->in[I_FCB] + (size_t)l * DFF, (LAS float*)((LAS unsigned char*)lds_ + XL_OFF), DFF};
    pg8::gemm_phase<pg8::EpiUp, pg8::StaticOrder, true, true>((LAS unsigned char*)lds_, g, S, E);
}
__device__ __forceinline__ void gemm_out_phase(KArgs a, int l, int M2) {
    unsigned char* ws = a->ws; extern __shared__ __attribute__((aligned(16))) unsigned char lds_[];
    pg8::Gemm g{(const bf16*)(ws + WS_MIX), (const bf16*)(ws + WS_WOUT) + (size_t)l * DM * MIXW, M2, DM, MIXW, MIXW, MIXW, 0, 0, 1};
    pg8::SplitOrder S; S.init(ML, (M2 - ML) / 256, DM, gridDim.x, blockIdx.x, MIXW);
    pg8::EpiResGate E{(bf16*)(ws + WS_X), (const float*)(ws + WS_MOD) + (size_t)l * 5 * NMOD, 2 * DM, (float*)(ws + WS_XP), l == 0 ? a->in[I_X] : (const float*)nullptr};
    pg8::gemm_phase<pg8::EpiResGate, pg8::SplitOrder, true, true>((LAS unsigned char*)lds_, g, S, E);
}
__device__ __forceinline__ void gemm_down_phase(KArgs a, int l, int M2) {
    unsigned char* ws = a->ws; extern __shared__ __attribute__((aligned(16))) unsigned char lds_[];
    pg8::Gemm g{(const bf16*)(ws + WS_ACT), (const bf16*)(ws + WS_WDN) + (size_t)l * DM * DFF, M2, DM, DFF, DFF, DFF, 0, 0, 1};
    pg8::SplitOrder S; S.init(ML, (M2 - ML) / 256, DM, gridDim.x, blockIdx.x, DFF);
    pg8::EpiResGate E{(bf16*)(ws + WS_X), (const float*)(ws + WS_MOD) + (size_t)l * 5 * NMOD, 5 * DM, (float*)(ws + WS_XP), (const float*)nullptr};
    pg8::gemm_phase<pg8::EpiResGate, pg8::SplitOrder, true, true>((LAS unsigned char*)lds_, g, S, E);
}
__device__ __forceinline__ void attn_phase(KArgs a, int l, int part, int wg0) {
    unsigned char* ws = a->ws; extern __shared__ __attribute__((aligned(16))) unsigned char lds_[];
    const bf16* QB = (const bf16*)(ws + WS_QB); const bf16* KB = (const bf16*)(ws + WS_KB); const bf16* VB = (const bf16*)(ws + WS_VB); bf16* MIX = (bf16*)(ws + WS_MIX);
    const int G = gridDim.x, bx = blockIdx.x;
    const int xcd = bx & 7, wq = bx >> 3;
    const int ulo = part ? 512 + ((bx - wg0 + G) % G) : bx, uhi = part ? ((l < DEPTH - 1) ? 544 : 0) : 512;
    for (int u = ulo; u < uhi; u += G) {
        int b, h, kvh, qrow, seq;
        if (u < 512) { const int i = u / G; const int j = (G == 256) ? wq + 32 * i : (u >> 3), x = (G == 256) ? xcd : (u & 7);
            b = x >> 1; kvh = x & 1; h = kvh * 4 + (j >> 4); qrow = b * SEQ + (j & 15) * 256; seq = SKV; }
        else { const int c = u - 512; b = c >> 3; h = c & 7; kvh = h >> 2; qrow = ML + b * CTXL; seq = CTXL; }
        att::attn_dense_body(QB + (size_t)qrow * 1024 + h * 128, KB + (size_t)b * SKV * 256 + kvh * 128, VB + (size_t)b * SKV * 256 + kvh * 128,
                             MIX + (size_t)qrow * MIXW + MX_ATT + h * 128, seq, (char*)lds_);
    }
}
__device__ __forceinline__ void dft1_phase(KArgs a, int l) {
    unsigned char* ws = a->ws; extern __shared__ __attribute__((aligned(16))) unsigned char lds_[];
    pg8::Gemm g{(const bf16*)(ws + WS_A1), (const bf16*)(ws + WS_T1T), 256, 65536, 256, 256, 256, 0};
    pg8::StaticOrder S; S.init(256, 65536, gridDim.x, blockIdx.x, 256);
    pg8::EpiS1 E{(bf16*)(ws + WS_S2IN)};
    pg8::gemm_phase<pg8::EpiS1, pg8::StaticOrder, true, true>((LAS unsigned char*)lds_, g, S, E);
}
__device__ __forceinline__ void dft2_phase(KArgs a, int l) {
    unsigned char* ws = a->ws; extern __shared__ __attribute__((aligned(16))) unsigned char lds_[];
    const int G = gridDim.x, bx = blockIdx.x;
    {
        pg8::Gemm g{(const bf16*)(ws + WS_A2), (const bf16*)(ws + WS_S2IN), 4096, 2048, 512, 512, 512, (size_t)2048 * 512 * 2};
        pg8::StaticOrder S; S.init(4096, 2048, G, (bx + G / 2) % G, 512);
        pg8::EpiS2 E{(bf16*)(ws + WS_MIX), 0.0013810679320049757f};
        pg8::gemm_phase<pg8::EpiS2, pg8::StaticOrder, true, true>((LAS unsigned char*)lds_, g, S, E);
    }
    if (l < DEPTH - 1) {
        pg8::Gemm g{(const bf16*)(ws + WS_F256), (const bf16*)(ws + WS_T1TC), CTXL, 2048, 512, 512, 512, 0};
        pg8::StaticOrder S; S.init(CTXL, 2048, G, (bx + G - 96) % G, 512);
        pg8::EpiDft E{(bf16*)(ws + WS_MIX), ML, CTXL, 0.005524271728019903f};
        pg8::gemm_phase<pg8::EpiDft, pg8::StaticOrder, true, true>((LAS unsigned char*)lds_, g, S, E);
    }
}

__global__ void __launch_bounds__(NTHR, 2) hybrid_fwd(Args args_by_value) {
    extern __shared__ __attribute__((aligned(16))) unsigned char lds[];
    (void)args_by_value;
    int lo, hi; unsigned* ctl;
    { KArgs a = kargs(); lo = a->ph_lo; hi = a->ph_hi; ctl = (unsigned*)(a->ws + WS_CTL); }
    volatile LAS unsigned* MISC = (volatile LAS unsigned*)((LAS unsigned char*)lds + MISC_OFF);
    for (int u = threadIdx.x; u < (LDS_BYTES - LDSCTL_OFF) / 4; u += NTHR) ((LAS unsigned*)((LAS unsigned char*)lds + LDSCTL_OFF))[u] = 0u;
    __syncthreads();
    XcdBarrier bar; bar.bar = ctl + CW_BAR; bar.x = 0; bar.st = nullptr;
    if (!MK_PER_PHASE) bar = xcd_barrier_post(ctl + CW_BAR, MISC + 8);
#define IN(k) (lo <= (k) && (k) < hi)
#define SEAM(k) do { if (IN((k) + 1)) { if (MK_PER_PHASE) { if (threadIdx.x == 0) __hip_atomic_store(ctl + CW_TMO, 0xBADBA0u, RLX_AGENT); } else { xcd_barrier(bar); if (DUP(8)) xcd_barrier(bar); } } } while (0)

    for (int rep = 0; rep < (DUP(13) ? 2 : 1); ++rep) {
    if (rep) xcd_barrier(bar);
    if (IN(PH_P0A)) { p0a_prologue(kargs()); if (DUP(0)) p0a_prologue(kargs()); SEAM(PH_P0A); }
    if (IN(PH_P0B)) { p0b_modreduce(kargs()); SEAM(PH_P0B); }

    for (int l = 0; l < DEPTH; ++l) {
        int ph = PH_L0 + l * PH_PER_LAYER;
        const int M2 = (l == DEPTH - 1) ? ML : MT;
#define PHASE(kbit, call) do { if (IN(ph)) { call; if (DUP(kbit)) { if (DUP(15) && !MK_PER_PHASE) xcd_barrier(bar); call; } SEAM(ph); } ++ph; } while (0)
#define MODL ((const float*)(kargs()->ws + WS_MOD) + (size_t)l * 5 * NMOD)
        PHASE(12, norm_phase(kargs(), MT, (const float*)(kargs()->ws + WS_MODG) + (size_t)(l * 2 + 0) * 5 * DM, MODL, 0 * DM, 1 * DM, l > 0, l == 0, l == 0));
        PHASE(2, gemm_in_phase(kargs(), l));
        if (DUP(11) && IN(ph)) { gemm_in_probe(kargs(), l); xcd_barrier(bar); }
        PHASE(9, postA_phase(kargs(), l));
        PHASE(3, { attn_phase(kargs(), l, 0, 0); dft1_phase(kargs(), l); gate_phase(kargs(), l, 0, (int)gridDim.x, 0, min((int)gridDim.x, (l == DEPTH - 1 ? 128 : 136) * 2)); });
        PHASE(6, { gate_phase(kargs(), l, 0, (int)gridDim.x / 2, (int)gridDim.x, (l == DEPTH - 1 ? 128 : 136) * 2); attn_phase(kargs(), l, 1, 16); dft2_phase(kargs(), l); });
        PHASE(14, gemm_out_phase(kargs(), l, M2));
        PHASE(12, norm_phase(kargs(), M2, (const float*)(kargs()->ws + WS_MODG) + (size_t)(l * 2 + 1) * 5 * DM, MODL, 3 * DM, 4 * DM, l < DEPTH - 1, false, l == 0));
        PHASE(5, gemm_up_phase(kargs(), l, M2));
        PHASE(10, act_fix_phase(kargs(), l, M2));
        PHASE(14, gemm_down_phase(kargs(), l, M2));
#undef MODL
#undef PHASE
    }
    if (IN(PH_FINAL)) { KArgs a = kargs(); final_norm_phase(a, a->in[I_FNG], a->out); }
    }
#undef IN
#undef SEAM
}

extern "C" void kernel_launch(void* const* d_in, const int* in_sizes, int n_in, void* d_out, int out_size, void* d_ws, size_t ws_size, hipStream_t stream) {
    static int grid = 0;
    if (grid == 0) {
        if (n_in != 22 || out_size != ML * DM || ws_size < WS_END) { fprintf(stderr, "kernel_launch: unexpected shapes: n_in %d out %d ws %zu (need %zu)\n", n_in, out_size, ws_size, (size_t)WS_END); grid = -1; return; }
        int dev = 0, cus = 0, per_cu = 0;
        if (hipGetDevice(&dev) != hipSuccess || hipDeviceGetAttribute(&cus, hipDeviceAttributeMultiprocessorCount, dev) != hipSuccess) { grid = -1; return; }
        if (hipFuncSetAttribute((const void*)hybrid_fwd, hipFuncAttributeMaxDynamicSharedMemorySize, LDS_BYTES) != hipSuccess) { fprintf(stderr, "kernel_launch: hipFuncSetAttribute failed\n"); grid = -1; return; }
        if (hipOccupancyMaxActiveBlocksPerMultiprocessor(&per_cu, (const void*)hybrid_fwd, NTHR, LDS_BYTES) != hipSuccess || per_cu < 1)
            fprintf(stderr, "kernel_launch: occupancy query reports %d workgroups per CU\n", per_cu);
        (void)hipGetLastError();
        grid = cus;
    }
    if (grid < 0) return;
    if (hipMemsetAsync((char*)d_ws + WS_CTL, 0, CTL_ZERO_BYTES, stream) != hipSuccess) return;
    Args a{};
    for (int i = 0; i < 22; ++i) a.in[i] = (const float*)d_in[i];
    a.out = (float*)d_out; a.ws = (unsigned char*)d_ws;
#if MK_PER_PHASE
    for (int ph = 0; ph < N_PHASES; ++ph) { a.ph_lo = ph; a.ph_hi = ph + 1; hipLaunchKernelGGL(hybrid_fwd, dim3(grid), dim3(NTHR), LDS_BYTES, stream, a); }
#else
    a.ph_lo = 0; a.ph_hi = N_PHASES;
    hipLaunchKernelGGL(hybrid_fwd, dim3(grid), dim3(NTHR), LDS_BYTES, stream, a);
#endif
    const hipError_t le = hipPeekAtLastError();
    if (le != hipSuccess) fprintf(stderr, "kernel_launch: launch failed: %s\n", hipGetErrorName(le));
}
```

```cpp
#include <hip/hip_runtime.h>
#include <cstdio>
#include <cstdint>

#ifndef DUPMASK
#define DUPMASK 0
#endif
#define DUP(k) ((DUPMASK >> (k)) & 1)
#ifndef MK_PER_PHASE
#define MK_PER_PHASE 0
#endif

namespace pg8 {
#define PG8_LAS __attribute__((address_space(3)))
typedef unsigned short bf16_t;
typedef short bf16x8 __attribute__((ext_vector_type(8)));
typedef float f32x4 __attribute__((ext_vector_type(4)));
typedef unsigned u32x4 __attribute__((ext_vector_type(4)));
constexpr int BM = 256, BK = 64, HALF = 128, HTB = HALF * BK * 2, STAGE_BYTES = 8 * HTB, NXCD = 8, WGM = 4;

__host__ __device__ __forceinline__ int lds_byte(int r, int c) { const int st = (r >> 4) * 2 + (c >> 5), rr = r & 15, cc = c & 31, ob = rr * 64 + cc * 2; return st * 1024 + (ob ^ (((ob >> 9) & 1) << 5)); }
__host__ __device__ __forceinline__ void stage_rc(int b, int& R, int& C) { const int st = b / 1024, sb = b % 1024, swz = sb ^ (((sb >> 9) & 1) << 5); R = (st >> 1) * 16 + swz / 64; C = (st & 1) * 32 + (swz % 64) / 2; }
__host__ __device__ __forceinline__ int perm32(int rho) { const int n = rho >> 4, i = rho & 15; return 8 * (i >> 2) + 4 * n + (i & 3); }

struct Unit { int pm, pn, kt0, nkt, split; };
struct Gemm { const bf16_t* A; const bf16_t* Bt; int M, N, K, lda, ldb; size_t bpm; int tiledA, tiledB; };

struct StaticOrder {
    int nM, nN, nwg, G, c, ntk;
    __host__ __device__ void init(int M, int N, int G_, int c_, int K) { nM = M / BM; nN = N / BM; nwg = nM * nN; G = G_; c = c_; ntk = K / BK; }
    __host__ __device__ bool next(int i, Unit& u) const {
        const long L = (long)i * G + c; if (L >= nwg) return false;
        return tile((int)L, u);
    }
    __host__ __device__ bool tile(int wgid, Unit& u) const {
        u.kt0 = 0; u.nkt = ntk; u.split = 0; { const int q = nwg / NXCD, r = nwg % NXCD, xcd = wgid % NXCD, off = wgid / NXCD; wgid = (xcd < r ? xcd * (q + 1) : r * (q + 1) + (xcd - r) * q) + off; }
        const int nig = WGM * nN, gid = wgid / nig, fm = gid * WGM, gsz = (nM - fm) < WGM ? (nM - fm) : WGM;
        u.pm = fm + ((wgid % nig) % gsz); u.pn = (wgid % nig) / gsz; return true;
    }
    __device__ __forceinline__ void a_ready(const Unit&) const {}
    __device__ __forceinline__ void done(const Unit&) const {}
};
struct SplitOrder {
    StaticOrder so; int xp, nsplit;
    __host__ __device__ void init(int Mfull, int xpanels, int N, int G_, int c_, int K) { so.init(Mfull, N, G_, c_, K); xp = xpanels; nsplit = xpanels * so.nN * 4; }
    __host__ __device__ bool next(int i, Unit& u) const {
        const int L = i * so.G + so.c; const bool full = L < so.nwg;
        Unit f; so.tile(full ? L : 0, f);
        const int q = L - so.nwg, ks = q & 3, t = q >> 2, qn = so.ntk / 4;
        u.pm = full ? f.pm : so.nM + t / so.nN; u.pn = full ? f.pn : t % so.nN; u.nkt = full ? f.nkt : qn; u.kt0 = full ? 0 : ks * qn; u.split = full ? 0 : 1;
        return full || q < nsplit;
    }
    __device__ __forceinline__ void a_ready(const Unit&) const {}
    __device__ __forceinline__ void done(const Unit&) const {}
};

__device__ __forceinline__ unsigned cvt_pk_bf16(float lo, float hi) { unsigned r; asm volatile("v_cvt_pk_bf16_f32 %0, %1, %2" : "=v"(r) : "v"(lo), "v"(hi)); return r; }

struct EpiNone {
    static constexpr bool PERM = true, AFTER_DRAIN = false;
    __device__ __forceinline__ void operator()(const f32x4 (&acc)[2][2][4][2], const Unit& u, int wr, int wc, int fr, int fq) const {
#pragma unroll
        for (int ai = 0; ai < 2; ++ai)
#pragma unroll
            for (int bj = 0; bj < 2; ++bj)
#pragma unroll
                for (int m = 0; m < 4; ++m)
#pragma unroll
                    for (int n = 0; n < 2; ++n) asm volatile("" :: "v"(acc[ai][bj][m][n]));
    }
};
struct EpiBf16 {
    static constexpr bool PERM = true, AFTER_DRAIN = false;
    bf16_t* O; int ldc;
    __device__ __forceinline__ void operator()(const f32x4 (&acc)[2][2][4][2], const Unit& u, int wr, int wc, int fr, int fq) const {
        const int row0 = u.pm * BM + wr * 64 + fr; const int col0 = u.pn * BM + wc * 32 + 8 * fq;
#pragma unroll
        for (int ai = 0; ai < 2; ++ai)
#pragma unroll
            for (int m = 0; m < 4; ++m) { bf16_t* rowp = O + (size_t)(row0 + ai * HALF + m * 16) * ldc + col0;
#pragma unroll
                for (int bj = 0; bj < 2; ++bj) { const f32x4 v0 = acc[ai][bj][m][0], v1 = acc[ai][bj][m][1];
                    u32x4 w; w.x = cvt_pk_bf16(v0[0], v0[1]); w.y = cvt_pk_bf16(v0[2], v0[3]); w.z = cvt_pk_bf16(v1[0], v1[1]); w.w = cvt_pk_bf16(v1[2], v1[3]);
                    *(u32x4*)(rowp + bj * HALF) = w; } }
    }
};
struct EpiDft {
    static constexpr bool PERM = true, AFTER_DRAIN = false;
    bf16_t* MIX; int rowbase, nper; float scale;
    __device__ __forceinline__ void operator()(const f32x4 (&acc)[2][2][4][2], const Unit& u, int wr, int wc, int fr, int fq) const {
        const int k0 = u.pm * BM + wr * 64 + fr; const int n0 = u.pn * BM + wc * 32 + 8 * fq;
#pragma unroll
        for (int ai = 0; ai < 2; ++ai)
#pragma unroll
            for (int m = 0; m < 4; ++m) { const int k = k0 + ai * HALF + m * 16;
#pragma unroll
                for (int bj = 0; bj < 2; ++bj) { const int n = n0 + bj * HALF; const int b = n >> 9, gd = n & 511;
                    const f32x4 v0 = acc[ai][bj][m][0] * scale, v1 = acc[ai][bj][m][1] * scale;
                    u32x4 w; w.x = cvt_pk_bf16(v0[0], v0[1]); w.y = cvt_pk_bf16(v0[2], v0[3]); w.z = cvt_pk_bf16(v1[0], v1[1]); w.w = cvt_pk_bf16(v1[2], v1[3]);
                    *(u32x4*)(MIX + (size_t)(rowbase + b * nper + k) * 2560 + 1024 + gd) = w; } }
    }
};

struct EpiS1 {
    static constexpr bool PERM = true, AFTER_DRAIN = false;
    bf16_t* S2;
    __device__ __forceinline__ void operator()(const f32x4 (&acc)[2][2][4][2], const Unit& u, int wr, int wc, int fr, int fq) const {
        const int m0 = wr * 64 + fr; const int n0 = u.pn * BM + wc * 32 + 8 * fq;
#pragma unroll
        for (int ai = 0; ai < 2; ++ai)
#pragma unroll
            for (int mm = 0; mm < 4; ++mm) { const int m = m0 + mm * 16; const int k2 = m >> 1, ro = m & 1;
#pragma unroll
                for (int bj = 0; bj < 2; ++bj) { const int np = n0 + bj * HALF; const int n = np >> 5, c = ai * 32 + (np & 31);
                    const f32x4 v0 = acc[ai][bj][mm][0], v1 = acc[ai][bj][mm][1];
                    u32x4 w; w.x = cvt_pk_bf16(v0[0], v0[1]); w.y = cvt_pk_bf16(v0[2], v0[3]); w.z = cvt_pk_bf16(v1[0], v1[1]); w.w = cvt_pk_bf16(v1[2], v1[3]);
                    *(u32x4*)(S2 + ((((size_t)(k2 >> 2) * 2048 + n) * 4 + (k2 & 3)) * 2 + ro) * 64 + c) = w; } }
    }
};
struct EpiS2 {
    static constexpr bool PERM = true, AFTER_DRAIN = false;
    bf16_t* MIX; float scale;
    __device__ __forceinline__ void operator()(const f32x4 (&acc)[2][2][4][2], const Unit& u, int wr, int wc, int fr, int fq) const {
        const int m0 = wr * 64 + fr; const int n0 = u.pn * BM + wc * 32 + 8 * fq;
#pragma unroll
        for (int ai = 0; ai < 2; ++ai)
#pragma unroll
            for (int mm = 0; mm < 4; ++mm) { const int m = ai * HALF + m0 + mm * 16; const int k = 4 * u.pm + (m >> 6) + 64 * (m & 63);
#pragma unroll
                for (int bj = 0; bj < 2; ++bj) { const int n = n0 + bj * HALF; const int b = n >> 9, gd = n & 511;
                    const f32x4 v0 = acc[ai][bj][mm][0] * scale, v1 = acc[ai][bj][mm][1] * scale;
                    u32x4 w; w.x = cvt_pk_bf16(v0[0], v0[1]); w.y = cvt_pk_bf16(v0[2], v0[3]); w.z = cvt_pk_bf16(v1[0], v1[1]); w.w = cvt_pk_bf16(v1[2], v1[3]);
                    *(u32x4*)(MIX + (size_t)(b * 4096 + k) * 2560 + 1024 + gd) = w; } }
    }
};
struct EpiResGate {
    static constexpr bool PERM = true, AFTER_DRAIN = false;
    bf16_t* X; const float* modl; int goff; float* XP; const float* basef;
    __device__ __forceinline__ void operator()(const f32x4 (&acc)[2][2][4][2], const Unit& u, int wr, int wc, int fr, int fq) const {
        const int row0 = u.pm * BM + wr * 64 + fr, col0 = u.pn * BM + wc * 32 + 8 * fq;
        const int v = u.pm < 64 ? (u.pm >> 4) : 4;
        const float* gate = modl + (size_t)v * 12288 + goff;
        f32x4 gv[2][2];
#pragma unroll
        for (int bj = 0; bj < 2; ++bj)
#pragma unroll
            for (int n = 0; n < 2; ++n) gv[bj][n] = *(const f32x4*)(gate + col0 + bj * HALF + n * 4);
#pragma unroll
        for (int ai = 0; ai < 2; ++ai)
#pragma unroll
            for (int m = 0; m < 4; ++m) { const size_t ro = (size_t)(row0 + ai * HALF + m * 16) * 2048 + col0;
#pragma unroll
                for (int bj = 0; bj < 2; ++bj) { const size_t o = ro + bj * HALF; const f32x4 d0 = gv[bj][0] * acc[ai][bj][m][0], d1 = gv[bj][1] * acc[ai][bj][m][1];
                    if (u.split) { float* xp = XP + ((size_t)(u.kt0 / u.nkt) * 1024 + (row0 + ai * HALF + m * 16 - 16384)) * 2048 + col0 + bj * HALF;
                        *(f32x4*)xp = d0; *(f32x4*)(xp + 4) = d1; }
                    else { f32x4 b0, b1;
                        if (basef) { b0 = *(const f32x4*)(basef + o); b1 = *(const f32x4*)(basef + o + 4); }
                        else { const u32x4 w = *(const u32x4*)(X + o);
                            b0 = (f32x4){__uint_as_float(w.x << 16), __uint_as_float(w.x & 0xffff0000u), __uint_as_float(w.y << 16), __uint_as_float(w.y & 0xffff0000u)};
                            b1 = (f32x4){__uint_as_float(w.z << 16), __uint_as_float(w.z & 0xffff0000u), __uint_as_float(w.w << 16), __uint_as_float(w.w & 0xffff0000u)}; }
                        const f32x4 x0 = b0 + d0, x1 = b1 + d1; u32x4 wo; wo.x = cvt_pk_bf16(x0[0], x0[1]); wo.y = cvt_pk_bf16(x0[2], x0[3]); wo.z = cvt_pk_bf16(x1[0], x1[1]); wo.w = cvt_pk_bf16(x1[2], x1[3]);
                        *(u32x4*)(X + o) = wo; } } }
    }
};


__device__ __forceinline__ float dpp_ror1(float x)  { return __builtin_bit_cast(float, __builtin_amdgcn_update_dpp(0, __builtin_bit_cast(int, x), 0x121, 0xF, 0xF, false)); }
__device__ __forceinline__ float dpp_ror15(float x) { return __builtin_bit_cast(float, __builtin_amdgcn_update_dpp(0, __builtin_bit_cast(int, x), 0x12F, 0xF, 0xF, false)); }
__device__ __forceinline__ f32x4 ror1v(const f32x4 v)  { return (f32x4){dpp_ror1(v[0]), dpp_ror1(v[1]), dpp_ror1(v[2]), dpp_ror1(v[3])}; }
__device__ __forceinline__ f32x4 ror15v(const f32x4 v) { return (f32x4){dpp_ror15(v[0]), dpp_ror15(v[1]), dpp_ror15(v[2]), dpp_ror15(v[3])}; }
struct EpiUp {
    static constexpr bool PERM = true, AFTER_DRAIN = false;
    bf16_t* ACT; float* EDGE; const float* cw; const float* cb; PG8_LAS float* xl; int dff;
    __device__ __forceinline__ void operator()(const f32x4 (&acc)[2][2][4][2], const Unit& u, int wr, int wc, int fr, int fq) const {
        const int ch0 = u.pn * 128 + wc * 32 + 8 * fq;
        f32x4 w0[2], w1[2], w2[2], bb[2];
#pragma unroll
        for (int n = 0; n < 2; ++n) { w0[n] = *(const f32x4*)(cw + ch0 + 4 * n); w1[n] = *(const f32x4*)(cw + dff + ch0 + 4 * n); w2[n] = *(const f32x4*)(cw + 2 * dff + ch0 + 4 * n); bb[n] = *(const f32x4*)(cb + ch0 + 4 * n); }
#pragma unroll
        for (int ai = 0; ai < 2; ++ai)
#pragma unroll
            for (int n = 0; n < 2; ++n) {
                if (fr == 0)  *(PG8_LAS f32x4*)(xl + ((((wr * 4 + wc) * 2 + ai) * 2 + 0) * 32) + 8 * fq + 4 * n) = acc[ai][0][0][n];
                if (fr == 15) *(PG8_LAS f32x4*)(xl + ((((wr * 4 + wc) * 2 + ai) * 2 + 1) * 32) + 8 * fq + 4 * n) = acc[ai][0][3][n];
            }
        { float* eg = EDGE + (size_t)u.pm * 6 * dff + ch0;
          if (wr == 0 && fr < 2) {
#pragma unroll
              for (int n = 0; n < 2; ++n) { *(f32x4*)(eg + (size_t)fr * dff + 4 * n) = acc[0][0][0][n]; if (fr == 0) *(f32x4*)(eg + (size_t)4 * dff + 4 * n) = acc[0][1][0][n]; } }
          if (wr == 1 && fr >= 14) {
#pragma unroll
              for (int n = 0; n < 2; ++n) { *(f32x4*)(eg + (size_t)(fr - 12) * dff + 4 * n) = acc[1][0][3][n]; if (fr == 15) *(f32x4*)(eg + (size_t)5 * dff + 4 * n) = acc[1][1][3][n]; } }
        }
        asm volatile("s_waitcnt lgkmcnt(0)" ::: "memory"); __builtin_amdgcn_s_barrier(); asm volatile("" ::: "memory");
        f32x4 pe[2][2], ne[2][2];
#pragma unroll
        for (int ai = 0; ai < 2; ++ai)
#pragma unroll
            for (int n = 0; n < 2; ++n) {
                const bool hp = (wr == 1) || (ai == 1), hn = (wr == 0) || (ai == 0);
                const int pai = (wr == 1) ? ai : ai - 1, nai = (wr == 0) ? ai : ai + 1;
                pe[ai][n] = hp ? *(const PG8_LAS f32x4*)(xl + (((((wr ^ 1) * 4 + wc) * 2 + pai) * 2 + 1) * 32) + 8 * fq + 4 * n) : (f32x4){0.f, 0.f, 0.f, 0.f};
                ne[ai][n] = hn ? *(const PG8_LAS f32x4*)(xl + (((((wr ^ 1) * 4 + wc) * 2 + nai) * 2 + 0) * 32) + 8 * fq + 4 * n) : (f32x4){0.f, 0.f, 0.f, 0.f};
            }
        const int row0 = u.pm * BM + wr * 64 + fr;
#pragma unroll
        for (int ai = 0; ai < 2; ++ai)
#pragma unroll
            for (int m = 0; m < 4; ++m) {
                float z[8], t[8];
#pragma unroll
                for (int n = 0; n < 2; ++n) {
                    const f32x4 g = acc[ai][0][m][n];
                    const f32x4 gp = (m > 0) ? acc[ai][0][m > 0 ? m - 1 : 0][n] : pe[ai][n];
                    const f32x4 gn = (m < 3) ? acc[ai][0][m < 3 ? m + 1 : 3][n] : ne[ai][n];
                    const f32x4 zz = w1[n] * g + bb[n];
#pragma unroll
                    for (int j = 0; j < 4; ++j) { float zj = zz[j];
                        if ((m == 0 || m == 3) && n == 0 && j == 0)
                            asm("s_nop 1\n\t"
                                "v_fmac_f32_dpp %0, %1, %4 row_shr:1 row_mask:0xf bank_mask:0xf\n\t"
                                "v_fmac_f32_dpp %0, %2, %4 row_shl:15 row_mask:0xf bank_mask:0xf\n\t"
                                "v_fmac_f32_dpp %0, %1, %5 row_shl:1 row_mask:0xf bank_mask:0xf\n\t"
                                "v_fmac_f32_dpp %0, %3, %5 row_shr:15 row_mask:0xf bank_mask:0xf"
                                : "+v"(zj) : "v"(g[j]), "v"(gp[j]), "v"(gn[j]), "v"(w0[n][j]), "v"(w2[n][j]));
                        else
                            asm("v_fmac_f32_dpp %0, %1, %4 row_shr:1 row_mask:0xf bank_mask:0xf\n\t"
                                "v_fmac_f32_dpp %0, %2, %4 row_shl:15 row_mask:0xf bank_mask:0xf\n\t"
                                "v_fmac_f32_dpp %0, %1, %5 row_shl:1 row_mask:0xf bank_mask:0xf\n\t"
                                "v_fmac_f32_dpp %0, %3, %5 row_shr:15 row_mask:0xf bank_mask:0xf"
                                : "+v"(zj) : "v"(g[j]), "v"(gp[j]), "v"(gn[j]), "v"(w0[n][j]), "v"(w2[n][j]));
                        z[n * 4 + j] = zj; }
                }
#pragma unroll
                for (int i = 0; i < 8; ++i) t[i] = -1.4426950408889634f * z[i];
#pragma unroll
                for (int i = 0; i < 8; ++i) t[i] = __builtin_amdgcn_exp2f(t[i]);
#pragma unroll
                for (int i = 0; i < 8; ++i) t[i] = 1.f + t[i];
#pragma unroll
                for (int i = 0; i < 8; ++i) t[i] = __builtin_amdgcn_rcpf(t[i]);
#pragma unroll
                for (int i = 0; i < 8; ++i) t[i] = z[i] * t[i] * acc[ai][1][m][i >> 2][i & 3];
                u32x4 w; w.x = cvt_pk_bf16(t[0], t[1]); w.y = cvt_pk_bf16(t[2], t[3]); w.z = cvt_pk_bf16(t[4], t[5]); w.w = cvt_pk_bf16(t[6], t[7]);
                *(u32x4*)(ACT + (size_t)(row0 + ai * HALF + m * 16) * dff + ch0) = w;
            }
    }
};

template <class Epi, class Sched, bool ALIGN_EPI = false, bool SP2 = false>
__device__ __forceinline__ void gemm_phase(PG8_LAS unsigned char* lds, const Gemm g, const Sched& S, const Epi& E) {
    int tid_ = threadIdx.x; asm volatile("" : "+v"(tid_));
    const int tid = tid_, wid = __builtin_amdgcn_readfirstlane(tid >> 6), lane = tid & 63, wr = wid >> 2, wc = wid & 3, fr = lane & 15, fq = lane >> 4;
    unsigned voffA[2], voffB[2];
#pragma unroll
    for (int i = 0; i < 2; ++i) { int R, C; stage_rc(tid * 16 + i * 8192, R, C); const int Rb = Epi::PERM ? ((R & ~31) + perm32(R & 31)) : R;
        voffA[i] = (unsigned)(R * (g.tiledA ? BK : g.lda) + C) * 2u; voffB[i] = (unsigned)(Rb * (g.tiledB ? BK : g.ldb) + C) * 2u; }
    const size_t kstepA = g.tiledA ? (size_t)BM * BK * 2 : (size_t)(BK * 2), kstepB = g.tiledB ? (size_t)BM * BK * 2 : (size_t)(BK * 2);
    const size_t hstepA = (size_t)HALF * (g.tiledA ? BK : g.lda) * 2, hstepB = (size_t)HALF * (g.tiledB ? BK : g.ldb) * 2;
    const size_t tstepA = g.tiledA ? (size_t)(g.K / BK) * BM * BK * 2 : 2 * hstepA, tstepB = g.tiledB ? (size_t)(g.K / BK) * BM * BK * 2 : 2 * hstepB;
    const unsigned ldsw = (unsigned)wid * 1024u;
    const int aoff = lds_byte(wr * 64 + fr, fq * 8), boff = lds_byte(wc * 32 + fr, fq * 8);
#define PG8_SA(b, h) (((b) * 2 + (h)) * HTB)
#define PG8_SB(b, h) ((4 + (b) * 2 + (h)) * HTB)
#define PG8_STAGE(bufoff, gbase, voff) do { _Pragma("unroll") for (int _i = 0; _i < 2; ++_i) \
        __builtin_amdgcn_global_load_lds((const unsigned*)((const char*)(gbase) + (voff)[_i]), (PG8_LAS unsigned*)(lds + (bufoff) + ldsw + _i * 8192), 16, 0, 0); } while (0)
#define PG8_LDA(dst, b, h) do { _Pragma("unroll") for (int m = 0; m < 4; ++m) _Pragma("unroll") for (int k = 0; k < 2; ++k) dst[m][k] = *(const PG8_LAS bf16x8*)(lds + PG8_SA(b, h) + aoff + m * 2048 + k * 1024); } while (0)
#define PG8_LDB(dst, b, h) do { _Pragma("unroll") for (int n = 0; n < 2; ++n) _Pragma("unroll") for (int k = 0; k < 2; ++k) dst[n][k] = *(const PG8_LAS bf16x8*)(lds + PG8_SB(b, h) + boff + n * 2048 + k * 1024); } while (0)
#define PG8_MMA(ai, bj, At, Bt) do { __builtin_amdgcn_s_setprio(1); _Pragma("unroll") for (int m = 0; m < 4; ++m) _Pragma("unroll") for (int n = 0; n < 2; ++n) _Pragma("unroll") for (int k = 0; k < 2; ++k) \
        acc[ai][bj][m][n] = __builtin_amdgcn_mfma_f32_16x16x32_bf16(Bt[n][k], At[m][k], acc[ai][bj][m][n], 0, 0, 0); __builtin_amdgcn_s_setprio(0); } while (0)
#define PG8_WAIT_V(n) asm volatile("s_waitcnt vmcnt(" #n ")" ::: "memory")
#define PG8_WAIT_L(n) asm volatile("s_waitcnt lgkmcnt(" #n ")" ::: "memory")
#define PG8_BAR __builtin_amdgcn_s_barrier()
#define PG8_SCHED __builtin_amdgcn_sched_barrier(0)
    Unit cur, nxt; int ui = 0;
    if (!S.next(0, cur)) return;
    f32x4 acc[2][2][4][2];
#pragma unroll
    for (int a = 0; a < 2; ++a)
#pragma unroll
        for (int b = 0; b < 2; ++b)
#pragma unroll
            for (int m = 0; m < 4; ++m)
#pragma unroll
                for (int n = 0; n < 2; ++n) acc[a][b][m][n] = (f32x4){0.f, 0.f, 0.f, 0.f};
    bf16x8 At[4][2], B0[2][2], B1[2][2];
    const char* cA = (const char*)g.A + (size_t)cur.pm * tstepA + (size_t)cur.kt0 * kstepA; const char* cB = (const char*)g.Bt + (size_t)cur.pm * g.bpm + (size_t)cur.pn * tstepB + (size_t)cur.kt0 * kstepB;
    int nt = cur.nkt;
    S.a_ready(cur);
    if constexpr (SP2) {
        PG8_STAGE(PG8_SB(0, 0), cB, voffB); PG8_STAGE(PG8_SB(0, 1), cB + hstepB, voffB); PG8_STAGE(PG8_SA(0, 0), cA, voffA); PG8_STAGE(PG8_SA(0, 1), cA + hstepA, voffA);
        if (wr == 1) PG8_BAR;
        PG8_WAIT_V(2); PG8_BAR;
        PG8_STAGE(PG8_SB(1, 0), cB + kstepB, voffB); PG8_STAGE(PG8_SA(1, 0), cA + kstepA, voffA); PG8_STAGE(PG8_SB(1, 1), cB + hstepB + kstepB, voffB);
        PG8_WAIT_V(6); PG8_BAR;
    } else {
        PG8_STAGE(PG8_SB(0, 0), cB, voffB); PG8_STAGE(PG8_SA(0, 0), cA, voffA); PG8_STAGE(PG8_SB(0, 1), cB + hstepB, voffB); PG8_STAGE(PG8_SA(0, 1), cA + hstepA, voffA);
        if (wr == 1) PG8_BAR;
        PG8_WAIT_V(4); PG8_BAR;
        PG8_STAGE(PG8_SB(1, 0), cB + kstepB, voffB); PG8_STAGE(PG8_SA(1, 0), cA + kstepA, voffA); PG8_STAGE(PG8_SB(1, 1), cB + hstepB + kstepB, voffB);
        PG8_WAIT_V(6); PG8_BAR;
    }
    for (;;) {
        const bool has_next = S.next(ui + 1, nxt);
        const char* nA = has_next ? (const char*)g.A + (size_t)nxt.pm * tstepA + (size_t)nxt.kt0 * kstepA : cA; const char* nB = has_next ? (const char*)g.Bt + (size_t)nxt.pm * g.bpm + (size_t)nxt.pn * tstepB + (size_t)nxt.kt0 * kstepB : cB;
        for (int t = 0; t < nt; t += 2) {
            const bool last = (t == nt - 2);
            const char* a1 = cA + (size_t)(t + 1) * kstepA;
            const char* a2 = last ? nA : cA + (size_t)(t + 2) * kstepA; const char* b2 = last ? nB : cB + (size_t)(t + 2) * kstepB;
            const char* a3 = a2 + kstepA; const char* b3 = b2 + kstepB;
            if (last && has_next) S.a_ready(nxt);
            if constexpr (SP2) {
            PG8_LDB(B0, 0, 0); PG8_LDB(B1, 0, 1); PG8_SCHED; PG8_LDA(At, 0, 0); PG8_STAGE(PG8_SA(1, 1), a1 + hstepA, voffA);
            PG8_WAIT_V(8); PG8_WAIT_L(0); PG8_BAR; PG8_MMA(0, 0, At, B0); PG8_MMA(0, 1, At, B1); PG8_BAR; PG8_SCHED;
            PG8_LDA(At, 0, 1); PG8_STAGE(PG8_SB(0, 0), b2, voffB); PG8_STAGE(PG8_SB(0, 1), b2 + hstepB, voffB); PG8_STAGE(PG8_SA(0, 0), a2, voffA);
            PG8_WAIT_V(8); PG8_WAIT_L(0); PG8_BAR; PG8_MMA(1, 0, At, B0); PG8_MMA(1, 1, At, B1); PG8_BAR; PG8_SCHED;
            PG8_LDB(B0, 1, 0); PG8_LDB(B1, 1, 1); PG8_SCHED; PG8_LDA(At, 1, 0); PG8_STAGE(PG8_SA(0, 1), a2 + hstepA, voffA);
            PG8_WAIT_V(8); PG8_WAIT_L(0); PG8_BAR; PG8_MMA(0, 0, At, B0); PG8_MMA(0, 1, At, B1); PG8_BAR; PG8_SCHED;
            PG8_LDA(At, 1, 1); PG8_STAGE(PG8_SB(1, 0), b3, voffB); PG8_STAGE(PG8_SB(1, 1), b3 + hstepB, voffB); PG8_STAGE(PG8_SA(1, 0), a3, voffA);
            PG8_WAIT_V(8); PG8_WAIT_L(0); PG8_BAR; PG8_MMA(1, 0, At, B0); PG8_MMA(1, 1, At, B1); PG8_BAR; PG8_SCHED;
            } else {
            PG8_LDB(B0, 0, 0); PG8_SCHED; PG8_LDA(At, 0, 0); PG8_STAGE(PG8_SA(1, 1), a1 + hstepA, voffA);
            PG8_WAIT_L(8); PG8_BAR; PG8_WAIT_L(0); PG8_MMA(0, 0, At, B0); PG8_BAR; PG8_SCHED;
            PG8_LDB(B1, 0, 1); PG8_STAGE(PG8_SB(0, 0), b2, voffB);
            PG8_BAR; PG8_WAIT_L(0); PG8_MMA(0, 1, At, B1); PG8_BAR;
            PG8_LDA(At, 0, 1); PG8_STAGE(PG8_SA(0, 0), a2, voffA);
            PG8_BAR; PG8_WAIT_L(0); PG8_MMA(1, 0, At, B0); PG8_BAR; PG8_SCHED;
            PG8_STAGE(PG8_SB(0, 1), b2 + hstepB, voffB);
            PG8_WAIT_V(6); PG8_BAR; PG8_MMA(1, 1, At, B1); PG8_BAR;
            PG8_LDB(B0, 1, 0); PG8_SCHED; PG8_LDA(At, 1, 0); PG8_STAGE(PG8_SA(0, 1), a2 + hstepA, voffA);
            PG8_WAIT_L(8); PG8_BAR; PG8_WAIT_L(0); PG8_MMA(0, 0, At, B0); PG8_BAR; PG8_SCHED;
            PG8_LDB(B1, 1, 1); PG8_STAGE(PG8_SB(1, 0), b3, voffB);
            PG8_BAR; PG8_WAIT_L(0); PG8_MMA(0, 1, At, B1); PG8_BAR;
            PG8_LDA(At, 1, 1); PG8_STAGE(PG8_SA(1, 0), a3, voffA);
            PG8_BAR; PG8_WAIT_L(0); PG8_MMA(1, 0, At, B0); PG8_BAR; PG8_SCHED;
            PG8_STAGE(PG8_SB(1, 1), b3 + hstepB, voffB);
            PG8_WAIT_V(6); PG8_BAR; PG8_MMA(1, 1, At, B1); PG8_BAR;
            }
        }
        if constexpr (ALIGN_EPI) { if (wr == 0) PG8_BAR; }
        if constexpr (!Epi::AFTER_DRAIN) { E(acc, cur, wr, wc, fr, fq); S.done(cur); }
        if (!has_next) break;
#pragma unroll
        for (int a = 0; a < 2; ++a)
#pragma unroll
            for (int b = 0; b < 2; ++b)
#pragma unroll
                for (int m = 0; m < 4; ++m)
#pragma unroll
                    for (int n = 0; n < 2; ++n) acc[a][b][m][n] = (f32x4){0.f, 0.f, 0.f, 0.f};
        cur = nxt; cA = nA; cB = nB; nt = cur.nkt; ++ui;
        if constexpr (ALIGN_EPI) { if (wr == 1) PG8_BAR; }
    }
    PG8_WAIT_V(0);
    if constexpr (!ALIGN_EPI) { if (wr == 0) PG8_BAR; }
    PG8_BAR;
#undef PG8_SA
#undef PG8_SB
#undef PG8_STAGE
#undef PG8_LDA
#undef PG8_LDB
#undef PG8_MMA
#undef PG8_WAIT_V
#undef PG8_WAIT_L
#undef PG8_BAR
#undef PG8_SCHED
}
}

namespace att {
typedef unsigned short bf16;
constexpr int   D = 128, NW = 8, QBLK = 32, KVBLK = 64;
constexpr float SCALE = 0.088388347648318440f;
constexpr float THR = 8.f;
constexpr int LDQ = 1024, LDK = 256, LDO = 2560;
constexpr size_t SHM_V = KVBLK * D * 2, SHM_K = KVBLK * D * 2, SHM_ATTN = 2 * SHM_V + 2 * SHM_K + NW * 64 * 4;
using bf16x8 = __attribute__((ext_vector_type(8))) short;
using s16x4  = __attribute__((ext_vector_type(4))) short;
using f32x16 = __attribute__((ext_vector_type(16))) float;
using u32x4  = __attribute__((ext_vector_type(4))) unsigned;
#define KSWZ(row, colB) ((row) * 256 + ((colB) ^ (((row) & 7) << 4)))
#define SBAR() __builtin_amdgcn_sched_barrier(0)
__device__ __forceinline__ int crow(int r, int hi) { return (r & 3) + 8 * (r >> 2) + 4 * hi; }
__device__ __forceinline__ unsigned cvtpk(float lo, float hi) { unsigned r; asm volatile("v_cvt_pk_bf16_f32 %0, %1, %2" : "=v"(r) : "v"(lo), "v"(hi)); return r; }
__device__ __forceinline__ bf16x8 ld8(const bf16* p) { return *reinterpret_cast<const bf16x8*>(p); }

__device__ __forceinline__ void partialSM(f32x16& p0, f32x16& p1, float& m_reg, float& mn, float& alpha) {
  constexpr float C = SCALE * 1.4426950408889634f;
  float pmax = p0[0]; for (int r = 1; r < 16; ++r) pmax = fmaxf(pmax, p0[r]); for (int r = 0; r < 16; ++r) pmax = fmaxf(pmax, p1[r]);
  { auto rr = __builtin_amdgcn_permlane32_swap(__float_as_uint(pmax), __float_as_uint(pmax), false, false);
    pmax = fmaxf(__uint_as_float(rr[0]), __uint_as_float(rr[1])); }
  if (__builtin_expect(__all(pmax - m_reg <= THR / SCALE), 1)) { mn = m_reg; alpha = 1.f; }
  else { mn = fmaxf(m_reg, pmax); alpha = __builtin_amdgcn_exp2f((m_reg - mn) * C); m_reg = mn; }
  float mnC = -mn * C;
  for (int r = 0; r < 16; ++r) p0[r] = fmaf(p0[r], C, mnC); for (int r = 0; r < 16; ++r) p1[r] = fmaf(p1[r], C, mnC);
  for (int r = 0; r < 16; ++r) p0[r] = __builtin_amdgcn_exp2f(p0[r]);
}
__device__ __forceinline__ void finishSM(f32x16& p0, f32x16& p1, float alpha, float& l_reg, bf16x8& pa0, bf16x8& pa1, bf16x8& pa2, bf16x8& pa3) {
  for (int r = 0; r < 16; ++r) p1[r] = __builtin_amdgcn_exp2f(p1[r]);
  float ps = 0; for (int r = 0; r < 16; ++r) ps += p0[r]; for (int r = 0; r < 16; ++r) ps += p1[r];
  { auto rr = __builtin_amdgcn_permlane32_swap(__float_as_uint(ps), __float_as_uint(ps), false, false);
    ps = __uint_as_float(rr[0]) + __uint_as_float(rr[1]); }
  l_reg = l_reg * alpha + ps;
#define PK4(P, BASE, OUT) do { unsigned a0 = cvtpk(P[BASE + 0], P[BASE + 1]), a1 = cvtpk(P[BASE + 2], P[BASE + 3]);   \
    unsigned b0 = cvtpk(P[BASE + 4], P[BASE + 5]), b1 = cvtpk(P[BASE + 6], P[BASE + 7]);                              \
    auto r0 = __builtin_amdgcn_permlane32_swap(a0, b0, false, false); auto r1 = __builtin_amdgcn_permlane32_swap(a1, b1, false, false); \
    u32x4 w = {r0[0], r1[0], r0[1], r1[1]}; OUT = *reinterpret_cast<bf16x8*>(&w); } while (0)
  PK4(p0, 0, pa0); PK4(p0, 8, pa1); PK4(p1, 0, pa2); PK4(p1, 8, pa3);
#undef PK4
}
__device__ __forceinline__ void qkt(f32x16& p0, f32x16& p1, const bf16* Ks, const bf16x8* qr, int r32, int hi) {
  p0 = f32x16{}; p1 = f32x16{};
  for (int d0 = 0; d0 < 8; ++d0) { int cb = (d0 * 16 + hi * 8) * 2;
    bf16x8 b0 = *reinterpret_cast<const bf16x8*>((const char*)Ks + KSWZ(r32, cb));
    bf16x8 b1 = *reinterpret_cast<const bf16x8*>((const char*)Ks + KSWZ(32 + r32, cb));
    p0 = __builtin_amdgcn_mfma_f32_32x32x16_bf16(b0, qr[d0], p0, 0, 0, 0);
    p1 = __builtin_amdgcn_mfma_f32_32x32x16_bf16(b1, qr[d0], p1, 0, 0, 0); }
}
__device__ __forceinline__ int v_st(int k, int c) { const int kk = (k & ~0xC) | ((k & 4) << 1) | ((k & 8) >> 1); return ((kk >> 3) * 4 + (c >> 5)) * 512 + ((kk & 7) * 32 + (c & 31)) * 2; }
__device__ __forceinline__ int v_rd_base(int lane) { return ((lane & 3) << 3) | (((lane >> 2) & 3) << 6) | (((lane >> 4) & 1) << 5) | (((lane >> 5) & 1) << 8); }
constexpr int v_rd_off(int d0, int ks, int half) { return d0 * 512 + ks * 4096 + half * 2048; }
template <int OFF> __device__ __forceinline__ s16x4 tr_read(int vb) {
  s16x4 r; asm volatile("ds_read_b64_tr_b16 %0, %1 offset:%2" : "=&v"(r) : "v"(vb), "i"(OFF) : "memory"); return r;
}
template <int D0> __device__ __forceinline__ void pv_one(f32x16& od, int vb, bf16x8 pa0, bf16x8 pa1, bf16x8 pa2, bf16x8 pa3) {
  const s16x4 l0 = tr_read<v_rd_off(D0, 0, 0)>(vb), h0 = tr_read<v_rd_off(D0, 0, 1)>(vb), l1 = tr_read<v_rd_off(D0, 1, 0)>(vb), h1 = tr_read<v_rd_off(D0, 1, 1)>(vb);
  const s16x4 l2 = tr_read<v_rd_off(D0, 2, 0)>(vb), h2 = tr_read<v_rd_off(D0, 2, 1)>(vb), l3 = tr_read<v_rd_off(D0, 3, 0)>(vb), h3 = tr_read<v_rd_off(D0, 3, 1)>(vb);
  asm volatile("s_waitcnt lgkmcnt(0)" ::: "memory"); SBAR();
#define PK(L, H) (bf16x8){L[0], L[1], L[2], L[3], H[0], H[1], H[2], H[3]}
  od = __builtin_amdgcn_mfma_f32_32x32x16_bf16(pa0, PK(l0, h0), od, 0, 0, 0);
  od = __builtin_amdgcn_mfma_f32_32x32x16_bf16(pa1, PK(l1, h1), od, 0, 0, 0);
  od = __builtin_amdgcn_mfma_f32_32x32x16_bf16(pa2, PK(l2, h2), od, 0, 0, 0);
  od = __builtin_amdgcn_mfma_f32_32x32x16_bf16(pa3, PK(l3, h3), od, 0, 0, 0);
#undef PK
}
__device__ __forceinline__ void pv_d0(f32x16* o, int vb, bf16x8 pa0, bf16x8 pa1, bf16x8 pa2, bf16x8 pa3) {
  pv_one<0>(o[0], vb, pa0, pa1, pa2, pa3); pv_one<1>(o[1], vb, pa0, pa1, pa2, pa3); pv_one<2>(o[2], vb, pa0, pa1, pa2, pa3); pv_one<3>(o[3], vb, pa0, pa1, pa2, pa3);
}

__device__ __forceinline__ void attn_dense_body(const bf16* __restrict__ Qb, const bf16* __restrict__ Kh, const bf16* __restrict__ Vh,
                                                bf16* __restrict__ Ob, int seq, char* lds) {
  constexpr int SDEPTH = 2;
  int tid_ = threadIdx.x; asm volatile("" : "+v"(tid_));
  const int tid = tid_, wid = tid >> 6, lane = tid & 63, r32 = lane & 31, hi = lane >> 5;
  bf16* V_lds = (bf16*)lds; bf16* K_lds = (bf16*)(lds + 2 * SHM_V);
  float* ws = (float*)(lds + 2 * SHM_V + 2 * SHM_K) + wid * 64; float* li_l = ws; float* al_l = ws + 32;
  float m_reg = -1e30f, l_reg = 0; f32x16 o[4] = {}; bf16x8 qr[8];
  const bf16* Qw = Qb + (long)(wid * QBLK + r32) * LDQ + hi * 8;
#pragma unroll
  for (int d0 = 0; d0 < 8; ++d0) qr[d0] = ld8(Qw + d0 * 16);
  const int sr = tid >> 4, sc = (tid & 15) * 8, vst0 = v_st(sr, sc), vst1 = v_st(32 + sr, sc);
  const int vb0 = (int)(uintptr_t)V_lds + v_rd_base(lane);
  struct { bf16x8 vs0, vs1, ks0, ks1; } sr_[SDEPTH];
#define SLOAD(i, k0) do { sr_[i].vs0 = ld8(&Vh[(long)((k0) + sr) * LDK + sc]); sr_[i].vs1 = ld8(&Vh[(long)((k0) + 32 + sr) * LDK + sc]); \
    sr_[i].ks0 = ld8(&Kh[(long)((k0) + sr) * LDK + sc]); sr_[i].ks1 = ld8(&Kh[(long)((k0) + 32 + sr) * LDK + sc]); } while (0)
#define SWRITE(b, i) do { *(bf16x8*)((char*)V_lds + (b) * SHM_V + vst0) = sr_[i].vs0;          \
    *(bf16x8*)((char*)V_lds + (b) * SHM_V + vst1) = sr_[i].vs1; int kc = sc * 2;               \
    *(bf16x8*)((char*)K_lds + (b) * SHM_K + KSWZ(sr, kc)) = sr_[i].ks0;                       \
    *(bf16x8*)((char*)K_lds + (b) * SHM_K + KSWZ(32 + sr, kc)) = sr_[i].ks1; } while (0)
#define SWAIT() do { asm volatile("s_waitcnt vmcnt(4)" ::: "memory"); } while (0)
#define RESC(a) do { if (__any((a) < 1.f)) { if (hi == 0) al_l[r32] = (a); asm volatile("s_waitcnt lgkmcnt(0)" ::: "memory"); \
    for (int d = 0; d < 4; ++d) for (int r = 0; r < 16; ++r) o[d][r] *= al_l[crow(r, hi)]; } } while (0)
  f32x16 pA0, pA1, pB0, pB1; float mnA, mnB, alA, alB; bf16x8 pa0, pa1, pa2, pa3; const int NT = seq / KVBLK;
  constexpr int SE = 0, SO = SDEPTH - 1;
  SLOAD(SE, 0); asm volatile("s_waitcnt vmcnt(0)" ::: "memory"); SWRITE(0, SE); __syncthreads();
  qkt(pA0, pA1, K_lds, qr, r32, hi); partialSM(pA0, pA1, m_reg, mnA, alA);
  SLOAD(SO, KVBLK); if (2 < NT) SLOAD(SE, 2 * KVBLK);
  SWAIT(); SWRITE(1, SO); __syncthreads();
  for (int j = 1; j + 1 < NT; j += 2) {
    SBAR(); qkt(pB0, pB1, (bf16*)((char*)K_lds + SHM_K), qr, r32, hi);
    finishSM(pA0, pA1, alA, l_reg, pa0, pa1, pa2, pa3); SBAR();
    SLOAD(SO, (j + SDEPTH) * KVBLK); SBAR();
    pv_d0(o, vb0, pa0, pa1, pa2, pa3); partialSM(pB0, pB1, m_reg, mnB, alB);
    __syncthreads(); SWAIT(); SWRITE(0, SE);
    RESC(alB); __syncthreads();
    SBAR(); qkt(pA0, pA1, K_lds, qr, r32, hi);
    finishSM(pB0, pB1, alB, l_reg, pa0, pa1, pa2, pa3); SBAR();
    if (j + 3 < NT) SLOAD(SE, (j + 1 + SDEPTH) * KVBLK); SBAR();
    pv_d0(o, vb0 + (int)SHM_V, pa0, pa1, pa2, pa3); partialSM(pA0, pA1, m_reg, mnA, alA);
    __syncthreads(); SWAIT(); SWRITE(1, SO);
    RESC(alA); __syncthreads();
  }
  SBAR(); qkt(pB0, pB1, (bf16*)((char*)K_lds + SHM_K), qr, r32, hi);
  finishSM(pA0, pA1, alA, l_reg, pa0, pa1, pa2, pa3); SBAR();
  pv_d0(o, vb0, pa0, pa1, pa2, pa3); partialSM(pB0, pB1, m_reg, mnB, alB);
  __syncthreads(); RESC(alB);
  finishSM(pB0, pB1, alB, l_reg, pa0, pa1, pa2, pa3); SBAR();
  pv_d0(o, vb0 + (int)SHM_V, pa0, pa1, pa2, pa3);
  if (hi == 0) li_l[r32] = l_reg; asm volatile("s_waitcnt lgkmcnt(0)" ::: "memory");
  float rli[16];
#pragma unroll
  for (int r = 0; r < 16; ++r) rli[r] = __builtin_amdgcn_rcpf(li_l[crow(r, hi)]);
  bf16* Ow = Ob + (long)(wid * QBLK) * LDO;
  __syncthreads();
  char* ob = lds + wid * (32 * 272);
#pragma unroll
  for (int r = 0; r < 16; ++r) { const int orow = crow(r, hi);
#pragma unroll
    for (int d0 = 0; d0 < 4; ++d0) { const float val = o[d0][r] * rli[r]; *(bf16*)(ob + orow * 272 + (d0 * 32 + r32) * 2) = (bf16)(cvtpk(val, val) & 0xffffu); } }
#pragma unroll
  for (int i = 0; i < 8; ++i) { const int row = i * 4 + (lane >> 4), ch = lane & 15;
    const u32x4 v = *(const u32x4*)(ob + row * 272 + ch * 16);
    *(u32x4*)(Ow + (long)row * LDO + ch * 8) = v; }
  __syncthreads();
#undef SLOAD
#undef SWRITE
#undef SWAIT
#undef RESC
}
#undef KSWZ
#undef SBAR
}

constexpr int NWAVES = 8, NTHR = 512;
constexpr int DM = 2048, NB = 4, SEQ = 4096, DEPTH = 4, CTXL = 256;
constexpr int ML = NB * SEQ, MC = NB * CTXL, MT = ML + MC;
constexpr int SKV = CTXL + SEQ;
constexpr int INW_SRC = 4608, PW = 5120;
constexpr int PQ = 0, PK = 1024, PV = 1280, PFA = 1536, PFB = 2048, PCB = 2560, PCC = 3072, PCH = 3584, PGU = 4096, PGV = 4608;
constexpr int MIXW = 2560, MX_ATT = 0, MX_FOUR = 1024, MX_CONV = 1536, MX_GM = 2048;
constexpr int DFF = 5632, UPW = 2 * DFF;
constexpr int NMOD = 6 * DM;
constexpr float EPS = 1e-6f;

constexpr size_t al256(size_t x) { return (x + 255) / 256 * 256; }
constexpr size_t WS_CTL = 0, CTL_ZERO_BYTES = 1u << 20;
constexpr size_t WS_WIN  = CTL_ZERO_BYTES;
constexpr size_t WS_WOUT = WS_WIN  + (size_t)DEPTH * PW * DM * 2;
constexpr size_t WS_WUP  = WS_WOUT + (size_t)DEPTH * DM * MIXW * 2;
constexpr size_t WS_WDN  = WS_WUP  + (size_t)DEPTH * UPW * DM * 2;
constexpr size_t WS_FN   = WS_WDN  + (size_t)DEPTH * DM * DFF * 2;
constexpr size_t WS_A1   = WS_FN;
constexpr size_t WS_A2   = WS_A1   + (size_t)256 * 256 * 2;
constexpr size_t WS_F256 = WS_A2   + (size_t)16 * 256 * 512 * 2;
constexpr size_t WS_GW   = WS_F256 + (size_t)256 * 512 * 2;
constexpr size_t WS_MODP = WS_GW   + (size_t)DEPTH * 4 * 128 * 128 * 2;
constexpr size_t WS_MOD  = WS_MODP + (size_t)16 * DEPTH * 5 * NMOD * 4;
constexpr size_t WS_ROPE = WS_MOD  + (size_t)DEPTH * 5 * NMOD * 4;
constexpr size_t WS_MODG = WS_ROPE + 64 * 32 * 8;
constexpr size_t WS_X    = WS_MODG + (size_t)DEPTH * 2 * 5 * DM * 4;
constexpr size_t WS_H    = WS_X    + (size_t)MT * DM * 2;
constexpr size_t WS_R    = WS_H    + (size_t)MT * DM * 2;
constexpr size_t WS_P    = WS_R;
constexpr size_t WS_MIX  = WS_P    + (size_t)MT * PW * 2;
constexpr size_t WS_T1T  = WS_MIX  + (size_t)MT * MIXW * 2;
constexpr size_t WS_T1TC = WS_T1T  + (size_t)2048 * 8192 * 2;
constexpr size_t WS_KB   = WS_T1TC + (size_t)2048 * 512 * 2;
constexpr size_t WS_VB   = WS_KB   + (size_t)NB * SKV * 256 * 2;
constexpr size_t WS_QB   = WS_VB   + (size_t)NB * SKV * 256 * 2;
constexpr size_t WS_UB   = WS_QB   + (size_t)MT * 1024 * 2;
constexpr size_t WS_V2B  = WS_UB   + (size_t)MT * 512 * 2;
constexpr size_t WS_S2IN = WS_V2B  + (size_t)MT * 512 * 2;
constexpr size_t WS_RA_END = WS_S2IN + (size_t)16 * 2048 * 512 * 2;
constexpr size_t WS_ACT  = WS_R;
constexpr size_t WS_ACT_END = WS_ACT + (size_t)MT * DFF * 2;
constexpr size_t WS_R_END = WS_RA_END > WS_ACT_END ? WS_RA_END : WS_ACT_END;
constexpr size_t WS_EDGE = WS_R_END;
constexpr size_t WS_XP   = WS_EDGE + (size_t)(MT / 256) * 6 * DFF * 4;
constexpr size_t WS_END  = WS_XP   + (size_t)4 * MC * DM * 4;
static_assert(WS_END <= 1600000000ull, "d_ws budget");
static_assert(WS_WIN % 256 == 0 && WS_FN % 256 == 0 && WS_X % 256 == 0 && WS_H % 256 == 0 && WS_P % 256 == 0 && WS_MIX % 256 == 0 && WS_T1T % 256 == 0 && WS_KB % 256 == 0 && WS_ACT % 256 == 0 && WS_MOD % 256 == 0, "alignment");
constexpr int CW_TMO = 0, CW_BAR = 4096;

constexpr int RING_BYTES = 131072;
constexpr int LDSCTL_OFF = RING_BYTES, MISC_OFF = LDSCTL_OFF + 320;
constexpr int XL_OFF = RING_BYTES + 1024;
constexpr int LDS_BYTES = 147456;

#define GAS __attribute__((address_space(1)))
#define LAS __attribute__((address_space(3)))
typedef unsigned short bf16;
typedef unsigned v4u __attribute__((ext_vector_type(4)));
typedef unsigned v2u __attribute__((ext_vector_type(2)));
typedef float f32x4 __attribute__((ext_vector_type(4)));
typedef float f32x2 __attribute__((ext_vector_type(2)));
#define RLX_AGENT __ATOMIC_RELAXED, __HIP_MEMORY_SCOPE_AGENT
#define LDS_WAIT() asm volatile("s_waitcnt lgkmcnt(0)" ::: "memory")
#define VM_WAIT() asm volatile("s_waitcnt vmcnt(0)" ::: "memory")
__device__ __forceinline__ unsigned pk2(float lo, float hi) { unsigned r; asm volatile("v_cvt_pk_bf16_f32 %0, %1, %2" : "=v"(r) : "v"(lo), "v"(hi)); return r; }
__device__ __forceinline__ float bflo(unsigned w) { return __uint_as_float(w << 16); }
__device__ __forceinline__ float bfhi(unsigned w) { return __uint_as_float(w & 0xffff0000u); }
__device__ __forceinline__ void unpack8(const v4u w, float (&x)[8]) { x[0] = bflo(w.x); x[1] = bfhi(w.x); x[2] = bflo(w.y); x[3] = bfhi(w.y); x[4] = bflo(w.z); x[5] = bfhi(w.z); x[6] = bflo(w.w); x[7] = bfhi(w.w); }
__device__ __forceinline__ v4u pack8(const float (&x)[8]) { v4u w; w.x = pk2(x[0], x[1]); w.y = pk2(x[2], x[3]); w.z = pk2(x[4], x[5]); w.w = pk2(x[6], x[7]); return w; }
__device__ __forceinline__ float wave_sum(float v) {
#pragma unroll
    for (int o = 1; o < 64; o <<= 1) v += __shfl_xor(v, o);
    return v;
}
__device__ __forceinline__ float gelu_tanh(float x) { const float y = 0.7978845608028654f * (x + 0.044715f * x * x * x); return 0.5f * x * (1.f + tanhf(y)); }

#define XB_TMO      128
#define XB_XCNT(j)  (256  + 64 * (j))
#define XB_XSUB(j)  (1280 + 64 * (j))
#define XB_XGEN(j)  (2304 + 64 * (j))
#define XB_TOP      3328
#define XB_TOPGEN   3392
#define XCD_BAR_WORDS 3456
#define XB_SPIN_CAP (1u << 18)
__device__ __forceinline__ unsigned xb_ld(unsigned* p)              { return __hip_atomic_load(p, __ATOMIC_RELAXED, __HIP_MEMORY_SCOPE_AGENT); }
__device__ __forceinline__ unsigned xb_add(unsigned* p, unsigned v) { return __hip_atomic_fetch_add(p, v, __ATOMIC_RELAXED, __HIP_MEMORY_SCOPE_AGENT); }
__device__ __forceinline__ unsigned xb_xcc_id() { return (unsigned)__builtin_amdgcn_s_getreg((3 << 11) | 20) & 0xFu; }
#define XB_SPIN(cond, bar) do { unsigned _sp = 0; while (cond) { __builtin_amdgcn_s_sleep(1); \
    if ((++_sp & 255u) == 0u) { if (xb_ld(&(bar)[XB_TMO])) break; if (_sp > XB_SPIN_CAP) { atomicAdd(&(bar)[XB_TMO], 1u); break; } } } } while (0)
struct XcdBarrier { unsigned* bar; unsigned x; volatile LAS unsigned* st; };
__device__ __forceinline__ XcdBarrier xcd_barrier_post(unsigned* bar, volatile LAS unsigned* st) {
    XcdBarrier b; b.bar = bar; b.x = xb_xcc_id(); b.st = st;
    if (threadIdx.x == 0) (void)xb_add(&bar[XB_XCNT(b.x)], 1u);
    return b;
}
__device__ __forceinline__ void xcd_barrier_complete(unsigned* bar, unsigned x, unsigned& nloc, unsigned& nx) {
    const unsigned G = gridDim.x * gridDim.y * gridDim.z;
    unsigned sum, cnt, mine, sp = 0u;
    for (;;) {
        sum = 0u; cnt = 0u; mine = 0u;
#pragma unroll
        for (unsigned j = 0; j < 16; ++j) { const unsigned c = xb_ld(&bar[XB_XCNT(j)]); sum += c; cnt += (c > 0u) ? 1u : 0u; mine = (j == x) ? c : mine; }
        if (sum == G) break;
        __builtin_amdgcn_s_sleep(1);
        if ((++sp & 255u) == 0u) { if (xb_ld(&bar[XB_TMO])) break; if (sp > XB_SPIN_CAP) { atomicAdd(&bar[XB_TMO], 1u); break; } }
    }
    nloc = mine > 0u ? mine : 1u; nx = cnt > 0u ? cnt : 1u;
}
__device__ __forceinline__ void xcd_barrier(const XcdBarrier& b) {
    asm volatile("s_waitcnt vmcnt(0)" ::: "memory");
    __syncthreads();
    if (threadIdx.x == 0) {
        unsigned* bar = b.bar;
        __builtin_amdgcn_s_waitcnt(0);
        unsigned nloc = b.st[0], nx = b.st[1];
        if (nloc == 0u) { xcd_barrier_complete(bar, b.x, nloc, nx); b.st[0] = nloc; b.st[1] = nx; }
        const unsigned old = xb_add(&bar[XB_XSUB(b.x)], 1u);
        const unsigned gen = old / nloc;
        if (old + 1u == (gen + 1u) * nloc) {
            __builtin_amdgcn_fence(__ATOMIC_RELEASE, "agent");
            asm volatile("s_waitcnt vmcnt(0)" ::: "memory");
            const unsigned og = xb_add(&bar[XB_TOP], 1u);
            const unsigned tg = og / nx;
            if (og + 1u == (tg + 1u) * nx) xb_add(&bar[XB_TOPGEN], 1u);
            else XB_SPIN(xb_ld(&bar[XB_TOPGEN]) == tg, bar);
            __builtin_amdgcn_fence(__ATOMIC_ACQUIRE, "agent");
            xb_add(&bar[XB_XGEN(b.x)], 1u);
            asm volatile("s_waitcnt vmcnt(0)" ::: "memory");
        } else {
            XB_SPIN(xb_ld(&bar[XB_XGEN(b.x)]) == gen, bar);
            __builtin_amdgcn_fence(__ATOMIC_ACQUIRE, "agent");
            asm volatile("s_waitcnt vmcnt(0)" ::: "memory");
        }
    }
    __syncthreads();
}

struct Args { const float* in[22]; float* out; unsigned char* ws; int ph_lo, ph_hi; };
enum { I_X = 0, I_C, I_CTX, I_CCTX, I_WMOD, I_BMOD, I_N1G, I_N2G, I_WIN, I_QG, I_KG, I_CONVW, I_LNG, I_LNB, I_GMWS, I_GMB, I_WOUT, I_WUP, I_FCW, I_FCB, I_WDN, I_FNG };

typedef const Args __attribute__((address_space(4)))* KArgs;
__device__ __forceinline__ KArgs kargs() { KArgs p = (KArgs)__builtin_amdgcn_kernarg_segment_ptr(); asm volatile("" : "+s"(p)); return p; }
struct Frame {
    LAS unsigned char* lds;
    int tid, lane, wave, G, bx, gw, ngw;
    unsigned char* ws;
};
__device__ __forceinline__ Frame make_frame(KArgs a) {
    extern __shared__ __attribute__((aligned(16))) unsigned char lds_[];
    Frame F; int t = threadIdx.x; asm volatile("" : "+v"(t));
    F.lds = (LAS unsigned char*)lds_; F.tid = t; F.lane = t & 63; F.wave = __builtin_amdgcn_readfirstlane(t >> 6);
    F.G = gridDim.x; F.bx = blockIdx.x; F.gw = F.bx * NWAVES + F.wave; F.ngw = F.G * NWAVES; F.ws = a->ws;
    return F;
}

__device__ __forceinline__ size_t toff(int n, int k, int K) { return ((size_t)(n >> 8) * (K >> 6) + (k >> 6)) * 16384 + (size_t)(n & 255) * 64 + (k & 63); }
__device__ __forceinline__ void transpose_item(const float* W, int ldw, int k0, int ns0, bf16* WT, int ldt, int nd0, LAS float* scr, int lane) {
    f32x4 v[8];
#pragma unroll
    for (int i = 0; i < 8; ++i) v[i] = *(const f32x4*)(W + (size_t)(k0 + i * 8 + (lane >> 3)) * ldw + ns0 + (lane & 7) * 4);
#pragma unroll
    for (int i = 0; i < 8; ++i) { LAS float* d = scr + (i * 8 + (lane >> 3)) * 33 + (lane & 7) * 4; d[0] = v[i].x; d[1] = v[i].y; d[2] = v[i].z; d[3] = v[i].w; }
    LDS_WAIT(); asm volatile("" ::: "memory");
    const int c = lane & 7;
#pragma unroll
    for (int j = 0; j < 4; ++j) { const int n = (lane >> 3) + 8 * j; const LAS float* s = scr + (8 * c) * 33 + n;
        v4u o; o.x = pk2(s[0 * 33], s[1 * 33]); o.y = pk2(s[2 * 33], s[3 * 33]); o.z = pk2(s[4 * 33], s[5 * 33]); o.w = pk2(s[6 * 33], s[7 * 33]);
        *(v4u*)(WT + toff(nd0 + n, k0 + 8 * c, ldt)) = o; }
    LDS_WAIT(); asm volatile("" ::: "memory");
}

__device__ __forceinline__ void p0a_prologue(KArgs a) {
    Frame F = make_frame(a); unsigned char* ws = F.ws;
    {
        LAS float* scr = (LAS float*)(F.lds + F.wave * 16384);
        constexpr int I_IN = 32 * 128, I_OUT = 40 * 64, I_UP = 32 * 352, I_DN = 88 * 64, I_L = I_IN + I_OUT + I_UP + I_DN;
        for (int it = F.gw; it < DEPTH * I_L; it += F.ngw) {
            const int l = it / I_L; int r = it % I_L;
            if (r < I_IN) { const int kb = r / 128, nb = r % 128; const int ns0 = nb < 48 ? nb * 32 : 2048 + (nb - 48) * 32; const int nd0 = nb < 48 ? ns0 : ns0 + 512;
                transpose_item(a->in[I_WIN] + (size_t)l * DM * INW_SRC, INW_SRC, kb * 64, ns0, (bf16*)(ws + WS_WIN) + (size_t)l * PW * DM, DM, nd0, scr, F.lane); continue; }
            r -= I_IN;
            if (r < I_OUT) { const int kb = r / 64, nb = r % 64;
                transpose_item(a->in[I_WOUT] + (size_t)l * MIXW * DM, DM, kb * 64, nb * 32, (bf16*)(ws + WS_WOUT) + (size_t)l * DM * MIXW, MIXW, nb * 32, scr, F.lane); continue; }
            r -= I_OUT;
            if (r < I_UP) { const int kb = r / 352, nb = r % 352; const int nd0 = nb * 32, ns0 = ((nd0 >> 7) & 1) * DFF + (nd0 >> 8) * 128 + (nd0 & 127);
                transpose_item(a->in[I_WUP] + (size_t)l * DM * UPW, UPW, kb * 64, ns0, (bf16*)(ws + WS_WUP) + (size_t)l * UPW * DM, DM, nb * 32, scr, F.lane); continue; }
            r -= I_UP;
            { const int kb = r / 64, nb = r % 64;
                transpose_item(a->in[I_WDN] + (size_t)l * DFF * DM, DM, kb * 64, nb * 32, (bf16*)(ws + WS_WDN) + (size_t)l * DM * DFF, DFF, nb * 32, scr, F.lane); }
        }
    }
    __syncthreads();
    {
        LAS float* sl = (LAS float*)F.lds;
        for (int i = F.tid; i < 5 * DM; i += NTHR) { const int v = i / DM, k = i % DM; const float cv = v < 4 ? a->in[I_C][v * DM + k] : a->in[I_CCTX][k]; sl[i] = cv / (1.f + expf(-cv)); }
        __syncthreads();
        float* MODP = (float*)(ws + WS_MODP);
        for (int it = F.gw; it < DEPTH * 16 * 48; it += F.ngw) {
            const int l = it / 768, r = it % 768, ks = r / 48, cg = r % 48;
            const float* wp = a->in[I_WMOD] + ((size_t)l * DM + ks * 128) * NMOD + cg * 256 + F.lane * 4;
            f32x4 acc[5];
#pragma unroll
            for (int v = 0; v < 5; ++v) acc[v] = (f32x4){0.f, 0.f, 0.f, 0.f};
            for (int k = 0; k < 128; k += 8) {
                f32x4 w[8];
#pragma unroll
                for (int u = 0; u < 8; ++u) w[u] = *(const f32x4*)(wp + (size_t)(k + u) * NMOD);
#pragma unroll
                for (int u = 0; u < 8; ++u)
#pragma unroll
                    for (int v = 0; v < 5; ++v) acc[v] += w[u] * sl[v * DM + ks * 128 + k + u];
            }
#pragma unroll
            for (int v = 0; v < 5; ++v) *(f32x4*)(MODP + ((size_t)ks * (DEPTH * 5) + l * 5 + v) * NMOD + cg * 256 + F.lane * 4) = acc[v];
        }
    }
    __syncthreads();
    {
        LAS float* T128 = (LAS float*)F.lds;
        LAS float* Wl = (LAS float*)(F.lds + 1024);
        if (F.tid < 128) T128[F.tid] = cospif((float)F.tid * (1.f / 64.f));
        __syncthreads();
        for (int it = F.bx; it < DEPTH * 4 * 64; it += F.G) {
            const int l = it / 256, g = (it / 64) % 4, kb = it % 64;
            for (int i = F.tid; i < 32 * 128; i += NTHR) { const int kk = i / 128, dd = i % 128; Wl[dd * 36 + kk] = a->in[I_WIN][((size_t)l * DM + kb * 32 + kk) * INW_SRC + 1536 + g * 128 + dd]; }
            __syncthreads();
            const int dout = F.tid & 127, cs = (F.tid >> 7) & 1, kg = F.tid >> 8;
            float acc[16];
#pragma unroll
            for (int kk = 0; kk < 16; ++kk) acc[kk] = 0.f;
            for (int dd = 0; dd < 128; ++dd) {
                const float tr = T128[(dout * dd - (cs ? 32 : 0)) & 127];
#pragma unroll
                for (int q4 = 0; q4 < 4; ++q4) { const f32x4 w4 = *(const LAS f32x4*)(Wl + dd * 36 + kg * 16 + 4 * q4);
                    acc[4 * q4] += w4.x * tr; acc[4 * q4 + 1] += w4.y * tr; acc[4 * q4 + 2] += w4.z * tr; acc[4 * q4 + 3] += w4.w * tr; }
            }
            bf16* dst = (bf16*)(ws + WS_WIN) + (size_t)l * PW * DM + toff(PFA + cs * 512 + g * 128 + dout, kb * 32 + kg * 16, DM);
            v4u o0, o1; o0.x = pk2(acc[0], acc[1]); o0.y = pk2(acc[2], acc[3]); o0.z = pk2(acc[4], acc[5]); o0.w = pk2(acc[6], acc[7]);
            o1.x = pk2(acc[8], acc[9]); o1.y = pk2(acc[10], acc[11]); o1.z = pk2(acc[12], acc[13]); o1.w = pk2(acc[14], acc[15]);
            *(v4u*)dst = o0; *(v4u*)(dst + 8) = o1;
            __syncthreads();
        }
    }
    __syncthreads();
    {
        LAS float* T = (LAS float*)F.lds;
        for (int i = F.tid; i < 4096; i += NTHR) T[i] = cospif((float)i * (1.f / 2048.f));
        __syncthreads();
        bf16* A1 = (bf16*)(ws + WS_A1);
        for (int idx = F.bx * NTHR + F.tid; idx < 256 * 32; idx += F.G * NTHR) {
            const int m = idx >> 5, kk0 = (idx & 31) * 8; const int cho = m >> 7, k2 = (m & 127) >> 1, ro = m & 1; float x[8];
#pragma unroll
            for (int e2 = 0; e2 < 8; ++e2) { const int kk = kk0 + e2, chi = kk >> 7, ri = (kk >> 6) & 1, aa = kk & 63;
                const float cs_ = T[(64 * k2 * aa) & 4095], sn_ = T[(64 * k2 * aa - 1024) & 4095];
                const float v = ro == 0 ? (ri == 0 ? cs_ : -sn_) : (ri == 0 ? -sn_ : -cs_);
                x[e2] = (cho == chi) ? v : 0.f; }
            *(v4u*)(A1 + (size_t)m * 256 + kk0) = pack8(x);
        }
        bf16* A2 = (bf16*)(ws + WS_A2);
        for (int idx = F.bx * NTHR + F.tid; idx < 16 * 256 * 64; idx += F.G * NTHR) {
            const int kk0 = (idx & 63) * 8, m = (idx >> 6) & 255, q = idx >> 14; const int k2p = m >> 6, k1 = m & 63, k = 4 * q + k2p + 64 * k1; float x[8];
#pragma unroll
            for (int e2 = 0; e2 < 8; ++e2) { const int kk = kk0 + e2, k2pp = kk >> 7, ro = (kk >> 6) & 1, c = kk & 63;
                const float v = ro == 0 ? T[(k * c) & 4095] : T[(k * c - 1024) & 4095];
                x[e2] = (k2pp == k2p) ? v : 0.f; }
            *(v4u*)(A2 + ((size_t)q * 256 + m) * 512 + kk0) = pack8(x);
        }
        { bf16* GW = (bf16*)(ws + WS_GW);
          for (int idx = F.bx * NTHR + F.tid; idx < DEPTH * 4 * 4 * 2 * 4 * 64; idx += F.G * NTHR) {
              const int ln = idx & 63, ks = (idx >> 6) & 3, kt = (idx >> 8) & 1, qb = (idx >> 9) & 3, lg = idx >> 11;
              const float* wrow = a->in[I_GMWS] + ((size_t)lg * 128 + 32 * qb + (ln & 31)) * 128 + 64 * kt + 16 * ks + 8 * (ln >> 5);
              const f32x4 w0 = *(const f32x4*)wrow, w1 = *(const f32x4*)(wrow + 4);
              v4u w; w.x = pk2(w0.x, w0.y); w.y = pk2(w0.z, w0.w); w.z = pk2(w1.x, w1.y); w.w = pk2(w1.z, w1.w);
              *(v4u*)(GW + (size_t)idx * 8) = w; } }
        bf16* F2 = (bf16*)(ws + WS_F256);
        for (int k = F.bx; k < 256; k += F.G) {
            if (F.tid < 64) { const int j0 = F.tid * 8; const int cs = j0 >> 8, t0 = j0 & 255; float x[8];
#pragma unroll
                for (int e = 0; e < 8; ++e) { const int m = (16 * k * (t0 + e) - (cs ? 1024 : 0)) & 4095; const float v = T[m]; x[e] = cs ? -v : v; }
                *(v4u*)(F2 + (size_t)k * 512 + j0) = pack8(x); }
        }
    }
    if (F.bx == 0) {
        f32x2* ROPE = (f32x2*)(ws + WS_ROPE);
        for (int i = F.tid; i < 64 * 32; i += NTHR) { const int pos = i >> 5, ii = i & 31; const float freq = powf(10000.f, -(float)(2 * ii) / 64.f); const float ang = (float)pos * freq;
            ROPE[i] = (f32x2){cosf(ang), sinf(ang)}; }
    }
    __syncthreads();
}

__device__ __forceinline__ void p0b_modreduce(KArgs a) {
    Frame F = make_frame(a);
    const float* MODP = (const float*)(F.ws + WS_MODP); float* MOD = (float*)(F.ws + WS_MOD);
    for (int i = F.bx * NTHR + F.tid; i < DEPTH * 5 * (NMOD / 4); i += F.G * NTHR) {
        const int j4 = i % (NMOD / 4), lv = i / (NMOD / 4), l = lv / 5;
        f32x4 s = *(const f32x4*)(a->in[I_BMOD] + (size_t)l * NMOD + j4 * 4);
#pragma unroll
        for (int ks = 0; ks < 16; ++ks) s += *(const f32x4*)(MODP + ((size_t)ks * (DEPTH * 5) + lv) * NMOD + j4 * 4);
        *(f32x4*)(MOD + (size_t)lv * NMOD + j4 * 4) = s;
        { const int chunk = (j4 * 4) / DM, col = (j4 * 4) % DM, v = lv % 5;
          if (chunk == 1 || chunk == 4) { const int which = chunk == 4; const f32x4 gg = *(const f32x4*)((which ? a->in[I_N2G] : a->in[I_N1G]) + l * DM + col);
              *(f32x4*)((float*)(F.ws + WS_MODG) + ((size_t)(l * 2 + which) * 5 + v) * DM + col) = gg * (s + 1.0f); } }
    }
}

__device__ __forceinline__ void norm_phase(KArgs a, int M, const float* g, const float* modl, int shoff, int scoff, bool fold, bool lat_in, bool ctx_in) {
    Frame F = make_frame(a);
    bf16* X = (bf16*)(F.ws + WS_X); bf16* H = (bf16*)(F.ws + WS_H); const float* XP = (const float*)(F.ws + WS_XP);
    for (int row = F.gw; row < M; row += F.ngw) {
        const int v = row < ML ? row >> 12 : 4;
        const float* sh = modl + (size_t)v * NMOD + shoff;
        v4u* xr = (v4u*)(X + (size_t)row * DM) + F.lane;
        f32x4 x[4][2]; float ss = 0.f;
        if (row < ML ? lat_in : ctx_in) { const f32x4* xs = (const f32x4*)(row < ML ? a->in[I_X] + (size_t)row * DM : a->in[I_CTX] + (size_t)(row - ML) * DM) + 2 * F.lane;
#pragma unroll
            for (int j = 0; j < 4; ++j) { x[j][0] = xs[128 * j]; x[j][1] = xs[128 * j + 1]; } }
        else {
#pragma unroll
            for (int j = 0; j < 4; ++j) { const v4u w = xr[64 * j]; x[j][0] = (f32x4){bflo(w.x), bfhi(w.x), bflo(w.y), bfhi(w.y)}; x[j][1] = (f32x4){bflo(w.z), bfhi(w.z), bflo(w.w), bfhi(w.w)}; } }
        if (fold && row >= ML) {
#pragma unroll
            for (int ks = 0; ks < 4; ++ks) { const f32x4* pr = (const f32x4*)(XP + ((size_t)ks * MC + (row - ML)) * DM) + 2 * F.lane;
#pragma unroll
                for (int j = 0; j < 4; ++j) { x[j][0] += pr[128 * j]; x[j][1] += pr[128 * j + 1]; } }
#pragma unroll
            for (int j = 0; j < 4; ++j) { v4u w; w.x = pk2(x[j][0].x, x[j][0].y); w.y = pk2(x[j][0].z, x[j][0].w); w.z = pk2(x[j][1].x, x[j][1].y); w.w = pk2(x[j][1].z, x[j][1].w); xr[64 * j] = w; }
        }
#pragma unroll
        for (int j = 0; j < 4; ++j)
#pragma unroll
            for (int h = 0; h < 2; ++h) ss += (x[j][h].x * x[j][h].x + x[j][h].y * x[j][h].y) + (x[j][h].z * x[j][h].z + x[j][h].w * x[j][h].w);
        const float rstd = 1.0f / sqrtf(wave_sum(ss) * (1.f / DM) + EPS);
#pragma unroll
        for (int j = 0; j < 4; ++j) { const int col = F.lane * 8 + 512 * j; f32x4 y[2];
#pragma unroll
            for (int h = 0; h < 2; ++h) { const f32x4 gg = *(const f32x4*)(g + (size_t)v * DM + col + 4 * h), s0 = *(const f32x4*)(sh + col + 4 * h);
                y[h] = x[j][h] * rstd * gg + s0; }
            v4u o; o.x = pk2(y[0].x, y[0].y); o.y = pk2(y[0].z, y[0].w); o.z = pk2(y[1].x, y[1].y); o.w = pk2(y[1].z, y[1].w);
            *(v4u*)(H + (size_t)row * DM + col) = o; }
    }
}

__device__ __forceinline__ void final_norm_phase(KArgs a, const float* g, float* out) {
    Frame F = make_frame(a);
    const bf16* X = (const bf16*)(F.ws + WS_X);
    for (int row = F.gw; row < ML; row += F.ngw) {
        const v4u* xr = (const v4u*)(X + (size_t)row * DM) + F.lane;
        f32x4 x[8]; float ss = 0.f;
#pragma unroll
        for (int j = 0; j < 4; ++j) { const v4u w = xr[64 * j]; x[2 * j] = (f32x4){bflo(w.x), bfhi(w.x), bflo(w.y), bfhi(w.y)}; x[2 * j + 1] = (f32x4){bflo(w.z), bfhi(w.z), bflo(w.w), bfhi(w.w)}; }
#pragma unroll
        for (int j = 0; j < 8; ++j) ss += (x[j].x * x[j].x + x[j].y * x[j].y) + (x[j].z * x[j].z + x[j].w * x[j].w);
        const float rstd = 1.0f / sqrtf(wave_sum(ss) * (1.f / DM) + EPS);
#pragma unroll
        for (int j = 0; j < 8; ++j) { const int col = F.lane * 8 + 512 * (j >> 1) + 4 * (j & 1); const f32x4 gg = *(const f32x4*)(g + col);
            *(f32x4*)(out + (size_t)row * DM + col) = x[j] * rstd * gg; }
    }
}

__device__ __forceinline__ float gelu_fast(float x) { const float y = 1.5957691216057308f * (x + 0.044715f * x * x * x); return x * __builtin_amdgcn_rcpf(1.f + __expf(-y)); }

__device__ __forceinline__ void postA_phase(KArgs a, int l) {
    Frame F = make_frame(a); unsigned char* ws = F.ws;
    const bf16* P = (const bf16*)(ws + WS_P); bf16* MIX = (bf16*)(ws + WS_MIX); bf16* KB = (bf16*)(ws + WS_KB); bf16* VB = (bf16*)(ws + WS_VB);
    bf16* QB = (bf16*)(ws + WS_QB); bf16* UB = (bf16*)(ws + WS_UB); bf16* V2B = (bf16*)(ws + WS_V2B);
    const f32x4* ROPE4 = (const f32x4*)(ws + WS_ROPE);
    const int lane = F.lane, tid = F.tid;
    {
        const int hl = lane & 15, axis = hl >> 3, i0 = (lane & 3) * 8; const bool first = (lane & 7) < 4;
        float qg8[8], kg8[8], cw0[8], cw1[8], cw2[8], lg8[8], lb8[8];
        { const float* qg = a->in[I_QG] + l * 128 + hl * 8; const float* kg = a->in[I_KG] + l * 128 + hl * 8; const float* cw = a->in[I_CONVW] + (size_t)l * 3 * 512 + lane * 8;
          const float* lng = a->in[I_LNG] + l * 512 + lane * 8; const float* lnb = a->in[I_LNB] + l * 512 + lane * 8;
#pragma unroll
          for (int e = 0; e < 8; ++e) { qg8[e] = qg[e]; kg8[e] = kg[e]; cw0[e] = cw[e]; cw1[e] = cw[512 + e]; cw2[e] = cw[1024 + e]; lg8[e] = lng[e]; lb8[e] = lnb[e]; } }
        for (int row = F.gw; row < MT; row += F.ngw) {
            const bool is_ctx = row >= ML;
            const int b = is_ctx ? (row - ML) >> 8 : row >> 12, p = is_ctx ? (row - ML) & 255 : row & 4095, nseq = is_ctx ? CTXL : SEQ;
            const bool kv_only = is_ctx && (l == DEPTH - 1);
            const bf16* Pr = P + (size_t)row * PW;
            const int kvpos = is_ctx ? p : CTXL + p;
            const v4u rkv = *(const v4u*)(Pr + PK + lane * 8);
            f32x4 c4[4];
            if (!is_ctx) { const int posax = axis ? (p & 63) : (p >> 6);
#pragma unroll
                for (int e = 0; e < 4; ++e) c4[e] = ROPE4[posax * 16 + (i0 >> 1) + e]; }
            {
                float x[8]; unpack8(rkv, x); float ss = 0.f;
#pragma unroll
                for (int e = 0; e < 8; ++e) ss += x[e] * x[e];
                ss += __shfl_xor(ss, 1); ss += __shfl_xor(ss, 2); ss += __shfl_xor(ss, 4); ss += __shfl_xor(ss, 8);
                const float rstd = 1.0f / sqrtf(ss * (1.f / 128.f) + EPS);
                float y[8];
#pragma unroll
                for (int e = 0; e < 8; ++e) y[e] = x[e] * rstd * kg8[e];
                if (!is_ctx) {
#pragma unroll
                    for (int e = 0; e < 8; ++e) { const float pr = __shfl_xor(y[e], 4); const float cs_ = c4[e >> 1][(e & 1) * 2], sn_ = c4[e >> 1][(e & 1) * 2 + 1]; y[e] = first ? y[e] * cs_ - pr * sn_ : y[e] * cs_ + pr * sn_; } }
                if (lane < 32) *(v4u*)(KB + ((size_t)b * SKV + kvpos) * 256 + lane * 8) = pack8(y);
                else *(v4u*)(VB + ((size_t)b * SKV + kvpos) * 256 + (lane - 32) * 8) = rkv;
            }
            if (kv_only) continue;
            const v4u rq0 = *(const v4u*)(Pr + PQ + lane * 8), rq1 = *(const v4u*)(Pr + PQ + 512 + lane * 8);
            const v4u rcb = *(const v4u*)(Pr + PCB + lane * 8), rc0 = *(const v4u*)(Pr + PCC + lane * 8), rh0 = *(const v4u*)(Pr + PCH + lane * 8);
            const bool hp = p > 0, hn = p < nseq - 1;
            const bf16* Pm = hp ? Pr - PW : Pr; const bf16* Pn = hn ? Pr + PW : Pr;
            const v4u rcm = *(const v4u*)(Pm + PCC + lane * 8), rhm = *(const v4u*)(Pm + PCH + lane * 8), rcp = *(const v4u*)(Pn + PCC + lane * 8), rhp = *(const v4u*)(Pn + PCH + lane * 8);
            const v4u rgu = *(const v4u*)(Pr + PGU + lane * 8), rgv = *(const v4u*)(Pr + PGV + lane * 8);
#pragma unroll
            for (int part = 0; part < 2; ++part) {
                float x[8]; unpack8(part ? rq1 : rq0, x); float ss = 0.f;
#pragma unroll
                for (int e = 0; e < 8; ++e) ss += x[e] * x[e];
                ss += __shfl_xor(ss, 1); ss += __shfl_xor(ss, 2); ss += __shfl_xor(ss, 4); ss += __shfl_xor(ss, 8);
                const float rstd = 1.0f / sqrtf(ss * (1.f / 128.f) + EPS);
                float y[8];
#pragma unroll
                for (int e = 0; e < 8; ++e) y[e] = x[e] * rstd * qg8[e];
                if (!is_ctx) {
#pragma unroll
                    for (int e = 0; e < 8; ++e) { const float pr = __shfl_xor(y[e], 4); const float cs_ = c4[e >> 1][(e & 1) * 2], sn_ = c4[e >> 1][(e & 1) * 2 + 1]; y[e] = first ? y[e] * cs_ - pr * sn_ : y[e] * cs_ + pr * sn_; } }
                *(v4u*)(QB + (size_t)row * 1024 + part * 512 + lane * 8) = pack8(y);
            }
            {
                float cb[8], c0[8], h0[8], cm[8], hm[8], cp[8], hq[8], o[8];
                unpack8(rcb, cb); unpack8(rc0, c0); unpack8(rh0, h0); unpack8(rcm, cm); unpack8(rhm, hm); unpack8(rcp, cp); unpack8(rhp, hq);
                const float fp = hp ? 1.f : 0.f, fn = hn ? 1.f : 0.f;
#pragma unroll
                for (int e = 0; e < 8; ++e) o[e] = cb[e] * (cw0[e] * fp * (cm[e] * hm[e]) + cw1[e] * (c0[e] * h0[e]) + cw2[e] * fn * (cp[e] * hq[e]));
                *(v4u*)(MIX + (size_t)row * MIXW + MX_CONV + lane * 8) = pack8(o);
            }
            {
                float u[8], t[8]; unpack8(rgu, u); unpack8(rgv, t);
                float s = 0.f;
#pragma unroll
                for (int e = 0; e < 8; ++e) { u[e] = gelu_fast(u[e]); t[e] = gelu_fast(t[e]); s += t[e]; }
                const float mean = wave_sum(s) * (1.f / 512.f);
                float q = 0.f;
#pragma unroll
                for (int e = 0; e < 8; ++e) { t[e] -= mean; q += t[e] * t[e]; }
                const float rstd = 1.0f / sqrtf(wave_sum(q) * (1.f / 512.f) + EPS);
#pragma unroll
                for (int e = 0; e < 8; ++e) t[e] = t[e] * rstd * lg8[e] + lb8[e];
                *(v4u*)(UB + (size_t)row * 512 + lane * 8) = pack8(u); *(v4u*)(V2B + (size_t)row * 512 + lane * 8) = pack8(t);
            }
        }
    }
    {
        LAS unsigned* tb = (LAS unsigned*)F.lds;
        bf16* S1 = (bf16*)(ws + WS_T1T);
        for (int un = F.bx; un < 512; un += F.G) {
            const int ab = un >> 6, b = (un >> 4) & 3, slab = un & 15;
            const size_t rowb = (size_t)b * SEQ + (size_t)ab * 512;
#pragma unroll
            for (int it = 0; it < 4; ++it) {
                const int idx = tid + it * NTHR; const int j = it, c8 = idx & 7, c = (idx >> 3) & 63;
                const bf16* src0 = P + (rowb + (size_t)(2 * j) * 64 + c) * PW + PFA + slab * 64 + c8 * 8;
                const v4u r0 = *(const v4u*)src0, r1 = *(const v4u*)(src0 + (size_t)64 * PW);
                const unsigned a0[4] = {r0.x, r0.y, r0.z, r0.w}, a1[4] = {r1.x, r1.y, r1.z, r1.w};
                const int js = j ^ (c8 & 3);
#pragma unroll
                for (int w = 0; w < 4; ++w) {
                    tb[((c8 * 8 + 2 * w) * 64 + c) * 4 + js]     = (a0[w] & 0xffffu) | (a1[w] << 16);
                    tb[((c8 * 8 + 2 * w + 1) * 64 + c) * 4 + js] = (a0[w] >> 16) | (a1[w] & 0xffff0000u);
                }
            }
            __syncthreads();
#pragma unroll
            for (int it = 0; it < 8; ++it) {
                const int idx = tid + it * NTHR; const int c = idx & 63, col = idx >> 6;
                const v4u oo = *(const LAS v4u*)(tb + (col * 64 + c) * 4); const unsigned od[4] = {oo.x, oo.y, oo.z, oo.w};
                v4u o; o.x = od[0 ^ (it & 3)]; o.y = od[1 ^ (it & 3)]; o.z = od[2 ^ (it & 3)]; o.w = od[3 ^ (it & 3)];
                const int gcol = slab * 64 + col, ri = gcol >> 9, n = b * 512 + (gcol & 511);
                *(v4u*)(S1 + ((((size_t)n * 32 + (c & 31)) * 2 + (c >> 5)) * 2 + ri) * 64 + ab * 8) = o;
            }
            __syncthreads();
        }
    }
    if (l < DEPTH - 1) {
        LAS unsigned* tb = (LAS unsigned*)F.lds;
        for (int un = F.bx; un < 32; un += F.G) {
            const int chc = un >> 2, slab = un & 3;
            const int b = chc >> 1, p0 = (chc & 1) * 128;
            const int row0 = ML + b * CTXL + p0;
            bf16* T1 = (bf16*)(ws + WS_T1TC);
#pragma unroll
            for (int it = 0; it < 4; ++it) {
                const int q = tid + it * NTHR;
                const int c8 = ((q >> 6) & 3) * 8 + (q & 7), rp = (q >> 8) * 8 + ((q >> 3) & 7);
                const v4u r0 = *(const v4u*)(P + (size_t)(row0 + 2 * rp) * PW + PFA + slab * 256 + c8 * 8);
                const v4u r1 = *(const v4u*)(P + (size_t)(row0 + 2 * rp + 1) * PW + PFA + slab * 256 + c8 * 8);
                const unsigned a0[4] = {r0.x, r0.y, r0.z, r0.w}, a1[4] = {r1.x, r1.y, r1.z, r1.w};
#pragma unroll
                for (int w = 0; w < 4; ++w) {
                    tb[(c8 * 8 + 2 * w) * 65 + rp]     = (a0[w] & 0xffffu) | (a1[w] << 16);
                    tb[(c8 * 8 + 2 * w + 1) * 65 + rp] = (a0[w] >> 16) | (a1[w] & 0xffff0000u);
                }
            }
            __syncthreads();
#pragma unroll
            for (int it = 0; it < 8; ++it) {
                const int idx = tid + it * NTHR; const int cc = idx >> 4, t8 = idx & 15;
                v4u o; o.x = tb[cc * 65 + t8 * 4]; o.y = tb[cc * 65 + t8 * 4 + 1]; o.z = tb[cc * 65 + t8 * 4 + 2]; o.w = tb[cc * 65 + t8 * 4 + 3];
                const int col = slab * 256 + cc, csn = col >> 9, gd = col & 511;
                *(v4u*)(T1 + (size_t)(b * 512 + gd) * 512 + csn * CTXL + p0 + t8 * 8) = o;
            }
            __syncthreads();
        }
    }
}

__device__ __forceinline__ void gate_phase(KArgs a, int l, int wg0, int nwg, int u_lo, int u_hi) {
    Frame F = make_frame(a); unsigned char* ws = F.ws;
    F.bx -= wg0; if (F.bx < 0 || F.bx >= nwg) return;
    const bf16* UB = (const bf16*)(ws + WS_UB); const bf16* V2B = (const bf16*)(ws + WS_V2B); bf16* MIX = (bf16*)(ws + WS_MIX);
    const bf16* GW = (const bf16*)(ws + WS_GW); const float* gmb = a->in[I_GMB] + l * 4 * 128;
    const int tid = F.tid, lane = F.lane, r32 = lane & 31, hi = lane >> 5, gsel = F.wave >> 2, qb = F.wave & 3;
    for (int un = u_lo + F.bx; un < u_hi; un += nwg) {
        const int ch = un >> 1, gp = un & 1;
        const bool is_ctx = ch >= 128;
        const int b = is_ctx ? (ch - 128) >> 1 : ch >> 5;
        const int p0 = is_ctx ? ((ch - 128) & 1) * 128 : (ch & 31) * 128;
        const int row0 = is_ctx ? ML + b * CTXL + p0 : b * SEQ + p0;
#pragma unroll
        for (int it = 0; it < 8; ++it) { const int idx = tid + it * NTHR; const int gi = idx >> 11, pp = (idx >> 4) & 127, c8 = idx & 15;
            const v4u v = *(const v4u*)(V2B + (size_t)(row0 + pp) * 512 + (2 * gp + gi) * 128 + c8 * 8);
            *(LAS v4u*)(F.lds + (gi * 2 + (pp >> 6)) * 16384 + att::v_st(pp & 63, c8 * 8)) = v; }
        __syncthreads();
        const int g = 2 * gp + gsel;
        att::f32x16 o[4] = {};
#pragma unroll
        for (int kt = 0; kt < 2; ++kt) {
            att::bf16x8 pa[4];
#pragma unroll
            for (int ks = 0; ks < 4; ++ks) { const v4u w = *(const v4u*)(GW + ((((size_t)(l * 4 + g) * 4 + qb) * 2 + kt) * 4 + ks) * 512 + lane * 8); pa[ks] = *reinterpret_cast<const att::bf16x8*>(&w); }
            const int vb = (int)(unsigned)(uintptr_t)(F.lds + (gsel * 2 + kt) * 16384) + att::v_rd_base(lane);
            att::pv_d0(o, vb, pa[0], pa[1], pa[2], pa[3]);
        }
        __syncthreads();
        { LAS unsigned char* ob = F.lds + F.wave * (32 * 272);
#pragma unroll
          for (int i = 0; i < 8; ++i) { const int row = i * 4 + (lane >> 4), chk = lane & 15;
              *(LAS v4u*)(ob + row * 272 + chk * 16) = *(const v4u*)(UB + (size_t)(row0 + 32 * qb + row) * 512 + g * 128 + chk * 8); }
#pragma unroll
          for (int r = 0; r < 16; ++r) { const int qq = att::crow(r, hi); const float bias = gmb[g * 128 + 32 * qb + qq];
#pragma unroll
              for (int d0 = 0; d0 < 4; ++d0) { LAS bf16* e = (LAS bf16*)(ob + qq * 272 + (d0 * 32 + r32) * 2);
                  const float u = __uint_as_float((unsigned)*e << 16); const float val = u * (o[d0][r] + bias); *e = (bf16)(pk2(val, val) & 0xffffu); } }
#pragma unroll
          for (int i = 0; i < 8; ++i) { const int row = i * 4 + (lane >> 4), chk = lane & 15;
              *(v4u*)(MIX + (size_t)(row0 + 32 * qb + row) * MIXW + MX_GM + g * 128 + chk * 8) = *(const LAS v4u*)(ob + row * 272 + chk * 16); }
        }
        __syncthreads();
    }
}

__device__ __forceinline__ void act_fix_phase(KArgs a, int l, int M) {
    Frame F = make_frame(a);
    const float* EDGE = (const float*)(F.ws + WS_EDGE); bf16* ACT = (bf16*)(F.ws + WS_ACT);
    const float* cw = a->in[I_FCW] + (size_t)l * 3 * DFF; const float* cb = a->in[I_FCB] + (size_t)l * DFF;
    constexpr int CG = DFF / 4;
    const int total = (M / 256) * 2 * CG;
    for (int idx = F.bx * NTHR + F.tid; idx < total; idx += F.G * NTHR) {
        const int c0 = (idx % CG) * 4, pw = idx / CG, which = pw & 1, pm = pw >> 1;
        const bool first = pm >= 64 || (pm & 15) == 0, last = pm >= 64 || (pm & 15) == 15;
        const float* e = EDGE + (size_t)pm * 6 * DFF + c0;
        f32x4 prev, cur, next, uu; const f32x4 zero = (f32x4){0.f, 0.f, 0.f, 0.f};
        if (which == 0) { prev = first ? zero : *(const f32x4*)(e - (size_t)6 * DFF + (size_t)3 * DFF); cur = *(const f32x4*)e; next = *(const f32x4*)(e + DFF); uu = *(const f32x4*)(e + (size_t)4 * DFF); }
        else { prev = *(const f32x4*)(e + (size_t)2 * DFF); cur = *(const f32x4*)(e + (size_t)3 * DFF); next = last ? zero : *(const f32x4*)(e + (size_t)6 * DFF); uu = *(const f32x4*)(e + (size_t)5 * DFF); }
        const f32x4 z = *(const f32x4*)(cw + c0) * prev + *(const f32x4*)(cw + DFF + c0) * cur + *(const f32x4*)(cw + 2 * DFF + c0) * next + *(const f32x4*)(cb + c0);
        float o[4];
#pragma unroll
        for (int j = 0; j < 4; ++j) o[j] = z[j] * __builtin_amdgcn_rcpf(1.f + __expf(-z[j])) * uu[j];
        v2u w; w.x = pk2(o[0], o[1]); w.y = pk2(o[2], o[3]);
        *(v2u*)(ACT + (size_t)(pm * 256 + (which ? 255 : 0)) * DFF + c0) = w;
    }
}

constexpr int PH_P0A = 0, PH_P0B = 1, PH_L0 = 2, PH_PER_LAYER = 10, PH_FINAL = PH_L0 + DEPTH * PH_PER_LAYER, N_PHASES = PH_FINAL + 1;

__device__ __forceinline__ void gemm_in_phase(KArgs a, int l) {
    unsigned char* ws = a->ws; extern __shared__ __attribute__((aligned(16))) unsigned char lds_[];
    pg8::Gemm g{(const bf16*)(ws + WS_H), (const bf16*)(ws + WS_WIN) + (size_t)l * PW * DM, MT, PW, DM, DM, DM, 0, 0, 1};
    pg8::StaticOrder S; S.init(MT, PW, gridDim.x, blockIdx.x, DM);
    pg8::EpiBf16 E{(bf16*)(ws + WS_P), PW};
    pg8::gemm_phase<pg8::EpiBf16, pg8::StaticOrder, true, true>((LAS unsigned char*)lds_, g, S, E);
}
__device__ __forceinline__ void gemm_in_probe(KArgs a, int l) {
    unsigned char* ws = a->ws; extern __shared__ __attribute__((aligned(16))) unsigned char lds_[];
    pg8::Gemm g{(const bf16*)(ws + WS_H), (const bf16*)(ws + WS_WIN) + (size_t)l * PW * DM, MT, PW, DM, DM, DM, 0, 0, 1};
    pg8::StaticOrder S; S.init(MT, PW, gridDim.x, blockIdx.x, DM);
    pg8::EpiNone E{};
    pg8::gemm_phase<pg8::EpiNone, pg8::StaticOrder, true, true>((LAS unsigned char*)lds_, g, S, E);
}
__device__ __forceinline__ void gemm_up_phase(KArgs a, int l, int M2) {
    unsigned char* ws = a->ws; extern __shared__ __attribute__((aligned(16))) unsigned char lds_[];
    pg8::Gemm g{(const bf16*)(ws + WS_H), (const bf16*)(ws + WS_WUP) + (size_t)l * UPW * DM, M2, UPW, DM, DM, DM, 0, 0, 1};
    pg8::StaticOrder S; S.init(M2, UPW, gridDim.x, blockIdx.x, DM);
    pg8::EpiUp E{(bf16*)(ws + WS_ACT), (float*)(ws + WS_EDGE), a->in[I_FCW] + (size_t)l * 3 * DFF, a->in[I_FCB] + (size_t)l * DFF, (LAS float*)((LAS unsigned char*)lds_ + XL_OFF), DFF};
    pg8::gemm_phase<pg8::EpiUp, pg8::StaticOrder, true, true>((LAS unsigned char*)lds_, g, S, E);
}
__device__ __forceinline__ void gemm_out_phase(KArgs a, int l, int M2) {
    unsigned char* ws = a->ws; extern __shared__ __attribute__((aligned(16))) unsigned char lds_[];
    pg8::Gemm g{(const bf16*)(ws + WS_MIX), (const bf16*)(ws + WS_WOUT) + (size_t)l * DM * MIXW, M2, DM, MIXW, MIXW, MIXW, 0, 0, 1};
    pg8::SplitOrder S; S.init(ML, (M2 - ML) / 256, DM, gridDim.x, blockIdx.x, MIXW);
    pg8::EpiResGate E{(bf16*)(ws + WS_X), (const float*)(ws + WS_MOD) + (size_t)l * 5 * NMOD, 2 * DM, (float*)(ws + WS_XP), l == 0 ? a->in[I_X] : (const float*)nullptr};
    pg8::gemm_phase<pg8::EpiResGate, pg8::SplitOrder, true, true>((LAS unsigned char*)lds_, g, S, E);
}
__device__ __forceinline__ void gemm_down_phase(KArgs a, int l, int M2) {
    unsigned char* ws = a->ws; extern __shared__ __attribute__((aligned(16))) unsigned char lds_[];
    pg8::Gemm g{(const bf16*)(ws + WS_ACT), (const bf16*)(ws + WS_WDN) + (size_t)l * DM * DFF, M2, DM, DFF, DFF, DFF, 0, 0, 1};
    pg8::SplitOrder S; S.init(ML, (M2 - ML) / 256, DM, gridDim.x, blockIdx.x, DFF);
    pg8::EpiResGate E{(bf16*)(ws + WS_X), (const float*)(ws + WS_MOD) + (size_t)l * 5 * NMOD, 5 * DM, (float*)(ws + WS_XP), (const float*)nullptr};
    pg8::gemm_phase<pg8::EpiResGate, pg8::SplitOrder, true, true>((LAS unsigned char*)lds_, g, S, E);
}
__device__ __forceinline__ void attn_phase(KArgs a, int l, int part, int wg0) {
    unsigned char* ws = a->ws; extern __shared__ __attribute__((aligned(16))) unsigned char lds_[];
    const bf16* QB = (const bf16*)(ws + WS_QB); const bf16* KB = (const bf16*)(ws + WS_KB); const bf16* VB = (const bf16*)(ws + WS_VB); bf16* MIX = (bf16*)(ws + WS_MIX);
    const int G = gridDim.x, bx = blockIdx.x;
    const int xcd = bx & 7, wq = bx >> 3;
    const int ulo = part ? 512 + ((bx - wg0 + G) % G) : bx, uhi = part ? ((l < DEPTH - 1) ? 544 : 0) : 512;
    for (int u = ulo; u < uhi; u += G) {
        int b, h, kvh, qrow, seq;
        if (u < 512) { const int i = u / G; const int j = (G == 256) ? wq + 32 * i : (u >> 3), x = (G == 256) ? xcd : (u & 7);
            b = x >> 1; kvh = x & 1; h = kvh * 4 + (j >> 4); qrow = b * SEQ + (j & 15) * 256; seq = SKV; }
        else { const int c = u - 512; b = c >> 3; h = c & 7; kvh = h >> 2; qrow = ML + b * CTXL; seq = CTXL; }
        att::attn_dense_body(QB + (size_t)qrow * 1024 + h * 128, KB + (size_t)b * SKV * 256 + kvh * 128, VB + (size_t)b * SKV * 256 + kvh * 128,
                             MIX + (size_t)qrow * MIXW + MX_ATT + h * 128, seq, (char*)lds_);
    }
}
__device__ __forceinline__ void dft1_phase(KArgs a, int l) {
    unsigned char* ws = a->ws; extern __shared__ __attribute__((aligned(16))) unsigned char lds_[];
    pg8::Gemm g{(const bf16*)(ws + WS_A1), (const bf16*)(ws + WS_T1T), 256, 65536, 256, 256, 256, 0};
    pg8::StaticOrder S; S.init(256, 65536, gridDim.x, blockIdx.x, 256);
    pg8::EpiS1 E{(bf16*)(ws + WS_S2IN)};
    pg8::gemm_phase<pg8::EpiS1, pg8::StaticOrder, true, true>((LAS unsigned char*)lds_, g, S, E);
}
__device__ __forceinline__ void dft2_phase(KArgs a, int l) {
    unsigned char* ws = a->ws; extern __shared__ __attribute__((aligned(16))) unsigned char lds_[];
    const int G = gridDim.x, bx = blockIdx.x;
    {
        pg8::Gemm g{(const bf16*)(ws + WS_A2), (const bf16*)(ws + WS_S2IN), 4096, 2048, 512, 512, 512, (size_t)2048 * 512 * 2};
        pg8::StaticOrder S; S.init(4096, 2048, G, (bx + G / 2) % G, 512);
        pg8::EpiS2 E{(bf16*)(ws + WS_MIX), 0.0013810679320049757f};
        pg8::gemm_phase<pg8::EpiS2, pg8::StaticOrder, true, true>((LAS unsigned char*)lds_, g, S, E);
    }
    if (l < DEPTH - 1) {
        pg8::Gemm g{(const bf16*)(ws + WS_F256), (const bf16*)(ws + WS_T1TC), CTXL, 2048, 512, 512, 512, 0};
        pg8::StaticOrder S; S.init(CTXL, 2048, G, (bx + G - 96) % G, 512);
        pg8::EpiDft E{(bf16*)(ws + WS_MIX), ML, CTXL, 0.005524271728019903f};
        pg8::gemm_phase<pg8::EpiDft, pg8::StaticOrder, true, true>((LAS unsigned char*)lds_, g, S, E);
    }
}

__global__ void __launch_bounds__(NTHR, 2) hybrid_fwd(Args args_by_value) {
    extern __shared__ __attribute__((aligned(16))) unsigned char lds[];
    (void)args_by_value;
    int lo, hi; unsigned* ctl;
    { KArgs a = kargs(); lo = a->ph_lo; hi = a->ph_hi; ctl = (unsigned*)(a->ws + WS_CTL); }
    volatile LAS unsigned* MISC = (volatile LAS unsigned*)((LAS unsigned char*)lds + MISC_OFF);
    for (int u = threadIdx.x; u < (LDS_BYTES - LDSCTL_OFF) / 4; u += NTHR) ((LAS unsigned*)((LAS unsigned char*)lds + LDSCTL_OFF))[u] = 0u;
    __syncthreads();
    XcdBarrier bar; bar.bar = ctl + CW_BAR; bar.x = 0; bar.st = nullptr;
    if (!MK_PER_PHASE) bar = xcd_barrier_post(ctl + CW_BAR, MISC + 8);
#define IN(k) (lo <= (k) && (k) < hi)
#define SEAM(k) do { if (IN((k) + 1)) { if (MK_PER_PHASE) { if (threadIdx.x == 0) __hip_atomic_store(ctl + CW_TMO, 0xBADBA0u, RLX_AGENT); } else { xcd_barrier(bar); if (DUP(8)) xcd_barrier(bar); } } } while (0)

    for (int rep = 0; rep < (DUP(13) ? 2 : 1); ++rep) {
    if (rep) xcd_barrier(bar);
    if (IN(PH_P0A)) { p0a_prologue(kargs()); if (DUP(0)) p0a_prologue(kargs()); SEAM(PH_P0A); }
    if (IN(PH_P0B)) { p0b_modreduce(kargs()); SEAM(PH_P0B); }

    for (int l = 0; l < DEPTH; ++l) {
        int ph = PH_L0 + l * PH_PER_LAYER;
        const int M2 = (l == DEPTH - 1) ? ML : MT;
#define PHASE(kbit, call) do { if (IN(ph)) { call; if (DUP(kbit)) { if (DUP(15) && !MK_PER_PHASE) xcd_barrier(bar); call; } SEAM(ph); } ++ph; } while (0)
#define MODL ((const float*)(kargs()->ws + WS_MOD) + (size_t)l * 5 * NMOD)
        PHASE(12, norm_phase(kargs(), MT, (const float*)(kargs()->ws + WS_MODG) + (size_t)(l * 2 + 0) * 5 * DM, MODL, 0 * DM, 1 * DM, l > 0, l == 0, l == 0));
        PHASE(2, gemm_in_phase(kargs(), l));
        if (DUP(11) && IN(ph)) { gemm_in_probe(kargs(), l); xcd_barrier(bar); }
        PHASE(9, postA_phase(kargs(), l));
        PHASE(3, { attn_phase(kargs(), l, 0, 0); dft1_phase(kargs(), l); gate_phase(kargs(), l, 0, (int)gridDim.x, 0, min((int)gridDim.x, (l == DEPTH - 1 ? 128 : 136) * 2)); });
        PHASE(6, { gate_phase(kargs(), l, 0, (int)gridDim.x / 2, (int)gridDim.x, (l == DEPTH - 1 ? 128 : 136) * 2); attn_phase(kargs(), l, 1, 16); dft2_phase(kargs(), l); });
        PHASE(14, gemm_out_phase(kargs(), l, M2));
        PHASE(12, norm_phase(kargs(), M2, (const float*)(kargs()->ws + WS_MODG) + (size_t)(l * 2 + 1) * 5 * DM, MODL, 3 * DM, 4 * DM, l < DEPTH - 1, false, l == 0));
        PHASE(5, gemm_up_phase(kargs(), l, M2));
        PHASE(10, act_fix_phase(kargs(), l, M2));
        PHASE(14, gemm_down_phase(kargs(), l, M2));
#undef MODL
#undef PHASE
    }
    if (IN(PH_FINAL)) { KArgs a = kargs(); final_norm_phase(a, a->in[I_FNG], a->out); }
    }
#undef IN
#undef SEAM
}

extern "C" void kernel_launch(void* const* d_in, const int* in_sizes, int n_in, void* d_out, int out_size, void* d_ws, size_t ws_size, hipStream_t stream) {
    static int grid = 0;
    if (grid == 0) {
        if (n_in != 22 || out_size != ML * DM || ws_size < WS_END) { fprintf(stderr, "kernel_launch: unexpected shapes: n_in %d out %d ws %zu (need %zu)\n", n_in, out_size, ws_size, (size_t)WS_END); grid = -1; return; }
        int dev = 0, cus = 0, per_cu = 0;
        if (hipGetDevice(&dev) != hipSuccess || hipDeviceGetAttribute(&cus, hipDeviceAttributeMultiprocessorCount, dev) != hipSuccess) { grid = -1; return; }
        if (hipFuncSetAttribute((const void*)hybrid_fwd, hipFuncAttributeMaxDynamicSharedMemorySize, LDS_BYTES) != hipSuccess) { fprintf(stderr, "kernel_launch: hipFuncSetAttribute failed\n"); grid = -1; return; }
        if (hipOccupancyMaxActiveBlocksPerMultiprocessor(&per_cu, (const void*)hybrid_fwd, NTHR, LDS_BYTES) != hipSuccess || per_cu < 1)
            fprintf(stderr, "kernel_launch: occupancy query reports %d workgroups per CU\n", per_cu);
        (void)hipGetLastError();
        grid = cus;
    }
    if (grid < 0) return;
    if (hipMemsetAsync((char*)d_ws + WS_CTL, 0, CTL_ZERO_BYTES, stream) != hipSuccess) return;
    Args a{};
    for (int i = 0; i < 22; ++i) a.in[i] = (const float*)d_in[i];
    a.out = (float*)d_out; a.ws = (unsigned char*)d_ws;
#if MK_PER_PHASE
    for (int ph = 0; ph < N_PHASES; ++ph) { a.ph_lo = ph; a.ph_hi = ph + 1; hipLaunchKernelGGL(hybrid_fwd, dim3(grid), dim3(NTHR), LDS_BYTES, stream, a); }
#else
    a.ph_lo = 0; a.ph_hi = N_PHASES;
    hipLaunchKernelGGL(hybrid_fwd, dim3(grid), dim3(NTHR), LDS_BYTES, stream, a);
#endif
    const hipError_t le = hipPeekAtLastError();
    if (le != hipSuccess) fprintf(stderr, "kernel_launch: launch failed: %s\n", hipGetErrorName(le));
}
```
